# Optimizing an MI355X kernel written in HIP

```python
import math
import jax, jax.numpy as jnp
from jax import lax
import numpy as np

D_MODEL = 1024
BATCH = 2
SEQ = 8192
DEPTH = 2
DEC_BATCH = 32
DEC_SEQ = 4
PAST_LEN = 16384
PAGE_SIZE = 128

N_A_LAYERS = DEPTH // 2
N_B_LAYERS = DEPTH - N_A_LAYERS
SSM_GROUP = 16
SSM_GROUPS = D_MODEL // SSM_GROUP
SSM_STATE = 64
DT_MIN = 1e-3
DT_MAX = 1e-1
HEAD_DIM = 64
HEADS_PER_BRANCH = D_MODEL // HEAD_DIM
KV_HEADS_PER_BRANCH = 4
Q_PER_KV = HEADS_PER_BRANCH // KV_HEADS_PER_BRANCH
BRANCHES = ((128, 1), (512, 4), (2048, 16))
N_BRANCH = len(BRANCHES)
Q_WIDTH = N_BRANCH * HEADS_PER_BRANCH * HEAD_DIM
KV_WIDTH = N_BRANCH * 2 * KV_HEADS_PER_BRANCH * HEAD_DIM
ATTN_OUT = HEADS_PER_BRANCH * HEAD_DIM
D_FF = 4 * D_MODEL
ROPE_THETA = 10000.0
NORM_EPS = 1e-6
MAX_Q_BLOCK = 128

kernel_name = "yoco_s5_dilated_swa_decode_step"


def rmsnorm(x, g):
    xf = x.astype(jnp.float32)
    y = xf * lax.rsqrt(jnp.mean(xf * xf, axis=-1, keepdims=True) + NORM_EPS)
    return (y * g.astype(jnp.float32)).astype(x.dtype)


def rope(x, pos):
    half = HEAD_DIM // 2
    inv = ROPE_THETA ** (-jnp.arange(half, dtype=jnp.float32) / half)
    ang = pos[:, None] * inv[None, :]
    shp = (ang.shape[0],) + (1,) * (x.ndim - 3) + (half,)
    cos = jnp.cos(ang).reshape(shp)
    sin = jnp.sin(ang).reshape(shp)
    xf = x.astype(jnp.float32)
    x1, x2 = xf[..., :half], xf[..., half:]
    return jnp.concatenate([x1 * cos - x2 * sin, x2 * cos + x1 * sin], axis=-1).astype(x.dtype)


def s5_mixer(u, h0_re, h0_im, a_re, a_im, log_dt, b_re, b_im, c_re, c_im, d_skip, w_glu):
    f32 = jnp.float32
    n, t, _ = u.shape
    uf = u.astype(f32)
    ug = uf.reshape(n, t, SSM_GROUPS, SSM_GROUP)
    dt = jnp.exp(log_dt.astype(f32))[:, None]
    ar, ai = a_re.astype(f32), a_im.astype(f32)
    mag = jnp.exp(ar * dt)
    lr, li = mag * jnp.cos(ai * dt), mag * jnp.sin(ai * dt)
    den = ar * ar + ai * ai
    nr, ni = lr - 1.0, li
    zr = (nr * ar + ni * ai) / den
    zi = (ni * ar - nr * ai) / den
    br, bi = b_re.astype(f32), b_im.astype(f32)
    bbr = zr[..., None] * br - zi[..., None] * bi
    bbi = zr[..., None] * bi + zi[..., None] * br
    xr = jnp.einsum('ntgc,gpc->ntgp', ug, bbr)
    xi = jnp.einsum('ntgc,gpc->ntgp', ug, bbi)
    if h0_re is not None:
        h0r, h0i = h0_re.astype(f32), h0_im.astype(f32)
        xr = xr.at[:, 0].add(lr * h0r - li * h0i)
        xi = xi.at[:, 0].add(lr * h0i + li * h0r)
    a_r = jnp.broadcast_to(lr, xr.shape)
    a_i = jnp.broadcast_to(li, xr.shape)

    def combine(e1, e2):
        a1r, a1i, b1r, b1i = e1
        a2r, a2i, b2r, b2i = e2
        return (a2r * a1r - a2i * a1i, a2r * a1i + a2i * a1r,
                a2r * b1r - a2i * b1i + b2r, a2r * b1i + a2i * b1r + b2i)

    _, _, hr, hi = lax.associative_scan(combine, (a_r, a_i, xr, xi), axis=1)
    y = (jnp.einsum('ntgp,gcp->ntgc', hr, c_re.astype(f32))
         - jnp.einsum('ntgp,gcp->ntgc', hi, c_im.astype(f32)))
    y = y.reshape(n, t, D_MODEL) + d_skip.astype(f32) * uf
    y = jax.nn.gelu(y).astype(u.dtype)
    z = y @ w_glu
    out = z[..., :D_MODEL] * jax.nn.sigmoid(z[..., D_MODEL:])
    return out, hr[:, -1], hi[:, -1]


def sqrelu_mlp(x, w_up, w_down):
    return jnp.square(jax.nn.relu(x @ w_up)) @ w_down


def shared_kv(h, pos, kv_norm, w_kv):
    n, t, _ = h.shape
    kv = (rmsnorm(h, kv_norm) @ w_kv).reshape(n, t, N_BRANCH, 2, KV_HEADS_PER_BRANCH, HEAD_DIM)
    k = rope(kv[:, :, :, 0], pos)
    kvs = jnp.stack([k, kv[:, :, :, 1]], axis=3)
    return [kvs[:, :, g] for g in range(N_BRANCH)]


def dilated_prompt(q, kv, window, dil):
    b, s = q.shape[:2]
    m = window // dil
    L = s // dil
    bq = math.gcd(L, MAX_Q_BLOCK)
    nb = L // bq
    kw = bq + m
    qs = q.reshape(b, L, dil, KV_HEADS_PER_BRANCH, Q_PER_KV, HEAD_DIM).transpose(0, 2, 1, 3, 4, 5)
    qs = qs.reshape(b, dil, nb, bq, KV_HEADS_PER_BRANCH, Q_PER_KV, HEAD_DIM)
    kvs = kv.reshape(b, L, dil, 2, KV_HEADS_PER_BRANCH, HEAD_DIM).transpose(0, 2, 1, 3, 4, 5)
    kvs = jnp.pad(kvs, ((0, 0), (0, 0), (m, 0), (0, 0), (0, 0), (0, 0)))
    kidx = (jnp.arange(nb) * bq)[:, None] + jnp.arange(kw)[None, :]
    kb = kvs[:, :, kidx]
    qpos = (jnp.arange(nb) * bq)[:, None] + jnp.arange(bq)[None, :]
    kpos = kidx - m
    dist = qpos[:, :, None] - kpos[:, None, :]
    mask = (dist >= 0) & (dist <= m) & (kpos[:, None, :] >= 0)
    sc = jnp.einsum('bwnqgre,bwnjge->bwngrqj', qs, kb[:, :, :, :, 0],
                    preferred_element_type=jnp.float32) * (HEAD_DIM ** -0.5)
    sc = jnp.where(mask[None, None, :, None, None], sc, -jnp.inf)
    lse = jax.nn.logsumexp(sc, axis=-1)
    p = jnp.exp(sc - lse[..., None])
    o = jnp.einsum('bwngrqj,bwnjge->bwnqgre', p.astype(kv.dtype), kb[:, :, :, :, 1],
                   preferred_element_type=jnp.float32)
    o = o.reshape(b, dil, L, KV_HEADS_PER_BRANCH, Q_PER_KV, HEAD_DIM).transpose(0, 2, 1, 3, 4, 5)
    o = o.reshape(b, s, HEADS_PER_BRANCH, HEAD_DIM)
    lse = lse.transpose(0, 1, 2, 5, 3, 4).reshape(b, dil, L, KV_HEADS_PER_BRANCH, Q_PER_KV)
    lse = lse.transpose(0, 2, 1, 3, 4).reshape(b, s, HEADS_PER_BRANCH)
    return o, lse


def dilated_sample(q, kv_new, kv_past, window, dil):
    n, t = q.shape[:2]
    wp = kv_past.shape[1]
    m = window // dil
    kv_all = jnp.concatenate([kv_past.astype(kv_new.dtype), kv_new], axis=1)
    idx = wp + jnp.arange(t)[:, None] - dil * jnp.arange(m + 1)[None, :]
    valid = idx >= 0
    kg = kv_all[:, jnp.clip(idx, 0, None)]
    qh = q.reshape(n, t, KV_HEADS_PER_BRANCH, Q_PER_KV, HEAD_DIM)
    sc = jnp.einsum('ntgre,ntjge->ntgrj', qh, kg[:, :, :, 0],
                    preferred_element_type=jnp.float32) * (HEAD_DIM ** -0.5)
    sc = jnp.where(valid[None, :, None, None, :], sc, -jnp.inf)
    lse = jax.nn.logsumexp(sc, axis=-1)
    p = jnp.exp(sc - lse[..., None])
    o = jnp.einsum('ntgrj,ntjge->ntgre', p.astype(kv_new.dtype), kg[:, :, :, 1],
                   preferred_element_type=jnp.float32)
    return o.reshape(n, t, HEADS_PER_BRANCH, HEAD_DIM), lse.reshape(n, t, HEADS_PER_BRANCH)


def dilated_mixer(h, pos, kv_branches, kv_past, w_q, w_o):
    n, t, _ = h.shape
    q = rope((h @ w_q).reshape(n, t, N_BRANCH, HEADS_PER_BRANCH, HEAD_DIM), pos)
    outs, lses = [], []
    for g, (win, dil) in enumerate(BRANCHES):
        if kv_past is None:
            o, l = dilated_prompt(q[:, :, g], kv_branches[g], win, dil)
        else:
            o, l = dilated_sample(q[:, :, g], kv_branches[g], kv_past[g], win, dil)
        outs.append(o)
        lses.append(l)
    wts = jax.nn.softmax(jnp.stack(lses, axis=0), axis=0)
    o = jnp.einsum('gnth,gnthe->nthe', wts, jnp.stack(outs, axis=0))
    return o.reshape(n, t, ATTN_OUT).astype(h.dtype) @ w_o


def run_trunk(x, pos, h0_re, h0_im, kv_past, norm_mix, norm_ffn, ssm_a_re, ssm_a_im, ssm_log_dt,
              ssm_b_re, ssm_b_im, ssm_c_re, ssm_c_im, ssm_d, w_glu, kv_norm, w_kv, w_q, w_o,
              w_up, w_down, final_norm):
    h = x
    fin_re, fin_im = [], []
    kv = None
    for i in range(DEPTH):
        hn = rmsnorm(h, norm_mix[i])
        if i < N_A_LAYERS:
            a = i
            mix, hr, hi = s5_mixer(hn, None if h0_re is None else h0_re[a],
                                   None if h0_im is None else h0_im[a],
                                   ssm_a_re[a], ssm_a_im[a], ssm_log_dt[a], ssm_b_re[a], ssm_b_im[a],
                                   ssm_c_re[a], ssm_c_im[a], ssm_d[a], w_glu[a])
            fin_re.append(hr)
            fin_im.append(hi)
        else:
            if kv is None:
                kv = shared_kv(h, pos, kv_norm, w_kv)
            j = i - N_A_LAYERS
            mix = dilated_mixer(hn, pos, kv, kv_past, w_q[j], w_o[j])
        h = h + mix
        h = h + sqrelu_mlp(rmsnorm(h, norm_ffn[i]), w_up[i], w_down[i])
    return rmsnorm(h, final_norm), kv, jnp.stack(fin_re, axis=0), jnp.stack(fin_im, axis=0)


def setup_inputs(seed: int = 0) -> dict:
    key = jax.random.key(seed)
    ks = iter(jax.random.split(key, 40))
    f32 = jnp.float32

    def nrm(shape, scale):
        return jax.random.normal(next(ks), shape, f32) * scale

    kvb = lambda w: (DEC_BATCH, min(w, PAST_LEN), 2, KV_HEADS_PER_BRANCH, HEAD_DIM)
    sshape = (N_A_LAYERS, DEC_BATCH, SSM_GROUPS, SSM_STATE)
    return {
        "x_prompt": nrm((BATCH, SEQ, D_MODEL), 1.0),
        "x_sample": nrm((DEC_BATCH, DEC_SEQ, D_MODEL), 1.0),
        "cache_kv_w128": nrm(kvb(BRANCHES[0][0]), 1.0),
        "cache_kv_w512": nrm(kvb(BRANCHES[1][0]), 1.0),
        "cache_kv_w2048": nrm(kvb(BRANCHES[2][0]), 1.0),
        "state_ssm_re": nrm(sshape, 0.1),
        "state_ssm_im": nrm(sshape, 0.1),
        "norm_mix": 1.0 + nrm((DEPTH, D_MODEL), 0.01),
        "norm_ffn": 1.0 + nrm((DEPTH, D_MODEL), 0.01),
        "ssm_a_re": -0.5 + nrm((N_A_LAYERS, SSM_GROUPS, SSM_STATE), 0.01),
        "ssm_a_im": math.pi * jnp.arange(SSM_STATE, dtype=f32) + nrm((N_A_LAYERS, SSM_GROUPS, SSM_STATE), 0.01),
        "ssm_log_dt": jax.random.uniform(next(ks), (N_A_LAYERS, SSM_GROUPS), f32,
                                         math.log(DT_MIN), math.log(DT_MAX)),
        "ssm_b_re": nrm((N_A_LAYERS, SSM_GROUPS, SSM_STATE, SSM_GROUP), (2 * SSM_GROUP) ** -0.5),
        "ssm_b_im": nrm((N_A_LAYERS, SSM_GROUPS, SSM_STATE, SSM_GROUP), (2 * SSM_GROUP) ** -0.5),
        "ssm_c_re": nrm((N_A_LAYERS, SSM_GROUPS, SSM_GROUP, SSM_STATE), SSM_STATE ** -0.5),
        "ssm_c_im": nrm((N_A_LAYERS, SSM_GROUPS, SSM_GROUP, SSM_STATE), SSM_STATE ** -0.5),
        "ssm_d": nrm((N_A_LAYERS, D_MODEL), 1.0),
        "w_glu": nrm((N_A_LAYERS, D_MODEL, 2 * D_MODEL), D_MODEL ** -0.5),
        "kv_norm": 1.0 + nrm((D_MODEL,), 0.01),
        "w_kv": nrm((D_MODEL, KV_WIDTH), D_MODEL ** -0.5),
        "w_q": nrm((N_B_LAYERS, D_MODEL, Q_WIDTH), D_MODEL ** -0.5),
        "w_o": nrm((N_B_LAYERS, ATTN_OUT, D_MODEL), ATTN_OUT ** -0.5),
        "w_up": nrm((DEPTH, D_MODEL, D_FF), D_MODEL ** -0.5),
        "w_down": nrm((DEPTH, D_FF, D_MODEL), D_FF ** -0.5),
        "final_norm": 1.0 + nrm((D_MODEL,), 0.01),
    }


def reference(x_prompt, x_sample, cache_kv_w128, cache_kv_w512, cache_kv_w2048, state_ssm_re, state_ssm_im,
              norm_mix, norm_ffn, ssm_a_re, ssm_a_im, ssm_log_dt, ssm_b_re, ssm_b_im, ssm_c_re, ssm_c_im,
              ssm_d, w_glu, kv_norm, w_kv, w_q, w_o, w_up, w_down, final_norm):
    seq = x_prompt.shape[1]
    dec_seq = x_sample.shape[1]
    pos_p = jnp.arange(seq, dtype=jnp.float32)
    pos_s = PAST_LEN + jnp.arange(dec_seq, dtype=jnp.float32)
    y_prompt, kv_p, re_p, im_p = run_trunk(
        x_prompt, pos_p, None, None, None, norm_mix, norm_ffn, ssm_a_re, ssm_a_im, ssm_log_dt,
        ssm_b_re, ssm_b_im, ssm_c_re, ssm_c_im, ssm_d, w_glu, kv_norm, w_kv, w_q, w_o, w_up, w_down, final_norm)
    y_sample, kv_s, re_s, im_s = run_trunk(
        x_sample, pos_s, state_ssm_re, state_ssm_im, (cache_kv_w128, cache_kv_w512, cache_kv_w2048),
        norm_mix, norm_ffn, ssm_a_re, ssm_a_im, ssm_log_dt, ssm_b_re, ssm_b_im, ssm_c_re, ssm_c_im,
        ssm_d, w_glu, kv_norm, w_kv, w_q, w_o, w_up, w_down, final_norm)
    w0 = min(BRANCHES[0][0], seq)
    w1 = min(BRANCHES[1][0], seq)
    w2 = min(BRANCHES[2][0], seq)
    return (y_prompt, y_sample,
            kv_p[0][:, seq - w0:], kv_p[1][:, seq - w1:], kv_p[2][:, seq - w2:],
            kv_s[0], kv_s[1], kv_s[2],
            re_p, im_p, re_s, im_s)
```

```cpp
#include <hip/hip_runtime.h>
#include <hip/hip_cooperative_groups.h>
#include <cstdio>
#include <cstdint>
#include <cmath>
namespace cg = cooperative_groups;
namespace pg8 {
#define PG8_LAS __attribute__((address_space(3)))
typedef unsigned short bf16_t;
typedef short bf16x8 __attribute__((ext_vector_type(8)));
typedef float f32x4 __attribute__((ext_vector_type(4)));
typedef unsigned u32x4 __attribute__((ext_vector_type(4)));
constexpr int BM = 256, BK = 64, HALF = 128, HTB = HALF * BK * 2  , STAGE_BYTES = 8 * HTB, NXCD = 8, WGM = 8;

__host__ __device__ __forceinline__ int lds_byte(int r, int c) { const int st = (r >> 4) * 2 + (c >> 5), rr = r & 15, cc = c & 31, ob = rr * 64 + cc * 2; return st * 1024 + (ob ^ (((ob >> 9) & 1) << 5)); }
__host__ __device__ __forceinline__ void stage_rc(int b, int& R, int& C) { const int st = b / 1024, sb = b % 1024, swz = sb ^ (((sb >> 9) & 1) << 5); R = (st >> 1) * 16 + swz / 64; C = (st & 1) * 32 + (swz % 64) / 2; }
__host__ __device__ __forceinline__ int perm32(int rho) { const int n = rho >> 4, i = rho & 15; return 8 * (i >> 2) + 4 * n + (i & 3); }

struct Unit { int pm, pn; };
struct Gemm { const bf16_t* A; const bf16_t* Bt; int M, N, K; };

struct StaticOrder {
    int nM, nN, nwg, G, c;
    __host__ __device__ void init(int M, int N, int G_, int c_) { nM = M / BM; nN = N / BM; nwg = nM * nN; G = G_; c = c_; }
    __host__ __device__ bool next(int i, Unit& u) const {
        const long L = (long)i * G + c; if (L >= nwg) return false;
        int wgid = (int)L; { const int q = nwg / NXCD, r = nwg % NXCD, xcd = wgid % NXCD, off = wgid / NXCD; wgid = (xcd < r ? xcd * (q + 1) : r * (q + 1) + (xcd - r) * q) + off; }
        const int nig = WGM * nN, gid = wgid / nig, fm = gid * WGM, gsz = (nM - fm) < WGM ? (nM - fm) : WGM;
        u.pm = fm + ((wgid % nig) % gsz); u.pn = (wgid % nig) / gsz; return true;
    }
    __device__ __forceinline__ void a_ready(const Unit&) const {}
    __device__ __forceinline__ void done(const Unit&) const {}
};

__device__ __forceinline__ unsigned cvt_pk_bf16(float lo, float hi) { unsigned r; asm volatile("v_cvt_pk_bf16_f32 %0, %1, %2" : "=v"(r) : "v"(lo), "v"(hi)); return r; }
typedef float f32x2 __attribute__((ext_vector_type(2)));
__device__ __forceinline__ f32x2 gelu_pk(f32x2 v) {
    const f32x2 av = __builtin_elementwise_abs(v), d = av * 0.2316418882f + 1.0f;
    f32x2 t; t.x = __builtin_amdgcn_rcpf(d.x); t.y = __builtin_amdgcn_rcpf(d.y);
    f32x2 q = t * 0.5307027145f + (-0.7265760135f); q = q * t + 0.7107068705f; q = q * t + (-0.142248368f); q = q * t + 0.127414796f; q = q * t;
    const f32x2 s = (v * v) * (-0.72134752044f);
    f32x2 e; e.x = __builtin_amdgcn_exp2f(s.x); e.y = __builtin_amdgcn_exp2f(s.y);
    const f32x2 m = v * (q * e), r = v - m;
    f32x2 o; o.x = v.x < 0.f ? m.x : r.x; o.y = v.y < 0.f ? m.y : r.y; return o;
}


template <class Epi, class Sched, bool ALIGN_EPI = false, bool SP2 = false>
__device__ __forceinline__ void gemm_phase(PG8_LAS unsigned char* lds, const Gemm g, const Sched& S, const Epi& E) {
    const int tid = threadIdx.x, wid = __builtin_amdgcn_readfirstlane(tid >> 6), lane = tid & 63, wr = wid >> 2, wc = wid & 3, fr = lane & 15, fq = lane >> 4;
    const int K = g.K, nt = K / BK;
    unsigned voffA[2], voffB[2];
#pragma unroll
    for (int i = 0; i < 2; ++i) { int R, C; stage_rc(tid * 16 + i * 8192, R, C); const int Rb = Epi::PERM ? ((R & ~31) + perm32(R & 31)) : R;
        voffA[i] = (unsigned)(R * K + C) * 2u; voffB[i] = (unsigned)(Rb * K + C) * 2u; }
    const size_t kstep = (size_t)(BK * 2);
    const size_t hstep = (size_t)HALF * K * 2;
    const size_t tstep = 2 * hstep;
    const unsigned ldsw = (unsigned)wid * 1024u;
    const int aoff = lds_byte(wr * 64 + fr, fq * 8), boff = lds_byte(wc * 32 + fr, fq * 8);
#define PG8_SA(b, h) (((b) * 2 + (h)) * HTB)
#define PG8_SB(b, h) ((4 + (b) * 2 + (h)) * HTB)
#define PG8_STAGE(bufoff, gbase, voff) do { _Pragma("unroll") for (int _i = 0; _i < 2; ++_i) \
        __builtin_amdgcn_global_load_lds((const unsigned*)((const char*)(gbase) + (voff)[_i]), (PG8_LAS unsigned*)(lds + (bufoff) + ldsw + _i * 8192), 16, 0, 0); } while (0)
#define PG8_LDA(dst, b, h) do { _Pragma("unroll") for (int m = 0; m < 4; ++m) _Pragma("unroll") for (int k = 0; k < 2; ++k) dst[m][k] = *(const PG8_LAS bf16x8*)(lds + PG8_SA(b, h) + aoff + m * 2048 + k * 1024); } while (0)
#define PG8_LDB(dst, b, h) do { _Pragma("unroll") for (int n = 0; n < 2; ++n) _Pragma("unroll") for (int k = 0; k < 2; ++k) dst[n][k] = *(const PG8_LAS bf16x8*)(lds + PG8_SB(b, h) + boff + n * 2048 + k * 1024); } while (0)
#define PG8_MMA(ai, bj, At, Bt) do { __builtin_amdgcn_s_setprio(1); _Pragma("unroll") for (int m = 0; m < 4; ++m) _Pragma("unroll") for (int n = 0; n < 2; ++n) _Pragma("unroll") for (int k = 0; k < 2; ++k) \
        acc[ai][bj][m][n] = __builtin_amdgcn_mfma_f32_16x16x32_bf16(Bt[n][k], At[m][k], acc[ai][bj][m][n], 0, 0, 0); __builtin_amdgcn_s_setprio(0); } while (0)
#define PG8_WAIT_V(n) asm volatile("s_waitcnt vmcnt(" #n ")" ::: "memory")
#define PG8_WAIT_L(n) asm volatile("s_waitcnt lgkmcnt(" #n ")" ::: "memory")
#define PG8_BAR __builtin_amdgcn_s_barrier()
#define PG8_SCHED __builtin_amdgcn_sched_barrier(0)
    Unit cur, nxt; int ui = 0;
    if (!S.next(0, cur)) return;
    f32x4 acc[2][2][4][2];
#pragma unroll
    for (int a = 0; a < 2; ++a)
#pragma unroll
        for (int b = 0; b < 2; ++b)
#pragma unroll
            for (int m = 0; m < 4; ++m)
#pragma unroll
                for (int n = 0; n < 2; ++n) acc[a][b][m][n] = (f32x4){0.f, 0.f, 0.f, 0.f};
    bf16x8 At[4][2], B0[2][2], B1[2][2];
    const char* cA = (const char*)g.A + (size_t)cur.pm * tstep; const char* cB = (const char*)g.Bt + (size_t)cur.pn * tstep;
    S.a_ready(cur);
    if constexpr (SP2) {
        PG8_STAGE(PG8_SB(0, 0), cB, voffB); PG8_STAGE(PG8_SB(0, 1), cB + hstep, voffB); PG8_STAGE(PG8_SA(0, 0), cA, voffA); PG8_STAGE(PG8_SA(0, 1), cA + hstep, voffA);
        if (wr == 1) PG8_BAR;
        PG8_WAIT_V(2); PG8_BAR;
        PG8_STAGE(PG8_SB(1, 0), cB + kstep, voffB); PG8_STAGE(PG8_SA(1, 0), cA + kstep, voffA); PG8_STAGE(PG8_SB(1, 1), cB + hstep + kstep, voffB);
        PG8_WAIT_V(6); PG8_BAR;
    } else {
        PG8_STAGE(PG8_SB(0, 0), cB, voffB); PG8_STAGE(PG8_SA(0, 0), cA, voffA); PG8_STAGE(PG8_SB(0, 1), cB + hstep, voffB); PG8_STAGE(PG8_SA(0, 1), cA + hstep, voffA);
        if (wr == 1) PG8_BAR;
        PG8_WAIT_V(4); PG8_BAR;
        PG8_STAGE(PG8_SB(1, 0), cB + kstep, voffB); PG8_STAGE(PG8_SA(1, 0), cA + kstep, voffA); PG8_STAGE(PG8_SB(1, 1), cB + hstep + kstep, voffB);
        PG8_WAIT_V(6); PG8_BAR;
    }
    for (;;) {
        const bool has_next = S.next(ui + 1, nxt);
        const char* nA = has_next ? (const char*)g.A + (size_t)nxt.pm * tstep : cA; const char* nB = has_next ? (const char*)g.Bt + (size_t)nxt.pn * tstep : cB;
        for (int t = 0; t < nt; t += 2) {
            const bool last = (t == nt - 2);
            const char* a1 = cA + (size_t)(t + 1) * kstep;
            const char* a2 = last ? nA : cA + (size_t)(t + 2) * kstep; const char* b2 = last ? nB : cB + (size_t)(t + 2) * kstep;
            const char* a3 = a2 + kstep; const char* b3 = b2 + kstep;
            if (last && has_next) S.a_ready(nxt);
            if constexpr (SP2) {
            PG8_LDB(B0, 0, 0); PG8_LDB(B1, 0, 1); PG8_SCHED; PG8_LDA(At, 0, 0); PG8_STAGE(PG8_SA(1, 1), a1 + hstep, voffA);
            PG8_WAIT_V(8); PG8_WAIT_L(0); PG8_BAR; PG8_MMA(0, 0, At, B0); PG8_MMA(0, 1, At, B1); PG8_BAR; PG8_SCHED;
            PG8_LDA(At, 0, 1); PG8_STAGE(PG8_SB(0, 0), b2, voffB); PG8_STAGE(PG8_SB(0, 1), b2 + hstep, voffB); PG8_STAGE(PG8_SA(0, 0), a2, voffA);
            PG8_WAIT_V(8); PG8_WAIT_L(0); PG8_BAR; PG8_MMA(1, 0, At, B0); PG8_MMA(1, 1, At, B1); PG8_BAR; PG8_SCHED;
            PG8_LDB(B0, 1, 0); PG8_LDB(B1, 1, 1); PG8_SCHED; PG8_LDA(At, 1, 0); PG8_STAGE(PG8_SA(0, 1), a2 + hstep, voffA);
            PG8_WAIT_V(8); PG8_WAIT_L(0); PG8_BAR; PG8_MMA(0, 0, At, B0); PG8_MMA(0, 1, At, B1); PG8_BAR; PG8_SCHED;
            PG8_LDA(At, 1, 1); PG8_STAGE(PG8_SB(1, 0), b3, voffB); PG8_STAGE(PG8_SB(1, 1), b3 + hstep, voffB); PG8_STAGE(PG8_SA(1, 0), a3, voffA);
            PG8_WAIT_V(8); PG8_WAIT_L(0); PG8_BAR; PG8_MMA(1, 0, At, B0); PG8_MMA(1, 1, At, B1); PG8_BAR; PG8_SCHED;
            } else {
            PG8_LDB(B0, 0, 0); PG8_SCHED; PG8_LDA(At, 0, 0); PG8_STAGE(PG8_SA(1, 1), a1 + hstep, voffA);
            PG8_WAIT_L(8); PG8_BAR; PG8_WAIT_L(0); PG8_MMA(0, 0, At, B0); PG8_BAR; PG8_SCHED;
            PG8_LDB(B1, 0, 1); PG8_STAGE(PG8_SB(0, 0), b2, voffB);
            PG8_BAR; PG8_WAIT_L(0); PG8_MMA(0, 1, At, B1); PG8_BAR;
            PG8_LDA(At, 0, 1); PG8_STAGE(PG8_SA(0, 0), a2, voffA);
            PG8_BAR; PG8_WAIT_L(0); PG8_MMA(1, 0, At, B0); PG8_BAR; PG8_SCHED;
            PG8_STAGE(PG8_SB(0, 1), b2 + hstep, voffB);
            PG8_WAIT_V(6); PG8_BAR; PG8_MMA(1, 1, At, B1); PG8_BAR;
            PG8_LDB(B0, 1, 0); PG8_SCHED; PG8_LDA(At, 1, 0); PG8_STAGE(PG8_SA(0, 1), a2 + hstep, voffA);
            PG8_WAIT_L(8); PG8_BAR; PG8_WAIT_L(0); PG8_MMA(0, 0, At, B0); PG8_BAR; PG8_SCHED;
            PG8_LDB(B1, 1, 1); PG8_STAGE(PG8_SB(1, 0), b3, voffB);
            PG8_BAR; PG8_WAIT_L(0); PG8_MMA(0, 1, At, B1); PG8_BAR;
            PG8_LDA(At, 1, 1); PG8_STAGE(PG8_SA(1, 0), a3, voffA);
            PG8_BAR; PG8_WAIT_L(0); PG8_MMA(1, 0, At, B0); PG8_BAR; PG8_SCHED;
            PG8_STAGE(PG8_SB(1, 1), b3 + hstep, voffB);
            PG8_WAIT_V(6); PG8_BAR; PG8_MMA(1, 1, At, B1); PG8_BAR;
            }
        }
        if constexpr (ALIGN_EPI) { if (wr == 0) PG8_BAR; }
        if constexpr (!Epi::AFTER_DRAIN) { E(acc, cur, wr, wc, fr, fq); S.done(cur); }
        if (!has_next) break;
#pragma unroll
        for (int a = 0; a < 2; ++a)
#pragma unroll
            for (int b = 0; b < 2; ++b)
#pragma unroll
                for (int m = 0; m < 4; ++m)
#pragma unroll
                    for (int n = 0; n < 2; ++n) acc[a][b][m][n] = (f32x4){0.f, 0.f, 0.f, 0.f};
        cur = nxt; cA = nA; cB = nB; ++ui;
        if constexpr (ALIGN_EPI) { if (wr == 1) PG8_BAR; }
    }
    PG8_WAIT_V(0);
    if constexpr (!ALIGN_EPI) { if (wr == 0) PG8_BAR; }
    PG8_BAR;
    if constexpr (Epi::AFTER_DRAIN) { E.fused(acc, cur, wr, wc, fr, fq, lds, wid, lane); S.done(cur); }
#undef PG8_SA
#undef PG8_SB
#undef PG8_STAGE
#undef PG8_LDA
#undef PG8_LDB
#undef PG8_MMA
#undef PG8_WAIT_V
#undef PG8_WAIT_L
#undef PG8_BAR
#undef PG8_SCHED
}
}

#define LAS __attribute__((address_space(3)))
typedef unsigned short bf16;
typedef short bf16x8 __attribute__((ext_vector_type(8)));
typedef float f32x4 __attribute__((ext_vector_type(4)));
typedef float f32x16 __attribute__((ext_vector_type(16)));
typedef unsigned u32x4 __attribute__((ext_vector_type(4)));
typedef unsigned u32x2 __attribute__((ext_vector_type(2)));
typedef float f32x2_t __attribute__((ext_vector_type(2)));
typedef __bf16 bf16x2_t __attribute__((ext_vector_type(2)));

constexpr int NWAVES = 8, NTHREADS = 512;
constexpr int D = 1024, SEQ = 8192, NPROMPT = 16384, NSAMP = 128, MREAL = NPROMPT + NSAMP, MP = 16640;
constexpr int FF = 4096, QW = 3072, KVW = 1536, NQKV = QW + KVW;
constexpr float EPS = 1e-6f;
constexpr float QSCALE = 0.125f * 1.4426950408889634f;
constexpr int LDS_BYTES = 147456;

constexpr size_t MiB = 1u << 20;
constexpr size_t WS_ROWSS = 0;
constexpr size_t WS_BAR = 384 * 1024;
constexpr size_t WS_LAM = 512 * 1024;
constexpr size_t WS_BBAR = 576 * 1024;
constexpr size_t WS_CC = 1 * MiB;
constexpr size_t WS_ROPE = 1536 * 1024;
constexpr size_t WS_E = 3840 * 1024;
constexpr size_t WS_W = 8 * MiB;
constexpr size_t W_GLU = WS_W, W_UP0 = W_GLU + 2048ull * 1024 * 2, W_DN0 = W_UP0 + 4096ull * 1024 * 2, W_QKV = W_DN0 + 4096ull * 1024 * 2,
                 W_O = W_QKV + (size_t)NQKV * 1024 * 2, W_UP1 = W_O + 1024ull * 1024 * 2, W_DN1 = W_UP1 + 4096ull * 1024 * 2, W_END = W_DN1 + 4096ull * 1024 * 2;
static_assert(W_END <= 56 * MiB, "weights");
constexpr size_t WS_H = 56 * MiB;
constexpr size_t WS_HB = 121 * MiB;
constexpr size_t WS_HN0 = 154 * MiB;
constexpr size_t WS_VT = WS_HN0;
constexpr size_t WS_Y = 187 * MiB;
constexpr size_t WS_ATT = WS_Y;
constexpr size_t WS_ACT = 220 * MiB;
constexpr size_t WS_Q = WS_ACT;
constexpr size_t WS_KB = WS_Q + (size_t)MP * QW * 2;
static_assert(WS_KB + 3ull * MP * 256 * 2 <= 350 * MiB, "q/k overlay");
constexpr size_t WS_OG = 350 * MiB;
constexpr size_t WS_LSE = 448 * MiB;
constexpr size_t WS_END = 452 * MiB;

constexpr size_t O_YP = 0, O_YS = 16777216, O_KVP0 = 16908288, O_KVP1 = 17039360, O_KVP2 = 17563648,
                 O_KVS0 = 19660800, O_KVS1 = 19726336, O_KVS2 = 19791872, O_SREP = 19857408, O_SIMP = 19865600, O_SRES = 19873792, O_SIMS = 20004864;

__device__ __forceinline__ unsigned pk2(float lo, float hi) { f32x2_t v = {lo, hi}; bf16x2_t b = __builtin_convertvector(v, bf16x2_t); return __builtin_bit_cast(unsigned, b); }
__device__ __forceinline__ float bf2f(unsigned short u) { return __uint_as_float(((unsigned)u) << 16); }
__device__ __forceinline__ float wave_sum(float v) {
#pragma unroll
    for (int o = 1; o < 64; o <<= 1) v += __shfl_xor(v, o);
    return v;
}
__device__ __forceinline__ float wave_max(float v) {
#pragma unroll
    for (int o = 1; o < 64; o <<= 1) v = fmaxf(v, __shfl_xor(v, o));
    return v;
}

struct Args { const float* in[25]; float* out; unsigned char* ws; int ph_lo, ph_hi; };

struct EpiGlu {
    static constexpr bool PERM = true, AFTER_DRAIN = false;
    const float* xp; const float* xs; float* H; bf16* HB; float* rowss;
    __device__ __forceinline__ void operator()(const pg8::f32x4 (&acc)[2][2][4][2], const pg8::Unit& u, int wr, int wc, int fr, int fq) const { run<2>(acc, u, wr, wc, fr, fq); }
    template <int NAI> __device__ __forceinline__ void run(const pg8::f32x4 (&acc)[NAI][2][4][2], const pg8::Unit& u, int wr, int wc, int fr, int fq) const {
        const int col = u.pn * 128 + wc * 32 + 8 * fq;
#pragma unroll
        for (int ai = 0; ai < NAI; ++ai)
#pragma unroll
            for (int m = 0; m < 4; ++m) {
                const int row = u.pm * 256 + ai * 128 + wr * 64 + m * 16 + fr;
                if (row < MREAL) {
                    const float* xr = (row < NPROMPT ? xp + (size_t)row * D : xs + (size_t)(row - NPROMPT) * D) + col;
                    const f32x4 x0 = *(const f32x4*)xr, x1 = *(const f32x4*)(xr + 4);
                    f32x4 h0, h1;
#pragma unroll
                    for (int i = 0; i < 4; ++i) {
                        h0[i] = x0[i] + acc[ai][0][m][0][i] / (1.f + __expf(-acc[ai][1][m][0][i]));
                        h1[i] = x1[i] + acc[ai][0][m][1][i] / (1.f + __expf(-acc[ai][1][m][1][i]));
                    }
                    u32x4 w; w.x = pk2(h0[0], h0[1]); w.y = pk2(h0[2], h0[3]); w.z = pk2(h1[0], h1[1]); w.w = pk2(h1[2], h1[3]);
                    *(u32x4*)(HB + (size_t)row * D + col) = w;
                    float ss = (h0[0] * h0[0] + h0[1] * h0[1]) + (h0[2] * h0[2] + h0[3] * h0[3]) + (h1[0] * h1[0] + h1[1] * h1[1]) + (h1[2] * h1[2] + h1[3] * h1[3]);
                    ss += __shfl_xor(ss, 16); ss += __shfl_xor(ss, 32);
                    if (fq == 0) __hip_atomic_fetch_add(rowss + row, ss, __ATOMIC_RELAXED, __HIP_MEMORY_SCOPE_AGENT);
                } else { float ss = 0.f; ss += __shfl_xor(ss, 16); ss += __shfl_xor(ss, 32); (void)ss; }
            }
    }
};
struct EpiNull {
    static constexpr bool PERM = true, AFTER_DRAIN = false; float* sink;
    __device__ __forceinline__ void operator()(const pg8::f32x4 (&acc)[2][2][4][2], const pg8::Unit& u, int wr, int wc, int fr, int fq) const { run<2>(acc, u, wr, wc, fr, fq); }
    template <int NAI> __device__ __forceinline__ void run(const pg8::f32x4 (&acc)[NAI][2][4][2], const pg8::Unit& u, int wr, int wc, int fr, int fq) const {
        float t = 0.f;
#pragma unroll
        for (int b = 0; b < 2; ++b)
#pragma unroll
            for (int m = 0; m < 4; ++m)
#pragma unroll
                for (int n = 0; n < 2; ++n) t += acc[0][b][m][n][0] + acc[0][b][m][n][3];
        if (t == 1234.5678f) sink[0] = t;
    }
};
struct EpiUp {
    static constexpr bool PERM = true, AFTER_DRAIN = false;
    bf16* O; const float* rowss;
    __device__ __forceinline__ void operator()(const pg8::f32x4 (&acc)[2][2][4][2], const pg8::Unit& u, int wr, int wc, int fr, int fq) const { run<2>(acc, u, wr, wc, fr, fq); }
    template <int NAI> __device__ __forceinline__ void run(const pg8::f32x4 (&acc)[NAI][2][4][2], const pg8::Unit& u, int wr, int wc, int fr, int fq) const {
        const int col = u.pn * 256 + wc * 32 + 8 * fq;
#pragma unroll
        for (int ai = 0; ai < NAI; ++ai)
#pragma unroll
            for (int m = 0; m < 4; ++m) {
                const int row = u.pm * 256 + ai * 128 + wr * 64 + m * 16 + fr;
                if (row < MREAL) {
                    const float rstd = rsqrtf(rowss[row] * (1.f / D) + EPS);
#pragma unroll
                    for (int bj = 0; bj < 2; ++bj) {
                        float v[8];
#pragma unroll
                        for (int i = 0; i < 4; ++i) { float a = fmaxf(acc[ai][bj][m][0][i] * rstd, 0.f), b = fmaxf(acc[ai][bj][m][1][i] * rstd, 0.f); v[i] = a * a; v[4 + i] = b * b; }
                        u32x4 w; w.x = pk2(v[0], v[1]); w.y = pk2(v[2], v[3]); w.z = pk2(v[4], v[5]); w.w = pk2(v[6], v[7]);
                        *(u32x4*)(O + (size_t)row * FF + col + bj * 128) = w;
                    }
                }
            }
    }
};
struct EpiRes {
    static constexpr bool PERM = true, AFTER_DRAIN = false;
    bf16* HB; float* OUT; float* rowss;
    __device__ __forceinline__ void operator()(const pg8::f32x4 (&acc)[2][2][4][2], const pg8::Unit& u, int wr, int wc, int fr, int fq) const { run<2>(acc, u, wr, wc, fr, fq); }
    template <int NAI> __device__ __forceinline__ void run(const pg8::f32x4 (&acc)[NAI][2][4][2], const pg8::Unit& u, int wr, int wc, int fr, int fq) const {
        const int col = u.pn * 256 + wc * 32 + 8 * fq;
#pragma unroll
        for (int ai = 0; ai < NAI; ++ai)
#pragma unroll
            for (int m = 0; m < 4; ++m) {
                const int row = u.pm * 256 + ai * 128 + wr * 64 + m * 16 + fr;
                float ss = 0.f;
                if (row < MREAL) {
#pragma unroll
                    for (int bj = 0; bj < 2; ++bj) {
                        bf16* hp = HB + (size_t)row * D + col + bj * 128;
                        const bf16x8 hv = *(const bf16x8*)hp;
                        f32x4 h0, h1;
#pragma unroll
                        for (int i = 0; i < 4; ++i) { h0[i] = bf2f((unsigned short)hv[i]) + acc[ai][bj][m][0][i]; h1[i] = bf2f((unsigned short)hv[4 + i]) + acc[ai][bj][m][1][i]; }
                        if (OUT) { float* op = OUT + (size_t)row * D + col + bj * 128; *(f32x4*)op = h0; *(f32x4*)(op + 4) = h1; }
                        else { u32x4 w; w.x = pk2(h0[0], h0[1]); w.y = pk2(h0[2], h0[3]); w.z = pk2(h1[0], h1[1]); w.w = pk2(h1[2], h1[3]); *(u32x4*)hp = w; }
                        ss += (h0[0] * h0[0] + h0[1] * h0[1]) + (h0[2] * h0[2] + h0[3] * h0[3]) + (h1[0] * h1[0] + h1[1] * h1[1]) + (h1[2] * h1[2] + h1[3] * h1[3]);
                    }
                }
                ss += __shfl_xor(ss, 16); ss += __shfl_xor(ss, 32);
                if (fq == 0 && row < MREAL) __hip_atomic_fetch_add(rowss + row, ss, __ATOMIC_RELAXED, __HIP_MEMORY_SCOPE_AGENT);
            }
    }
};
struct EpiQKV {
    static constexpr bool PERM = true, AFTER_DRAIN = false;
    bf16* Q; bf16* KB; bf16* VB; float* out; const float* rowss; const float* ropec; const float* ropes; const float* offc; const float* offs;
    __device__ __forceinline__ void operator()(const pg8::f32x4 (&acc)[2][2][4][2], const pg8::Unit& u, int wr, int wc, int fr, int fq) const { run<2>(acc, u, wr, wc, fr, fq); }
    template <int NAI> __device__ __forceinline__ void run(const pg8::f32x4 (&acc)[NAI][2][4][2], const pg8::Unit& u, int wr, int wc, int fr, int fq) const {
        const int pn = u.pn;
        const bool isq = pn < 12; const int kvi = pn - 12; const int g = isq ? (pn >> 2) : (kvi >> 1); const bool isv = (!isq) && (kvi & 1);
        const int sh = 2 * g, W = 128 << sh;
        const bool stile = u.pm == 64;
        const int d0 = 8 * fq;
        const int slb = ((u.pm * 256 + wr * 64 + fr) & (SEQ - 1)) * 32 + d0;
#pragma unroll
        for (int ai = 0; ai < NAI; ++ai)
#pragma unroll
            for (int m = 0; m < 4; ++m) {
                const int row = u.pm * 256 + ai * 128 + wr * 64 + m * 16 + fr;
                if (row >= MREAL) continue;
                const float rstd = rsqrtf(rowss[row] * (1.f / D) + EPS);
                const bool samp = row >= NPROMPT; const int t = samp ? ((row - NPROMPT) & 3) : (row & (SEQ - 1));
                int rowp = row;
                if (!samp) { const int b = row >> 13, r = t & ((1 << sh) - 1), uu = t >> sh; rowp = b * SEQ + r * (SEQ >> sh) + uu; }
                float* ob = nullptr;
                if (!isq) {
                    if (samp) ob = out + (g == 0 ? O_KVS0 : g == 1 ? O_KVS1 : O_KVS2) + (size_t)(row - NPROMPT) * 512;
                    else if (t >= SEQ - W) ob = out + (g == 0 ? O_KVP0 : g == 1 ? O_KVP1 : O_KVP2) + ((size_t)(row >> 13) * W + (t - (SEQ - W))) * 512;
                }
                f32x4 av[2], bv[2];
#pragma unroll
                for (int n = 0; n < 2; ++n) {
                    f32x4 a = acc[ai][0][m][n] * rstd, b = acc[ai][1][m][n] * rstd;
                    if (!isv) {
                        const int sl = (samp ? SEQ + t : t) * 32 + d0 + 4 * n; const f32x4 c = *(const f32x4*)(ropec + sl), sn = *(const f32x4*)(ropes + sl);
                        const f32x4 ra = a * c - b * sn, rb = b * c + a * sn; a = ra; b = rb;
                    }
                    av[n] = a; bv[n] = b;
                }
                if (isq) {
                    bf16* qp = Q + (size_t)row * QW + pn * 256 + wc * 64 + d0;
                    u32x4 w0, w1; w0.x = pk2(av[0][0] * QSCALE, av[0][1] * QSCALE); w0.y = pk2(av[0][2] * QSCALE, av[0][3] * QSCALE); w0.z = pk2(av[1][0] * QSCALE, av[1][1] * QSCALE); w0.w = pk2(av[1][2] * QSCALE, av[1][3] * QSCALE);
                    w1.x = pk2(bv[0][0] * QSCALE, bv[0][1] * QSCALE); w1.y = pk2(bv[0][2] * QSCALE, bv[0][3] * QSCALE); w1.z = pk2(bv[1][0] * QSCALE, bv[1][1] * QSCALE); w1.w = pk2(bv[1][2] * QSCALE, bv[1][3] * QSCALE);
                    *(u32x4*)qp = w0; *(u32x4*)(qp + 32) = w1;
                } else {
                    bf16* kp = (isv ? VB : KB) + ((size_t)g * MP + rowp) * 256 + wc * 64 + d0;
                    u32x4 w0, w1; w0.x = pk2(av[0][0], av[0][1]); w0.y = pk2(av[0][2], av[0][3]); w0.z = pk2(av[1][0], av[1][1]); w0.w = pk2(av[1][2], av[1][3]);
                    w1.x = pk2(bv[0][0], bv[0][1]); w1.y = pk2(bv[0][2], bv[0][3]); w1.z = pk2(bv[1][0], bv[1][1]); w1.w = pk2(bv[1][2], bv[1][3]);
                    *(u32x4*)kp = w0; *(u32x4*)(kp + 32) = w1;
                    if (ob) { float* o2 = ob + (isv ? 256 : 0) + wc * 64 + d0; *(f32x4*)o2 = av[0]; *(f32x4*)(o2 + 4) = av[1]; *(f32x4*)(o2 + 32) = bv[0]; *(f32x4*)(o2 + 36) = bv[1]; }
                }
            }
    }
};

template <class Epi>
__device__ __forceinline__ void skinny_phase(LAS unsigned char* lds, const bf16* Abuf, const bf16* Bt, int N, int K, const Epi& E, int first, int wave, int lane) {
    const int nroles = (N >> 8) * 8, G = gridDim.x;
    const int fr = lane & 15, fq = lane >> 4;
    LAS float* red = (LAS float*)lds;
    const int rstep = first ? G - first : G;
    for (int role = (int)blockIdx.x - first; role < nroles; role += rstep) {
        if (role < 0) break;
        const int pn = role >> 3, wr = (role >> 2) & 1, wc = role & 3;
        pg8::f32x4 acc[1][2][4][2];
#pragma unroll
        for (int b = 0; b < 2; ++b)
#pragma unroll
            for (int m = 0; m < 4; ++m)
#pragma unroll
                for (int n = 0; n < 2; ++n) acc[0][b][m][n] = (pg8::f32x4){0.f, 0.f, 0.f, 0.f};
        const int kper = K >> 3, k0 = wave * kper;
        const bf16* ap = Abuf + (size_t)(NPROMPT + 64 * wr + fr) * K + k0 + 8 * fq;
        const int r0 = Epi::PERM ? (8 * (fr >> 2) + (fr & 3)) : fr, r1 = Epi::PERM ? r0 + 4 : fr + 16;
        const bf16* bp = Bt + (size_t)(256 * pn + 32 * wc) * K + k0 + 8 * fq;
#pragma unroll 4
        for (int ks = 0; ks < kper; ks += 32) {
            bf16x8 af[4], bf_[2][2];
#pragma unroll
            for (int m = 0; m < 4; ++m) af[m] = *(const bf16x8*)(ap + (size_t)(16 * m) * K + ks);
#pragma unroll
            for (int b = 0; b < 2; ++b) { bf_[b][0] = *(const bf16x8*)(bp + (size_t)(128 * b + r0) * K + ks); bf_[b][1] = *(const bf16x8*)(bp + (size_t)(128 * b + r1) * K + ks); }
#pragma unroll
            for (int b = 0; b < 2; ++b)
#pragma unroll
                for (int m = 0; m < 4; ++m)
#pragma unroll
                    for (int n = 0; n < 2; ++n) acc[0][b][m][n] = __builtin_amdgcn_mfma_f32_16x16x32_bf16(bf_[b][n], af[m], acc[0][b][m][n], 0, 0, 0);
        }
        if (wave != 0) {
#pragma unroll
            for (int b = 0; b < 2; ++b)
#pragma unroll
                for (int m = 0; m < 4; ++m)
#pragma unroll
                    for (int n = 0; n < 2; ++n) *(LAS pg8::f32x4*)(red + ((size_t)((wave - 1) * 16 + b * 8 + m * 2 + n) * 64 + lane) * 4) = acc[0][b][m][n];
        }
        __syncthreads();
        if (wave == 0) {
#pragma unroll 1
            for (int w = 0; w < 7; ++w)
#pragma unroll
                for (int b = 0; b < 2; ++b)
#pragma unroll
                    for (int m = 0; m < 4; ++m)
#pragma unroll
                        for (int n = 0; n < 2; ++n) acc[0][b][m][n] += *(const LAS pg8::f32x4*)(red + ((size_t)(w * 16 + b * 8 + m * 2 + n) * 64 + lane) * 4);
            const pg8::Unit u{64, pn};
            E.template run<1>(acc, u, wr, wc, fr, fq);
        }
        __syncthreads();
    }
}
__device__ __forceinline__ int conv_srcc(int mode, int nb) {
    if (mode == 0) return 32 * nb;
    if (mode == 1) { const int pn = nb >> 3, bj = (nb >> 2) & 1, cb = nb & 3; return bj * 1024 + 128 * pn + 32 * cb; }
    const int pn = nb >> 3, bj = (nb >> 2) & 1, wc = nb & 3; return 256 * pn + 64 * wc + 32 * bj;
}
__device__ __forceinline__ void transpose_item(const float* W, int K, int N, bf16* WT, const float* gain, int mode, LAS float* scr, int item, int lane) {
    const int nblk = N >> 6, kb = item / nblk, nb64 = item % nblk, k0 = 64 * kb;
    const int l16 = lane & 15, srcc = conv_srcc(mode, 2 * nb64 + (l16 >> 3)) + 4 * (l16 & 7);
    f32x4 v[16];
#pragma unroll
    for (int i = 0; i < 16; ++i) { const int kk = 4 * i + (lane >> 4); v[i] = *(const f32x4*)(W + (size_t)(k0 + kk) * N + srcc); }
    if (gain) {
#pragma unroll
        for (int i = 0; i < 16; ++i) { const int kk = 4 * i + (lane >> 4); v[i] = v[i] * gain[k0 + kk]; }
    }
#pragma unroll
    for (int i = 0; i < 16; ++i) { const int kk = 4 * i + (lane >> 4); LAS float* d = scr + kk * 65 + 4 * l16; d[0] = v[i][0]; d[1] = v[i][1]; d[2] = v[i][2]; d[3] = v[i][3]; }
    asm volatile("s_waitcnt lgkmcnt(0)" ::: "memory");
    const int c = lane & 7;
#pragma unroll
    for (int j = 0; j < 8; ++j) { const int n = (lane >> 3) + 8 * j; const LAS float* sp = scr + (8 * c) * 65 + n;
        u32x4 o; o.x = pk2(sp[0 * 65], sp[1 * 65]); o.y = pk2(sp[2 * 65], sp[3 * 65]); o.z = pk2(sp[4 * 65], sp[5 * 65]); o.w = pk2(sp[6 * 65], sp[7 * 65]);
        *(u32x4*)(WT + (size_t)(64 * nb64 + n) * K + k0 + 8 * c) = o; }
    asm volatile("s_waitcnt lgkmcnt(0)" ::: "memory");
}
__device__ __forceinline__ void convert_late(const Args& A, LAS unsigned char* lds, int vw, int NVW, int wave, int lane) {
    unsigned char* ws = A.ws;
    LAS float* scr = (LAS float*)(lds + wave * 16640);
    constexpr int I_UP = 16 * 64, I_DN = 64 * 16, I_O = 16 * 16, NIT = I_O + I_UP + I_DN;
    for (int it = vw; it < NIT; it += NVW) {
        int r = it;
        if (r < I_O) { transpose_item(A.in[21], 1024, 1024, (bf16*)(ws + W_O), nullptr, 0, scr, r, lane); continue; } r -= I_O;
        if (r < I_UP) { transpose_item(A.in[22] + 1024ull * 4096, 1024, 4096, (bf16*)(ws + W_UP1), A.in[8] + 1024, 0, scr, r, lane); continue; } r -= I_UP;
        transpose_item(A.in[23] + 4096ull * 1024, 4096, 1024, (bf16*)(ws + W_DN1), nullptr, 0, scr, r, lane);
    }
}

__device__ __forceinline__ void phase_prologue(const Args& A, LAS unsigned char* lds, int gw, int NGW, int wave, int lane) {
    unsigned char* ws = A.ws;
    LAS float* scr = (LAS float*)(lds + wave * 16640);
    constexpr int I_GLU = 16 * 32, I_UP = 16 * 64, I_DN = 64 * 16, I_Q = 16 * 48, I_KV = 16 * 24;
    constexpr int NIT = I_GLU + I_UP + I_DN + I_Q + I_KV;
    for (int it = gw; it < NIT; it += NGW) {
        int r = it;
        if (r < I_GLU) { transpose_item(A.in[17], 1024, 2048, (bf16*)(ws + W_GLU), nullptr, 1, scr, r, lane); continue; } r -= I_GLU;
        if (r < I_UP) { transpose_item(A.in[22], 1024, 4096, (bf16*)(ws + W_UP0), A.in[8], 0, scr, r, lane); continue; } r -= I_UP;
        if (r < I_DN) { transpose_item(A.in[23], 4096, 1024, (bf16*)(ws + W_DN0), nullptr, 0, scr, r, lane); continue; } r -= I_DN;
        if (r < I_Q) { transpose_item(A.in[20], 1024, 3072, (bf16*)(ws + W_QKV), A.in[7] + 1024, 2, scr, r, lane); continue; } r -= I_Q;
        transpose_item(A.in[19], 1024, 1536, (bf16*)(ws + W_QKV) + 3072ull * 1024, A.in[18], 2, scr, r, lane);
    }
    {
        const float* gmix = A.in[7];
        bf16* HN0 = (bf16*)(ws + WS_HN0);
        for (int row0 = 4 * gw; row0 < MREAL; row0 += 4 * NGW) {
            f32x4 v[4][4]; float ssq[4];
#pragma unroll
            for (int q = 0; q < 4; ++q) { const int row = row0 + q; const float* xr = row < NPROMPT ? A.in[0] + (size_t)row * D : A.in[1] + (size_t)(row - NPROMPT) * D;
#pragma unroll
                for (int j = 0; j < 4; ++j) v[q][j] = *((const f32x4*)xr + lane + 64 * j); }
#pragma unroll
            for (int q = 0; q < 4; ++q) { float sq = 0.f;
#pragma unroll
                for (int j = 0; j < 4; ++j) sq += (v[q][j][0] * v[q][j][0] + v[q][j][1] * v[q][j][1]) + (v[q][j][2] * v[q][j][2] + v[q][j][3] * v[q][j][3]);
                ssq[q] = rsqrtf(wave_sum(sq) * (1.f / D) + EPS); }
#pragma unroll
            for (int j = 0; j < 4; ++j) { const f32x4 gg = *((const f32x4*)gmix + lane + 64 * j);
#pragma unroll
                for (int q = 0; q < 4; ++q) { const float rstd = ssq[q];
                    u32x2 w; w.x = pk2(v[q][j][0] * rstd * gg[0], v[q][j][1] * rstd * gg[1]); w.y = pk2(v[q][j][2] * rstd * gg[2], v[q][j][3] * rstd * gg[3]);
                    *((u32x2*)(HN0 + (size_t)(row0 + q) * D) + lane + 64 * j) = w; } }
        }
    }
    const int gt = gw * 64 + lane, NGT = NGW * 64;
    { float* rs = (float*)(ws + WS_ROWSS); for (int i = gt; i < 4 * MP; i += NGT) rs[i] = 0.f; }
    { float* rc = (float*)(ws + WS_ROPE); float* rsn = rc + 8196 * 32;
      for (int i = gt; i < 8196 * 32; i += NGT) { const int slot = i >> 5, d = i & 31; const float pos = slot < SEQ ? (float)slot : (float)(16384 + (slot - SEQ));
          const float inv = powf(10000.0f, -(float)d / 32.0f); const float ang = pos * inv; rc[i] = cosf(ang); rsn[i] = sinf(ang); } }
    { float* oc = (float*)(ws + WS_ROPE) + 2 * 8196 * 32; float* os = oc + 8 * 32;
      for (int i = gt; i < 8 * 32; i += NGT) { const int oi = i >> 5, d = i & 31; const float pos = (float)(128 * (oi >> 2) + 16 * (oi & 3));
          const float inv = powf(10000.0f, -(float)d / 32.0f); const float ang = pos * inv; oc[i] = cosf(ang); os[i] = sinf(ang); } }
    { float* lam = (float*)(ws + WS_LAM); bf16* BB = (bf16*)(ws + WS_BBAR); bf16* CC = (bf16*)(ws + WS_CC);
      const float *are = A.in[9], *aim = A.in[10], *ldt = A.in[11], *bre = A.in[12], *bim = A.in[13], *cre = A.in[14], *cim = A.in[15];
      for (int i = gt; i < 64 * 64 * 16; i += NGT) {
          const int c = i & 15, p = (i >> 4) & 63, g = i >> 10;
          const float dt = expf(ldt[g]); const float ar = are[g * 64 + p], ai = aim[g * 64 + p];
          const float mag = expf(ar * dt); const float lr = mag * cosf(ai * dt), li = mag * sinf(ai * dt);
          const float den = ar * ar + ai * ai, nr = lr - 1.f, ni = li;
          const float zr = (nr * ar + ni * ai) / den, zi = (ni * ar - nr * ai) / den;
          const float br = bre[(g * 64 + p) * 16 + c], bi = bim[(g * 64 + p) * 16 + c];
          const float bbr = zr * br - zi * bi, bbi = zr * bi + zi * br;
          BB[(g * 128 + p) * 16 + c] = (bf16)(pk2(bbr, 0.f) & 0xffffu);
          BB[(g * 128 + 64 + p) * 16 + c] = (bf16)(pk2(bbi, 0.f) & 0xffffu);
          CC[(g * 16 + c) * 128 + p] = (bf16)(pk2(cre[(g * 16 + c) * 64 + p], 0.f) & 0xffffu);
          CC[(g * 16 + c) * 128 + 64 + p] = (bf16)(pk2(-cim[(g * 16 + c) * 64 + p], 0.f) & 0xffffu);
          if (c == 0) { lam[(g * 64 + p) * 2] = lr; lam[(g * 64 + p) * 2 + 1] = li; }
      } }
}

#define CMUL_ADD(orr, oi, ar_, ai_, br_, bi_, cr_, ci_) do { const float _r = __builtin_fmaf((ar_), (br_), __builtin_fmaf(-(ai_), (bi_), (cr_))); const float _i = __builtin_fmaf((ar_), (bi_), __builtin_fmaf((ai_), (br_), (ci_))); orr = _r; oi = _i; } while (0)
template <bool PASS2>
__device__ __forceinline__ void s5_item(const Args& A, LAS unsigned char* hs, int item, int lane) {
    unsigned char* ws = A.ws;
    const bf16* HN0 = (const bf16*)(ws + WS_HN0);
    const bool samp = item >= 2048;
    const int g = item & 63, ch = samp ? 128 + ((item - 2048) >> 6) : 4 * (item >> 6);
    const int s = lane & 31, hf = lane >> 5;
    bf16x8 Bf[4], Cf[4];
    { const bf16* BB = (const bf16*)(ws + WS_BBAR) + (size_t)g * 128 * 16;
#pragma unroll
      for (int n = 0; n < 4; ++n) Bf[n] = *(const bf16x8*)(BB + (32 * n + s) * 16 + 8 * hf);
      if (PASS2) { const bf16* CC = (const bf16*)(ws + WS_CC) + (size_t)g * 16 * 128;
#pragma unroll
        for (int st = 0; st < 4; ++st) Cf[st] = *(const bf16x8*)(CC + (lane & 15) * 128 + 32 * st + 8 * (lane >> 4)); } }
    const float* lam = (const float*)(ws + WS_LAM) + (size_t)g * 128;
    float lr[2], li[2], l16r[2], l16i[2], l128r[2], l128i[2];
#pragma unroll
    for (int j = 0; j < 2; ++j) { lr[j] = lam[(s + 32 * j) * 2]; li[j] = lam[(s + 32 * j) * 2 + 1];
        float pr = lr[j], pi = li[j];
#pragma unroll
        for (int q = 0; q < 4; ++q) { const float nr = pr * pr - pi * pi, ni = 2.f * pr * pi; pr = nr; pi = ni; }
        l16r[j] = pr; l16i[j] = pi;
#pragma unroll
        for (int q = 0; q < 3; ++q) { const float nr = pr * pr - pi * pi, ni = 2.f * pr * pi; pr = nr; pi = ni; }
        l128r[j] = pr; l128i[j] = pi; }
    float cr[2] = {0.f, 0.f}, ci[2] = {0.f, 0.f};
    const float* E = (const float*)(ws + WS_E);
    if (PASS2) {
        if (samp) { const int n = ch - 128;
#pragma unroll
            for (int j = 0; j < 2; ++j) { cr[j] = A.in[5][((size_t)n * 64 + g) * 64 + s + 32 * j]; ci[j] = A.in[6][((size_t)n * 64 + g) * 64 + s + 32 * j]; } }
        else { const int first = (ch >> 6) << 6;
#pragma unroll 8
            for (int jj = first; jj < ch; ++jj) { const float* e = E + ((size_t)jj * 64 + g) * 128;
#pragma unroll
                for (int j = 0; j < 2; ++j) { const float er = e[j * 32 + s], ei = e[64 + j * 32 + s]; CMUL_ADD(cr[j], ci[j], l128r[j], l128i[j], cr[j], ci[j], er, ei); } } }
    }
    const int nblk = samp ? 1 : 16;
    const int rowbase = samp ? NPROMPT + 4 * (ch - 128) : ch * 128;
    const int tokA = 16 * ((s >> 2) & 1) + 4 * (s >> 3) + (s & 3);
    const float* dsk = A.in[16] + g * 16;
    bf16* Y = (bf16*)(ws + WS_Y);
    bf16x8 afn = *(const bf16x8*)(HN0 + (size_t)(rowbase + tokA) * D + g * 16 + 8 * hf);
    for (int blk = 0; blk < nblk; ++blk) {
        const int row0 = rowbase + 32 * blk;
        const bf16x8 af = afn;
        if (!PASS2 && (blk & 3) == 0) { cr[0] = 0.f; cr[1] = 0.f; ci[0] = 0.f; ci[1] = 0.f; }
        if (blk + 1 < nblk) afn = *(const bf16x8*)(HN0 + (size_t)(row0 + 32 + tokA) * D + g * 16 + 8 * hf);
        f32x16 X[4];
        const f32x16 z16 = {0.f, 0.f, 0.f, 0.f, 0.f, 0.f, 0.f, 0.f, 0.f, 0.f, 0.f, 0.f, 0.f, 0.f, 0.f, 0.f};
#pragma unroll
        for (int n = 0; n < 4; ++n) X[n] = __builtin_amdgcn_mfma_f32_32x32x16_bf16(af, Bf[n], z16, 0, 0, 0);
        float cinr[2], cini[2];
#pragma unroll
        for (int j = 0; j < 2; ++j) {
            float er = 0.f, ei = 0.f;
#pragma unroll
            for (int r = 0; r < 16; ++r) CMUL_ADD(er, ei, lr[j], li[j], er, ei, X[j][r], X[2 + j][r]);
            const float or_ = __shfl_xor(er, 32), oi_ = __shfl_xor(ei, 32);
            const float e0r = hf ? or_ : er, e0i = hf ? oi_ : ei, e1r = hf ? er : or_, e1i = hf ? ei : oi_;
            float mr, mi; CMUL_ADD(mr, mi, l16r[j], l16i[j], cr[j], ci[j], e0r, e0i);
            cinr[j] = hf ? mr : cr[j]; cini[j] = hf ? mi : ci[j];
            CMUL_ADD(cr[j], ci[j], l16r[j], l16i[j], mr, mi, e1r, e1i);
        }
        if (PASS2) {
#pragma unroll
            for (int j = 0; j < 2; ++j) {
                float hr = cinr[j], hi = cini[j];
#pragma unroll
                for (int r = 0; r < 16; ++r) { CMUL_ADD(hr, hi, lr[j], li[j], hr, hi, X[j][r], X[2 + j][r]);
                    X[j][r] = hr; X[2 + j][r] = hi; }
            }
            if (samp && hf == 0) { const int n = ch - 128;
#pragma unroll
                for (int j = 0; j < 2; ++j) { A.out[O_SRES + ((size_t)n * 64 + g) * 64 + s + 32 * j] = X[j][3]; A.out[O_SIMS + ((size_t)n * 64 + g) * 64 + s + 32 * j] = X[2 + j][3]; } }
#pragma unroll
            for (int r = 0; r < 16; ++r) { LAS unsigned short* hp = (LAS unsigned short*)(hs + (16 * hf + r) * 272);
                const unsigned w01 = pk2(X[0][r], X[1][r]), w23 = pk2(X[2][r], X[3][r]);
                hp[s] = (unsigned short)w01; hp[32 + s] = (unsigned short)(w01 >> 16); hp[64 + s] = (unsigned short)w23; hp[96 + s] = (unsigned short)(w23 >> 16); }
            asm volatile("s_waitcnt lgkmcnt(0)" ::: "memory");
#pragma unroll
            for (int tb = 0; tb < 2; ++tb) {
                f32x4 y = {0.f, 0.f, 0.f, 0.f};
#pragma unroll
                for (int st = 0; st < 4; ++st) { const bf16x8 hfrag = *(const LAS bf16x8*)(hs + (16 * tb + (lane & 15)) * 272 + 64 * st + 16 * (lane >> 4));
                    y = __builtin_amdgcn_mfma_f32_16x16x32_bf16(hfrag, Cf[st], y, 0, 0, 0); }
                const int c = lane & 15; const float dk = dsk[c];
#pragma unroll
                for (int j = 0; j < 4; ++j) { const int tk = 16 * tb + 4 * (lane >> 4) + j;
                    if (!samp || tk < 4) { const size_t off = (size_t)(row0 + tk) * D + g * 16 + c;
                        const float v = y[j] + dk * bf2f(HN0[off]);
                        const float z = 0.7978845608f * (v + 0.044715f * v * v * v);
                        const float ge = v / (1.f + __expf(-2.f * z));
                        Y[off] = (bf16)(pk2(ge, 0.f) & 0xffffu); } }
            }
            asm volatile("s_waitcnt lgkmcnt(0)" ::: "memory");
        }
        if (!PASS2 && (blk & 3) == 3 && hf == 0) { float* e = (float*)(ws + WS_E) + ((size_t)(ch + (blk >> 2)) * 64 + g) * 128;
#pragma unroll
            for (int j = 0; j < 2; ++j) { e[j * 32 + s] = cr[j]; e[64 + j * 32 + s] = ci[j]; } }
    }
    if (PASS2 && !samp && hf == 0 && ((ch + 3) & 63) == 63) { const int b = ch >> 6;
#pragma unroll
        for (int j = 0; j < 2; ++j) { A.out[O_SREP + ((size_t)b * 64 + g) * 64 + s + 32 * j] = cr[j]; A.out[O_SIMP + ((size_t)b * 64 + g) * 64 + s + 32 * j] = ci[j]; } }
}

typedef short v4i16_t __attribute__((ext_vector_type(4)));
constexpr int KIMG_STRIDE = 144, KIMG_BYTES = 192 * KIMG_STRIDE, VIMG_HALF = 192 * 64, NATT_ITEMS = 3072;
struct AttItem { int g, sh, b, r, u0, kvh; };
__device__ __forceinline__ AttItem att_decode(int bi) {
    AttItem I; I.g = bi >> 10; const int rem = bi & 1023; I.kvh = rem & 3; I.b = (rem >> 2) & 1; const int rq = rem >> 3;
    I.sh = 2 * I.g; const int nqb = 128 >> I.sh; I.r = rq / nqb; I.u0 = 64 * (rq % nqb); return I;
}
template <bool COMBINE, int MODE = 0>
__device__ __forceinline__ void attn_prompt_phase(const Args& A, LAS unsigned char* lds, int tid, int wave, int lane, int item_lo, int item_hi) {
    unsigned char* ws = A.ws;
    const bf16* Q = (const bf16*)(ws + WS_Q); const bf16* KB = (const bf16*)(ws + WS_KB); const bf16* VB = (const bf16*)(ws + WS_VT);
    bf16* OG = (bf16*)(ws + WS_OG); float* LSE = (float*)(ws + WS_LSE);
    const int G = gridDim.x, hh = wave & 3, sub = wave >> 2, n = lane & 31, hf = lane >> 5;
    const int kap = (n & 3) + 4 * ((n >> 3) & 1) + 8 * ((n >> 2) & 1) + 16 * (n >> 4);
    int bi = item_lo + blockIdx.x;
    const int NATT_HI = item_hi;
    if (bi >= NATT_HI) return;
    bf16* AT = (bf16*)(ws + WS_ATT);
    u32x4 pk_[3], pv_[3]; bf16x8 qn[4];
#define ATT_ISSUE_KV(bix) do { const AttItem J = att_decode(bix); const int L_ = SEQ >> J.sh; const size_t pb_ = (size_t)J.g * MP + (size_t)J.b * SEQ + (size_t)J.r * L_; \
        _Pragma("unroll") for (int i = 0; i < 3; ++i) { const int c_ = tid + 512 * i, row_ = c_ >> 3, ch_ = c_ & 7; int u_ = J.u0 - 128 + row_; u_ = u_ < 0 ? 0 : u_; \
            pk_[i] = *(const u32x4*)(KB + (pb_ + u_) * 256 + J.kvh * 64 + 8 * ch_); pv_[i] = *(const u32x4*)(VB + (pb_ + u_) * 256 + J.kvh * 64 + 8 * ch_); } } while (0)
#define ATT_ISSUE_Q(bix) do { const AttItem J = att_decode(bix); const int qrow_ = J.b * SEQ + ((J.u0 + 32 * sub + n) << J.sh) + J.r; \
        _Pragma("unroll") for (int ks = 0; ks < 4; ++ks) qn[ks] = *(const bf16x8*)(Q + (size_t)qrow_ * QW + J.g * 1024 + (4 * J.kvh + hh) * 64 + 16 * ks + 8 * hf); } while (0)
#define ATT_WRITE(bufo) do { _Pragma("unroll") for (int i = 0; i < 3; ++i) { const int c = tid + 512 * i, row = c >> 3, ch = c & 7; \
            *(LAS u32x4*)(lds + (bufo) + row * KIMG_STRIDE + 16 * ch) = pk_[i]; \
            *(LAS u32x4*)(lds + (bufo) + KIMG_BYTES + (ch >> 2) * VIMG_HALF + row * 64 + (ch & 3) * 16) = pv_[i]; } } while (0)
    constexpr int ABUF = KIMG_BYTES + 2 * VIMG_HALF;
    bf16x8 qf[4];
    ATT_ISSUE_KV(bi); ATT_ISSUE_Q(bi);
    ATT_WRITE(0);
#pragma unroll
    for (int ks = 0; ks < 4; ++ks) qf[ks] = qn[ks];
    if (bi + G < NATT_HI) ATT_ISSUE_KV(bi + G);
    asm volatile("s_waitcnt lgkmcnt(0)\n\ts_barrier" ::: "memory");
    int par = 0;
    for (; bi < NATT_HI; bi += G, par ^= 1) {
        const AttItem I = att_decode(bi);
        if (bi + G < NATT_HI) { ATT_WRITE((par ^ 1) * ABUF); ATT_ISSUE_Q(bi + G); }
        if (bi + 2 * G < NATT_HI) ATT_ISSUE_KV(bi + 2 * G);
        const LAS unsigned char* lbuf = lds + par * ABUF;
        const int u0w = I.u0 + 32 * sub;
        const int qrow = I.b * SEQ + ((u0w + n) << I.sh) + I.r;
        const int h = 4 * I.kvh + hh;
        f32x16 O0, O1;
#pragma unroll
        for (int i = 0; i < 16; ++i) { O0[i] = 0.f; O1[i] = 0.f; }
        float mrun = -INFINITY, lrun = 0.f;
        const int cc_ = lane & 7, rr0_ = lane >> 3;
        bf16x8 x1[4], x2[4]; float l1 = 0.f, l2 = 0.f;
        if (COMBINE) {
            l1 = LSE[((size_t)1 * MP + qrow) * 16 + h]; l2 = LSE[((size_t)2 * MP + qrow) * 16 + h];
#pragma unroll
            for (int j = 0; j < 4; ++j) { const int qr_ = I.b * SEQ + ((u0w + rr0_ + 8 * j) << I.sh) + I.r;
                x1[j] = *(const bf16x8*)(OG + ((size_t)1 * MP + qr_) * D + h * 64 + 8 * cc_); x2[j] = *(const bf16x8*)(OG + ((size_t)2 * MP + qr_) * D + h * 64 + 8 * cc_); }
        }
        const int kt0 = (MODE == 1 || MODE == 3) ? 5 : (u0w >= 128 ? 0 : (128 - u0w) >> 5);
        const LAS unsigned char* kimg = lbuf + (32 * sub + kap) * KIMG_STRIDE + 16 * hf;
        const LAS unsigned char* vimg = lbuf + KIMG_BYTES + (32 * sub + 8 * hf + ((lane & 15) >> 2)) * 64 + (16 * ((lane >> 4) & 1) + 4 * (lane & 3)) * 2;
        for (int kt = kt0; kt < 5; ++kt) {
            bf16x8 kf[4], vf[2][2];
#pragma unroll
            for (int ks = 0; ks < 4; ++ks) kf[ks] = *(const LAS bf16x8*)(kimg + (32 * kt) * KIMG_STRIDE + 32 * ks);
#pragma unroll
            for (int mb = 0; mb < 2; ++mb)
#pragma unroll
                for (int st = 0; st < 2; ++st) {
                    const LAS unsigned char* vp = vimg + mb * VIMG_HALF + (32 * kt + 16 * st) * 64;
                    const v4i16_t lo = __builtin_amdgcn_ds_read_tr16_b64_v4i16((LAS v4i16_t*)vp);
                    const v4i16_t hi = __builtin_amdgcn_ds_read_tr16_b64_v4i16((LAS v4i16_t*)(vp + 4 * 64));
                    vf[mb][st] = (bf16x8){lo[0], lo[1], lo[2], lo[3], hi[0], hi[1], hi[2], hi[3]};
                }
            f32x16 S;
#pragma unroll
            for (int i = 0; i < 16; ++i) S[i] = 0.f;
#pragma unroll
            for (int ks = 0; ks < 4; ++ks) S = __builtin_amdgcn_mfma_f32_32x32x16_bf16(kf[ks], qf[ks], S, 0, 0, 0);
            if (kt == 0) {
#pragma unroll
                for (int rr = 0; rr < 16; ++rr) { const int kp = (rr & 7) + 8 * hf + 16 * (rr >> 3); if (kp < n) S[rr] = -INFINITY; }
            } else if (kt == 4) {
#pragma unroll
                for (int rr = 0; rr < 16; ++rr) { const int kp = (rr & 7) + 8 * hf + 16 * (rr >> 3); if (kp > n) S[rr] = -INFINITY; }
            }
            float tm = S[0];
#pragma unroll
            for (int rr = 1; rr < 16; ++rr) tm = fmaxf(tm, S[rr]);
            tm = fmaxf(tm, __shfl_xor(tm, 32));
            const float mnew = fmaxf(mrun, tm);
            const float alpha = __builtin_amdgcn_exp2f(mrun - mnew);
            float ps = 0.f; float p[16];
#pragma unroll
            for (int rr = 0; rr < 16; ++rr) { p[rr] = __builtin_amdgcn_exp2f(S[rr] - mnew); ps += p[rr]; }
            lrun = lrun * alpha + ps; mrun = mnew;
            if (__builtin_amdgcn_ballot_w64(alpha != 1.f) != 0ull) {
#pragma unroll
                for (int i = 0; i < 16; ++i) { O0[i] *= alpha; O1[i] *= alpha; }
            }
#pragma unroll
            for (int st = 0; st < 2; ++st) {
                u32x4 pw; pw.x = pk2(p[8 * st + 0], p[8 * st + 1]); pw.y = pk2(p[8 * st + 2], p[8 * st + 3]); pw.z = pk2(p[8 * st + 4], p[8 * st + 5]); pw.w = pk2(p[8 * st + 6], p[8 * st + 7]);
                const bf16x8 pf = __builtin_bit_cast(bf16x8, pw);
                O0 = __builtin_amdgcn_mfma_f32_32x32x16_bf16(vf[0][st], pf, O0, 0, 0, 0);
                O1 = __builtin_amdgcn_mfma_f32_32x32x16_bf16(vf[1][st], pf, O1, 0, 0, 0);
            }
        }
        const float ltot = lrun + __shfl_xor(lrun, 32);
        LAS unsigned char* ost = lds + 2 * ABUF + wave * 4864;
        float sc0;
        if (!COMBINE) { sc0 = 1.f / ltot; if (hf == 0) LSE[((size_t)I.g * MP + qrow) * 16 + h] = mrun + log2f(ltot); }
        else { const float l0 = mrun + log2f(ltot); const float mx = fmaxf(l0, fmaxf(l1, l2));
            const float w0 = __builtin_amdgcn_exp2f(l0 - mx), w1 = __builtin_amdgcn_exp2f(l1 - mx), w2 = __builtin_amdgcn_exp2f(l2 - mx);
            const float invw = 1.f / (w0 + w1 + w2); sc0 = w0 * invw / ltot;
            if (hf == 0) { LAS float* wp = (LAS float*)(ost + 4608) + 2 * n; wp[0] = w1 * invw; wp[1] = w2 * invw; } }
        if (MODE < 2) {
#pragma unroll
            for (int a = 0; a < 4; ++a) {
                u32x2 w0v, w1v; w0v.x = pk2(O0[4 * a] * sc0, O0[4 * a + 1] * sc0); w0v.y = pk2(O0[4 * a + 2] * sc0, O0[4 * a + 3] * sc0);
                w1v.x = pk2(O1[4 * a] * sc0, O1[4 * a + 1] * sc0); w1v.y = pk2(O1[4 * a + 2] * sc0, O1[4 * a + 3] * sc0);
                *(LAS u32x2*)(ost + n * 144 + (8 * a + 4 * hf) * 2) = w0v; *(LAS u32x2*)(ost + n * 144 + 64 + (8 * a + 4 * hf) * 2) = w1v;
            }
            asm volatile("s_waitcnt lgkmcnt(0)" ::: "memory");
#pragma unroll
            for (int j = 0; j < 4; ++j) { const int rr_ = rr0_ + 8 * j; const int qr_ = I.b * SEQ + ((u0w + rr_) << I.sh) + I.r;
                const bf16x8 tv = *(const LAS bf16x8*)(ost + rr_ * 144 + 16 * cc_);
                if (!COMBINE) *(bf16x8*)(OG + ((size_t)I.g * MP + qr_) * D + h * 64 + 8 * cc_) = tv;
                else { const LAS float* wp = (const LAS float*)(ost + 4608) + 2 * rr_; const float w1 = wp[0], w2 = wp[1];
                    float o[8];
#pragma unroll
                    for (int i = 0; i < 8; ++i) o[i] = bf2f((unsigned short)tv[i]) + w1 * bf2f((unsigned short)x1[j][i]) + w2 * bf2f((unsigned short)x2[j][i]);
                    u32x4 y; y.x = pk2(o[0], o[1]); y.y = pk2(o[2], o[3]); y.z = pk2(o[4], o[5]); y.w = pk2(o[6], o[7]);
                    *(u32x4*)(AT + (size_t)qr_ * D + h * 64 + 8 * cc_) = y; }
            }
        } else { if (ltot == 123.456f) LSE[0] = ltot; }
#pragma unroll
        for (int ks = 0; ks < 4; ++ks) qf[ks] = qn[ks];
        asm volatile("s_waitcnt lgkmcnt(0)\n\ts_barrier" ::: "memory");
    }
#undef ATT_ISSUE_KV
#undef ATT_ISSUE_Q
#undef ATT_WRITE
}

__device__ __forceinline__ void attn_sample_item(const Args& A, LAS float* sl, int it, int lane) {
    unsigned char* ws = A.ws;
    const int h = it & 15, t = (it >> 4) & 3, n = it >> 6, kvh = h >> 2;
    const int row = NPROMPT + 4 * n + t;
    const bf16* Q = (const bf16*)(ws + WS_Q) + (size_t)row * QW + h * 64;
    const int kq = lane >> 2, dq = lane & 3;
    float mxl = -INFINITY;
#pragma unroll 1
    for (int g = 0; g < 3; ++g) {
        const int W = 128 << (2 * g), dil = 1 << (2 * g);
        const float* cache = A.in[2 + g] + (size_t)n * W * 512;
        const float* newkv = A.out + (g == 0 ? O_KVS0 : g == 1 ? O_KVS1 : O_KVS2) + (size_t)n * 4 * 512;
        float q[16];
#pragma unroll
        for (int c8 = 0; c8 < 2; ++c8) { const bf16x8 v = *(const bf16x8*)(Q + g * 1024 + 16 * dq + 8 * c8);
#pragma unroll
            for (int i = 0; i < 8; ++i) q[8 * c8 + i] = bf2f((unsigned short)v[i]); }
#pragma unroll 9
        for (int bt = 0; bt < 9; ++bt) {
            const int j = 16 * bt + kq; const bool valid = j <= 128; const int jj = valid ? j : 128;
            const int idx = W + t - dil * jj;
            const float* kp = (idx >= W ? newkv + (size_t)(idx - W) * 512 : cache + (size_t)idx * 512) + kvh * 64 + 16 * dq;
            float s = 0.f;
#pragma unroll
            for (int c4 = 0; c4 < 4; ++c4) { const f32x4 kv = *(const f32x4*)(kp + 4 * c4); s += q[4 * c4] * kv[0] + q[4 * c4 + 1] * kv[1] + q[4 * c4 + 2] * kv[2] + q[4 * c4 + 3] * kv[3]; }
            s += __shfl_xor(s, 1); s += __shfl_xor(s, 2);
            if (valid && dq == 0) sl[g * 132 + j] = s;
            mxl = fmaxf(mxl, valid ? s : -INFINITY);
        }
    }
    const float mx = wave_max(mxl);
    asm volatile("s_waitcnt lgkmcnt(0)" ::: "memory");
    float sum = 0.f;
#pragma unroll 1
    for (int i = lane; i < 396; i += 64) { const int j = i % 132; if (j <= 128) { const float p = exp2f(sl[i] - mx); sl[i] = p; sum += p; } }
    sum = wave_sum(sum);
    asm volatile("s_waitcnt lgkmcnt(0)" ::: "memory");
    f32x4 acc = {0.f, 0.f, 0.f, 0.f};
    const int ksl = lane >> 4, dq4 = lane & 15;
#pragma unroll 1
    for (int g = 0; g < 3; ++g) {
        const int W = 128 << (2 * g), dil = 1 << (2 * g);
        const float* cache = A.in[2 + g] + (size_t)n * W * 512;
        const float* newkv = A.out + (g == 0 ? O_KVS0 : g == 1 ? O_KVS1 : O_KVS2) + (size_t)n * 4 * 512;
#pragma unroll 33
        for (int jb = 0; jb < 33; ++jb) {
            const int j = 4 * jb + ksl; const bool valid = j <= 128; const int jj = valid ? j : 128;
            const int idx = W + t - dil * jj;
            const float* vp = (idx >= W ? newkv + (size_t)(idx - W) * 512 : cache + (size_t)idx * 512) + 256 + kvh * 64 + 4 * dq4;
            const f32x4 v = *(const f32x4*)vp;
            const float pj = valid ? sl[g * 132 + jj] : 0.f;
            acc += v * pj;
        }
    }
#pragma unroll
    for (int i = 0; i < 4; ++i) { acc[i] += __shfl_xor(acc[i], 16); acc[i] += __shfl_xor(acc[i], 32); }
    bf16* AT = (bf16*)(ws + WS_ATT);
    if (lane < 16) { const float inv = 1.f / sum; u32x2 w; w.x = pk2(acc[0] * inv, acc[1] * inv); w.y = pk2(acc[2] * inv, acc[3] * inv);
        *(u32x2*)(AT + (size_t)row * D + h * 64 + 4 * dq4) = w; }
    asm volatile("s_waitcnt lgkmcnt(0)" ::: "memory");
}

__device__ __forceinline__ void attn_combine(const Args& A, int gt, int NGT) {
    unsigned char* ws = A.ws;
    const bf16* OG = (const bf16*)(ws + WS_OG); const float* LSE = (const float*)(ws + WS_LSE); bf16* AT = (bf16*)(ws + WS_ATT);
    for (int i = gt; i < NPROMPT * 128; i += NGT) {
        const int row = i >> 7, c8 = i & 127, h = c8 >> 3;
        const float l0 = LSE[((size_t)0 * MP + row) * 16 + h], l1 = LSE[((size_t)1 * MP + row) * 16 + h], l2 = LSE[((size_t)2 * MP + row) * 16 + h];
        const float mx = fmaxf(l0, fmaxf(l1, l2));
        float w0 = exp2f(l0 - mx), w1 = exp2f(l1 - mx), w2 = exp2f(l2 - mx); const float inv = 1.f / (w0 + w1 + w2); w0 *= inv; w1 *= inv; w2 *= inv;
        const bf16x8 a = *(const bf16x8*)(OG + ((size_t)0 * MP + row) * D + 8 * c8), b = *(const bf16x8*)(OG + ((size_t)1 * MP + row) * D + 8 * c8), c = *(const bf16x8*)(OG + ((size_t)2 * MP + row) * D + 8 * c8);
        float o[8];
#pragma unroll
        for (int k = 0; k < 8; ++k) o[k] = w0 * bf2f((unsigned short)a[k]) + w1 * bf2f((unsigned short)b[k]) + w2 * bf2f((unsigned short)c[k]);
        u32x4 w; w.x = pk2(o[0], o[1]); w.y = pk2(o[2], o[3]); w.z = pk2(o[4], o[5]); w.w = pk2(o[6], o[7]);
        *(u32x4*)(AT + (size_t)row * D + 8 * c8) = w;
    }
}

#define XB_TMO      128
#define XB_XCNT(j)  (256  + 64 * (j))
#define XB_XSUB(j)  (1280 + 64 * (j))
#define XB_XGEN(j)  (2304 + 64 * (j))
#define XB_TOP      3328
#define XB_TOPGEN   3392
#define XCD_BAR_WORDS 3456
#define XB_SPIN_CAP (1u << 18)

__device__ __forceinline__ unsigned xb_ld(unsigned* p)              { return __hip_atomic_load(p, __ATOMIC_RELAXED, __HIP_MEMORY_SCOPE_AGENT); }
__device__ __forceinline__ unsigned xb_add(unsigned* p, unsigned v) { return __hip_atomic_fetch_add(p, v, __ATOMIC_RELAXED, __HIP_MEMORY_SCOPE_AGENT); }
__device__ __forceinline__ unsigned xb_xcc_id() { return (unsigned)__builtin_amdgcn_s_getreg((3 << 11) | 20) & 0xFu; }
#define XB_SPIN(cond, bar) do { unsigned _sp = 0; while (cond) { __builtin_amdgcn_s_sleep(1); \
    if ((++_sp & 255u) == 0u) { if (xb_ld(&(bar)[XB_TMO])) break; if (_sp > XB_SPIN_CAP) { atomicAdd(&(bar)[XB_TMO], 1u); break; } } } } while (0)

struct XcdBarrier {
    unsigned* bar; unsigned x;
    volatile LAS unsigned* st;
};

__device__ __forceinline__ XcdBarrier xcd_barrier_post(unsigned* bar, volatile LAS unsigned* st) {
    XcdBarrier b; b.bar = bar; b.x = xb_xcc_id(); b.st = st;
    if (threadIdx.x == 0) (void)xb_add(&bar[XB_XCNT(b.x)], 1u);
    return b;
}
__device__ __forceinline__ void xcd_barrier_complete(unsigned* bar, unsigned x, unsigned& nloc, unsigned& nx) {
    const unsigned G = gridDim.x * gridDim.y * gridDim.z;
    unsigned sum, cnt, mine, sp = 0u;
    for (;;) {
        sum = 0u; cnt = 0u; mine = 0u;
#pragma unroll
        for (unsigned j = 0; j < 16; ++j) { const unsigned c = xb_ld(&bar[XB_XCNT(j)]); sum += c; cnt += (c > 0u) ? 1u : 0u; mine = (j == x) ? c : mine; }
        if (sum == G) break;
        __builtin_amdgcn_s_sleep(1);
        if ((++sp & 255u) == 0u) { if (xb_ld(&bar[XB_TMO])) break; if (sp > XB_SPIN_CAP) { atomicAdd(&bar[XB_TMO], 1u); break; } }
    }
    nloc = mine > 0u ? mine : 1u; nx = cnt > 0u ? cnt : 1u;
}

__device__ __forceinline__ void xcd_barrier(const XcdBarrier& b) {
    asm volatile("s_waitcnt vmcnt(0)" ::: "memory");
    __syncthreads();
    if (threadIdx.x == 0) {
        unsigned* bar = b.bar;
        __builtin_amdgcn_s_waitcnt(0);
        unsigned nloc = b.st[0], nx = b.st[1];
        if (nloc == 0u) { xcd_barrier_complete(bar, b.x, nloc, nx); b.st[0] = nloc; b.st[1] = nx; }
        const unsigned old = xb_add(&bar[XB_XSUB(b.x)], 1u);
        const unsigned gen = old / nloc;
        if (old + 1u == (gen + 1u) * nloc) {
            __builtin_amdgcn_fence(__ATOMIC_RELEASE, "agent");
            asm volatile("s_waitcnt vmcnt(0)" ::: "memory");
            const unsigned og = xb_add(&bar[XB_TOP], 1u);
            const unsigned tg = og / nx;
            if (og + 1u == (tg + 1u) * nx) xb_add(&bar[XB_TOPGEN], 1u);
            else XB_SPIN(xb_ld(&bar[XB_TOPGEN]) == tg, bar);
            __builtin_amdgcn_fence(__ATOMIC_ACQUIRE, "agent");
            xb_add(&bar[XB_XGEN(b.x)], 1u);
            asm volatile("s_waitcnt vmcnt(0)" ::: "memory");
        } else {
            XB_SPIN(xb_ld(&bar[XB_XGEN(b.x)]) == gen, bar);
            __builtin_amdgcn_fence(__ATOMIC_ACQUIRE, "agent");
            asm volatile("s_waitcnt vmcnt(0)" ::: "memory");
        }
    }
    __syncthreads();
}

constexpr int NPHASE = 13;
#ifndef REP0
#define REP0 1
#endif
#ifndef REP12
#define REP12 1
#endif
#ifndef REP7
#define REP7 1
#endif
#ifndef REP8
#define REP8 1
#endif
#ifndef REP4
#define REP4 1
#endif
#ifndef REP6
#define REP6 1
#endif
#ifndef DUP4
#define DUP4 0
#endif
#ifndef DUP6
#define DUP6 0
#endif
#ifndef DUP5
#define DUP5 0
#endif
#ifndef PROBE8
#define PROBE8 0
#endif
#ifndef XSYNC
#define XSYNC 0
#endif
__global__ void __launch_bounds__(NTHREADS, 2) yoco_fwd(Args A) {
    extern __shared__ __attribute__((aligned(16))) unsigned char lds_raw[];
    LAS unsigned char* lds = (LAS unsigned char*)lds_raw;
    cg::grid_group grid = cg::this_grid();
    const int tid = threadIdx.x, lane = tid & 63, wave = __builtin_amdgcn_readfirstlane(tid >> 6);
    const int G = gridDim.x, gw = blockIdx.x * NWAVES + wave, NGW = G * NWAVES, gt = gw * 64 + lane, NGT = NGW * 64;
    unsigned char* ws = A.ws;
    float* rowss = (float*)(ws + WS_ROWSS);
    float* Hf = (float*)(ws + WS_H); bf16* HB = (bf16*)(ws + WS_HB);
    const int lo = A.ph_lo, hi = A.ph_hi;
    volatile LAS unsigned* bst = (volatile LAS unsigned*)(lds + LDS_BYTES - 64);
    if (tid < 2) bst[tid] = 0u;
    __syncthreads();
    XcdBarrier xbar = xcd_barrier_post((unsigned*)(ws + WS_BAR), bst);
    if (lo < 0) grid.sync();
#ifndef PH_MASK
#define PH_MASK 0xffff
#endif
#define IN(k) (((PH_MASK >> (k)) & 1) && lo <= (k) && (k) < hi)
#define SEAM(k) do { if (IN(k) && IN((k) + 1)) xcd_barrier(xbar); } while (0)
    if (IN(0)) { for (int rp = 0; rp < REP0; ++rp) phase_prologue(A, lds, gw, NGW, wave, lane); for (int rp = 0; rp < XSYNC; ++rp) xcd_barrier(xbar); }
    SEAM(0);
    if (IN(1)) for (int rp = 0; rp < REP12; ++rp) { for (int it = gw; it < 2048; it += NGW) s5_item<false>(A, lds + wave * 8704, it, lane); }
    SEAM(1);
    if (IN(2)) for (int rp = 0; rp < REP12; ++rp) { for (int it = gw; it < 4096; it += NGW) s5_item<true>(A, lds + wave * 8704, it, lane); }
    SEAM(2);
    if (IN(3)) { pg8::Gemm g{(const bf16*)(ws + WS_Y), (const bf16*)(ws + W_GLU), NPROMPT, 2048, 1024}; pg8::StaticOrder S; S.init(NPROMPT, 2048, G, (int)blockIdx.x);
        EpiGlu E{A.in[0], A.in[1], Hf, HB, rowss};
        pg8::gemm_phase<EpiGlu, pg8::StaticOrder, true, true>(lds, g, S, E);
        skinny_phase(lds, g.A, g.Bt, 2048, 1024, E, 0, wave, lane); }
    SEAM(3);
    if (IN(4)) { pg8::Gemm g{HB, (const bf16*)(ws + W_UP0), NPROMPT, FF, 1024}; pg8::StaticOrder S; S.init(NPROMPT, FF, G, (int)blockIdx.x);
        EpiUp E{(bf16*)(ws + WS_ACT), rowss};
        pg8::gemm_phase<EpiUp, pg8::StaticOrder, true, true>(lds, g, S, E);
        skinny_phase(lds, g.A, g.Bt, FF, 1024, E, 0, wave, lane);
#if DUP4 == 1
        pg8::gemm_phase<EpiUp, pg8::StaticOrder, true, true>(lds, g, S, E);
#endif
#if DUP4 == 3
        { EpiNull E0{(float*)(ws + WS_OG)};
        skinny_phase(lds, g.A, g.Bt, FF, 1024, E0, 0, wave, lane); skinny_phase(lds, g.A, g.Bt, FF, 1024, E0, 0, wave, lane);
        skinny_phase(lds, g.A, g.Bt, FF, 1024, E0, 0, wave, lane); skinny_phase(lds, g.A, g.Bt, FF, 1024, E0, 0, wave, lane); }
#endif
#if DUP4 == 2
        skinny_phase(lds, g.A, g.Bt, FF, 1024, E, 0, wave, lane);
        skinny_phase(lds, g.A, g.Bt, FF, 1024, E, 0, wave, lane);
        skinny_phase(lds, g.A, g.Bt, FF, 1024, E, 0, wave, lane);
        skinny_phase(lds, g.A, g.Bt, FF, 1024, E, 0, wave, lane);
#endif
    }
    SEAM(4);
    if (IN(5)) { pg8::Gemm g{(const bf16*)(ws + WS_ACT), (const bf16*)(ws + W_DN0), NPROMPT, 1024, FF}; pg8::StaticOrder S; S.init(NPROMPT, 1024, G, (int)blockIdx.x);
        EpiRes E{HB, nullptr, rowss + MP};
        pg8::gemm_phase<EpiRes, pg8::StaticOrder, true, true>(lds, g, S, E);
        skinny_phase(lds, g.A, g.Bt, 1024, FF, E, 0, wave, lane);
#if DUP5 == 2
        { EpiUp E2{(bf16*)(ws + WS_OG), rowss}; pg8::gemm_phase<EpiUp, pg8::StaticOrder, true, true>(lds, g, S, E2); }
#endif
    }
    SEAM(5);
    if (IN(6)) { pg8::Gemm g{HB, (const bf16*)(ws + W_QKV), NPROMPT, NQKV, 1024}; pg8::StaticOrder S; S.init(NPROMPT, NQKV, G, (int)blockIdx.x);
        EpiQKV E{(bf16*)(ws + WS_Q), (bf16*)(ws + WS_KB), (bf16*)(ws + WS_VT), A.out, rowss + MP, (const float*)(ws + WS_ROPE), (const float*)(ws + WS_ROPE) + 8196 * 32, (const float*)(ws + WS_ROPE) + 2 * 8196 * 32, (const float*)(ws + WS_ROPE) + 2 * 8196 * 32 + 8 * 32};
        pg8::gemm_phase<EpiQKV, pg8::StaticOrder, true, true>(lds, g, S, E);
        skinny_phase(lds, g.A, g.Bt, NQKV, 1024, E, G >= 256 ? 128 : 0, wave, lane);
        { const int cf = G >= 256 ? 128 : 0; if ((int)blockIdx.x >= cf) convert_late(A, lds, ((int)blockIdx.x - cf) * NWAVES + wave, (G - cf) * NWAVES, wave, lane); }
#if DUP6 == 1
        pg8::gemm_phase<EpiQKV, pg8::StaticOrder, true, true>(lds, g, S, E);
#endif
#if DUP6 == 2
        { EpiUp E2{(bf16*)(ws + WS_OG), rowss + MP}; pg8::gemm_phase<EpiUp, pg8::StaticOrder, true, true>(lds, g, S, E2); }
#endif
    }
    SEAM(6);
    if (IN(7)) for (int rp = 0; rp < REP7; ++rp) {
        for (int it = gw; it < 2048; it += NGW) attn_sample_item(A, (LAS float*)(lds + 65536 + wave * 2048), it, lane);
        __syncthreads();
        attn_prompt_phase<false>(A, lds, tid, wave, lane, 1024, NATT_ITEMS);
    }
    SEAM(7);
    if (IN(8)) {
#if PROBE8 > 0
        attn_prompt_phase<true, PROBE8>(A, lds, tid, wave, lane, 0, 1024); __syncthreads();
#endif
        attn_prompt_phase<true>(A, lds, tid, wave, lane, 0, 1024); }
    SEAM(8);
    if (IN(9)) { pg8::Gemm g{(const bf16*)(ws + WS_ATT), (const bf16*)(ws + W_O), NPROMPT, 1024, 1024}; pg8::StaticOrder S; S.init(NPROMPT, 1024, G, (int)blockIdx.x);
        EpiRes E{HB, nullptr, rowss + 2 * MP};
        pg8::gemm_phase<EpiRes, pg8::StaticOrder, true, true>(lds, g, S, E);
        skinny_phase(lds, g.A, g.Bt, 1024, 1024, E, 0, wave, lane); }
    SEAM(9);
    if (IN(10)) { pg8::Gemm g{HB, (const bf16*)(ws + W_UP1), NPROMPT, FF, 1024}; pg8::StaticOrder S; S.init(NPROMPT, FF, G, (int)blockIdx.x);
        EpiUp E{(bf16*)(ws + WS_ACT), rowss + 2 * MP};
        pg8::gemm_phase<EpiUp, pg8::StaticOrder, true, true>(lds, g, S, E);
        skinny_phase(lds, g.A, g.Bt, FF, 1024, E, 0, wave, lane); }
    SEAM(10);
    if (IN(11)) { pg8::Gemm g{(const bf16*)(ws + WS_ACT), (const bf16*)(ws + W_DN1), NPROMPT, 1024, FF}; pg8::StaticOrder S; S.init(NPROMPT, 1024, G, (int)blockIdx.x);
        EpiRes E{HB, nullptr, rowss + 3 * MP};
        pg8::gemm_phase<EpiRes, pg8::StaticOrder, true, true>(lds, g, S, E);
        skinny_phase(lds, g.A, g.Bt, 1024, FF, E, 0, wave, lane); }
    SEAM(11);
    if (IN(12)) {
        const float* gfin = A.in[24];
        for (int row0 = 4 * gw; row0 < MREAL; row0 += 4 * NGW) {
            bf16x8 hv[4][2]; float rs[4];
#pragma unroll
            for (int q = 0; q < 4; ++q) { rs[q] = rowss[3 * MP + row0 + q];
#pragma unroll
                for (int j = 0; j < 2; ++j) hv[q][j] = *((const bf16x8*)(HB + (size_t)(row0 + q) * D) + lane + 64 * j); }
#pragma unroll
            for (int j = 0; j < 2; ++j) { const f32x4 g0 = *((const f32x4*)gfin + 2 * (lane + 64 * j)), g1 = *((const f32x4*)gfin + 2 * (lane + 64 * j) + 1);
#pragma unroll
                for (int q = 0; q < 4; ++q) { const float rstd = rsqrtf(rs[q] * (1.f / D) + EPS); float* orow = A.out + (size_t)(row0 + q) * D;
                    f32x4 o0, o1;
#pragma unroll
                    for (int i = 0; i < 4; ++i) { o0[i] = bf2f((unsigned short)hv[q][j][i]) * rstd * g0[i]; o1[i] = bf2f((unsigned short)hv[q][j][4 + i]) * rstd * g1[i]; }
                    *((f32x4*)orow + 2 * (lane + 64 * j)) = o0; *((f32x4*)orow + 2 * (lane + 64 * j) + 1) = o1; } }
        }
    }
#undef IN
#undef SEAM
}

#ifndef N_LAUNCHES
#define N_LAUNCHES 1
#endif
extern "C" void kernel_launch(void* const* d_in, const int* in_sizes, int n_in, void* d_out, int out_size, void* d_ws, size_t ws_size, hipStream_t stream) {
    static int grid = 0;
    if (grid == 0) {
        if (n_in != 25 || ws_size < WS_END) { fprintf(stderr, "kernel_launch: unexpected n_in %d / ws %zu\n", n_in, ws_size); grid = -1; return; }
        int dev = 0, cus = 0, per_cu = 0;
        hipGetDevice(&dev); hipDeviceGetAttribute(&cus, hipDeviceAttributeMultiprocessorCount, dev);
        if (hipFuncSetAttribute((const void*)yoco_fwd, hipFuncAttributeMaxDynamicSharedMemorySize, LDS_BYTES) != hipSuccess) { fprintf(stderr, "hipFuncSetAttribute failed\n"); grid = -1; return; }
        hipOccupancyMaxActiveBlocksPerMultiprocessor(&per_cu, (const void*)yoco_fwd, NTHREADS, LDS_BYTES);
        (void)hipGetLastError();
        if (per_cu < 1) per_cu = 1;
        grid = cus * per_cu;
    }
    if (grid < 0) return;
    Args a{};
    for (int i = 0; i < 25; ++i) a.in[i] = (const float*)d_in[i];
    a.out = (float*)d_out; a.ws = (unsigned char*)d_ws;
    if (hipMemsetAsync((char*)d_ws + WS_BAR, 0, 16384, stream) != hipSuccess) { fprintf(stderr, "memset failed\n"); return; }
    if (N_LAUNCHES == 1) {
        a.ph_lo = 0; a.ph_hi = NPHASE;
        void* args[] = {&a};
        hipError_t e = hipLaunchCooperativeKernel((const void*)yoco_fwd, dim3(grid), dim3(NTHREADS), args, LDS_BYTES, stream);
        if (e != hipSuccess) fprintf(stderr, "cooperative launch failed: %s (grid %d)\n", hipGetErrorString(e), grid);
    } else {
        for (int p = 0; p < NPHASE; ++p) { a.ph_lo = p; a.ph_hi = p + 1; hipLaunchKernelGGL(yoco_fwd, dim3(grid), dim3(NTHREADS), LDS_BYTES, stream, a); }
    }
}
```

```cpp
#include <hip/hip_runtime.h>
#include <hip/hip_cooperative_groups.h>
#include <cstdio>
#include <cstdint>
#include <cmath>
namespace cg = cooperative_groups;
namespace pg8 {
#define PG8_LAS __attribute__((address_space(3)))
typedef unsigned short bf16_t;
typedef short bf16x8 __attribute__((ext_vector_type(8)));
typedef float f32x4 __attribute__((ext_vector_type(4)));
typedef unsigned u32x4 __attribute__((ext_vector_type(4)));
constexpr int BM = 256, BK = 64, HALF = 128, HTB = HALF * BK * 2  , STAGE_BYTES = 8 * HTB, NXCD = 8, WGM = 8;

__host__ __device__ __forceinline__ int lds_byte(int r, int c) { const int st = (r >> 4) * 2 + (c >> 5), rr = r & 15, cc = c & 31, ob = rr * 64 + cc * 2; return st * 1024 + (ob ^ (((ob >> 9) & 1) << 5)); }
__host__ __device__ __forceinline__ void stage_rc(int b, int& R, int& C) { const int st = b / 1024, sb = b % 1024, swz = sb ^ (((sb >> 9) & 1) << 5); R = (st >> 1) * 16 + swz / 64; C = (st & 1) * 32 + (swz % 64) / 2; }
__host__ __device__ __forceinline__ int perm32(int rho) { const int n = rho >> 4, i = rho & 15; return 8 * (i >> 2) + 4 * n + (i & 3); }

struct Unit { int pm, pn; };
struct Gemm { const bf16_t* A; const bf16_t* Bt; int M, N, K; };

struct StaticOrder {
    int nM, nN, nwg, G, c;
    __host__ __device__ void init(int M, int N, int G_, int c_) { nM = M / BM; nN = N / BM; nwg = nM * nN; G = G_; c = c_; }
    __host__ __device__ bool next(int i, Unit& u) const {
        const long L = (long)i * G + c; if (L >= nwg) return false;
        int wgid = (int)L; { const int q = nwg / NXCD, r = nwg % NXCD, xcd = wgid % NXCD, off = wgid / NXCD; wgid = (xcd < r ? xcd * (q + 1) : r * (q + 1) + (xcd - r) * q) + off; }
        const int nig = WGM * nN, gid = wgid / nig, fm = gid * WGM, gsz = (nM - fm) < WGM ? (nM - fm) : WGM;
        u.pm = fm + ((wgid % nig) % gsz); u.pn = (wgid % nig) / gsz; return true;
    }
    __device__ __forceinline__ void a_ready(const Unit&) const {}
    __device__ __forceinline__ void done(const Unit&) const {}
};

__device__ __forceinline__ unsigned cvt_pk_bf16(float lo, float hi) { unsigned r; asm volatile("v_cvt_pk_bf16_f32 %0, %1, %2" : "=v"(r) : "v"(lo), "v"(hi)); return r; }
typedef float f32x2 __attribute__((ext_vector_type(2)));
__device__ __forceinline__ f32x2 gelu_pk(f32x2 v) {
    const f32x2 av = __builtin_elementwise_abs(v), d = av * 0.2316418882f + 1.0f;
    f32x2 t; t.x = __builtin_amdgcn_rcpf(d.x); t.y = __builtin_amdgcn_rcpf(d.y);
    f32x2 q = t * 0.5307027145f + (-0.7265760135f); q = q * t + 0.7107068705f; q = q * t + (-0.142248368f); q = q * t + 0.127414796f; q = q * t;
    const f32x2 s = (v * v) * (-0.72134752044f);
    f32x2 e; e.x = __builtin_amdgcn_exp2f(s.x); e.y = __builtin_amdgcn_exp2f(s.y);
    const f32x2 m = v * (q * e), r = v - m;
    f32x2 o; o.x = v.x < 0.f ? m.x : r.x; o.y = v.y < 0.f ? m.y : r.y; return o;
}


template <class Epi, class Sched, bool ALIGN_EPI = false, bool SP2 = false>
__device__ __forceinline__ void gemm_phase(PG8_LAS unsigned char* lds, const Gemm g, const Sched& S, const Epi& E) {
    const int tid = threadIdx.x, wid = __builtin_amdgcn_readfirstlane(tid >> 6), lane = tid & 63, wr = wid >> 2, wc = wid & 3, fr = lane & 15, fq = lane >> 4;
    const int K = g.K, nt = K / BK;
    unsigned voffA[2], voffB[2];
#pragma unroll
    for (int i = 0; i < 2; ++i) { int R, C; stage_rc(tid * 16 + i * 8192, R, C); const int Rb = Epi::PERM ? ((R & ~31) + perm32(R & 31)) : R;
        voffA[i] = (unsigned)(R * K + C) * 2u; voffB[i] = (unsigned)(Rb * K + C) * 2u; }
    const size_t kstep = (size_t)(BK * 2);
    const size_t hstep = (size_t)HALF * K * 2;
    const size_t tstep = 2 * hstep;
    const unsigned ldsw = (unsigned)wid * 1024u;
    const int aoff = lds_byte(wr * 64 + fr, fq * 8), boff = lds_byte(wc * 32 + fr, fq * 8);
#define PG8_SA(b, h) (((b) * 2 + (h)) * HTB)
#define PG8_SB(b, h) ((4 + (b) * 2 + (h)) * HTB)
#define PG8_STAGE(bufoff, gbase, voff) do { _Pragma("unroll") for (int _i = 0; _i < 2; ++_i) \
        __builtin_amdgcn_global_load_lds((const unsigned*)((const char*)(gbase) + (voff)[_i]), (PG8_LAS unsigned*)(lds + (bufoff) + ldsw + _i * 8192), 16, 0, 0); } while (0)
#define PG8_LDA(dst, b, h) do { _Pragma("unroll") for (int m = 0; m < 4; ++m) _Pragma("unroll") for (int k = 0; k < 2; ++k) dst[m][k] = *(const PG8_LAS bf16x8*)(lds + PG8_SA(b, h) + aoff + m * 2048 + k * 1024); } while (0)
#define PG8_LDB(dst, b, h) do { _Pragma("unroll") for (int n = 0; n < 2; ++n) _Pragma("unroll") for (int k = 0; k < 2; ++k) dst[n][k] = *(const PG8_LAS bf16x8*)(lds + PG8_SB(b, h) + boff + n * 2048 + k * 1024); } while (0)
#define PG8_MMA(ai, bj, At, Bt) do { __builtin_amdgcn_s_setprio(1); _Pragma("unroll") for (int m = 0; m < 4; ++m) _Pragma("unroll") for (int n = 0; n < 2; ++n) _Pragma("unroll") for (int k = 0; k < 2; ++k) \
        acc[ai][bj][m][n] = __builtin_amdgcn_mfma_f32_16x16x32_bf16(Bt[n][k], At[m][k], acc[ai][bj][m][n], 0, 0, 0); __builtin_amdgcn_s_setprio(0); } while (0)
#define PG8_WAIT_V(n) asm volatile("s_waitcnt vmcnt(" #n ")" ::: "memory")
#define PG8_WAIT_L(n) asm volatile("s_waitcnt lgkmcnt(" #n ")" ::: "memory")
#define PG8_BAR __builtin_amdgcn_s_barrier()
#define PG8_SCHED __builtin_amdgcn_sched_barrier(0)
    Unit cur, nxt; int ui = 0;
    if (!S.next(0, cur)) return;
    f32x4 acc[2][2][4][2];
#pragma unroll
    for (int a = 0; a < 2; ++a)
#pragma unroll
        for (int b = 0; b < 2; ++b)
#pragma unroll
            for (int m = 0; m < 4; ++m)
#pragma unroll
                for (int n = 0; n < 2; ++n) acc[a][b][m][n] = (f32x4){0.f, 0.f, 0.f, 0.f};
    bf16x8 At[4][2], B0[2][2], B1[2][2];
    const char* cA = (const char*)g.A + (size_t)cur.pm * tstep; const char* cB = (const char*)g.Bt + (size_t)cur.pn * tstep;
    S.a_ready(cur);
    if constexpr (SP2) {
        PG8_STAGE(PG8_SB(0, 0), cB, voffB); PG8_STAGE(PG8_SB(0, 1), cB + hstep, voffB); PG8_STAGE(PG8_SA(0, 0), cA, voffA); PG8_STAGE(PG8_SA(0, 1), cA + hstep, voffA);
        if (wr == 1) PG8_BAR;
        PG8_WAIT_V(2); PG8_BAR;
        PG8_STAGE(PG8_SB(1, 0), cB + kstep, voffB); PG8_STAGE(PG8_SA(1, 0), cA + kstep, voffA); PG8_STAGE(PG8_SB(1, 1), cB + hstep + kstep, voffB);
        PG8_WAIT_V(6); PG8_BAR;
    } else {
        PG8_STAGE(PG8_SB(0, 0), cB, voffB); PG8_STAGE(PG8_SA(0, 0), cA, voffA); PG8_STAGE(PG8_SB(0, 1), cB + hstep, voffB); PG8_STAGE(PG8_SA(0, 1), cA + hstep, voffA);
        if (wr == 1) PG8_BAR;
        PG8_WAIT_V(4); PG8_BAR;
        PG8_STAGE(PG8_SB(1, 0), cB + kstep, voffB); PG8_STAGE(PG8_SA(1, 0), cA + kstep, voffA); PG8_STAGE(PG8_SB(1, 1), cB + hstep + kstep, voffB);
        PG8_WAIT_V(6); PG8_BAR;
    }
    for (;;) {
        const bool has_next = S.next(ui + 1, nxt);
        const char* nA = has_next ? (const char*)g.A + (size_t)nxt.pm * tstep : cA; const char* nB = has_next ? (const char*)g.Bt + (size_t)nxt.pn * tstep : cB;
        for (int t = 0; t < nt; t += 2) {
            const bool last = (t == nt - 2);
            const char* a1 = cA + (size_t)(t + 1) * kstep;
            const char* a2 = last ? nA : cA + (size_t)(t + 2) * kstep; const char* b2 = last ? nB : cB + (size_t)(t + 2) * kstep;
            const char* a3 = a2 + kstep; const char* b3 = b2 + kstep;
            if (last && has_next) S.a_ready(nxt);
            if constexpr (SP2) {
            PG8_LDB(B0, 0, 0); PG8_LDB(B1, 0, 1); PG8_SCHED; PG8_LDA(At, 0, 0); PG8_STAGE(PG8_SA(1, 1), a1 + hstep, voffA);
            PG8_WAIT_V(8); PG8_WAIT_L(0); PG8_BAR; PG8_MMA(0, 0, At, B0); PG8_MMA(0, 1, At, B1); PG8_BAR; PG8_SCHED;
            PG8_LDA(At, 0, 1); PG8_STAGE(PG8_SB(0, 0), b2, voffB); PG8_STAGE(PG8_SB(0, 1), b2 + hstep, voffB); PG8_STAGE(PG8_SA(0, 0), a2, voffA);
            PG8_WAIT_V(8); PG8_WAIT_L(0); PG8_BAR; PG8_MMA(1, 0, At, B0); PG8_MMA(1, 1, At, B1); PG8_BAR; PG8_SCHED;
            PG8_LDB(B0, 1, 0); PG8_LDB(B1, 1, 1); PG8_SCHED; PG8_LDA(At, 1, 0); PG8_STAGE(PG8_SA(0, 1), a2 + hstep, voffA);
            PG8_WAIT_V(8); PG8_WAIT_L(0); PG8_BAR; PG8_MMA(0, 0, At, B0); PG8_MMA(0, 1, At, B1); PG8_BAR; PG8_SCHED;
            PG8_LDA(At, 1, 1); PG8_STAGE(PG8_SB(1, 0), b3, voffB); PG8_STAGE(PG8_SB(1, 1), b3 + hstep, voffB); PG8_STAGE(PG8_SA(1, 0), a3, voffA);
            PG8_WAIT_V(8); PG8_WAIT_L(0); PG8_BAR; PG8_MMA(1, 0, At, B0); PG8_MMA(1, 1, At, B1); PG8_BAR; PG8_SCHED;
            } else {
            PG8_LDB(B0, 0, 0); PG8_SCHED; PG8_LDA(At, 0, 0); PG8_STAGE(PG8_SA(1, 1), a1 + hstep, voffA);
            PG8_WAIT_L(8); PG8_BAR; PG8_WAIT_L(0); PG8_MMA(0, 0, At, B0); PG8_BAR; PG8_SCHED;
            PG8_LDB(B1, 0, 1); PG8_STAGE(PG8_SB(0, 0), b2, voffB);
            PG8_BAR; PG8_WAIT_L(0); PG8_MMA(0, 1, At, B1); PG8_BAR;
            PG8_LDA(At, 0, 1); PG8_STAGE(PG8_SA(0, 0), a2, voffA);
            PG8_BAR; PG8_WAIT_L(0); PG8_MMA(1, 0, At, B0); PG8_BAR; PG8_SCHED;
            PG8_STAGE(PG8_SB(0, 1), b2 + hstep, voffB);
            PG8_WAIT_V(6); PG8_BAR; PG8_MMA(1, 1, At, B1); PG8_BAR;
            PG8_LDB(B0, 1, 0); PG8_SCHED; PG8_LDA(At, 1, 0); PG8_STAGE(PG8_SA(0, 1), a2 + hstep, voffA);
            PG8_WAIT_L(8); PG8_BAR; PG8_WAIT_L(0); PG8_MMA(0, 0, At, B0); PG8_BAR; PG8_SCHED;
            PG8_LDB(B1, 1, 1); PG8_STAGE(PG8_SB(1, 0), b3, voffB);
            PG8_BAR; PG8_WAIT_L(0); PG8_MMA(0, 1, At, B1); PG8_BAR;
            PG8_LDA(At, 1, 1); PG8_STAGE(PG8_SA(1, 0), a3, voffA);
            PG8_BAR; PG8_WAIT_L(0); PG8_MMA(1, 0, At, B0); PG8_BAR; PG8_SCHED;
            PG8_STAGE(PG8_SB(1, 1), b3 + hstep, voffB);
            PG8_WAIT_V(6); PG8_BAR; PG8_MMA(1, 1, At, B1); PG8_BAR;
            }
        }
        if constexpr (ALIGN_EPI) { if (wr == 0) PG8_BAR; }
        if constexpr (!Epi::AFTER_DRAIN) { E(acc, cur, wr, wc, fr, fq); S.done(cur); }
        if (!has_next) break;
#pragma unroll
        for (int a = 0; a < 2; ++a)
#pragma unroll
            for (int b = 0; b < 2; ++b)
#pragma unroll
                for (int m = 0; m < 4; ++m)
#pragma unroll
                    for (int n = 0; n < 2; ++n) acc[a][b][m][n] = (f32x4){0.f, 0.f, 0.f, 0.f};
        cur = nxt; cA = nA; cB = nB; ++ui;
        if constexpr (ALIGN_EPI) { if (wr == 1) PG8_BAR; }
    }
    PG8_WAIT_V(0);
    if constexpr (!ALIGN_EPI) { if (wr == 0) PG8_BAR; }
    PG8_BAR;
    if constexpr (Epi::AFTER_DRAIN) { E.fused(acc, cur, wr, wc, fr, fq, lds, wid, lane); S.done(cur); }
#undef PG8_SA
#undef PG8_SB
#undef PG8_STAGE
#undef PG8_LDA
#undef PG8_LDB
#undef PG8_MMA
#undef PG8_WAIT_V
#undef PG8_WAIT_L
#undef PG8_BAR
#undef PG8_SCHED
}
}

#define LAS __attribute__((address_space(3)))
typedef unsigned short bf16;
typedef short bf16x8 __attribute__((ext_vector_type(8)));
typedef float f32x4 __attribute__((ext_vector_type(4)));
typedef float f32x16 __attribute__((ext_vector_type(16)));
typedef unsigned u32x4 __attribute__((ext_vector_type(4)));
typedef unsigned u32x2 __attribute__((ext_vector_type(2)));
typedef float f32x2_t __attribute__((ext_vector_type(2)));
typedef __bf16 bf16x2_t __attribute__((ext_vector_type(2)));

constexpr int NWAVES = 8, NTHREADS = 512;
constexpr int D = 1024, SEQ = 8192, NPROMPT = 16384, NSAMP = 128, MREAL = NPROMPT + NSAMP, MP = 16640;
constexpr int FF = 4096, QW = 3072, KVW = 1536, NQKV = QW + KVW;
constexpr float EPS = 1e-6f;
constexpr float QSCALE = 0.125f * 1.4426950408889634f;
constexpr int LDS_BYTES = 147456;

constexpr size_t MiB = 1u << 20;
constexpr size_t WS_ROWSS = 0;
constexpr size_t WS_BAR = 384 * 1024;
constexpr size_t WS_LAM = 512 * 1024;
constexpr size_t WS_BBAR = 576 * 1024;
constexpr size_t WS_CC = 1 * MiB;
constexpr size_t WS_ROPE = 1536 * 1024;
constexpr size_t WS_E = 3840 * 1024;
constexpr size_t WS_W = 8 * MiB;
constexpr size_t W_GLU = WS_W, W_UP0 = W_GLU + 2048ull * 1024 * 2, W_DN0 = W_UP0 + 4096ull * 1024 * 2, W_QKV = W_DN0 + 4096ull * 1024 * 2,
                 W_O = W_QKV + (size_t)NQKV * 1024 * 2, W_UP1 = W_O + 1024ull * 1024 * 2, W_DN1 = W_UP1 + 4096ull * 1024 * 2, W_END = W_DN1 + 4096ull * 1024 * 2;
static_assert(W_END <= 56 * MiB, "weights");
constexpr size_t WS_H = 56 * MiB;
constexpr size_t WS_HB = 121 * MiB;
constexpr size_t WS_HN0 = 154 * MiB;
constexpr size_t WS_VT = WS_HN0;
constexpr size_t WS_Y = 187 * MiB;
constexpr size_t WS_ATT = WS_Y;
constexpr size_t WS_ACT = 220 * MiB;
constexpr size_t WS_Q = WS_ACT;
constexpr size_t WS_KB = WS_Q + (size_t)MP * QW * 2;
static_assert(WS_KB + 3ull * MP * 256 * 2 <= 350 * MiB, "q/k overlay");
constexpr size_t WS_OG = 350 * MiB;
constexpr size_t WS_LSE = 448 * MiB;
constexpr size_t WS_END = 452 * MiB;

constexpr size_t O_YP = 0, O_YS = 16777216, O_KVP0 = 16908288, O_KVP1 = 17039360, O_KVP2 = 17563648,
                 O_KVS0 = 19660800, O_KVS1 = 19726336, O_KVS2 = 19791872, O_SREP = 19857408, O_SIMP = 19865600, O_SRES = 19873792, O_SIMS = 20004864;

__device__ __forceinline__ unsigned pk2(float lo, float hi) { f32x2_t v = {lo, hi}; bf16x2_t b = __builtin_convertvector(v, bf16x2_t); return __builtin_bit_cast(unsigned, b); }
__device__ __forceinline__ float bf2f(unsigned short u) { return __uint_as_float(((unsigned)u) << 16); }
__device__ __forceinline__ float wave_sum(float v) {
#pragma unroll
    for (int o = 1; o < 64; o <<= 1) v += __shfl_xor(v, o);
    return v;
}
__device__ __forceinline__ float wave_max(float v) {
#pragma unroll
    for (int o = 1; o < 64; o <<= 1) v = fmaxf(v, __shfl_xor(v, o));
    return v;
}

struct Args { const float* in[25]; float* out; unsigned char* ws; int ph_lo, ph_hi; };

struct EpiGlu {
    static constexpr bool PERM = true, AFTER_DRAIN = false;
    const float* xp; const float* xs; float* H; bf16* HB; float* rowss;
    __device__ __forceinline__ void operator()(const pg8::f32x4 (&acc)[2][2][4][2], const pg8::Unit& u, int wr, int wc, int fr, int fq) const { run<2>(acc, u, wr, wc, fr, fq); }
    template <int NAI> __device__ __forceinline__ void run(const pg8::f32x4 (&acc)[NAI][2][4][2], const pg8::Unit& u, int wr, int wc, int fr, int fq) const {
        const int col = u.pn * 128 + wc * 32 + 8 * fq;
#pragma unroll
        for (int ai = 0; ai < NAI; ++ai)
#pragma unroll
            for (int m = 0; m < 4; ++m) {
                const int row = u.pm * 256 + ai * 128 + wr * 64 + m * 16 + fr;
                if (row < MREAL) {
                    const float* xr = (row < NPROMPT ? xp + (size_t)row * D : xs + (size_t)(row - NPROMPT) * D) + col;
                    const f32x4 x0 = *(const f32x4*)xr, x1 = *(const f32x4*)(xr + 4);
                    f32x4 h0, h1;
#pragma unroll
                    for (int i = 0; i < 4; ++i) {
                        h0[i] = x0[i] + acc[ai][0][m][0][i] / (1.f + __expf(-acc[ai][1][m][0][i]));
                        h1[i] = x1[i] + acc[ai][0][m][1][i] / (1.f + __expf(-acc[ai][1][m][1][i]));
                    }
                    u32x4 w; w.x = pk2(h0[0], h0[1]); w.y = pk2(h0[2], h0[3]); w.z = pk2(h1[0], h1[1]); w.w = pk2(h1[2], h1[3]);
                    *(u32x4*)(HB + (size_t)row * D + col) = w;
                    float ss = (h0[0] * h0[0] + h0[1] * h0[1]) + (h0[2] * h0[2] + h0[3] * h0[3]) + (h1[0] * h1[0] + h1[1] * h1[1]) + (h1[2] * h1[2] + h1[3] * h1[3]);
                    ss += __shfl_xor(ss, 16); ss += __shfl_xor(ss, 32);
                    if (fq == 0) __hip_atomic_fetch_add(rowss + row, ss, __ATOMIC_RELAXED, __HIP_MEMORY_SCOPE_AGENT);
                } else { float ss = 0.f; ss += __shfl_xor(ss, 16); ss += __shfl_xor(ss, 32); (void)ss; }
            }
    }
};
struct EpiNull {
    static constexpr bool PERM = true, AFTER_DRAIN = false; float* sink;
    __device__ __forceinline__ void operator()(const pg8::f32x4 (&acc)[2][2][4][2], const pg8::Unit& u, int wr, int wc, int fr, int fq) const { run<2>(acc, u, wr, wc, fr, fq); }
    template <int NAI> __device__ __forceinline__ void run(const pg8::f32x4 (&acc)[NAI][2][4][2], const pg8::Unit& u, int wr, int wc, int fr, int fq) const {
        float t = 0.f;
#pragma unroll
        for (int b = 0; b < 2; ++b)
#pragma unroll
            for (int m = 0; m < 4; ++m)
#pragma unroll
                for (int n = 0; n < 2; ++n) t += acc[0][b][m][n][0] + acc[0][b][m][n][3];
        if (t == 1234.5678f) sink[0] = t;
    }
};
struct EpiUp {
    static constexpr bool PERM = true, AFTER_DRAIN = false;
    bf16* O; const float* rowss;
    __device__ __forceinline__ void operator()(const pg8::f32x4 (&acc)[2][2][4][2], const pg8::Unit& u, int wr, int wc, int fr, int fq) const { run<2>(acc, u, wr, wc, fr, fq); }
    template <int NAI> __device__ __forceinline__ void run(const pg8::f32x4 (&acc)[NAI][2][4][2], const pg8::Unit& u, int wr, int wc, int fr, int fq) const {
        const int col = u.pn * 256 + wc * 32 + 8 * fq;
#pragma unroll
        for (int ai = 0; ai < NAI; ++ai)
#pragma unroll
            for (int m = 0; m < 4; ++m) {
                const int row = u.pm * 256 + ai * 128 + wr * 64 + m * 16 + fr;
                if (row < MREAL) {
                    const float rstd = rsqrtf(rowss[row] * (1.f / D) + EPS);
#pragma unroll
                    for (int bj = 0; bj < 2; ++bj) {
                        float v[8];
#pragma unroll
                        for (int i = 0; i < 4; ++i) { float a = fmaxf(acc[ai][bj][m][0][i] * rstd, 0.f), b = fmaxf(acc[ai][bj][m][1][i] * rstd, 0.f); v[i] = a * a; v[4 + i] = b * b; }
                        u32x4 w; w.x = pk2(v[0], v[1]); w.y = pk2(v[2], v[3]); w.z = pk2(v[4], v[5]); w.w = pk2(v[6], v[7]);
                        *(u32x4*)(O + (size_t)row * FF + col + bj * 128) = w;
                    }
                }
            }
    }
};
struct EpiRes {
    static constexpr bool PERM = true, AFTER_DRAIN = false;
    bf16* HB; float* OUT; float* rowss;
    __device__ __forceinline__ void operator()(const pg8::f32x4 (&acc)[2][2][4][2], const pg8::Unit& u, int wr, int wc, int fr, int fq) const { run<2>(acc, u, wr, wc, fr, fq); }
    template <int NAI> __device__ __forceinline__ void run(const pg8::f32x4 (&acc)[NAI][2][4][2], const pg8::Unit& u, int wr, int wc, int fr, int fq) const {
        const int col = u.pn * 256 + wc * 32 + 8 * fq;
#pragma unroll
        for (int ai = 0; ai < NAI; ++ai)
#pragma unroll
            for (int m = 0; m < 4; ++m) {
                const int row = u.pm * 256 + ai * 128 + wr * 64 + m * 16 + fr;
                float ss = 0.f;
                if (row < MREAL) {
#pragma unroll
                    for (int bj = 0; bj < 2; ++bj) {
                        bf16* hp = HB + (size_t)row * D + col + bj * 128;
                        const bf16x8 hv = *(const bf16x8*)hp;
                        f32x4 h0, h1;
#pragma unroll
                        for (int i = 0; i < 4; ++i) { h0[i] = bf2f((unsigned short)hv[i]) + acc[ai][bj][m][0][i]; h1[i] = bf2f((unsigned short)hv[4 + i]) + acc[ai][bj][m][1][i]; }
                        if (OUT) { float* op = OUT + (size_t)row * D + col + bj * 128; *(f32x4*)op = h0; *(f32x4*)(op + 4) = h1; }
                        else { u32x4 w; w.x = pk2(h0[0], h0[1]); w.y = pk2(h0[2], h0[3]); w.z = pk2(h1[0], h1[1]); w.w = pk2(h1[2], h1[3]); *(u32x4*)hp = w; }
                        ss += (h0[0] * h0[0] + h0[1] * h0[1]) + (h0[2] * h0[2] + h0[3] * h0[3]) + (h1[0] * h1[0] + h1[1] * h1[1]) + (h1[2] * h1[2] + h1[3] * h1[3]);
                    }
                }
                ss += __shfl_xor(ss, 16); ss += __shfl_xor(ss, 32);
                if (fq == 0 && row < MREAL) __hip_atomic_fetch_add(rowss + row, ss, __ATOMIC_RELAXED, __HIP_MEMORY_SCOPE_AGENT);
            }
    }
};
struct EpiQKV {
    static constexpr bool PERM = true, AFTER_DRAIN = false;
    bf16* Q; bf16* KB; bf16* VB; float* out; const float* rowss; const float* ropec; const float* ropes; const float* offc; const float* offs;
    __device__ __forceinline__ void operator()(const pg8::f32x4 (&acc)[2][2][4][2], const pg8::Unit& u, int wr, int wc, int fr, int fq) const { run<2>(acc, u, wr, wc, fr, fq); }
    template <int NAI> __device__ __forceinline__ void run(const pg8::f32x4 (&acc)[NAI][2][4][2], const pg8::Unit& u, int wr, int wc, int fr, int fq) const {
        const int pn = u.pn;
        const bool isq = pn < 12; const int kvi = pn - 12; const int g = isq ? (pn >> 2) : (kvi >> 1); const bool isv = (!isq) && (kvi & 1);
        const int sh = 2 * g, W = 128 << sh;
        const bool stile = u.pm == 64;
        const int d0 = 8 * fq;
        const int slb = ((u.pm * 256 + wr * 64 + fr) & (SEQ - 1)) * 32 + d0;
#pragma unroll
        for (int ai = 0; ai < NAI; ++ai)
#pragma unroll
            for (int m = 0; m < 4; ++m) {
                const int row = u.pm * 256 + ai * 128 + wr * 64 + m * 16 + fr;
                if (row >= MREAL) continue;
                const float rstd = rsqrtf(rowss[row] * (1.f / D) + EPS);
                const bool samp = row >= NPROMPT; const int t = samp ? ((row - NPROMPT) & 3) : (row & (SEQ - 1));
                int rowp = row;
                if (!samp) { const int b = row >> 13, r = t & ((1 << sh) - 1), uu = t >> sh; rowp = b * SEQ + r * (SEQ >> sh) + uu; }
                float* ob = nullptr;
                if (!isq) {
                    if (samp) ob = out + (g == 0 ? O_KVS0 : g == 1 ? O_KVS1 : O_KVS2) + (size_t)(row - NPROMPT) * 512;
                    else if (t >= SEQ - W) ob = out + (g == 0 ? O_KVP0 : g == 1 ? O_KVP1 : O_KVP2) + ((size_t)(row >> 13) * W + (t - (SEQ - W))) * 512;
                }
                f32x4 av[2], bv[2];
#pragma unroll
                for (int n = 0; n < 2; ++n) {
                    f32x4 a = acc[ai][0][m][n] * rstd, b = acc[ai][1][m][n] * rstd;
                    if (!isv) {
                        const int sl = (samp ? SEQ + t : t) * 32 + d0 + 4 * n; const f32x4 c = *(const f32x4*)(ropec + sl), sn = *(const f32x4*)(ropes + sl);
                        const f32x4 ra = a * c - b * sn, rb = b * c + a * sn; a = ra; b = rb;
                    }
                    av[n] = a; bv[n] = b;
                }
                if (isq) {
                    bf16* qp = Q + (size_t)row * QW + pn * 256 + wc * 64 + d0;
                    u32x4 w0, w1; w0.x = pk2(av[0][0] * QSCALE, av[0][1] * QSCALE); w0.y = pk2(av[0][2] * QSCALE, av[0][3] * QSCALE); w0.z = pk2(av[1][0] * QSCALE, av[1][1] * QSCALE); w0.w = pk2(av[1][2] * QSCALE, av[1][3] * QSCALE);
                    w1.x = pk2(bv[0][0] * QSCALE, bv[0][1] * QSCALE); w1.y = pk2(bv[0][2] * QSCALE, bv[0][3] * QSCALE); w1.z = pk2(bv[1][0] * QSCALE, bv[1][1] * QSCALE); w1.w = pk2(bv[1][2] * QSCALE, bv[1][3] * QSCALE);
                    *(u32x4*)qp = w0; *(u32x4*)(qp + 32) = w1;
                } else {
                    bf16* kp = (isv ? VB : KB) + ((size_t)g * MP + rowp) * 256 + wc * 64 + d0;
                    u32x4 w0, w1; w0.x = pk2(av[0][0], av[0][1]); w0.y = pk2(av[0][2], av[0][3]); w0.z = pk2(av[1][0], av[1][1]); w0.w = pk2(av[1][2], av[1][3]);
                    w1.x = pk2(bv[0][0], bv[0][1]); w1.y = pk2(bv[0][2], bv[0][3]); w1.z = pk2(bv[1][0], bv[1][1]); w1.w = pk2(bv[1][2], bv[1][3]);
                    *(u32x4*)kp = w0; *(u32x4*)(kp + 32) = w1;
                    if (ob) { float* o2 = ob + (isv ? 256 : 0) + wc * 64 + d0; *(f32x4*)o2 = av[0]; *(f32x4*)(o2 + 4) = av[1]; *(f32x4*)(o2 + 32) = bv[0]; *(f32x4*)(o2 + 36) = bv[1]; }
                }
            }
    }
};

template <class Epi>
__device__ __forceinline__ void skinny_phase(LAS unsigned char* lds, const bf16* Abuf, const bf16* Bt, int N, int K, const Epi& E, int first, int wave, int lane) {
    const int nroles = (N >> 8) * 8, G = gridDim.x;
    const int fr = lane & 15, fq = lane >> 4;
    LAS float* red = (LAS float*)lds;
    const int rstep = first ? G - first : G;
    for (int role = (int)blockIdx.x - first; role < nroles; role += rstep) {
        if (role < 0) break;
        const int pn = role >> 3, wr = (role >> 2) & 1, wc = role & 3;
        pg8::f32x4 acc[1][2][4][2];
#pragma unroll
        for (int b = 0; b < 2; ++b)
#pragma unroll
            for (int m = 0; m < 4; ++m)
#pragma unroll
                for (int n = 0; n < 2; ++n) acc[0][b][m][n] = (pg8::f32x4){0.f, 0.f, 0.f, 0.f};
        const int kper = K >> 3, k0 = wave * kper;
        const bf16* ap = Abuf + (size_t)(NPROMPT + 64 * wr + fr) * K + k0 + 8 * fq;
        const int r0 = Epi::PERM ? (8 * (fr >> 2) + (fr & 3)) : fr, r1 = Epi::PERM ? r0 + 4 : fr + 16;
        const bf16* bp = Bt + (size_t)(256 * pn + 32 * wc) * K + k0 + 8 * fq;
#pragma unroll 4
        for (int ks = 0; ks < kper; ks += 32) {
            bf16x8 af[4], bf_[2][2];
#pragma unroll
            for (int m = 0; m < 4; ++m) af[m] = *(const bf16x8*)(ap + (size_t)(16 * m) * K + ks);
#pragma unroll
            for (int b = 0; b < 2; ++b) { bf_[b][0] = *(const bf16x8*)(bp + (size_t)(128 * b + r0) * K + ks); bf_[b][1] = *(const bf16x8*)(bp + (size_t)(128 * b + r1) * K + ks); }
#pragma unroll
            for (int b = 0; b < 2; ++b)
#pragma unroll
                for (int m = 0; m < 4; ++m)
#pragma unroll
                    for (int n = 0; n < 2; ++n) acc[0][b][m][n] = __builtin_amdgcn_mfma_f32_16x16x32_bf16(bf_[b][n], af[m], acc[0][b][m][n], 0, 0, 0);
        }
        if (wave != 0) {
#pragma unroll
            for (int b = 0; b < 2; ++b)
#pragma unroll
                for (int m = 0; m < 4; ++m)
#pragma unroll
                    for (int n = 0; n < 2; ++n) *(LAS pg8::f32x4*)(red + ((size_t)((wave - 1) * 16 + b * 8 + m * 2 + n) * 64 + lane) * 4) = acc[0][b][m][n];
        }
        __syncthreads();
        if (wave == 0) {
#pragma unroll 1
            for (int w = 0; w < 7; ++w)
#pragma unroll
                for (int b = 0; b < 2; ++b)
#pragma unroll
                    for (int m = 0; m < 4; ++m)
#pragma unroll
                        for (int n = 0; n < 2; ++n) acc[0][b][m][n] += *(const LAS pg8::f32x4*)(red + ((size_t)(w * 16 + b * 8 + m * 2 + n) * 64 + lane) * 4);
            const pg8::Unit u{64, pn};
            E.template run<1>(acc, u, wr, wc, fr, fq);
        }
        __syncthreads();
    }
}
__device__ __forceinline__ int conv_srcc(int mode, int nb) {
    if (mode == 0) return 32 * nb;
    if (mode == 1) { const int pn = nb >> 3, bj = (nb >> 2) & 1, cb = nb & 3; return bj * 1024 + 128 * pn + 32 * cb; }
    const int pn = nb >> 3, bj = (nb >> 2) & 1, wc = nb & 3; return 256 * pn + 64 * wc + 32 * bj;
}
__device__ __forceinline__ void transpose_item(const float* W, int K, int N, bf16* WT, const float* gain, int mode, LAS float* scr, int item, int lane) {
    const int nblk = N >> 6, kb = item / nblk, nb64 = item % nblk, k0 = 64 * kb;
    const int l16 = lane & 15, srcc = conv_srcc(mode, 2 * nb64 + (l16 >> 3)) + 4 * (l16 & 7);
    f32x4 v[16];
#pragma unroll
    for (int i = 0; i < 16; ++i) { const int kk = 4 * i + (lane >> 4); v[i] = *(const f32x4*)(W + (size_t)(k0 + kk) * N + srcc); }
    if (gain) {
#pragma unroll
        for (int i = 0; i < 16; ++i) { const int kk = 4 * i + (lane >> 4); v[i] = v[i] * gain[k0 + kk]; }
    }
#pragma unroll
    for (int i = 0; i < 16; ++i) { const int kk = 4 * i + (lane >> 4); LAS float* d = scr + kk * 65 + 4 * l16; d[0] = v[i][0]; d[1] = v[i][1]; d[2] = v[i][2]; d[3] = v[i][3]; }
    asm volatile("s_waitcnt lgkmcnt(0)" ::: "memory");
    const int c = lane & 7;
#pragma unroll
    for (int j = 0; j < 8; ++j) { const int n = (lane >> 3) + 8 * j; const LAS float* sp = scr + (8 * c) * 65 + n;
        u32x4 o; o.x = pk2(sp[0 * 65], sp[1 * 65]); o.y = pk2(sp[2 * 65], sp[3 * 65]); o.z = pk2(sp[4 * 65], sp[5 * 65]); o.w = pk2(sp[6 * 65], sp[7 * 65]);
        *(u32x4*)(WT + (size_t)(64 * nb64 + n) * K + k0 + 8 * c) = o; }
    asm volatile("s_waitcnt lgkmcnt(0)" ::: "memory");
}
__device__ __forceinline__ void convert_late(const Args& A, LAS unsigned char* lds, int vw, int NVW, int wave, int lane) {
    unsigned char* ws = A.ws;
    LAS float* scr = (LAS float*)(lds + wave * 16640);
    constexpr int I_UP = 16 * 64, I_DN = 64 * 16, I_O = 16 * 16, NIT = I_O + I_UP + I_DN;
    for (int it = vw; it < NIT; it += NVW) {
        int r = it;
        if (r < I_O) { transpose_item(A.in[21], 1024, 1024, (bf16*)(ws + W_O), nullptr, 0, scr, r, lane); continue; } r -= I_O;
        if (r < I_UP) { transpose_item(A.in[22] + 1024ull * 4096, 1024, 4096, (bf16*)(ws + W_UP1), A.in[8] + 1024, 0, scr, r, lane); continue; } r -= I_UP;
        transpose_item(A.in[23] + 4096ull * 1024, 4096, 1024, (bf16*)(ws + W_DN1), nullptr, 0, scr, r, lane);
    }
}

__device__ __forceinline__ void phase_prologue(const Args& A, LAS unsigned char* lds, int gw, int NGW, int wave, int lane) {
    unsigned char* ws = A.ws;
    LAS float* scr = (LAS float*)(lds + wave * 16640);
    constexpr int I_GLU = 16 * 32, I_UP = 16 * 64, I_DN = 64 * 16, I_Q = 16 * 48, I_KV = 16 * 24;
    constexpr int NIT = I_GLU + I_UP + I_DN + I_Q + I_KV;
    for (int it = gw; it < NIT; it += NGW) {
        int r = it;
        if (r < I_GLU) { transpose_item(A.in[17], 1024, 2048, (bf16*)(ws + W_GLU), nullptr, 1, scr, r, lane); continue; } r -= I_GLU;
        if (r < I_UP) { transpose_item(A.in[22], 1024, 4096, (bf16*)(ws + W_UP0), A.in[8], 0, scr, r, lane); continue; } r -= I_UP;
        if (r < I_DN) { transpose_item(A.in[23], 4096, 1024, (bf16*)(ws + W_DN0), nullptr, 0, scr, r, lane); continue; } r -= I_DN;
        if (r < I_Q) { transpose_item(A.in[20], 1024, 3072, (bf16*)(ws + W_QKV), A.in[7] + 1024, 2, scr, r, lane); continue; } r -= I_Q;
        transpose_item(A.in[19], 1024, 1536, (bf16*)(ws + W_QKV) + 3072ull * 1024, A.in[18], 2, scr, r, lane);
    }
    {
        const float* gmix = A.in[7];
        bf16* HN0 = (bf16*)(ws + WS_HN0);
        for (int row0 = 4 * gw; row0 < MREAL; row0 += 4 * NGW) {
            f32x4 v[4][4]; float ssq[4];
#pragma unroll
            for (int q = 0; q < 4; ++q) { const int row = row0 + q; const float* xr = row < NPROMPT ? A.in[0] + (size_t)row * D : A.in[1] + (size_t)(row - NPROMPT) * D;
#pragma unroll
                for (int j = 0; j < 4; ++j) v[q][j] = *((const f32x4*)xr + lane + 64 * j); }
#pragma unroll
            for (int q = 0; q < 4; ++q) { float sq = 0.f;
#pragma unroll
                for (int j = 0; j < 4; ++j) sq += (v[q][j][0] * v[q][j][0] + v[q][j][1] * v[q][j][1]) + (v[q][j][2] * v[q][j][2] + v[q][j][3] * v[q][j][3]);
                ssq[q] = rsqrtf(wave_sum(sq) * (1.f / D) + EPS); }
#pragma unroll
            for (int j = 0; j < 4; ++j) { const f32x4 gg = *((const f32x4*)gmix + lane + 64 * j);
#pragma unroll
                for (int q = 0; q < 4; ++q) { const float rstd = ssq[q];
                    u32x2 w; w.x = pk2(v[q][j][0] * rstd * gg[0], v[q][j][1] * rstd * gg[1]); w.y = pk2(v[q][j][2] * rstd * gg[2], v[q][j][3] * rstd * gg[3]);
                    *((u32x2*)(HN0 + (size_t)(row0 + q) * D) + lane + 64 * j) = w; } }
        }
    }
    const int gt = gw * 64 + lane, NGT = NGW * 64;
    { float* rs = (float*)(ws + WS_ROWSS); for (int i = gt; i < 4 * MP; i += NGT) rs[i] = 0.f; }
    { float* rc = (float*)(ws + WS_ROPE); float* rsn = rc + 8196 * 32;
      for (int i = gt; i < 8196 * 32; i += NGT) { const int slot = i >> 5, d = i & 31; const float pos = slot < SEQ ? (float)slot : (float)(16384 + (slot - SEQ));
          const float inv = powf(10000.0f, -(float)d / 32.0f); const float ang = pos * inv; rc[i] = cosf(ang); rsn[i] = sinf(ang); } }
    { float* oc = (float*)(ws + WS_ROPE) + 2 * 8196 * 32; float* os = oc + 8 * 32;
      for (int i = gt; i < 8 * 32; i += NGT) { const int oi = i >> 5, d = i & 31; const float pos = (float)(128 * (oi >> 2) + 16 * (oi & 3));
          const float inv = powf(10000.0f, -(float)d / 32.0f); const float ang = pos * inv; oc[i] = cosf(ang); os[i] = sinf(ang); } }
    { float* lam = (float*)(ws + WS_LAM); bf16* BB = (bf16*)(ws + WS_BBAR); bf16* CC = (bf16*)(ws + WS_CC);
      const float *are = A.in[9], *aim = A.in[10], *ldt = A.in[11], *bre = A.in[12], *bim = A.in[13], *cre = A.in[14], *cim = A.in[15];
      for (int i = gt; i < 64 * 64 * 16; i += NGT) {
          const int c = i & 15, p = (i >> 4) & 63, g = i >> 10;
          const float dt = expf(ldt[g]); const float ar = are[g * 64 + p], ai = aim[g * 64 + p];
          const float mag = expf(ar * dt); const float lr = mag * cosf(ai * dt), li = mag * sinf(ai * dt);
          const float den = ar * ar + ai * ai, nr = lr - 1.f, ni = li;
          const float zr = (nr * ar + ni * ai) / den, zi = (ni * ar - nr * ai) / den;
          const float br = bre[(g * 64 + p) * 16 + c], bi = bim[(g * 64 + p) * 16 + c];
          const float bbr = zr * br - zi * bi, bbi = zr * bi + zi * br;
          BB[(g * 128 + p) * 16 + c] = (bf16)(pk2(bbr, 0.f) & 0xffffu);
          BB[(g * 128 + 64 + p) * 16 + c] = (bf16)(pk2(bbi, 0.f) & 0xffffu);
          CC[(g * 16 + c) * 128 + p] = (bf16)(pk2(cre[(g * 16 + c) * 64 + p], 0.f) & 0xffffu);
          CC[(g * 16 + c) * 128 + 64 + p] = (bf16)(pk2(-cim[(g * 16 + c) * 64 + p], 0.f) & 0xffffu);
          if (c == 0) { lam[(g * 64 + p) * 2] = lr; lam[(g * 64 + p) * 2 + 1] = li; }
      } }
}

#define CMUL_ADD(orr, oi, ar_, ai_, br_, bi_, cr_, ci_) do { const float _r = __builtin_fmaf((ar_), (br_), __builtin_fmaf(-(ai_), (bi_), (cr_))); const float _i = __builtin_fmaf((ar_), (bi_), __builtin_fmaf((ai_), (br_), (ci_))); orr = _r; oi = _i; } while (0)
template <bool PASS2>
__device__ __forceinline__ void s5_item(const Args& A, LAS unsigned char* hs, int item, int lane) {
    unsigned char* ws = A.ws;
    const bf16* HN0 = (const bf16*)(ws + WS_HN0);
    const bool samp = item >= 2048;
    const int g = item & 63, ch = samp ? 128 + ((item - 2048) >> 6) : 4 * (item >> 6);
    const int s = lane & 31, hf = lane >> 5;
    bf16x8 Bf[4], Cf[4];
    { const bf16* BB = (const bf16*)(ws + WS_BBAR) + (size_t)g * 128 * 16;
#pragma unroll
      for (int n = 0; n < 4; ++n) Bf[n] = *(const bf16x8*)(BB + (32 * n + s) * 16 + 8 * hf);
      if (PASS2) { const bf16* CC = (const bf16*)(ws + WS_CC) + (size_t)g * 16 * 128;
#pragma unroll
        for (int st = 0; st < 4; ++st) Cf[st] = *(const bf16x8*)(CC + (lane & 15) * 128 + 32 * st + 8 * (lane >> 4)); } }
    const float* lam = (const float*)(ws + WS_LAM) + (size_t)g * 128;
    float lr[2], li[2], l16r[2], l16i[2], l128r[2], l128i[2];
#pragma unroll
    for (int j = 0; j < 2; ++j) { lr[j] = lam[(s + 32 * j) * 2]; li[j] = lam[(s + 32 * j) * 2 + 1];
        float pr = lr[j], pi = li[j];
#pragma unroll
        for (int q = 0; q < 4; ++q) { const float nr = pr * pr - pi * pi, ni = 2.f * pr * pi; pr = nr; pi = ni; }
        l16r[j] = pr; l16i[j] = pi;
#pragma unroll
        for (int q = 0; q < 3; ++q) { const float nr = pr * pr - pi * pi, ni = 2.f * pr * pi; pr = nr; pi = ni; }
        l128r[j] = pr; l128i[j] = pi; }
    float cr[2] = {0.f, 0.f}, ci[2] = {0.f, 0.f};
    const float* E = (const float*)(ws + WS_E);
    if (PASS2) {
        if (samp) { const int n = ch - 128;
#pragma unroll
            for (int j = 0; j < 2; ++j) { cr[j] = A.in[5][((size_t)n * 64 + g) * 64 + s + 32 * j]; ci[j] = A.in[6][((size_t)n * 64 + g) * 64 + s + 32 * j]; } }
        else { const int first = (ch >> 6) << 6;
#pragma unroll 8
            for (int jj = first; jj < ch; ++jj) { const float* e = E + ((size_t)jj * 64 + g) * 128;
#pragma unroll
                for (int j = 0; j < 2; ++j) { const float er = e[j * 32 + s], ei = e[64 + j * 32 + s]; CMUL_ADD(cr[j], ci[j], l128r[j], l128i[j], cr[j], ci[j], er, ei); } } }
    }
    const int nblk = samp ? 1 : 16;
    const int rowbase = samp ? NPROMPT + 4 * (ch - 128) : ch * 128;
    const int tokA = 16 * ((s >> 2) & 1) + 4 * (s >> 3) + (s & 3);
    const float* dsk = A.in[16] + g * 16;
    bf16* Y = (bf16*)(ws + WS_Y);
    bf16x8 afn = *(const bf16x8*)(HN0 + (size_t)(rowbase + tokA) * D + g * 16 + 8 * hf);
    const int uoff = (4 * (lane >> 4)) * D + g * 16 + (lane & 15);
    unsigned short un[8];
    if (PASS2) {
#pragma unroll
        for (int q = 0; q < 8; ++q) un[q] = HN0[(size_t)(rowbase + 16 * (q >> 2) + (q & 3)) * D + uoff];
    }
    for (int blk = 0; blk < nblk; ++blk) {
        const int row0 = rowbase + 32 * blk;
        const bf16x8 af = afn;
        unsigned short uc[8];
        if (PASS2) {
#pragma unroll
            for (int q = 0; q < 8; ++q) uc[q] = un[q];
            if (blk + 1 < nblk) {
#pragma unroll
                for (int q = 0; q < 8; ++q) un[q] = HN0[(size_t)(row0 + 32 + 16 * (q >> 2) + (q & 3)) * D + uoff];
            }
        }
        if (!PASS2 && (blk & 3) == 0) { cr[0] = 0.f; cr[1] = 0.f; ci[0] = 0.f; ci[1] = 0.f; }
        if (blk + 1 < nblk) afn = *(const bf16x8*)(HN0 + (size_t)(row0 + 32 + tokA) * D + g * 16 + 8 * hf);
        f32x16 X[4];
        const f32x16 z16 = {0.f, 0.f, 0.f, 0.f, 0.f, 0.f, 0.f, 0.f, 0.f, 0.f, 0.f, 0.f, 0.f, 0.f, 0.f, 0.f};
#pragma unroll
        for (int n = 0; n < 4; ++n) X[n] = __builtin_amdgcn_mfma_f32_32x32x16_bf16(af, Bf[n], z16, 0, 0, 0);
        float cinr[2], cini[2];
#pragma unroll
        for (int j = 0; j < 2; ++j) {
            float er = 0.f, ei = 0.f;
#pragma unroll
            for (int r = 0; r < 16; ++r) CMUL_ADD(er, ei, lr[j], li[j], er, ei, X[j][r], X[2 + j][r]);
            const float or_ = __shfl_xor(er, 32), oi_ = __shfl_xor(ei, 32);
            const float e0r = hf ? or_ : er, e0i = hf ? oi_ : ei, e1r = hf ? er : or_, e1i = hf ? ei : oi_;
            float mr, mi; CMUL_ADD(mr, mi, l16r[j], l16i[j], cr[j], ci[j], e0r, e0i);
            cinr[j] = hf ? mr : cr[j]; cini[j] = hf ? mi : ci[j];
            CMUL_ADD(cr[j], ci[j], l16r[j], l16i[j], mr, mi, e1r, e1i);
        }
        if (PASS2) {
#pragma unroll
            for (int j = 0; j < 2; ++j) {
                float hr = cinr[j], hi = cini[j];
#pragma unroll
                for (int r = 0; r < 16; ++r) { CMUL_ADD(hr, hi, lr[j], li[j], hr, hi, X[j][r], X[2 + j][r]);
                    X[j][r] = hr; X[2 + j][r] = hi; }
            }
            if (samp && hf == 0) { const int n = ch - 128;
#pragma unroll
                for (int j = 0; j < 2; ++j) { A.out[O_SRES + ((size_t)n * 64 + g) * 64 + s + 32 * j] = X[j][3]; A.out[O_SIMS + ((size_t)n * 64 + g) * 64 + s + 32 * j] = X[2 + j][3]; } }
#pragma unroll
            for (int r = 0; r < 16; ++r) { LAS unsigned short* hp = (LAS unsigned short*)(hs + (16 * hf + r) * 272);
                const unsigned w01 = pk2(X[0][r], X[1][r]), w23 = pk2(X[2][r], X[3][r]);
                hp[s] = (unsigned short)w01; hp[32 + s] = (unsigned short)(w01 >> 16); hp[64 + s] = (unsigned short)w23; hp[96 + s] = (unsigned short)(w23 >> 16); }
            asm volatile("s_waitcnt lgkmcnt(0)" ::: "memory");
#pragma unroll
            for (int tb = 0; tb < 2; ++tb) {
                f32x4 y = {0.f, 0.f, 0.f, 0.f};
#pragma unroll
                for (int st = 0; st < 4; ++st) { const bf16x8 hfrag = *(const LAS bf16x8*)(hs + (16 * tb + (lane & 15)) * 272 + 64 * st + 16 * (lane >> 4));
                    y = __builtin_amdgcn_mfma_f32_16x16x32_bf16(hfrag, Cf[st], y, 0, 0, 0); }
                const int c = lane & 15; const float dk = dsk[c];
#pragma unroll
                for (int j = 0; j < 4; ++j) { const int tk = 16 * tb + 4 * (lane >> 4) + j;
                    if (!samp || tk < 4) { const size_t off = (size_t)(row0 + tk) * D + g * 16 + c;
                        const float v = y[j] + dk * bf2f(uc[4 * tb + j]);
                        const float z = 0.7978845608f * (v + 0.044715f * v * v * v);
                        const float ge = v / (1.f + __expf(-2.f * z));
                        Y[off] = (bf16)(pk2(ge, 0.f) & 0xffffu); } }
            }
            asm volatile("s_waitcnt lgkmcnt(0)" ::: "memory");
        }
        if (!PASS2 && (blk & 3) == 3 && hf == 0) { float* e = (float*)(ws + WS_E) + ((size_t)(ch + (blk >> 2)) * 64 + g) * 128;
#pragma unroll
            for (int j = 0; j < 2; ++j) { e[j * 32 + s] = cr[j]; e[64 + j * 32 + s] = ci[j]; } }
    }
    if (PASS2 && !samp && hf == 0 && ((ch + 3) & 63) == 63) { const int b = ch >> 6;
#pragma unroll
        for (int j = 0; j < 2; ++j) { A.out[O_SREP + ((size_t)b * 64 + g) * 64 + s + 32 * j] = cr[j]; A.out[O_SIMP + ((size_t)b * 64 + g) * 64 + s + 32 * j] = ci[j]; } }
}

typedef short v4i16_t __attribute__((ext_vector_type(4)));
constexpr int KIMG_STRIDE = 144, KIMG_BYTES = 192 * KIMG_STRIDE, VIMG_HALF = 192 * 64, NATT_ITEMS = 3072;
struct AttItem { int g, sh, b, r, u0, kvh; };
__device__ __forceinline__ AttItem att_decode(int bi) {
    AttItem I; I.g = bi >> 10; const int rem = bi & 1023; I.kvh = rem & 3; I.b = (rem >> 2) & 1; const int rq = rem >> 3;
    I.sh = 2 * I.g; const int nqb = 128 >> I.sh; I.r = rq / nqb; I.u0 = 64 * (rq % nqb); return I;
}
template <bool COMBINE, int MODE = 0>
__device__ __forceinline__ void attn_prompt_phase(const Args& A, LAS unsigned char* lds, int tid, int wave, int lane, int item_lo, int item_hi) {
    unsigned char* ws = A.ws;
    const bf16* Q = (const bf16*)(ws + WS_Q); const bf16* KB = (const bf16*)(ws + WS_KB); const bf16* VB = (const bf16*)(ws + WS_VT);
    bf16* OG = (bf16*)(ws + WS_OG); float* LSE = (float*)(ws + WS_LSE);
    const int G = gridDim.x, hh = wave & 3, sub = wave >> 2, n = lane & 31, hf = lane >> 5;
    const int kap = (n & 3) + 4 * ((n >> 3) & 1) + 8 * ((n >> 2) & 1) + 16 * (n >> 4);
    int bi = item_lo + blockIdx.x;
    const int NATT_HI = item_hi;
    if (bi >= NATT_HI) return;
    bf16* AT = (bf16*)(ws + WS_ATT);
    u32x4 pk_[3], pv_[3]; bf16x8 qn[4];
#define ATT_ISSUE_KV(bix) do { const AttItem J = att_decode(bix); const int L_ = SEQ >> J.sh; const size_t pb_ = (size_t)J.g * MP + (size_t)J.b * SEQ + (size_t)J.r * L_; \
        _Pragma("unroll") for (int i = 0; i < 3; ++i) { const int c_ = tid + 512 * i, row_ = c_ >> 3, ch_ = c_ & 7; int u_ = J.u0 - 128 + row_; u_ = u_ < 0 ? 0 : u_; \
            pk_[i] = *(const u32x4*)(KB + (pb_ + u_) * 256 + J.kvh * 64 + 8 * ch_); pv_[i] = *(const u32x4*)(VB + (pb_ + u_) * 256 + J.kvh * 64 + 8 * ch_); } } while (0)
#define ATT_ISSUE_Q(bix) do { const AttItem J = att_decode(bix); const int qrow_ = J.b * SEQ + ((J.u0 + 32 * sub + n) << J.sh) + J.r; \
        _Pragma("unroll") for (int ks = 0; ks < 4; ++ks) qn[ks] = *(const bf16x8*)(Q + (size_t)qrow_ * QW + J.g * 1024 + (4 * J.kvh + hh) * 64 + 16 * ks + 8 * hf); } while (0)
#define ATT_WRITE(bufo) do { _Pragma("unroll") for (int i = 0; i < 3; ++i) { const int c = tid + 512 * i, row = c >> 3, ch = c & 7; \
            *(LAS u32x4*)(lds + (bufo) + row * KIMG_STRIDE + 16 * ch) = pk_[i]; \
            *(LAS u32x4*)(lds + (bufo) + KIMG_BYTES + (ch >> 2) * VIMG_HALF + row * 64 + (ch & 3) * 16) = pv_[i]; } } while (0)
    constexpr int ABUF = KIMG_BYTES + 2 * VIMG_HALF;
    bf16x8 qf[4];
    ATT_ISSUE_KV(bi); ATT_ISSUE_Q(bi);
    ATT_WRITE(0);
#pragma unroll
    for (int ks = 0; ks < 4; ++ks) qf[ks] = qn[ks];
    if (bi + G < NATT_HI) ATT_ISSUE_KV(bi + G);
    asm volatile("s_waitcnt lgkmcnt(0)\n\ts_barrier" ::: "memory");
    int par = 0;
    for (; bi < NATT_HI; bi += G, par ^= 1) {
        const AttItem I = att_decode(bi);
        if (bi + G < NATT_HI) { ATT_WRITE((par ^ 1) * ABUF); ATT_ISSUE_Q(bi + G); }
        if (bi + 2 * G < NATT_HI) ATT_ISSUE_KV(bi + 2 * G);
        const LAS unsigned char* lbuf = lds + par * ABUF;
        const int u0w = I.u0 + 32 * sub;
        const int qrow = I.b * SEQ + ((u0w + n) << I.sh) + I.r;
        const int h = 4 * I.kvh + hh;
        f32x16 O0, O1;
#pragma unroll
        for (int i = 0; i < 16; ++i) { O0[i] = 0.f; O1[i] = 0.f; }
        float mrun = -INFINITY, lrun = 0.f;
        const int cc_ = lane & 7, rr0_ = lane >> 3;
        bf16x8 x1[4], x2[4]; float l1 = 0.f, l2 = 0.f;
        if (COMBINE) {
            l1 = LSE[((size_t)1 * MP + qrow) * 16 + h]; l2 = LSE[((size_t)2 * MP + qrow) * 16 + h];
#pragma unroll
            for (int j = 0; j < 4; ++j) { const int qr_ = I.b * SEQ + ((u0w + rr0_ + 8 * j) << I.sh) + I.r;
                x1[j] = *(const bf16x8*)(OG + ((size_t)1 * MP + qr_) * D + h * 64 + 8 * cc_); x2[j] = *(const bf16x8*)(OG + ((size_t)2 * MP + qr_) * D + h * 64 + 8 * cc_); }
        }
        const int kt0 = (MODE == 1 || MODE == 3) ? 5 : (u0w >= 128 ? 0 : (128 - u0w) >> 5);
        const LAS unsigned char* kimg = lbuf + (32 * sub + kap) * KIMG_STRIDE + 16 * hf;
        const LAS unsigned char* vimg = lbuf + KIMG_BYTES + (32 * sub + 8 * hf + ((lane & 15) >> 2)) * 64 + (16 * ((lane >> 4) & 1) + 4 * (lane & 3)) * 2;
        for (int kt = kt0; kt < 5; ++kt) {
            bf16x8 kf[4], vf[2][2];
#pragma unroll
            for (int ks = 0; ks < 4; ++ks) kf[ks] = *(const LAS bf16x8*)(kimg + (32 * kt) * KIMG_STRIDE + 32 * ks);
#pragma unroll
            for (int mb = 0; mb < 2; ++mb)
#pragma unroll
                for (int st = 0; st < 2; ++st) {
                    const LAS unsigned char* vp = vimg + mb * VIMG_HALF + (32 * kt + 16 * st) * 64;
                    const v4i16_t lo = __builtin_amdgcn_ds_read_tr16_b64_v4i16((LAS v4i16_t*)vp);
                    const v4i16_t hi = __builtin_amdgcn_ds_read_tr16_b64_v4i16((LAS v4i16_t*)(vp + 4 * 64));
                    vf[mb][st] = (bf16x8){lo[0], lo[1], lo[2], lo[3], hi[0], hi[1], hi[2], hi[3]};
                }
            f32x16 S;
#pragma unroll
            for (int i = 0; i < 16; ++i) S[i] = 0.f;
#pragma unroll
            for (int ks = 0; ks < 4; ++ks) S = __builtin_amdgcn_mfma_f32_32x32x16_bf16(kf[ks], qf[ks], S, 0, 0, 0);
            if (kt == 0) {
#pragma unroll
                for (int rr = 0; rr < 16; ++rr) { const int kp = (rr & 7) + 8 * hf + 16 * (rr >> 3); if (kp < n) S[rr] = -INFINITY; }
            } else if (kt == 4) {
#pragma unroll
                for (int rr = 0; rr < 16; ++rr) { const int kp = (rr & 7) + 8 * hf + 16 * (rr >> 3); if (kp > n) S[rr] = -INFINITY; }
            }
            float tm = S[0];
#pragma unroll
            for (int rr = 1; rr < 16; ++rr) tm = fmaxf(tm, S[rr]);
            tm = fmaxf(tm, __shfl_xor(tm, 32));
            const float mnew = fmaxf(mrun, tm);
            const float alpha = __builtin_amdgcn_exp2f(mrun - mnew);
            float ps = 0.f; float p[16];
#pragma unroll
            for (int rr = 0; rr < 16; ++rr) { p[rr] = __builtin_amdgcn_exp2f(S[rr] - mnew); ps += p[rr]; }
            lrun = lrun * alpha + ps; mrun = mnew;
            if (__builtin_amdgcn_ballot_w64(alpha != 1.f) != 0ull) {
#pragma unroll
                for (int i = 0; i < 16; ++i) { O0[i] *= alpha; O1[i] *= alpha; }
            }
#pragma unroll
            for (int st = 0; st < 2; ++st) {
                u32x4 pw; pw.x = pk2(p[8 * st + 0], p[8 * st + 1]); pw.y = pk2(p[8 * st + 2], p[8 * st + 3]); pw.z = pk2(p[8 * st + 4], p[8 * st + 5]); pw.w = pk2(p[8 * st + 6], p[8 * st + 7]);
                const bf16x8 pf = __builtin_bit_cast(bf16x8, pw);
                O0 = __builtin_amdgcn_mfma_f32_32x32x16_bf16(vf[0][st], pf, O0, 0, 0, 0);
                O1 = __builtin_amdgcn_mfma_f32_32x32x16_bf16(vf[1][st], pf, O1, 0, 0, 0);
            }
        }
        const float ltot = lrun + __shfl_xor(lrun, 32);
        LAS unsigned char* ost = lds + 2 * ABUF + wave * 4864;
        float sc0;
        if (!COMBINE) { sc0 = 1.f / ltot; if (hf == 0) LSE[((size_t)I.g * MP + qrow) * 16 + h] = mrun + log2f(ltot); }
        else { const float l0 = mrun + log2f(ltot); const float mx = fmaxf(l0, fmaxf(l1, l2));
            const float w0 = __builtin_amdgcn_exp2f(l0 - mx), w1 = __builtin_amdgcn_exp2f(l1 - mx), w2 = __builtin_amdgcn_exp2f(l2 - mx);
            const float invw = 1.f / (w0 + w1 + w2); sc0 = w0 * invw / ltot;
            if (hf == 0) { LAS float* wp = (LAS float*)(ost + 4608) + 2 * n; wp[0] = w1 * invw; wp[1] = w2 * invw; } }
        if (MODE < 2) {
#pragma unroll
            for (int a = 0; a < 4; ++a) {
                u32x2 w0v, w1v; w0v.x = pk2(O0[4 * a] * sc0, O0[4 * a + 1] * sc0); w0v.y = pk2(O0[4 * a + 2] * sc0, O0[4 * a + 3] * sc0);
                w1v.x = pk2(O1[4 * a] * sc0, O1[4 * a + 1] * sc0); w1v.y = pk2(O1[4 * a + 2] * sc0, O1[4 * a + 3] * sc0);
                *(LAS u32x2*)(ost + n * 144 + (8 * a + 4 * hf) * 2) = w0v; *(LAS u32x2*)(ost + n * 144 + 64 + (8 * a + 4 * hf) * 2) = w1v;
            }
            asm volatile("s_waitcnt lgkmcnt(0)" ::: "memory");
#pragma unroll
            for (int j = 0; j < 4; ++j) { const int rr_ = rr0_ + 8 * j; const int qr_ = I.b * SEQ + ((u0w + rr_) << I.sh) + I.r;
                const bf16x8 tv = *(const LAS bf16x8*)(ost + rr_ * 144 + 16 * cc_);
                if (!COMBINE) *(bf16x8*)(OG + ((size_t)I.g * MP + qr_) * D + h * 64 + 8 * cc_) = tv;
                else { const LAS float* wp = (const LAS float*)(ost + 4608) + 2 * rr_; const float w1 = wp[0], w2 = wp[1];
                    float o[8];
#pragma unroll
                    for (int i = 0; i < 8; ++i) o[i] = bf2f((unsigned short)tv[i]) + w1 * bf2f((unsigned short)x1[j][i]) + w2 * bf2f((unsigned short)x2[j][i]);
                    u32x4 y; y.x = pk2(o[0], o[1]); y.y = pk2(o[2], o[3]); y.z = pk2(o[4], o[5]); y.w = pk2(o[6], o[7]);
                    *(u32x4*)(AT + (size_t)qr_ * D + h * 64 + 8 * cc_) = y; }
            }
        } else { if (ltot == 123.456f) LSE[0] = ltot; }
#pragma unroll
        for (int ks = 0; ks < 4; ++ks) qf[ks] = qn[ks];
        asm volatile("s_waitcnt lgkmcnt(0)\n\ts_barrier" ::: "memory");
    }
#undef ATT_ISSUE_KV
#undef ATT_ISSUE_Q
#undef ATT_WRITE
}

__device__ __forceinline__ void attn_sample_item(const Args& A, LAS float* sl, int it, int lane) {
    unsigned char* ws = A.ws;
    const int h = it & 15, t = (it >> 4) & 3, n = it >> 6, kvh = h >> 2;
    const int row = NPROMPT + 4 * n + t;
    const bf16* Q = (const bf16*)(ws + WS_Q) + (size_t)row * QW + h * 64;
    const int kq = lane >> 2, dq = lane & 3;
    float mxl = -INFINITY;
#pragma unroll 1
    for (int g = 0; g < 3; ++g) {
        const int W = 128 << (2 * g), dil = 1 << (2 * g);
        const float* cache = A.in[2 + g] + (size_t)n * W * 512;
        const float* newkv = A.out + (g == 0 ? O_KVS0 : g == 1 ? O_KVS1 : O_KVS2) + (size_t)n * 4 * 512;
        float q[16];
#pragma unroll
        for (int c8 = 0; c8 < 2; ++c8) { const bf16x8 v = *(const bf16x8*)(Q + g * 1024 + 16 * dq + 8 * c8);
#pragma unroll
            for (int i = 0; i < 8; ++i) q[8 * c8 + i] = bf2f((unsigned short)v[i]); }
#pragma unroll 9
        for (int bt = 0; bt < 9; ++bt) {
            const int j = 16 * bt + kq; const bool valid = j <= 128; const int jj = valid ? j : 128;
            const int idx = W + t - dil * jj;
            const float* kp = (idx >= W ? newkv + (size_t)(idx - W) * 512 : cache + (size_t)idx * 512) + kvh * 64 + 16 * dq;
            float s = 0.f;
#pragma unroll
            for (int c4 = 0; c4 < 4; ++c4) { const f32x4 kv = *(const f32x4*)(kp + 4 * c4); s += q[4 * c4] * kv[0] + q[4 * c4 + 1] * kv[1] + q[4 * c4 + 2] * kv[2] + q[4 * c4 + 3] * kv[3]; }
            s += __shfl_xor(s, 1); s += __shfl_xor(s, 2);
            if (valid && dq == 0) sl[g * 132 + j] = s;
            mxl = fmaxf(mxl, valid ? s : -INFINITY);
        }
    }
    const float mx = wave_max(mxl);
    asm volatile("s_waitcnt lgkmcnt(0)" ::: "memory");
    float sum = 0.f;
#pragma unroll 1
    for (int i = lane; i < 396; i += 64) { const int j = i % 132; if (j <= 128) { const float p = exp2f(sl[i] - mx); sl[i] = p; sum += p; } }
    sum = wave_sum(sum);
    asm volatile("s_waitcnt lgkmcnt(0)" ::: "memory");
    f32x4 acc = {0.f, 0.f, 0.f, 0.f};
    const int ksl = lane >> 4, dq4 = lane & 15;
#pragma unroll 1
    for (int g = 0; g < 3; ++g) {
        const int W = 128 << (2 * g), dil = 1 << (2 * g);
        const float* cache = A.in[2 + g] + (size_t)n * W * 512;
        const float* newkv = A.out + (g == 0 ? O_KVS0 : g == 1 ? O_KVS1 : O_KVS2) + (size_t)n * 4 * 512;
#pragma unroll 33
        for (int jb = 0; jb < 33; ++jb) {
            const int j = 4 * jb + ksl; const bool valid = j <= 128; const int jj = valid ? j : 128;
            const int idx = W + t - dil * jj;
            const float* vp = (idx >= W ? newkv + (size_t)(idx - W) * 512 : cache + (size_t)idx * 512) + 256 + kvh * 64 + 4 * dq4;
            const f32x4 v = *(const f32x4*)vp;
            const float pj = valid ? sl[g * 132 + jj] : 0.f;
            acc += v * pj;
        }
    }
#pragma unroll
    for (int i = 0; i < 4; ++i) { acc[i] += __shfl_xor(acc[i], 16); acc[i] += __shfl_xor(acc[i], 32); }
    bf16* AT = (bf16*)(ws + WS_ATT);
    if (lane < 16) { const float inv = 1.f / sum; u32x2 w; w.x = pk2(acc[0] * inv, acc[1] * inv); w.y = pk2(acc[2] * inv, acc[3] * inv);
        *(u32x2*)(AT + (size_t)row * D + h * 64 + 4 * dq4) = w; }
    asm volatile("s_waitcnt lgkmcnt(0)" ::: "memory");
}

__device__ __forceinline__ void attn_combine(const Args& A, int gt, int NGT) {
    unsigned char* ws = A.ws;
    const bf16* OG = (const bf16*)(ws + WS_OG); const float* LSE = (const float*)(ws + WS_LSE); bf16* AT = (bf16*)(ws + WS_ATT);
    for (int i = gt; i < NPROMPT * 128; i += NGT) {
        const int row = i >> 7, c8 = i & 127, h = c8 >> 3;
        const float l0 = LSE[((size_t)0 * MP + row) * 16 + h], l1 = LSE[((size_t)1 * MP + row) * 16 + h], l2 = LSE[((size_t)2 * MP + row) * 16 + h];
        const float mx = fmaxf(l0, fmaxf(l1, l2));
        float w0 = exp2f(l0 - mx), w1 = exp2f(l1 - mx), w2 = exp2f(l2 - mx); const float inv = 1.f / (w0 + w1 + w2); w0 *= inv; w1 *= inv; w2 *= inv;
        const bf16x8 a = *(const bf16x8*)(OG + ((size_t)0 * MP + row) * D + 8 * c8), b = *(const bf16x8*)(OG + ((size_t)1 * MP + row) * D + 8 * c8), c = *(const bf16x8*)(OG + ((size_t)2 * MP + row) * D + 8 * c8);
        float o[8];
#pragma unroll
        for (int k = 0; k < 8; ++k) o[k] = w0 * bf2f((unsigned short)a[k]) + w1 * bf2f((unsigned short)b[k]) + w2 * bf2f((unsigned short)c[k]);
        u32x4 w; w.x = pk2(o[0], o[1]); w.y = pk2(o[2], o[3]); w.z = pk2(o[4], o[5]); w.w = pk2(o[6], o[7]);
        *(u32x4*)(AT + (size_t)row * D + 8 * c8) = w;
    }
}

#define XB_TMO      128
#define XB_XCNT(j)  (256  + 64 * (j))
#define XB_XSUB(j)  (1280 + 64 * (j))
#define XB_XGEN(j)  (2304 + 64 * (j))
#define XB_TOP      3328
#define XB_TOPGEN   3392
#define XCD_BAR_WORDS 3456
#define XB_SPIN_CAP (1u << 18)

__device__ __forceinline__ unsigned xb_ld(unsigned* p)              { return __hip_atomic_load(p, __ATOMIC_RELAXED, __HIP_MEMORY_SCOPE_AGENT); }
__device__ __forceinline__ unsigned xb_add(unsigned* p, unsigned v) { return __hip_atomic_fetch_add(p, v, __ATOMIC_RELAXED, __HIP_MEMORY_SCOPE_AGENT); }
__device__ __forceinline__ unsigned xb_xcc_id() { return (unsigned)__builtin_amdgcn_s_getreg((3 << 11) | 20) & 0xFu; }
#define XB_SPIN(cond, bar) do { unsigned _sp = 0; while (cond) { __builtin_amdgcn_s_sleep(1); \
    if ((++_sp & 255u) == 0u) { if (xb_ld(&(bar)[XB_TMO])) break; if (_sp > XB_SPIN_CAP) { atomicAdd(&(bar)[XB_TMO], 1u); break; } } } } while (0)

struct XcdBarrier {
    unsigned* bar; unsigned x;
    volatile LAS unsigned* st;
};

__device__ __forceinline__ XcdBarrier xcd_barrier_post(unsigned* bar, volatile LAS unsigned* st) {
    XcdBarrier b; b.bar = bar; b.x = xb_xcc_id(); b.st = st;
    if (threadIdx.x == 0) (void)xb_add(&bar[XB_XCNT(b.x)], 1u);
    return b;
}
__device__ __forceinline__ void xcd_barrier_complete(unsigned* bar, unsigned x, unsigned& nloc, unsigned& nx) {
    const unsigned G = gridDim.x * gridDim.y * gridDim.z;
    unsigned sum, cnt, mine, sp = 0u;
    for (;;) {
        sum = 0u; cnt = 0u; mine = 0u;
#pragma unroll
        for (unsigned j = 0; j < 16; ++j) { const unsigned c = xb_ld(&bar[XB_XCNT(j)]); sum += c; cnt += (c > 0u) ? 1u : 0u; mine = (j == x) ? c : mine; }
        if (sum == G) break;
        __builtin_amdgcn_s_sleep(1);
        if ((++sp & 255u) == 0u) { if (xb_ld(&bar[XB_TMO])) break; if (sp > XB_SPIN_CAP) { atomicAdd(&bar[XB_TMO], 1u); break; } }
    }
    nloc = mine > 0u ? mine : 1u; nx = cnt > 0u ? cnt : 1u;
}

__device__ __forceinline__ void xcd_barrier(const XcdBarrier& b) {
    asm volatile("s_waitcnt vmcnt(0)" ::: "memory");
    __syncthreads();
    if (threadIdx.x == 0) {
        unsigned* bar = b.bar;
        __builtin_amdgcn_s_waitcnt(0);
        unsigned nloc = b.st[0], nx = b.st[1];
        if (nloc == 0u) { xcd_barrier_complete(bar, b.x, nloc, nx); b.st[0] = nloc; b.st[1] = nx; }
        const unsigned old = xb_add(&bar[XB_XSUB(b.x)], 1u);
        const unsigned gen = old / nloc;
        if (old + 1u == (gen + 1u) * nloc) {
            __builtin_amdgcn_fence(__ATOMIC_RELEASE, "agent");
            asm volatile("s_waitcnt vmcnt(0)" ::: "memory");
            const unsigned og = xb_add(&bar[XB_TOP], 1u);
            const unsigned tg = og / nx;
            if (og + 1u == (tg + 1u) * nx) xb_add(&bar[XB_TOPGEN], 1u);
            else XB_SPIN(xb_ld(&bar[XB_TOPGEN]) == tg, bar);
            __builtin_amdgcn_fence(__ATOMIC_ACQUIRE, "agent");
            xb_add(&bar[XB_XGEN(b.x)], 1u);
            asm volatile("s_waitcnt vmcnt(0)" ::: "memory");
        } else {
            XB_SPIN(xb_ld(&bar[XB_XGEN(b.x)]) == gen, bar);
            __builtin_amdgcn_fence(__ATOMIC_ACQUIRE, "agent");
            asm volatile("s_waitcnt vmcnt(0)" ::: "memory");
        }
    }
    __syncthreads();
}

constexpr int NPHASE = 13;
#ifndef REP0
#define REP0 1
#endif
#ifndef REP12
#define REP12 1
#endif
#ifndef REP7
#define REP7 1
#endif
#ifndef REP8
#define REP8 1
#endif
#ifndef REP4
#define REP4 1
#endif
#ifndef REP6
#define REP6 1
#endif
#ifndef DUP4
#define DUP4 0
#endif
#ifndef DUP6
#define DUP6 0
#endif
#ifndef DUP5
#define DUP5 0
#endif
#ifndef PROBE8
#define PROBE8 0
#endif
#ifndef XSYNC
#define XSYNC 0
#endif
__global__ void __launch_bounds__(NTHREADS, 2) yoco_fwd(Args A) {
    extern __shared__ __attribute__((aligned(16))) unsigned char lds_raw[];
    LAS unsigned char* lds = (LAS unsigned char*)lds_raw;
    cg::grid_group grid = cg::this_grid();
    const int tid = threadIdx.x, lane = tid & 63, wave = __builtin_amdgcn_readfirstlane(tid >> 6);
    const int G = gridDim.x, gw = blockIdx.x * NWAVES + wave, NGW = G * NWAVES, gt = gw * 64 + lane, NGT = NGW * 64;
    unsigned char* ws = A.ws;
    float* rowss = (float*)(ws + WS_ROWSS);
    float* Hf = (float*)(ws + WS_H); bf16* HB = (bf16*)(ws + WS_HB);
    const int lo = A.ph_lo, hi = A.ph_hi;
    volatile LAS unsigned* bst = (volatile LAS unsigned*)(lds + LDS_BYTES - 64);
    if (tid < 2) bst[tid] = 0u;
    __syncthreads();
    XcdBarrier xbar = xcd_barrier_post((unsigned*)(ws + WS_BAR), bst);
    if (lo < 0) grid.sync();
#ifndef PH_MASK
#define PH_MASK 0xffff
#endif
#define IN(k) (((PH_MASK >> (k)) & 1) && lo <= (k) && (k) < hi)
#define SEAM(k) do { if (IN(k) && IN((k) + 1)) xcd_barrier(xbar); } while (0)
    if (IN(0)) { for (int rp = 0; rp < REP0; ++rp) phase_prologue(A, lds, gw, NGW, wave, lane); for (int rp = 0; rp < XSYNC; ++rp) xcd_barrier(xbar); }
    SEAM(0);
    if (IN(1)) for (int rp = 0; rp < REP12; ++rp) { for (int it = gw; it < 2048; it += NGW) s5_item<false>(A, lds + wave * 8704, it, lane); }
    SEAM(1);
    if (IN(2)) for (int rp = 0; rp < REP12; ++rp) { for (int it = gw; it < 4096; it += NGW) s5_item<true>(A, lds + wave * 8704, it, lane); }
    SEAM(2);
    if (IN(3)) { pg8::Gemm g{(const bf16*)(ws + WS_Y), (const bf16*)(ws + W_GLU), NPROMPT, 2048, 1024}; pg8::StaticOrder S; S.init(NPROMPT, 2048, G, (int)blockIdx.x);
        EpiGlu E{A.in[0], A.in[1], Hf, HB, rowss};
        pg8::gemm_phase<EpiGlu, pg8::StaticOrder, true, true>(lds, g, S, E);
        skinny_phase(lds, g.A, g.Bt, 2048, 1024, E, 0, wave, lane); }
    SEAM(3);
    if (IN(4)) { pg8::Gemm g{HB, (const bf16*)(ws + W_UP0), NPROMPT, FF, 1024}; pg8::StaticOrder S; S.init(NPROMPT, FF, G, (int)blockIdx.x);
        EpiUp E{(bf16*)(ws + WS_ACT), rowss};
        pg8::gemm_phase<EpiUp, pg8::StaticOrder, true, true>(lds, g, S, E);
        skinny_phase(lds, g.A, g.Bt, FF, 1024, E, 0, wave, lane);
#if DUP4 == 1
        pg8::gemm_phase<EpiUp, pg8::StaticOrder, true, true>(lds, g, S, E);
#endif
#if DUP4 == 3
        { EpiNull E0{(float*)(ws + WS_OG)};
        skinny_phase(lds, g.A, g.Bt, FF, 1024, E0, 0, wave, lane); skinny_phase(lds, g.A, g.Bt, FF, 1024, E0, 0, wave, lane);
        skinny_phase(lds, g.A, g.Bt, FF, 1024, E0, 0, wave, lane); skinny_phase(lds, g.A, g.Bt, FF, 1024, E0, 0, wave, lane); }
#endif
#if DUP4 == 2
        skinny_phase(lds, g.A, g.Bt, FF, 1024, E, 0, wave, lane);
        skinny_phase(lds, g.A, g.Bt, FF, 1024, E, 0, wave, lane);
        skinny_phase(lds, g.A, g.Bt, FF, 1024, E, 0, wave, lane);
        skinny_phase(lds, g.A, g.Bt, FF, 1024, E, 0, wave, lane);
#endif
    }
    SEAM(4);
    if (IN(5)) { pg8::Gemm g{(const bf16*)(ws + WS_ACT), (const bf16*)(ws + W_DN0), NPROMPT, 1024, FF}; pg8::StaticOrder S; S.init(NPROMPT, 1024, G, (int)blockIdx.x);
        EpiRes E{HB, nullptr, rowss + MP};
        pg8::gemm_phase<EpiRes, pg8::StaticOrder, true, true>(lds, g, S, E);
        skinny_phase(lds, g.A, g.Bt, 1024, FF, E, 0, wave, lane);
#if DUP5 == 2
        { EpiUp E2{(bf16*)(ws + WS_OG), rowss}; pg8::gemm_phase<EpiUp, pg8::StaticOrder, true, true>(lds, g, S, E2); }
#endif
    }
    SEAM(5);
    if (IN(6)) { pg8::Gemm g{HB, (const bf16*)(ws + W_QKV), NPROMPT, NQKV, 1024}; pg8::StaticOrder S; S.init(NPROMPT, NQKV, G, (int)blockIdx.x);
        EpiQKV E{(bf16*)(ws + WS_Q), (bf16*)(ws + WS_KB), (bf16*)(ws + WS_VT), A.out, rowss + MP, (const float*)(ws + WS_ROPE), (const float*)(ws + WS_ROPE) + 8196 * 32, (const float*)(ws + WS_ROPE) + 2 * 8196 * 32, (const float*)(ws + WS_ROPE) + 2 * 8196 * 32 + 8 * 32};
        pg8::gemm_phase<EpiQKV, pg8::StaticOrder, true, true>(lds, g, S, E);
        skinny_phase(lds, g.A, g.Bt, NQKV, 1024, E, G >= 256 ? 128 : 0, wave, lane);
        { const int cf = G >= 256 ? 128 : 0; if ((int)blockIdx.x >= cf) convert_late(A, lds, ((int)blockIdx.x - cf) * NWAVES + wave, (G - cf) * NWAVES, wave, lane); }
#if DUP6 == 1
        pg8::gemm_phase<EpiQKV, pg8::StaticOrder, true, true>(lds, g, S, E);
#endif
#if DUP6 == 2
        { EpiUp E2{(bf16*)(ws + WS_OG), rowss + MP}; pg8::gemm_phase<EpiUp, pg8::StaticOrder, true, true>(lds, g, S, E2); }
#endif
    }
    SEAM(6);
    if (IN(7)) for (int rp = 0; rp < REP7; ++rp) {
        for (int it = gw; it < 2048; it += NGW) attn_sample_item(A, (LAS float*)(lds + 65536 + wave * 2048), it, lane);
        __syncthreads();
        attn_prompt_phase<false>(A, lds, tid, wave, lane, 1024, NATT_ITEMS);
    }
    SEAM(7);
    if (IN(8)) {
#if PROBE8 > 0
        attn_prompt_phase<true, PROBE8>(A, lds, tid, wave, lane, 0, 1024); __syncthreads();
#endif
        attn_prompt_phase<true>(A, lds, tid, wave, lane, 0, 1024); }
    SEAM(8);
    if (IN(9)) { pg8::Gemm g{(const bf16*)(ws + WS_ATT), (const bf16*)(ws + W_O), NPROMPT, 1024, 1024}; pg8::StaticOrder S; S.init(NPROMPT, 1024, G, (int)blockIdx.x);
        EpiRes E{HB, nullptr, rowss + 2 * MP};
        pg8::gemm_phase<EpiRes, pg8::StaticOrder, true, true>(lds, g, S, E);
        skinny_phase(lds, g.A, g.Bt, 1024, 1024, E, 0, wave, lane); }
    SEAM(9);
    if (IN(10)) { pg8::Gemm g{HB, (const bf16*)(ws + W_UP1), NPROMPT, FF, 1024}; pg8::StaticOrder S; S.init(NPROMPT, FF, G, (int)blockIdx.x);
        EpiUp E{(bf16*)(ws + WS_ACT), rowss + 2 * MP};
        pg8::gemm_phase<EpiUp, pg8::StaticOrder, true, true>(lds, g, S, E);
        skinny_phase(lds, g.A, g.Bt, FF, 1024, E, 0, wave, lane); }
    SEAM(10);
    if (IN(11)) { pg8::Gemm g{(const bf16*)(ws + WS_ACT), (const bf16*)(ws + W_DN1), NPROMPT, 1024, FF}; pg8::StaticOrder S; S.init(NPROMPT, 1024, G, (int)blockIdx.x);
        EpiRes E{HB, nullptr, rowss + 3 * MP};
        pg8::gemm_phase<EpiRes, pg8::StaticOrder, true, true>(lds, g, S, E);
        skinny_phase(lds, g.A, g.Bt, 1024, FF, E, 0, wave, lane); }
    SEAM(11);
    if (IN(12)) {
        const float* gfin = A.in[24];
        for (int row0 = 4 * gw; row0 < MREAL; row0 += 4 * NGW) {
            bf16x8 hv[4][2]; float rs[4];
#pragma unroll
            for (int q = 0; q < 4; ++q) { rs[q] = rowss[3 * MP + row0 + q];
#pragma unroll
                for (int j = 0; j < 2; ++j) hv[q][j] = *((const bf16x8*)(HB + (size_t)(row0 + q) * D) + lane + 64 * j); }
#pragma unroll
            for (int j = 0; j < 2; ++j) { const f32x4 g0 = *((const f32x4*)gfin + 2 * (lane + 64 * j)), g1 = *((const f32x4*)gfin + 2 * (lane + 64 * j) + 1);
#pragma unroll
                for (int q = 0; q < 4; ++q) { const float rstd = rsqrtf(rs[q] * (1.f / D) + EPS); float* orow = A.out + (size_t)(row0 + q) * D;
                    f32x4 o0, o1;
#pragma unroll
                    for (int i = 0; i < 4; ++i) { o0[i] = bf2f((unsigned short)hv[q][j][i]) * rstd * g0[i]; o1[i] = bf2f((unsigned short)hv[q][j][4 + i]) * rstd * g1[i]; }
                    *((f32x4*)orow + 2 * (lane + 64 * j)) = o0; *((f32x4*)orow + 2 * (lane + 64 * j) + 1) = o1; } }
        }
    }
#undef IN
#undef SEAM
}

#ifndef N_LAUNCHES
#define N_LAUNCHES 1
#endif
extern "C" void kernel_launch(void* const* d_in, const int* in_sizes, int n_in, void* d_out, int out_size, void* d_ws, size_t ws_size, hipStream_t stream) {
    static int grid = 0;
    if (grid == 0) {
        if (n_in != 25 || ws_size < WS_END) { fprintf(stderr, "kernel_launch: unexpected n_in %d / ws %zu\n", n_in, ws_size); grid = -1; return; }
        int dev = 0, cus = 0, per_cu = 0;
        hipGetDevice(&dev); hipDeviceGetAttribute(&cus, hipDeviceAttributeMultiprocessorCount, dev);
        if (hipFuncSetAttribute((const void*)yoco_fwd, hipFuncAttributeMaxDynamicSharedMemorySize, LDS_BYTES) != hipSuccess) { fprintf(stderr, "hipFuncSetAttribute failed\n"); grid = -1; return; }
        hipOccupancyMaxActiveBlocksPerMultiprocessor(&per_cu, (const void*)yoco_fwd, NTHREADS, LDS_BYTES);
        (void)hipGetLastError();
        if (per_cu < 1) per_cu = 1;
        grid = cus * per_cu;
    }
    if (grid < 0) return;
    Args a{};
    for (int i = 0; i < 25; ++i) a.in[i] = (const float*)d_in[i];
    a.out = (float*)d_out; a.ws = (unsigned char*)d_ws;
    if (hipMemsetAsync((char*)d_ws + WS_BAR, 0, 16384, stream) != hipSuccess) { fprintf(stderr, "memset failed\n"); return; }
    if (N_LAUNCHES == 1) {
        a.ph_lo = 0; a.ph_hi = NPHASE;
        void* args[] = {&a};
        hipError_t e = hipLaunchCooperativeKernel((const void*)yoco_fwd, dim3(grid), dim3(NTHREADS), args, LDS_BYTES, stream);
        if (e != hipSuccess) fprintf(stderr, "cooperative launch failed: %s (grid %d)\n", hipGetErrorString(e), grid);
    } else {
        for (int p = 0; p < NPHASE; ++p) { a.ph_lo = p; a.ph_hi = p + 1; hipLaunchKernelGGL(yoco_fwd, dim3(grid), dim3(NTHREADS), LDS_BYTES, stream, a); }
    }
}
```

```cpp
#include <hip/hip_runtime.h>
#include <hip/hip_cooperative_groups.h>
#include <cstdio>
#include <cstdint>
#include <cmath>
namespace cg = cooperative_groups;
namespace pg8 {
#define PG8_LAS __attribute__((address_space(3)))
typedef unsigned short bf16_t;
typedef short bf16x8 __attribute__((ext_vector_type(8)));
typedef float f32x4 __attribute__((ext_vector_type(4)));
typedef unsigned u32x4 __attribute__((ext_vector_type(4)));
constexpr int BM = 256, BK = 64, HALF = 128, HTB = HALF * BK * 2  , STAGE_BYTES = 8 * HTB, NXCD = 8, WGM = 8;

__host__ __device__ __forceinline__ int lds_byte(int r, int c) { const int st = (r >> 4) * 2 + (c >> 5), rr = r & 15, cc = c & 31, ob = rr * 64 + cc * 2; return st * 1024 + (ob ^ (((ob >> 9) & 1) << 5)); }
__host__ __device__ __forceinline__ void stage_rc(int b, int& R, int& C) { const int st = b / 1024, sb = b % 1024, swz = sb ^ (((sb >> 9) & 1) << 5); R = (st >> 1) * 16 + swz / 64; C = (st & 1) * 32 + (swz % 64) / 2; }
__host__ __device__ __forceinline__ int perm32(int rho) { const int n = rho >> 4, i = rho & 15; return 8 * (i >> 2) + 4 * n + (i & 3); }

struct Unit { int pm, pn; };
struct Gemm { const bf16_t* A; const bf16_t* Bt; int M, N, K; };

struct StaticOrder {
    int nM, nN, nwg, G, c;
    __host__ __device__ void init(int M, int N, int G_, int c_) { nM = M / BM; nN = N / BM; nwg = nM * nN; G = G_; c = c_; }
    __host__ __device__ bool next(int i, Unit& u) const {
        const long L = (long)i * G + c; if (L >= nwg) return false;
        int wgid = (int)L; { const int q = nwg / NXCD, r = nwg % NXCD, xcd = wgid % NXCD, off = wgid / NXCD; wgid = (xcd < r ? xcd * (q + 1) : r * (q + 1) + (xcd - r) * q) + off; }
        const int nig = WGM * nN, gid = wgid / nig, fm = gid * WGM, gsz = (nM - fm) < WGM ? (nM - fm) : WGM;
        u.pm = fm + ((wgid % nig) % gsz); u.pn = (wgid % nig) / gsz; return true;
    }
    __device__ __forceinline__ void a_ready(const Unit&) const {}
    __device__ __forceinline__ void done(const Unit&) const {}
};

__device__ __forceinline__ unsigned cvt_pk_bf16(float lo, float hi) { unsigned r; asm volatile("v_cvt_pk_bf16_f32 %0, %1, %2" : "=v"(r) : "v"(lo), "v"(hi)); return r; }
typedef float f32x2 __attribute__((ext_vector_type(2)));
__device__ __forceinline__ f32x2 gelu_pk(f32x2 v) {
    const f32x2 av = __builtin_elementwise_abs(v), d = av * 0.2316418882f + 1.0f;
    f32x2 t; t.x = __builtin_amdgcn_rcpf(d.x); t.y = __builtin_amdgcn_rcpf(d.y);
    f32x2 q = t * 0.5307027145f + (-0.7265760135f); q = q * t + 0.7107068705f; q = q * t + (-0.142248368f); q = q * t + 0.127414796f; q = q * t;
    const f32x2 s = (v * v) * (-0.72134752044f);
    f32x2 e; e.x = __builtin_amdgcn_exp2f(s.x); e.y = __builtin_amdgcn_exp2f(s.y);
    const f32x2 m = v * (q * e), r = v - m;
    f32x2 o; o.x = v.x < 0.f ? m.x : r.x; o.y = v.y < 0.f ? m.y : r.y; return o;
}


template <class Epi, class Sched, bool ALIGN_EPI = false, bool SP2 = false>
__device__ __forceinline__ void gemm_phase(PG8_LAS unsigned char* lds, const Gemm g, const Sched& S, const Epi& E) {
    const int tid = threadIdx.x, wid = __builtin_amdgcn_readfirstlane(tid >> 6), lane = tid & 63, wr = wid >> 2, wc = wid & 3, fr = lane & 15, fq = lane >> 4;
    const int K = g.K, nt = K / BK;
    unsigned voffA[2], voffB[2];
#pragma unroll
    for (int i = 0; i < 2; ++i) { int R, C; stage_rc(tid * 16 + i * 8192, R, C); const int Rb = Epi::PERM ? ((R & ~31) + perm32(R & 31)) : R;
        voffA[i] = (unsigned)(R * K + C) * 2u; voffB[i] = (unsigned)(Rb * K + C) * 2u; }
    const size_t kstep = (size_t)(BK * 2);
    const size_t hstep = (size_t)HALF * K * 2;
    const size_t tstep = 2 * hstep;
    const unsigned ldsw = (unsigned)wid * 1024u;
    const int aoff = lds_byte(wr * 64 + fr, fq * 8), boff = lds_byte(wc * 32 + fr, fq * 8);
#define PG8_SA(b, h) (((b) * 2 + (h)) * HTB)
#define PG8_SB(b, h) ((4 + (b) * 2 + (h)) * HTB)
#define PG8_STAGE(bufoff, gbase, voff) do { _Pragma("unroll") for (int _i = 0; _i < 2; ++_i) \
        __builtin_amdgcn_global_load_lds((const unsigned*)((const char*)(gbase) + (voff)[_i]), (PG8_LAS unsigned*)(lds + (bufoff) + ldsw + _i * 8192), 16, 0, 0); } while (0)
#define PG8_LDA(dst, b, h) do { _Pragma("unroll") for (int m = 0; m < 4; ++m) _Pragma("unroll") for (int k = 0; k < 2; ++k) dst[m][k] = *(const PG8_LAS bf16x8*)(lds + PG8_SA(b, h) + aoff + m * 2048 + k * 1024); } while (0)
#define PG8_LDB(dst, b, h) do { _Pragma("unroll") for (int n = 0; n < 2; ++n) _Pragma("unroll") for (int k = 0; k < 2; ++k) dst[n][k] = *(const PG8_LAS bf16x8*)(lds + PG8_SB(b, h) + boff + n * 2048 + k * 1024); } while (0)
#define PG8_MMA(ai, bj, At, Bt) do { __builtin_amdgcn_s_setprio(1); _Pragma("unroll") for (int m = 0; m < 4; ++m) _Pragma("unroll") for (int n = 0; n < 2; ++n) _Pragma("unroll") for (int k = 0; k < 2; ++k) \
        acc[ai][bj][m][n] = __builtin_amdgcn_mfma_f32_16x16x32_bf16(Bt[n][k], At[m][k], acc[ai][bj][m][n], 0, 0, 0); __builtin_amdgcn_s_setprio(0); } while (0)
#define PG8_WAIT_V(n) asm volatile("s_waitcnt vmcnt(" #n ")" ::: "memory")
#define PG8_WAIT_L(n) asm volatile("s_waitcnt lgkmcnt(" #n ")" ::: "memory")
#define PG8_BAR __builtin_amdgcn_s_barrier()
#define PG8_SCHED __builtin_amdgcn_sched_barrier(0)
    Unit cur, nxt; int ui = 0;
    if (!S.next(0, cur)) return;
    f32x4 acc[2][2][4][2];
#pragma unroll
    for (int a = 0; a < 2; ++a)
#pragma unroll
        for (int b = 0; b < 2; ++b)
#pragma unroll
            for (int m = 0; m < 4; ++m)
#pragma unroll
                for (int n = 0; n < 2; ++n) acc[a][b][m][n] = (f32x4){0.f, 0.f, 0.f, 0.f};
    bf16x8 At[4][2], B0[2][2], B1[2][2];
    const char* cA = (const char*)g.A + (size_t)cur.pm * tstep; const char* cB = (const char*)g.Bt + (size_t)cur.pn * tstep;
    S.a_ready(cur);
    if constexpr (SP2) {
        PG8_STAGE(PG8_SB(0, 0), cB, voffB); PG8_STAGE(PG8_SB(0, 1), cB + hstep, voffB); PG8_STAGE(PG8_SA(0, 0), cA, voffA); PG8_STAGE(PG8_SA(0, 1), cA + hstep, voffA);
        if (wr == 1) PG8_BAR;
        PG8_WAIT_V(2); PG8_BAR;
        PG8_STAGE(PG8_SB(1, 0), cB + kstep, voffB); PG8_STAGE(PG8_SA(1, 0), cA + kstep, voffA); PG8_STAGE(PG8_SB(1, 1), cB + hstep + kstep, voffB);
        PG8_WAIT_V(6); PG8_BAR;
    } else {
        PG8_STAGE(PG8_SB(0, 0), cB, voffB); PG8_STAGE(PG8_SA(0, 0), cA, voffA); PG8_STAGE(PG8_SB(0, 1), cB + hstep, voffB); PG8_STAGE(PG8_SA(0, 1), cA + hstep, voffA);
        if (wr == 1) PG8_BAR;
        PG8_WAIT_V(4); PG8_BAR;
        PG8_STAGE(PG8_SB(1, 0), cB + kstep, voffB); PG8_STAGE(PG8_SA(1, 0), cA + kstep, voffA); PG8_STAGE(PG8_SB(1, 1), cB + hstep + kstep, voffB);
        PG8_WAIT_V(6); PG8_BAR;
    }
    for (;;) {
        const bool has_next = S.next(ui + 1, nxt);
        const char* nA = has_next ? (const char*)g.A + (size_t)nxt.pm * tstep : cA; const char* nB = has_next ? (const char*)g.Bt + (size_t)nxt.pn * tstep : cB;
        for (int t = 0; t < nt; t += 2) {
            const bool last = (t == nt - 2);
            const char* a1 = cA + (size_t)(t + 1) * kstep;
            const char* a2 = last ? nA : cA + (size_t)(t + 2) * kstep; const char* b2 = last ? nB : cB + (size_t)(t + 2) * kstep;
            const char* a3 = a2 + kstep; const char* b3 = b2 + kstep;
            if (last && has_next) S.a_ready(nxt);
            if constexpr (SP2) {
            PG8_LDB(B0, 0, 0); PG8_LDB(B1, 0, 1); PG8_SCHED; PG8_LDA(At, 0, 0); PG8_STAGE(PG8_SA(1, 1), a1 + hstep, voffA);
            PG8_WAIT_V(8); PG8_WAIT_L(0); PG8_BAR; PG8_MMA(0, 0, At, B0); PG8_MMA(0, 1, At, B1); PG8_BAR; PG8_SCHED;
            PG8_LDA(At, 0, 1); PG8_STAGE(PG8_SB(0, 0), b2, voffB); PG8_STAGE(PG8_SB(0, 1), b2 + hstep, voffB); PG8_STAGE(PG8_SA(0, 0), a2, voffA);
            PG8_WAIT_V(8); PG8_WAIT_L(0); PG8_BAR; PG8_MMA(1, 0, At, B0); PG8_MMA(1, 1, At, B1); PG8_BAR; PG8_SCHED;
            PG8_LDB(B0, 1, 0); PG8_LDB(B1, 1, 1); PG8_SCHED; PG8_LDA(At, 1, 0); PG8_STAGE(PG8_SA(0, 1), a2 + hstep, voffA);
            PG8_WAIT_V(8); PG8_WAIT_L(0); PG8_BAR; PG8_MMA(0, 0, At, B0); PG8_MMA(0, 1, At, B1); PG8_BAR; PG8_SCHED;
            PG8_LDA(At, 1, 1); PG8_STAGE(PG8_SB(1, 0), b3, voffB); PG8_STAGE(PG8_SB(1, 1), b3 + hstep, voffB); PG8_STAGE(PG8_SA(1, 0), a3, voffA);
            PG8_WAIT_V(8); PG8_WAIT_L(0); PG8_BAR; PG8_MMA(1, 0, At, B0); PG8_MMA(1, 1, At, B1); PG8_BAR; PG8_SCHED;
            } else {
            PG8_LDB(B0, 0, 0); PG8_SCHED; PG8_LDA(At, 0, 0); PG8_STAGE(PG8_SA(1, 1), a1 + hstep, voffA);
            PG8_WAIT_L(8); PG8_BAR; PG8_WAIT_L(0); PG8_MMA(0, 0, At, B0); PG8_BAR; PG8_SCHED;
            PG8_LDB(B1, 0, 1); PG8_STAGE(PG8_SB(0, 0), b2, voffB);
            PG8_BAR; PG8_WAIT_L(0); PG8_MMA(0, 1, At, B1); PG8_BAR;
            PG8_LDA(At, 0, 1); PG8_STAGE(PG8_SA(0, 0), a2, voffA);
            PG8_BAR; PG8_WAIT_L(0); PG8_MMA(1, 0, At, B0); PG8_BAR; PG8_SCHED;
            PG8_STAGE(PG8_SB(0, 1), b2 + hstep, voffB);
            PG8_WAIT_V(6); PG8_BAR; PG8_MMA(1, 1, At, B1); PG8_BAR;
            PG8_LDB(B0, 1, 0); PG8_SCHED; PG8_LDA(At, 1, 0); PG8_STAGE(PG8_SA(0, 1), a2 + hstep, voffA);
            PG8_WAIT_L(8); PG8_BAR; PG8_WAIT_L(0); PG8_MMA(0, 0, At, B0); PG8_BAR; PG8_SCHED;
            PG8_LDB(B1, 1, 1); PG8_STAGE(PG8_SB(1, 0), b3, voffB);
            PG8_BAR; PG8_WAIT_L(0); PG8_MMA(0, 1, At, B1); PG8_BAR;
            PG8_LDA(At, 1, 1); PG8_STAGE(PG8_SA(1, 0), a3, voffA);
            PG8_BAR; PG8_WAIT_L(0); PG8_MMA(1, 0, At, B0); PG8_BAR; PG8_SCHED;
            PG8_STAGE(PG8_SB(1, 1), b3 + hstep, voffB);
            PG8_WAIT_V(6); PG8_BAR; PG8_MMA(1, 1, At, B1); PG8_BAR;
            }
        }
        if constexpr (ALIGN_EPI) { if (wr == 0) PG8_BAR; }
        if constexpr (!Epi::AFTER_DRAIN) { E(acc, cur, wr, wc, fr, fq); S.done(cur); }
        if (!has_next) break;
#pragma unroll
        for (int a = 0; a < 2; ++a)
#pragma unroll
            for (int b = 0; b < 2; ++b)
#pragma unroll
                for (int m = 0; m < 4; ++m)
#pragma unroll
                    for (int n = 0; n < 2; ++n) acc[a][b][m][n] = (f32x4){0.f, 0.f, 0.f, 0.f};
        cur = nxt; cA = nA; cB = nB; ++ui;
        if constexpr (ALIGN_EPI) { if (wr == 1) PG8_BAR; }
    }
    PG8_WAIT_V(0);
    if constexpr (!ALIGN_EPI) { if (wr == 0) PG8_BAR; }
    PG8_BAR;
    if constexpr (Epi::AFTER_DRAIN) { E.fused(acc, cur, wr, wc, fr, fq, lds, wid, lane); S.done(cur); }
#undef PG8_SA
#undef PG8_SB
#undef PG8_STAGE
#undef PG8_LDA
#undef PG8_LDB
#undef PG8_MMA
#undef PG8_WAIT_V
#undef PG8_WAIT_L
#undef PG8_BAR
#undef PG8_SCHED
}
}

#define LAS __attribute__((address_space(3)))
typedef unsigned short bf16;
typedef short bf16x8 __attribute__((ext_vector_type(8)));
typedef float f32x4 __attribute__((ext_vector_type(4)));
typedef float f32x16 __attribute__((ext_vector_type(16)));
typedef unsigned u32x4 __attribute__((ext_vector_type(4)));
typedef unsigned u32x2 __attribute__((ext_vector_type(2)));
typedef float f32x2_t __attribute__((ext_vector_type(2)));
typedef __bf16 bf16x2_t __attribute__((ext_vector_type(2)));

constexpr int NWAVES = 8, NTHREADS = 512;
constexpr int D = 1024, SEQ = 8192, NPROMPT = 16384, NSAMP = 128, MREAL = NPROMPT + NSAMP, MP = 16640;
constexpr int FF = 4096, QW = 3072, KVW = 1536, NQKV = QW + KVW;
constexpr float EPS = 1e-6f;
constexpr float QSCALE = 0.125f * 1.4426950408889634f;
constexpr int LDS_BYTES = 147456;

constexpr size_t MiB = 1u << 20;
constexpr size_t WS_ROWSS = 0;
constexpr size_t WS_BAR = 384 * 1024;
constexpr size_t WS_LAM = 512 * 1024;
constexpr size_t WS_BBAR = 576 * 1024;
constexpr size_t WS_CC = 1 * MiB;
constexpr size_t WS_ROPE = 1536 * 1024;
constexpr size_t WS_E = 3840 * 1024;
constexpr size_t WS_W = 8 * MiB;
constexpr size_t W_GLU = WS_W, W_UP0 = W_GLU + 2048ull * 1024 * 2, W_DN0 = W_UP0 + 4096ull * 1024 * 2, W_QKV = W_DN0 + 4096ull * 1024 * 2,
                 W_O = W_QKV + (size_t)NQKV * 1024 * 2, W_UP1 = W_O + 1024ull * 1024 * 2, W_DN1 = W_UP1 + 4096ull * 1024 * 2, W_END = W_DN1 + 4096ull * 1024 * 2;
static_assert(W_END <= 56 * MiB, "weights");
constexpr size_t WS_H = 56 * MiB;
constexpr size_t WS_HB = 121 * MiB;
constexpr size_t WS_HN0 = 154 * MiB;
constexpr size_t WS_VT = WS_HN0;
constexpr size_t WS_Y = 187 * MiB;
constexpr size_t WS_ATT = WS_Y;
constexpr size_t WS_ACT = 220 * MiB;
constexpr size_t WS_Q = WS_ACT;
constexpr size_t WS_KB = WS_Q + (size_t)MP * QW * 2;
static_assert(WS_KB + 3ull * MP * 256 * 2 <= 350 * MiB, "q/k overlay");
constexpr size_t WS_OG = 350 * MiB;
constexpr size_t WS_LSE = 448 * MiB;
constexpr size_t WS_END = 452 * MiB;

constexpr size_t O_YP = 0, O_YS = 16777216, O_KVP0 = 16908288, O_KVP1 = 17039360, O_KVP2 = 17563648,
                 O_KVS0 = 19660800, O_KVS1 = 19726336, O_KVS2 = 19791872, O_SREP = 19857408, O_SIMP = 19865600, O_SRES = 19873792, O_SIMS = 20004864;

__device__ __forceinline__ unsigned pk2(float lo, float hi) { f32x2_t v = {lo, hi}; bf16x2_t b = __builtin_convertvector(v, bf16x2_t); return __builtin_bit_cast(unsigned, b); }
__device__ __forceinline__ float bf2f(unsigned short u) { return __uint_as_float(((unsigned)u) << 16); }
__device__ __forceinline__ float wave_sum(float v) {
#pragma unroll
    for (int o = 1; o < 64; o <<= 1) v += __shfl_xor(v, o);
    return v;
}
__device__ __forceinline__ float wave_max(float v) {
#pragma unroll
    for (int o = 1; o < 64; o <<= 1) v = fmaxf(v, __shfl_xor(v, o));
    return v;
}

struct Args { const float* in[25]; float* out; unsigned char* ws; int ph_lo, ph_hi; };

struct EpiGlu {
    static constexpr bool PERM = true, AFTER_DRAIN = false;
    const float* xp; const float* xs; float* H; bf16* HB; float* rowss;
    __device__ __forceinline__ void operator()(const pg8::f32x4 (&acc)[2][2][4][2], const pg8::Unit& u, int wr, int wc, int fr, int fq) const { run<2>(acc, u, wr, wc, fr, fq); }
    template <int NAI> __device__ __forceinline__ void run(const pg8::f32x4 (&acc)[NAI][2][4][2], const pg8::Unit& u, int wr, int wc, int fr, int fq) const {
        const int col = u.pn * 128 + wc * 32 + 8 * fq;
#pragma unroll
        for (int ai = 0; ai < NAI; ++ai)
#pragma unroll
            for (int m = 0; m < 4; ++m) {
                const int row = u.pm * 256 + ai * 128 + wr * 64 + m * 16 + fr;
                if (row < MREAL) {
                    const float* xr = (row < NPROMPT ? xp + (size_t)row * D : xs + (size_t)(row - NPROMPT) * D) + col;
                    const f32x4 x0 = *(const f32x4*)xr, x1 = *(const f32x4*)(xr + 4);
                    f32x4 h0, h1;
#pragma unroll
                    for (int i = 0; i < 4; ++i) {
                        h0[i] = x0[i] + acc[ai][0][m][0][i] / (1.f + __expf(-acc[ai][1][m][0][i]));
                        h1[i] = x1[i] + acc[ai][0][m][1][i] / (1.f + __expf(-acc[ai][1][m][1][i]));
                    }
                    u32x4 w; w.x = pk2(h0[0], h0[1]); w.y = pk2(h0[2], h0[3]); w.z = pk2(h1[0], h1[1]); w.w = pk2(h1[2], h1[3]);
                    *(u32x4*)(HB + (size_t)row * D + col) = w;
                    float ss = (h0[0] * h0[0] + h0[1] * h0[1]) + (h0[2] * h0[2] + h0[3] * h0[3]) + (h1[0] * h1[0] + h1[1] * h1[1]) + (h1[2] * h1[2] + h1[3] * h1[3]);
                    ss += __shfl_xor(ss, 16); ss += __shfl_xor(ss, 32);
                    if (fq == 0) __hip_atomic_fetch_add(rowss + row, ss, __ATOMIC_RELAXED, __HIP_MEMORY_SCOPE_AGENT);
                } else { float ss = 0.f; ss += __shfl_xor(ss, 16); ss += __shfl_xor(ss, 32); (void)ss; }
            }
    }
};
struct EpiNull {
    static constexpr bool PERM = true, AFTER_DRAIN = false; float* sink;
    __device__ __forceinline__ void operator()(const pg8::f32x4 (&acc)[2][2][4][2], const pg8::Unit& u, int wr, int wc, int fr, int fq) const { run<2>(acc, u, wr, wc, fr, fq); }
    template <int NAI> __device__ __forceinline__ void run(const pg8::f32x4 (&acc)[NAI][2][4][2], const pg8::Unit& u, int wr, int wc, int fr, int fq) const {
        float t = 0.f;
#pragma unroll
        for (int b = 0; b < 2; ++b)
#pragma unroll
            for (int m = 0; m < 4; ++m)
#pragma unroll
                for (int n = 0; n < 2; ++n) t += acc[0][b][m][n][0] + acc[0][b][m][n][3];
        if (t == 1234.5678f) sink[0] = t;
    }
};
struct EpiUp {
    static constexpr bool PERM = true, AFTER_DRAIN = false;
    bf16* O; const float* rowss;
    __device__ __forceinline__ void operator()(const pg8::f32x4 (&acc)[2][2][4][2], const pg8::Unit& u, int wr, int wc, int fr, int fq) const { run<2>(acc, u, wr, wc, fr, fq); }
    template <int NAI> __device__ __forceinline__ void run(const pg8::f32x4 (&acc)[NAI][2][4][2], const pg8::Unit& u, int wr, int wc, int fr, int fq) const {
        const int col = u.pn * 256 + wc * 32 + 8 * fq;
#pragma unroll
        for (int ai = 0; ai < NAI; ++ai)
#pragma unroll
            for (int m = 0; m < 4; ++m) {
                const int row = u.pm * 256 + ai * 128 + wr * 64 + m * 16 + fr;
                if (row < MREAL) {
                    const float rstd = rsqrtf(rowss[row] * (1.f / D) + EPS);
#pragma unroll
                    for (int bj = 0; bj < 2; ++bj) {
                        float v[8];
#pragma unroll
                        for (int i = 0; i < 4; ++i) { float a = fmaxf(acc[ai][bj][m][0][i] * rstd, 0.f), b = fmaxf(acc[ai][bj][m][1][i] * rstd, 0.f); v[i] = a * a; v[4 + i] = b * b; }
                        u32x4 w; w.x = pk2(v[0], v[1]); w.y = pk2(v[2], v[3]); w.z = pk2(v[4], v[5]); w.w = pk2(v[6], v[7]);
                        *(u32x4*)(O + (size_t)row * FF + col + bj * 128) = w;
                    }
                }
            }
    }
};
struct EpiRes {
    static constexpr bool PERM = true, AFTER_DRAIN = false;
    bf16* HB; float* OUT; float* rowss;
    __device__ __forceinline__ void operator()(const pg8::f32x4 (&acc)[2][2][4][2], const pg8::Unit& u, int wr, int wc, int fr, int fq) const { run<2>(acc, u, wr, wc, fr, fq); }
    template <int NAI> __device__ __forceinline__ void run(const pg8::f32x4 (&acc)[NAI][2][4][2], const pg8::Unit& u, int wr, int wc, int fr, int fq) const {
        const int col = u.pn * 256 + wc * 32 + 8 * fq;
#pragma unroll
        for (int ai = 0; ai < NAI; ++ai)
#pragma unroll
            for (int m = 0; m < 4; ++m) {
                const int row = u.pm * 256 + ai * 128 + wr * 64 + m * 16 + fr;
                float ss = 0.f;
                if (row < MREAL) {
#pragma unroll
                    for (int bj = 0; bj < 2; ++bj) {
                        bf16* hp = HB + (size_t)row * D + col + bj * 128;
                        const bf16x8 hv = *(const bf16x8*)hp;
                        f32x4 h0, h1;
#pragma unroll
                        for (int i = 0; i < 4; ++i) { h0[i] = bf2f((unsigned short)hv[i]) + acc[ai][bj][m][0][i]; h1[i] = bf2f((unsigned short)hv[4 + i]) + acc[ai][bj][m][1][i]; }
                        if (OUT) { float* op = OUT + (size_t)row * D + col + bj * 128; *(f32x4*)op = h0; *(f32x4*)(op + 4) = h1; }
                        else { u32x4 w; w.x = pk2(h0[0], h0[1]); w.y = pk2(h0[2], h0[3]); w.z = pk2(h1[0], h1[1]); w.w = pk2(h1[2], h1[3]); *(u32x4*)hp = w; }
                        ss += (h0[0] * h0[0] + h0[1] * h0[1]) + (h0[2] * h0[2] + h0[3] * h0[3]) + (h1[0] * h1[0] + h1[1] * h1[1]) + (h1[2] * h1[2] + h1[3] * h1[3]);
                    }
                }
                ss += __shfl_xor(ss, 16); ss += __shfl_xor(ss, 32);
                if (fq == 0 && row < MREAL) __hip_atomic_fetch_add(rowss + row, ss, __ATOMIC_RELAXED, __HIP_MEMORY_SCOPE_AGENT);
            }
    }
};
struct EpiQKV {
    static constexpr bool PERM = true, AFTER_DRAIN = false;
    bf16* Q; bf16* KB; bf16* VB; float* out; const float* rowss; const float* ropec; const float* ropes; const float* offc; const float* offs;
    __device__ __forceinline__ void operator()(const pg8::f32x4 (&acc)[2][2][4][2], const pg8::Unit& u, int wr, int wc, int fr, int fq) const { run<2>(acc, u, wr, wc, fr, fq); }
    template <int NAI> __device__ __forceinline__ void run(const pg8::f32x4 (&acc)[NAI][2][4][2], const pg8::Unit& u, int wr, int wc, int fr, int fq) const {
        const int pn = u.pn;
        const bool isq = pn < 12; const int kvi = pn - 12; const int g = isq ? (pn >> 2) : (kvi >> 1); const bool isv = (!isq) && (kvi & 1);
        const int sh = 2 * g, W = 128 << sh;
        const bool stile = u.pm == 64;
        const int d0 = 8 * fq;
        const int slb = ((u.pm * 256 + wr * 64 + fr) & (SEQ - 1)) * 32 + d0;
#pragma unroll
        for (int ai = 0; ai < NAI; ++ai)
#pragma unroll
            for (int m = 0; m < 4; ++m) {
                const int row = u.pm * 256 + ai * 128 + wr * 64 + m * 16 + fr;
                if (row >= MREAL) continue;
                const float rstd = rsqrtf(rowss[row] * (1.f / D) + EPS);
                const bool samp = row >= NPROMPT; const int t = samp ? ((row - NPROMPT) & 3) : (row & (SEQ - 1));
                int rowp = row;
                if (!samp) { const int b = row >> 13, r = t & ((1 << sh) - 1), uu = t >> sh; rowp = b * SEQ + r * (SEQ >> sh) + uu; }
                float* ob = nullptr;
                if (!isq) {
                    if (samp) ob = out + (g == 0 ? O_KVS0 : g == 1 ? O_KVS1 : O_KVS2) + (size_t)(row - NPROMPT) * 512;
                    else if (t >= SEQ - W) ob = out + (g == 0 ? O_KVP0 : g == 1 ? O_KVP1 : O_KVP2) + ((size_t)(row >> 13) * W + (t - (SEQ - W))) * 512;
                }
                f32x4 av[2], bv[2];
#pragma unroll
                for (int n = 0; n < 2; ++n) {
                    f32x4 a = acc[ai][0][m][n] * rstd, b = acc[ai][1][m][n] * rstd;
                    if (!isv) {
                        const int sl = (samp ? SEQ + t : t) * 32 + d0 + 4 * n; const f32x4 c = *(const f32x4*)(ropec + sl), sn = *(const f32x4*)(ropes + sl);
                        const f32x4 ra = a * c - b * sn, rb = b * c + a * sn; a = ra; b = rb;
                    }
                    av[n] = a; bv[n] = b;
                }
                if (isq) {
                    bf16* qp = Q + (size_t)row * QW + pn * 256 + wc * 64 + d0;
                    u32x4 w0, w1; w0.x = pk2(av[0][0] * QSCALE, av[0][1] * QSCALE); w0.y = pk2(av[0][2] * QSCALE, av[0][3] * QSCALE); w0.z = pk2(av[1][0] * QSCALE, av[1][1] * QSCALE); w0.w = pk2(av[1][2] * QSCALE, av[1][3] * QSCALE);
                    w1.x = pk2(bv[0][0] * QSCALE, bv[0][1] * QSCALE); w1.y = pk2(bv[0][2] * QSCALE, bv[0][3] * QSCALE); w1.z = pk2(bv[1][0] * QSCALE, bv[1][1] * QSCALE); w1.w = pk2(bv[1][2] * QSCALE, bv[1][3] * QSCALE);
                    *(u32x4*)qp = w0; *(u32x4*)(qp + 32) = w1;
                } else {
                    bf16* kp = (isv ? VB : KB) + ((size_t)g * MP + rowp) * 256 + wc * 64 + d0;
                    u32x4 w0, w1; w0.x = pk2(av[0][0], av[0][1]); w0.y = pk2(av[0][2], av[0][3]); w0.z = pk2(av[1][0], av[1][1]); w0.w = pk2(av[1][2], av[1][3]);
                    w1.x = pk2(bv[0][0], bv[0][1]); w1.y = pk2(bv[0][2], bv[0][3]); w1.z = pk2(bv[1][0], bv[1][1]); w1.w = pk2(bv[1][2], bv[1][3]);
                    *(u32x4*)kp = w0; *(u32x4*)(kp + 32) = w1;
                    if (ob) { float* o2 = ob + (isv ? 256 : 0) + wc * 64 + d0; *(f32x4*)o2 = av[0]; *(f32x4*)(o2 + 4) = av[1]; *(f32x4*)(o2 + 32) = bv[0]; *(f32x4*)(o2 + 36) = bv[1]; }
                }
            }
    }
};

template <class Epi>
__device__ __forceinline__ void skinny_phase(LAS unsigned char* lds, const bf16* Abuf, const bf16* Bt, int N, int K, const Epi& E, int first, int wave, int lane) {
    const int nroles = (N >> 8) * 8, G = gridDim.x;
    const int fr = lane & 15, fq = lane >> 4;
    LAS float* red = (LAS float*)lds;
    const int rstep = first ? G - first : G;
    for (int role = (int)blockIdx.x - first; role < nroles; role += rstep) {
        if (role < 0) break;
        const int pn = role >> 3, wr = (role >> 2) & 1, wc = role & 3;
        pg8::f32x4 acc[1][2][4][2];
#pragma unroll
        for (int b = 0; b < 2; ++b)
#pragma unroll
            for (int m = 0; m < 4; ++m)
#pragma unroll
                for (int n = 0; n < 2; ++n) acc[0][b][m][n] = (pg8::f32x4){0.f, 0.f, 0.f, 0.f};
        const int kper = K >> 3, k0 = wave * kper;
        const bf16* ap = Abuf + (size_t)(NPROMPT + 64 * wr + fr) * K + k0 + 8 * fq;
        const int r0 = Epi::PERM ? (8 * (fr >> 2) + (fr & 3)) : fr, r1 = Epi::PERM ? r0 + 4 : fr + 16;
        const bf16* bp = Bt + (size_t)(256 * pn + 32 * wc) * K + k0 + 8 * fq;
#pragma unroll 4
        for (int ks = 0; ks < kper; ks += 32) {
            bf16x8 af[4], bf_[2][2];
#pragma unroll
            for (int m = 0; m < 4; ++m) af[m] = *(const bf16x8*)(ap + (size_t)(16 * m) * K + ks);
#pragma unroll
            for (int b = 0; b < 2; ++b) { bf_[b][0] = *(const bf16x8*)(bp + (size_t)(128 * b + r0) * K + ks); bf_[b][1] = *(const bf16x8*)(bp + (size_t)(128 * b + r1) * K + ks); }
#pragma unroll
            for (int b = 0; b < 2; ++b)
#pragma unroll
                for (int m = 0; m < 4; ++m)
#pragma unroll
                    for (int n = 0; n < 2; ++n) acc[0][b][m][n] = __builtin_amdgcn_mfma_f32_16x16x32_bf16(bf_[b][n], af[m], acc[0][b][m][n], 0, 0, 0);
        }
        if (wave != 0) {
#pragma unroll
            for (int b = 0; b < 2; ++b)
#pragma unroll
                for (int m = 0; m < 4; ++m)
#pragma unroll
                    for (int n = 0; n < 2; ++n) *(LAS pg8::f32x4*)(red + ((size_t)((wave - 1) * 16 + b * 8 + m * 2 + n) * 64 + lane) * 4) = acc[0][b][m][n];
        }
        __syncthreads();
        if (wave == 0) {
#pragma unroll 1
            for (int w = 0; w < 7; ++w)
#pragma unroll
                for (int b = 0; b < 2; ++b)
#pragma unroll
                    for (int m = 0; m < 4; ++m)
#pragma unroll
                        for (int n = 0; n < 2; ++n) acc[0][b][m][n] += *(const LAS pg8::f32x4*)(red + ((size_t)(w * 16 + b * 8 + m * 2 + n) * 64 + lane) * 4);
            const pg8::Unit u{64, pn};
            E.template run<1>(acc, u, wr, wc, fr, fq);
        }
        __syncthreads();
    }
}
__device__ __forceinline__ int conv_srcc(int mode, int nb) {
    if (mode == 0) return 32 * nb;
    if (mode == 1) { const int pn = nb >> 3, bj = (nb >> 2) & 1, cb = nb & 3; return bj * 1024 + 128 * pn + 32 * cb; }
    const int pn = nb >> 3, bj = (nb >> 2) & 1, wc = nb & 3; return 256 * pn + 64 * wc + 32 * bj;
}
__device__ __forceinline__ void transpose_item(const float* W, int K, int N, bf16* WT, const float* gain, int mode, LAS float* scr, int item, int lane) {
    const int nblk = N >> 6, kb = item / nblk, nb64 = item % nblk, k0 = 64 * kb;
    const int l16 = lane & 15, srcc = conv_srcc(mode, 2 * nb64 + (l16 >> 3)) + 4 * (l16 & 7);
    f32x4 v[16];
#pragma unroll
    for (int i = 0; i < 16; ++i) { const int kk = 4 * i + (lane >> 4); v[i] = *(const f32x4*)(W + (size_t)(k0 + kk) * N + srcc); }
    if (gain) {
#pragma unroll
        for (int i = 0; i < 16; ++i) { const int kk = 4 * i + (lane >> 4); v[i] = v[i] * gain[k0 + kk]; }
    }
#pragma unroll
    for (int i = 0; i < 16; ++i) { const int kk = 4 * i + (lane >> 4); LAS float* d = scr + kk * 65 + 4 * l16; d[0] = v[i][0]; d[1] = v[i][1]; d[2] = v[i][2]; d[3] = v[i][3]; }
    asm volatile("s_waitcnt lgkmcnt(0)" ::: "memory");
    const int c = lane & 7;
#pragma unroll
    for (int j = 0; j < 8; ++j) { const int n = (lane >> 3) + 8 * j; const LAS float* sp = scr + (8 * c) * 65 + n;
        u32x4 o; o.x = pk2(sp[0 * 65], sp[1 * 65]); o.y = pk2(sp[2 * 65], sp[3 * 65]); o.z = pk2(sp[4 * 65], sp[5 * 65]); o.w = pk2(sp[6 * 65], sp[7 * 65]);
        *(u32x4*)(WT + (size_t)(64 * nb64 + n) * K + k0 + 8 * c) = o; }
    asm volatile("s_waitcnt lgkmcnt(0)" ::: "memory");
}
__device__ __forceinline__ void convert_late(const Args& A, LAS unsigned char* lds, int vw, int NVW, int wave, int lane) {
    unsigned char* ws = A.ws;
    LAS float* scr = (LAS float*)(lds + wave * 16640);
    constexpr int I_UP = 16 * 64, I_DN = 64 * 16, I_O = 16 * 16, NIT = I_O + I_UP + I_DN;
    for (int it = vw; it < NIT; it += NVW) {
        int r = it;
        if (r < I_O) { transpose_item(A.in[21], 1024, 1024, (bf16*)(ws + W_O), nullptr, 0, scr, r, lane); continue; } r -= I_O;
        if (r < I_UP) { transpose_item(A.in[22] + 1024ull * 4096, 1024, 4096, (bf16*)(ws + W_UP1), A.in[8] + 1024, 0, scr, r, lane); continue; } r -= I_UP;
        transpose_item(A.in[23] + 4096ull * 1024, 4096, 1024, (bf16*)(ws + W_DN1), nullptr, 0, scr, r, lane);
    }
}

__device__ __forceinline__ void phase_prologue(const Args& A, LAS unsigned char* lds, int gw, int NGW, int wave, int lane) {
    unsigned char* ws = A.ws;
    LAS float* scr = (LAS float*)(lds + wave * 16640);
    constexpr int I_GLU = 16 * 32, I_UP = 16 * 64, I_DN = 64 * 16, I_Q = 16 * 48, I_KV = 16 * 24;
    constexpr int NIT = I_GLU + I_UP + I_DN + I_Q + I_KV;
    for (int it = gw; it < NIT; it += NGW) {
        int r = it;
        if (r < I_GLU) { transpose_item(A.in[17], 1024, 2048, (bf16*)(ws + W_GLU), nullptr, 1, scr, r, lane); continue; } r -= I_GLU;
        if (r < I_UP) { transpose_item(A.in[22], 1024, 4096, (bf16*)(ws + W_UP0), A.in[8], 0, scr, r, lane); continue; } r -= I_UP;
        if (r < I_DN) { transpose_item(A.in[23], 4096, 1024, (bf16*)(ws + W_DN0), nullptr, 0, scr, r, lane); continue; } r -= I_DN;
        if (r < I_Q) { transpose_item(A.in[20], 1024, 3072, (bf16*)(ws + W_QKV), A.in[7] + 1024, 2, scr, r, lane); continue; } r -= I_Q;
        transpose_item(A.in[19], 1024, 1536, (bf16*)(ws + W_QKV) + 3072ull * 1024, A.in[18], 2, scr, r, lane);
    }
    {
        const float* gmix = A.in[7];
        bf16* HN0 = (bf16*)(ws + WS_HN0);
        for (int row0 = 4 * gw; row0 < MREAL; row0 += 4 * NGW) {
            f32x4 v[4][4]; float ssq[4];
#pragma unroll
            for (int q = 0; q < 4; ++q) { const int row = row0 + q; const float* xr = row < NPROMPT ? A.in[0] + (size_t)row * D : A.in[1] + (size_t)(row - NPROMPT) * D;
#pragma unroll
                for (int j = 0; j < 4; ++j) v[q][j] = *((const f32x4*)xr + lane + 64 * j); }
#pragma unroll
            for (int q = 0; q < 4; ++q) { float sq = 0.f;
#pragma unroll
                for (int j = 0; j < 4; ++j) sq += (v[q][j][0] * v[q][j][0] + v[q][j][1] * v[q][j][1]) + (v[q][j][2] * v[q][j][2] + v[q][j][3] * v[q][j][3]);
                ssq[q] = rsqrtf(wave_sum(sq) * (1.f / D) + EPS); }
#pragma unroll
            for (int j = 0; j < 4; ++j) { const f32x4 gg = *((const f32x4*)gmix + lane + 64 * j);
#pragma unroll
                for (int q = 0; q < 4; ++q) { const float rstd = ssq[q];
                    u32x2 w; w.x = pk2(v[q][j][0] * rstd * gg[0], v[q][j][1] * rstd * gg[1]); w.y = pk2(v[q][j][2] * rstd * gg[2], v[q][j][3] * rstd * gg[3]);
                    *((u32x2*)(HN0 + (size_t)(row0 + q) * D) + lane + 64 * j) = w; } }
        }
    }
    const int gt = gw * 64 + lane, NGT = NGW * 64;
    { float* rs = (float*)(ws + WS_ROWSS); for (int i = gt; i < 4 * MP; i += NGT) rs[i] = 0.f; }
    { float* rc = (float*)(ws + WS_ROPE); float* rsn = rc + 8196 * 32;
      for (int i = gt; i < 8196 * 32; i += NGT) { const int slot = i >> 5, d = i & 31; const float pos = slot < SEQ ? (float)slot : (float)(16384 + (slot - SEQ));
          const float inv = powf(10000.0f, -(float)d / 32.0f); const float ang = pos * inv; rc[i] = cosf(ang); rsn[i] = sinf(ang); } }
    { float* oc = (float*)(ws + WS_ROPE) + 2 * 8196 * 32; float* os = oc + 8 * 32;
      for (int i = gt; i < 8 * 32; i += NGT) { const int oi = i >> 5, d = i & 31; const float pos = (float)(128 * (oi >> 2) + 16 * (oi & 3));
          const float inv = powf(10000.0f, -(float)d / 32.0f); const float ang = pos * inv; oc[i] = cosf(ang); os[i] = sinf(ang); } }
    { float* lam = (float*)(ws + WS_LAM); bf16* BB = (bf16*)(ws + WS_BBAR); bf16* CC = (bf16*)(ws + WS_CC);
      const float *are = A.in[9], *aim = A.in[10], *ldt = A.in[11], *bre = A.in[12], *bim = A.in[13], *cre = A.in[14], *cim = A.in[15];
      for (int i = gt; i < 64 * 64 * 16; i += NGT) {
          const int c = i & 15, p = (i >> 4) & 63, g = i >> 10;
          const float dt = expf(ldt[g]); const float ar = are[g * 64 + p], ai = aim[g * 64 + p];
          const float mag = expf(ar * dt); const float lr = mag * cosf(ai * dt), li = mag * sinf(ai * dt);
          const float den = ar * ar + ai * ai, nr = lr - 1.f, ni = li;
          const float zr = (nr * ar + ni * ai) / den, zi = (ni * ar - nr * ai) / den;
          const float br = bre[(g * 64 + p) * 16 + c], bi = bim[(g * 64 + p) * 16 + c];
          const float bbr = zr * br - zi * bi, bbi = zr * bi + zi * br;
          BB[(g * 128 + p) * 16 + c] = (bf16)(pk2(bbr, 0.f) & 0xffffu);
          BB[(g * 128 + 64 + p) * 16 + c] = (bf16)(pk2(bbi, 0.f) & 0xffffu);
          CC[(g * 16 + c) * 128 + p] = (bf16)(pk2(cre[(g * 16 + c) * 64 + p], 0.f) & 0xffffu);
          CC[(g * 16 + c) * 128 + 64 + p] = (bf16)(pk2(-cim[(g * 16 + c) * 64 + p], 0.f) & 0xffffu);
          if (c == 0) { lam[(g * 64 + p) * 2] = lr; lam[(g * 64 + p) * 2 + 1] = li; }
      } }
}

#define CMUL_ADD(orr, oi, ar_, ai_, br_, bi_, cr_, ci_) do { const float _r = __builtin_fmaf((ar_), (br_), __builtin_fmaf(-(ai_), (bi_), (cr_))); const float _i = __builtin_fmaf((ar_), (bi_), __builtin_fmaf((ai_), (br_), (ci_))); orr = _r; oi = _i; } while (0)
template <bool PASS2>
__device__ __forceinline__ void s5_item(const Args& A, LAS unsigned char* hs, int item, int lane) {
    unsigned char* ws = A.ws;
    const bf16* HN0 = (const bf16*)(ws + WS_HN0);
    const bool samp = item >= 2048;
    const int g = item & 63, ch = samp ? 128 + ((item - 2048) >> 6) : 4 * (item >> 6);
    const int s = lane & 31, hf = lane >> 5;
    bf16x8 Bf[4], Cf[4];
    { const bf16* BB = (const bf16*)(ws + WS_BBAR) + (size_t)g * 128 * 16;
#pragma unroll
      for (int n = 0; n < 4; ++n) Bf[n] = *(const bf16x8*)(BB + (32 * n + s) * 16 + 8 * hf);
      if (PASS2) { const bf16* CC = (const bf16*)(ws + WS_CC) + (size_t)g * 16 * 128;
#pragma unroll
        for (int st = 0; st < 4; ++st) Cf[st] = *(const bf16x8*)(CC + (lane & 15) * 128 + 32 * st + 8 * (lane >> 4)); } }
    const float* lam = (const float*)(ws + WS_LAM) + (size_t)g * 128;
    float lr[2], li[2], l16r[2], l16i[2], l128r[2], l128i[2];
#pragma unroll
    for (int j = 0; j < 2; ++j) { lr[j] = lam[(s + 32 * j) * 2]; li[j] = lam[(s + 32 * j) * 2 + 1];
        float pr = lr[j], pi = li[j];
#pragma unroll
        for (int q = 0; q < 4; ++q) { const float nr = pr * pr - pi * pi, ni = 2.f * pr * pi; pr = nr; pi = ni; }
        l16r[j] = pr; l16i[j] = pi;
#pragma unroll
        for (int q = 0; q < 3; ++q) { const float nr = pr * pr - pi * pi, ni = 2.f * pr * pi; pr = nr; pi = ni; }
        l128r[j] = pr; l128i[j] = pi; }
    float cr[2] = {0.f, 0.f}, ci[2] = {0.f, 0.f};
    const float* E = (const float*)(ws + WS_E);
    if (PASS2) {
        if (samp) { const int n = ch - 128;
#pragma unroll
            for (int j = 0; j < 2; ++j) { cr[j] = A.in[5][((size_t)n * 64 + g) * 64 + s + 32 * j]; ci[j] = A.in[6][((size_t)n * 64 + g) * 64 + s + 32 * j]; } }
        else { const int first = (ch >> 6) << 6;
#pragma unroll 8
            for (int jj = first; jj < ch; ++jj) { const float* e = E + ((size_t)jj * 64 + g) * 128;
#pragma unroll
                for (int j = 0; j < 2; ++j) { const float er = e[j * 32 + s], ei = e[64 + j * 32 + s]; CMUL_ADD(cr[j], ci[j], l128r[j], l128i[j], cr[j], ci[j], er, ei); } } }
    }
    const int nblk = samp ? 1 : 16;
    const int rowbase = samp ? NPROMPT + 4 * (ch - 128) : ch * 128;
    const int tokA = 16 * ((s >> 2) & 1) + 4 * (s >> 3) + (s & 3);
    const float* dsk = A.in[16] + g * 16;
    bf16* Y = (bf16*)(ws + WS_Y);
    bf16x8 afn = *(const bf16x8*)(HN0 + (size_t)(rowbase + tokA) * D + g * 16 + 8 * hf);
    const int uoff = (lane & 15) * D + g * 16 + 4 * (lane >> 4);
    u32x2 un[2];
    if (PASS2) {
#pragma unroll
        for (int q = 0; q < 2; ++q) un[q] = *(const u32x2*)(HN0 + (size_t)(rowbase + 16 * q) * D + uoff);
    }
    const f32x4 dk4 = *(const f32x4*)(dsk + 4 * (lane >> 4));
    for (int blk = 0; blk < nblk; ++blk) {
        const int row0 = rowbase + 32 * blk;
        const bf16x8 af = afn;
        u32x2 uc[2];
        if (PASS2) {
#pragma unroll
            for (int q = 0; q < 2; ++q) uc[q] = un[q];
            if (blk + 1 < nblk) {
#pragma unroll
                for (int q = 0; q < 2; ++q) un[q] = *(const u32x2*)(HN0 + (size_t)(row0 + 32 + 16 * q) * D + uoff);
            }
        }
        if (!PASS2 && (blk & 3) == 0) { cr[0] = 0.f; cr[1] = 0.f; ci[0] = 0.f; ci[1] = 0.f; }
        if (blk + 1 < nblk) afn = *(const bf16x8*)(HN0 + (size_t)(row0 + 32 + tokA) * D + g * 16 + 8 * hf);
        f32x16 X[4];
        const f32x16 z16 = {0.f, 0.f, 0.f, 0.f, 0.f, 0.f, 0.f, 0.f, 0.f, 0.f, 0.f, 0.f, 0.f, 0.f, 0.f, 0.f};
#pragma unroll
        for (int n = 0; n < 4; ++n) X[n] = __builtin_amdgcn_mfma_f32_32x32x16_bf16(af, Bf[n], z16, 0, 0, 0);
        float cinr[2], cini[2];
#pragma unroll
        for (int j = 0; j < 2; ++j) {
            float er = 0.f, ei = 0.f;
#pragma unroll
            for (int r = 0; r < 16; ++r) CMUL_ADD(er, ei, lr[j], li[j], er, ei, X[j][r], X[2 + j][r]);
            const float or_ = __shfl_xor(er, 32), oi_ = __shfl_xor(ei, 32);
            const float e0r = hf ? or_ : er, e0i = hf ? oi_ : ei, e1r = hf ? er : or_, e1i = hf ? ei : oi_;
            float mr, mi; CMUL_ADD(mr, mi, l16r[j], l16i[j], cr[j], ci[j], e0r, e0i);
            cinr[j] = hf ? mr : cr[j]; cini[j] = hf ? mi : ci[j];
            CMUL_ADD(cr[j], ci[j], l16r[j], l16i[j], mr, mi, e1r, e1i);
        }
        if (PASS2) {
#pragma unroll
            for (int j = 0; j < 2; ++j) {
                float hr = cinr[j], hi = cini[j];
#pragma unroll
                for (int r = 0; r < 16; ++r) { CMUL_ADD(hr, hi, lr[j], li[j], hr, hi, X[j][r], X[2 + j][r]);
                    X[j][r] = hr; X[2 + j][r] = hi; }
            }
            if (samp && hf == 0) { const int n = ch - 128;
#pragma unroll
                for (int j = 0; j < 2; ++j) { A.out[O_SRES + ((size_t)n * 64 + g) * 64 + s + 32 * j] = X[j][3]; A.out[O_SIMS + ((size_t)n * 64 + g) * 64 + s + 32 * j] = X[2 + j][3]; } }
#pragma unroll
            for (int r = 0; r < 16; ++r) { LAS unsigned short* hp = (LAS unsigned short*)(hs + (16 * hf + r) * 272);
                const unsigned w01 = pk2(X[0][r], X[1][r]), w23 = pk2(X[2][r], X[3][r]);
                hp[s] = (unsigned short)w01; hp[32 + s] = (unsigned short)(w01 >> 16); hp[64 + s] = (unsigned short)w23; hp[96 + s] = (unsigned short)(w23 >> 16); }
            asm volatile("s_waitcnt lgkmcnt(0)" ::: "memory");
#pragma unroll
            for (int tb = 0; tb < 2; ++tb) {
                f32x4 y = {0.f, 0.f, 0.f, 0.f};
#pragma unroll
                for (int st = 0; st < 4; ++st) { const bf16x8 hfrag = *(const LAS bf16x8*)(hs + (16 * tb + (lane & 15)) * 272 + 64 * st + 16 * (lane >> 4));
                    y = __builtin_amdgcn_mfma_f32_16x16x32_bf16(Cf[st], hfrag, y, 0, 0, 0); }
                const int tk = 16 * tb + (lane & 15);
                if (!samp || tk < 4) {
                    const float u0 = __uint_as_float(uc[tb].x << 16), u1 = __uint_as_float(uc[tb].x & 0xffff0000u), u2 = __uint_as_float(uc[tb].y << 16), u3 = __uint_as_float(uc[tb].y & 0xffff0000u);
                    f32x4 v = {y[0] + dk4[0] * u0, y[1] + dk4[1] * u1, y[2] + dk4[2] * u2, y[3] + dk4[3] * u3};
                    float ge[4];
#pragma unroll
                    for (int j = 0; j < 4; ++j) { const float z = 0.7978845608f * (v[j] + 0.044715f * v[j] * v[j] * v[j]); ge[j] = v[j] / (1.f + __expf(-2.f * z)); }
                    u32x2 w; w.x = pk2(ge[0], ge[1]); w.y = pk2(ge[2], ge[3]);
                    *(u32x2*)(Y + (size_t)(row0 + tk) * D + g * 16 + 4 * (lane >> 4)) = w;
                }
            }
            asm volatile("s_waitcnt lgkmcnt(0)" ::: "memory");
        }
        if (!PASS2 && (blk & 3) == 3 && hf == 0) { float* e = (float*)(ws + WS_E) + ((size_t)(ch + (blk >> 2)) * 64 + g) * 128;
#pragma unroll
            for (int j = 0; j < 2; ++j) { e[j * 32 + s] = cr[j]; e[64 + j * 32 + s] = ci[j]; } }
    }
    if (PASS2 && !samp && hf == 0 && ((ch + 3) & 63) == 63) { const int b = ch >> 6;
#pragma unroll
        for (int j = 0; j < 2; ++j) { A.out[O_SREP + ((size_t)b * 64 + g) * 64 + s + 32 * j] = cr[j]; A.out[O_SIMP + ((size_t)b * 64 + g) * 64 + s + 32 * j] = ci[j]; } }
}

typedef short v4i16_t __attribute__((ext_vector_type(4)));
constexpr int KIMG_STRIDE = 144, KIMG_BYTES = 192 * KIMG_STRIDE, VIMG_HALF = 192 * 64, NATT_ITEMS = 3072;
struct AttItem { int g, sh, b, r, u0, kvh; };
__device__ __forceinline__ AttItem att_decode(int bi) {
    AttItem I; I.g = bi >> 10; const int rem = bi & 1023; I.kvh = rem & 3; I.b = (rem >> 2) & 1; const int rq = rem >> 3;
    I.sh = 2 * I.g; const int nqb = 128 >> I.sh; I.r = rq / nqb; I.u0 = 64 * (rq % nqb); return I;
}
template <bool COMBINE, int MODE = 0>
__device__ __forceinline__ void attn_prompt_phase(const Args& A, LAS unsigned char* lds, int tid, int wave, int lane, int item_lo, int item_hi) {
    unsigned char* ws = A.ws;
    const bf16* Q = (const bf16*)(ws + WS_Q); const bf16* KB = (const bf16*)(ws + WS_KB); const bf16* VB = (const bf16*)(ws + WS_VT);
    bf16* OG = (bf16*)(ws + WS_OG); float* LSE = (float*)(ws + WS_LSE);
    const int G = gridDim.x, hh = wave & 3, sub = wave >> 2, n = lane & 31, hf = lane >> 5;
    const int kap = (n & 3) + 4 * ((n >> 3) & 1) + 8 * ((n >> 2) & 1) + 16 * (n >> 4);
    int bi = item_lo + blockIdx.x;
    const int NATT_HI = item_hi;
    if (bi >= NATT_HI) return;
    bf16* AT = (bf16*)(ws + WS_ATT);
    u32x4 pk_[3], pv_[3]; bf16x8 qn[4];
#define ATT_ISSUE_KV(bix) do { const AttItem J = att_decode(bix); const int L_ = SEQ >> J.sh; const size_t pb_ = (size_t)J.g * MP + (size_t)J.b * SEQ + (size_t)J.r * L_; \
        _Pragma("unroll") for (int i = 0; i < 3; ++i) { const int c_ = tid + 512 * i, row_ = c_ >> 3, ch_ = c_ & 7; int u_ = J.u0 - 128 + row_; u_ = u_ < 0 ? 0 : u_; \
            pk_[i] = *(const u32x4*)(KB + (pb_ + u_) * 256 + J.kvh * 64 + 8 * ch_); pv_[i] = *(const u32x4*)(VB + (pb_ + u_) * 256 + J.kvh * 64 + 8 * ch_); } } while (0)
#define ATT_ISSUE_Q(bix) do { const AttItem J = att_decode(bix); const int qrow_ = J.b * SEQ + ((J.u0 + 32 * sub + n) << J.sh) + J.r; \
        _Pragma("unroll") for (int ks = 0; ks < 4; ++ks) qn[ks] = *(const bf16x8*)(Q + (size_t)qrow_ * QW + J.g * 1024 + (4 * J.kvh + hh) * 64 + 16 * ks + 8 * hf); } while (0)
#define ATT_WRITE(bufo) do { _Pragma("unroll") for (int i = 0; i < 3; ++i) { const int c = tid + 512 * i, row = c >> 3, ch = c & 7; \
            *(LAS u32x4*)(lds + (bufo) + row * KIMG_STRIDE + 16 * ch) = pk_[i]; \
            *(LAS u32x4*)(lds + (bufo) + KIMG_BYTES + (ch >> 2) * VIMG_HALF + row * 64 + (ch & 3) * 16) = pv_[i]; } } while (0)
    constexpr int ABUF = KIMG_BYTES + 2 * VIMG_HALF;
    bf16x8 qf[4];
    ATT_ISSUE_KV(bi); ATT_ISSUE_Q(bi);
    ATT_WRITE(0);
#pragma unroll
    for (int ks = 0; ks < 4; ++ks) qf[ks] = qn[ks];
    if (bi + G < NATT_HI) ATT_ISSUE_KV(bi + G);
    asm volatile("s_waitcnt lgkmcnt(0)\n\ts_barrier" ::: "memory");
    int par = 0;
    for (; bi < NATT_HI; bi += G, par ^= 1) {
        const AttItem I = att_decode(bi);
        if (bi + G < NATT_HI) { ATT_WRITE((par ^ 1) * ABUF); ATT_ISSUE_Q(bi + G); }
        if (bi + 2 * G < NATT_HI) ATT_ISSUE_KV(bi + 2 * G);
        const LAS unsigned char* lbuf = lds + par * ABUF;
        const int u0w = I.u0 + 32 * sub;
        const int qrow = I.b * SEQ + ((u0w + n) << I.sh) + I.r;
        const int h = 4 * I.kvh + hh;
        f32x16 O0, O1;
#pragma unroll
        for (int i = 0; i < 16; ++i) { O0[i] = 0.f; O1[i] = 0.f; }
        float mrun = -INFINITY, lrun = 0.f;
        const int cc_ = lane & 7, rr0_ = lane >> 3;
        bf16x8 x1[4], x2[4]; float l1 = 0.f, l2 = 0.f;
        if (COMBINE) {
            l1 = LSE[((size_t)1 * MP + qrow) * 16 + h]; l2 = LSE[((size_t)2 * MP + qrow) * 16 + h];
#pragma unroll
            for (int j = 0; j < 4; ++j) { const int qr_ = I.b * SEQ + ((u0w + rr0_ + 8 * j) << I.sh) + I.r;
                x1[j] = *(const bf16x8*)(OG + ((size_t)1 * MP + qr_) * D + h * 64 + 8 * cc_); x2[j] = *(const bf16x8*)(OG + ((size_t)2 * MP + qr_) * D + h * 64 + 8 * cc_); }
        }
        const int kt0 = (MODE == 1 || MODE == 3) ? 5 : (u0w >= 128 ? 0 : (128 - u0w) >> 5);
        const LAS unsigned char* kimg = lbuf + (32 * sub + kap) * KIMG_STRIDE + 16 * hf;
        const LAS unsigned char* vimg = lbuf + KIMG_BYTES + (32 * sub + 8 * hf + ((lane & 15) >> 2)) * 64 + (16 * ((lane >> 4) & 1) + 4 * (lane & 3)) * 2;
        for (int kt = kt0; kt < 5; ++kt) {
            bf16x8 kf[4], vf[2][2];
#pragma unroll
            for (int ks = 0; ks < 4; ++ks) kf[ks] = *(const LAS bf16x8*)(kimg + (32 * kt) * KIMG_STRIDE + 32 * ks);
#pragma unroll
            for (int mb = 0; mb < 2; ++mb)
#pragma unroll
                for (int st = 0; st < 2; ++st) {
                    const LAS unsigned char* vp = vimg + mb * VIMG_HALF + (32 * kt + 16 * st) * 64;
                    const v4i16_t lo = __builtin_amdgcn_ds_read_tr16_b64_v4i16((LAS v4i16_t*)vp);
                    const v4i16_t hi = __builtin_amdgcn_ds_read_tr16_b64_v4i16((LAS v4i16_t*)(vp + 4 * 64));
                    vf[mb][st] = (bf16x8){lo[0], lo[1], lo[2], lo[3], hi[0], hi[1], hi[2], hi[3]};
                }
            f32x16 S;
#pragma unroll
            for (int i = 0; i < 16; ++i) S[i] = 0.f;
#pragma unroll
            for (int ks = 0; ks < 4; ++ks) S = __builtin_amdgcn_mfma_f32_32x32x16_bf16(kf[ks], qf[ks], S, 0, 0, 0);
            if (kt == 0) {
#pragma unroll
                for (int rr = 0; rr < 16; ++rr) { const int kp = (rr & 7) + 8 * hf + 16 * (rr >> 3); if (kp < n) S[rr] = -INFINITY; }
            } else if (kt == 4) {
#pragma unroll
                for (int rr = 0; rr < 16; ++rr) { const int kp = (rr & 7) + 8 * hf + 16 * (rr >> 3); if (kp > n) S[rr] = -INFINITY; }
            }
            float tm = S[0];
#pragma unroll
            for (int rr = 1; rr < 16; ++rr) tm = fmaxf(tm, S[rr]);
            tm = fmaxf(tm, __shfl_xor(tm, 32));
            const float mnew = fmaxf(mrun, tm);
            const float alpha = __builtin_amdgcn_exp2f(mrun - mnew);
            float ps = 0.f; float p[16];
#pragma unroll
            for (int rr = 0; rr < 16; ++rr) { p[rr] = __builtin_amdgcn_exp2f(S[rr] - mnew); ps += p[rr]; }
            lrun = lrun * alpha + ps; mrun = mnew;
            if (__builtin_amdgcn_ballot_w64(alpha != 1.f) != 0ull) {
#pragma unroll
                for (int i = 0; i < 16; ++i) { O0[i] *= alpha; O1[i] *= alpha; }
            }
#pragma unroll
            for (int st = 0; st < 2; ++st) {
                u32x4 pw; pw.x = pk2(p[8 * st + 0], p[8 * st + 1]); pw.y = pk2(p[8 * st + 2], p[8 * st + 3]); pw.z = pk2(p[8 * st + 4], p[8 * st + 5]); pw.w = pk2(p[8 * st + 6], p[8 * st + 7]);
                const bf16x8 pf = __builtin_bit_cast(bf16x8, pw);
                O0 = __builtin_amdgcn_mfma_f32_32x32x16_bf16(vf[0][st], pf, O0, 0, 0, 0);
                O1 = __builtin_amdgcn_mfma_f32_32x32x16_bf16(vf[1][st], pf, O1, 0, 0, 0);
            }
        }
        const float ltot = lrun + __shfl_xor(lrun, 32);
        LAS unsigned char* ost = lds + 2 * ABUF + wave * 4864;
        float sc0;
        if (!COMBINE) { sc0 = 1.f / ltot; if (hf == 0) LSE[((size_t)I.g * MP + qrow) * 16 + h] = mrun + log2f(ltot); }
        else { const float l0 = mrun + log2f(ltot); const float mx = fmaxf(l0, fmaxf(l1, l2));
            const float w0 = __builtin_amdgcn_exp2f(l0 - mx), w1 = __builtin_amdgcn_exp2f(l1 - mx), w2 = __builtin_amdgcn_exp2f(l2 - mx);
            const float invw = 1.f / (w0 + w1 + w2); sc0 = w0 * invw / ltot;
            if (hf == 0) { LAS float* wp = (LAS float*)(ost + 4608) + 2 * n; wp[0] = w1 * invw; wp[1] = w2 * invw; } }
        if (MODE < 2) {
#pragma unroll
            for (int a = 0; a < 4; ++a) {
                u32x2 w0v, w1v; w0v.x = pk2(O0[4 * a] * sc0, O0[4 * a + 1] * sc0); w0v.y = pk2(O0[4 * a + 2] * sc0, O0[4 * a + 3] * sc0);
                w1v.x = pk2(O1[4 * a] * sc0, O1[4 * a + 1] * sc0); w1v.y = pk2(O1[4 * a + 2] * sc0, O1[4 * a + 3] * sc0);
                *(LAS u32x2*)(ost + n * 144 + (8 * a + 4 * hf) * 2) = w0v; *(LAS u32x2*)(ost + n * 144 + 64 + (8 * a + 4 * hf) * 2) = w1v;
            }
            asm volatile("s_waitcnt lgkmcnt(0)" ::: "memory");
#pragma unroll
            for (int j = 0; j < 4; ++j) { const int rr_ = rr0_ + 8 * j; const int qr_ = I.b * SEQ + ((u0w + rr_) << I.sh) + I.r;
                const bf16x8 tv = *(const LAS bf16x8*)(ost + rr_ * 144 + 16 * cc_);
                if (!COMBINE) *(bf16x8*)(OG + ((size_t)I.g * MP + qr_) * D + h * 64 + 8 * cc_) = tv;
                else { const LAS float* wp = (const LAS float*)(ost + 4608) + 2 * rr_; const float w1 = wp[0], w2 = wp[1];
                    float o[8];
#pragma unroll
                    for (int i = 0; i < 8; ++i) o[i] = bf2f((unsigned short)tv[i]) + w1 * bf2f((unsigned short)x1[j][i]) + w2 * bf2f((unsigned short)x2[j][i]);
                    u32x4 y; y.x = pk2(o[0], o[1]); y.y = pk2(o[2], o[3]); y.z = pk2(o[4], o[5]); y.w = pk2(o[6], o[7]);
                    *(u32x4*)(AT + (size_t)qr_ * D + h * 64 + 8 * cc_) = y; }
            }
        } else { if (ltot == 123.456f) LSE[0] = ltot; }
#pragma unroll
        for (int ks = 0; ks < 4; ++ks) qf[ks] = qn[ks];
        asm volatile("s_waitcnt lgkmcnt(0)\n\ts_barrier" ::: "memory");
    }
#undef ATT_ISSUE_KV
#undef ATT_ISSUE_Q
#undef ATT_WRITE
}

__device__ __forceinline__ void attn_sample_item(const Args& A, LAS float* sl, int it, int lane) {
    unsigned char* ws = A.ws;
    const int h = it & 15, t = (it >> 4) & 3, n = it >> 6, kvh = h >> 2;
    const int row = NPROMPT + 4 * n + t;
    const bf16* Q = (const bf16*)(ws + WS_Q) + (size_t)row * QW + h * 64;
    const int kq = lane >> 2, dq = lane & 3;
    float mxl = -INFINITY;
#pragma unroll 1
    for (int g = 0; g < 3; ++g) {
        const int W = 128 << (2 * g), dil = 1 << (2 * g);
        const float* cache = A.in[2 + g] + (size_t)n * W * 512;
        const float* newkv = A.out + (g == 0 ? O_KVS0 : g == 1 ? O_KVS1 : O_KVS2) + (size_t)n * 4 * 512;
        float q[16];
#pragma unroll
        for (int c8 = 0; c8 < 2; ++c8) { const bf16x8 v = *(const bf16x8*)(Q + g * 1024 + 16 * dq + 8 * c8);
#pragma unroll
            for (int i = 0; i < 8; ++i) q[8 * c8 + i] = bf2f((unsigned short)v[i]); }
#pragma unroll 9
        for (int bt = 0; bt < 9; ++bt) {
            const int j = 16 * bt + kq; const bool valid = j <= 128; const int jj = valid ? j : 128;
            const int idx = W + t - dil * jj;
            const float* kp = (idx >= W ? newkv + (size_t)(idx - W) * 512 : cache + (size_t)idx * 512) + kvh * 64 + 16 * dq;
            float s = 0.f;
#pragma unroll
            for (int c4 = 0; c4 < 4; ++c4) { const f32x4 kv = *(const f32x4*)(kp + 4 * c4); s += q[4 * c4] * kv[0] + q[4 * c4 + 1] * kv[1] + q[4 * c4 + 2] * kv[2] + q[4 * c4 + 3] * kv[3]; }
            s += __shfl_xor(s, 1); s += __shfl_xor(s, 2);
            if (valid && dq == 0) sl[g * 132 + j] = s;
            mxl = fmaxf(mxl, valid ? s : -INFINITY);
        }
    }
    const float mx = wave_max(mxl);
    asm volatile("s_waitcnt lgkmcnt(0)" ::: "memory");
    float sum = 0.f;
#pragma unroll 1
    for (int i = lane; i < 396; i += 64) { const int j = i % 132; if (j <= 128) { const float p = exp2f(sl[i] - mx); sl[i] = p; sum += p; } }
    sum = wave_sum(sum);
    asm volatile("s_waitcnt lgkmcnt(0)" ::: "memory");
    f32x4 acc = {0.f, 0.f, 0.f, 0.f};
    const int ksl = lane >> 4, dq4 = lane & 15;
#pragma unroll 1
    for (int g = 0; g < 3; ++g) {
        const int W = 128 << (2 * g), dil = 1 << (2 * g);
        const float* cache = A.in[2 + g] + (size_t)n * W * 512;
        const float* newkv = A.out + (g == 0 ? O_KVS0 : g == 1 ? O_KVS1 : O_KVS2) + (size_t)n * 4 * 512;
#pragma unroll 33
        for (int jb = 0; jb < 33; ++jb) {
            const int j = 4 * jb + ksl; const bool valid = j <= 128; const int jj = valid ? j : 128;
            const int idx = W + t - dil * jj;
            const float* vp = (idx >= W ? newkv + (size_t)(idx - W) * 512 : cache + (size_t)idx * 512) + 256 + kvh * 64 + 4 * dq4;
            const f32x4 v = *(const f32x4*)vp;
            const float pj = valid ? sl[g * 132 + jj] : 0.f;
            acc += v * pj;
        }
    }
#pragma unroll
    for (int i = 0; i < 4; ++i) { acc[i] += __shfl_xor(acc[i], 16); acc[i] += __shfl_xor(acc[i], 32); }
    bf16* AT = (bf16*)(ws + WS_ATT);
    if (lane < 16) { const float inv = 1.f / sum; u32x2 w; w.x = pk2(acc[0] * inv, acc[1] * inv); w.y = pk2(acc[2] * inv, acc[3] * inv);
        *(u32x2*)(AT + (size_t)row * D + h * 64 + 4 * dq4) = w; }
    asm volatile("s_waitcnt lgkmcnt(0)" ::: "memory");
}

__device__ __forceinline__ void attn_combine(const Args& A, int gt, int NGT) {
    unsigned char* ws = A.ws;
    const bf16* OG = (const bf16*)(ws + WS_OG); const float* LSE = (const float*)(ws + WS_LSE); bf16* AT = (bf16*)(ws + WS_ATT);
    for (int i = gt; i < NPROMPT * 128; i += NGT) {
        const int row = i >> 7, c8 = i & 127, h = c8 >> 3;
        const float l0 = LSE[((size_t)0 * MP + row) * 16 + h], l1 = LSE[((size_t)1 * MP + row) * 16 + h], l2 = LSE[((size_t)2 * MP + row) * 16 + h];
        const float mx = fmaxf(l0, fmaxf(l1, l2));
        float w0 = exp2f(l0 - mx), w1 = exp2f(l1 - mx), w2 = exp2f(l2 - mx); const float inv = 1.f / (w0 + w1 + w2); w0 *= inv; w1 *= inv; w2 *= inv;
        const bf16x8 a = *(const bf16x8*)(OG + ((size_t)0 * MP + row) * D + 8 * c8), b = *(const bf16x8*)(OG + ((size_t)1 * MP + row) * D + 8 * c8), c = *(const bf16x8*)(OG + ((size_t)2 * MP + row) * D + 8 * c8);
        float o[8];
#pragma unroll
        for (int k = 0; k < 8; ++k) o[k] = w0 * bf2f((unsigned short)a[k]) + w1 * bf2f((unsigned short)b[k]) + w2 * bf2f((unsigned short)c[k]);
        u32x4 w; w.x = pk2(o[0], o[1]); w.y = pk2(o[2], o[3]); w.z = pk2(o[4], o[5]); w.w = pk2(o[6], o[7]);
        *(u32x4*)(AT + (size_t)row * D + 8 * c8) = w;
    }
}

#define XB_TMO      128
#define XB_XCNT(j)  (256  + 64 * (j))
#define XB_XSUB(j)  (1280 + 64 * (j))
#define XB_XGEN(j)  (2304 + 64 * (j))
#define XB_TOP      3328
#define XB_TOPGEN   3392
#define XCD_BAR_WORDS 3456
#define XB_SPIN_CAP (1u << 18)

__device__ __forceinline__ unsigned xb_ld(unsigned* p)              { return __hip_atomic_load(p, __ATOMIC_RELAXED, __HIP_MEMORY_SCOPE_AGENT); }
__device__ __forceinline__ unsigned xb_add(unsigned* p, unsigned v) { return __hip_atomic_fetch_add(p, v, __ATOMIC_RELAXED, __HIP_MEMORY_SCOPE_AGENT); }
__device__ __forceinline__ unsigned xb_xcc_id() { return (unsigned)__builtin_amdgcn_s_getreg((3 << 11) | 20) & 0xFu; }
#define XB_SPIN(cond, bar) do { unsigned _sp = 0; while (cond) { __builtin_amdgcn_s_sleep(1); \
    if ((++_sp & 255u) == 0u) { if (xb_ld(&(bar)[XB_TMO])) break; if (_sp > XB_SPIN_CAP) { atomicAdd(&(bar)[XB_TMO], 1u); break; } } } } while (0)

struct XcdBarrier {
    unsigned* bar; unsigned x;
    volatile LAS unsigned* st;
};

__device__ __forceinline__ XcdBarrier xcd_barrier_post(unsigned* bar, volatile LAS unsigned* st) {
    XcdBarrier b; b.bar = bar; b.x = xb_xcc_id(); b.st = st;
    if (threadIdx.x == 0) (void)xb_add(&bar[XB_XCNT(b.x)], 1u);
    return b;
}
__device__ __forceinline__ void xcd_barrier_complete(unsigned* bar, unsigned x, unsigned& nloc, unsigned& nx) {
    const unsigned G = gridDim.x * gridDim.y * gridDim.z;
    unsigned sum, cnt, mine, sp = 0u;
    for (;;) {
        sum = 0u; cnt = 0u; mine = 0u;
#pragma unroll
        for (unsigned j = 0; j < 16; ++j) { const unsigned c = xb_ld(&bar[XB_XCNT(j)]); sum += c; cnt += (c > 0u) ? 1u : 0u; mine = (j == x) ? c : mine; }
        if (sum == G) break;
        __builtin_amdgcn_s_sleep(1);
        if ((++sp & 255u) == 0u) { if (xb_ld(&bar[XB_TMO])) break; if (sp > XB_SPIN_CAP) { atomicAdd(&bar[XB_TMO], 1u); break; } }
    }
    nloc = mine > 0u ? mine : 1u; nx = cnt > 0u ? cnt : 1u;
}

__device__ __forceinline__ void xcd_barrier(const XcdBarrier& b) {
    asm volatile("s_waitcnt vmcnt(0)" ::: "memory");
    __syncthreads();
    if (threadIdx.x == 0) {
        unsigned* bar = b.bar;
        __builtin_amdgcn_s_waitcnt(0);
        unsigned nloc = b.st[0], nx = b.st[1];
        if (nloc == 0u) { xcd_barrier_complete(bar, b.x, nloc, nx); b.st[0] = nloc; b.st[1] = nx; }
        const unsigned old = xb_add(&bar[XB_XSUB(b.x)], 1u);
        const unsigned gen = old / nloc;
        if (old + 1u == (gen + 1u) * nloc) {
            __builtin_amdgcn_fence(__ATOMIC_RELEASE, "agent");
            asm volatile("s_waitcnt vmcnt(0)" ::: "memory");
            const unsigned og = xb_add(&bar[XB_TOP], 1u);
            const unsigned tg = og / nx;
            if (og + 1u == (tg + 1u) * nx) xb_add(&bar[XB_TOPGEN], 1u);
            else XB_SPIN(xb_ld(&bar[XB_TOPGEN]) == tg, bar);
            __builtin_amdgcn_fence(__ATOMIC_ACQUIRE, "agent");
            xb_add(&bar[XB_XGEN(b.x)], 1u);
            asm volatile("s_waitcnt vmcnt(0)" ::: "memory");
        } else {
            XB_SPIN(xb_ld(&bar[XB_XGEN(b.x)]) == gen, bar);
            __builtin_amdgcn_fence(__ATOMIC_ACQUIRE, "agent");
            asm volatile("s_waitcnt vmcnt(0)" ::: "memory");
        }
    }
    __syncthreads();
}

constexpr int NPHASE = 13;
#ifndef REP0
#define REP0 1
#endif
#ifndef REP12
#define REP12 1
#endif
#ifndef REP7
#define REP7 1
#endif
#ifndef REP8
#define REP8 1
#endif
#ifndef REP4
#define REP4 1
#endif
#ifndef REP6
#define REP6 1
#endif
#ifndef DUP4
#define DUP4 0
#endif
#ifndef DUP6
#define DUP6 0
#endif
#ifndef DUP5
#define DUP5 0
#endif
#ifndef PROBE8
#define PROBE8 0
#endif
#ifndef XSYNC
#define XSYNC 0
#endif
__global__ void __launch_bounds__(NTHREADS, 2) yoco_fwd(Args A) {
    extern __shared__ __attribute__((aligned(16))) unsigned char lds_raw[];
    LAS unsigned char* lds = (LAS unsigned char*)lds_raw;
    cg::grid_group grid = cg::this_grid();
    const int tid = threadIdx.x, lane = tid & 63, wave = __builtin_amdgcn_readfirstlane(tid >> 6);
    const int G = gridDim.x, gw = blockIdx.x * NWAVES + wave, NGW = G * NWAVES, gt = gw * 64 + lane, NGT = NGW * 64;
    unsigned char* ws = A.ws;
    float* rowss = (float*)(ws + WS_ROWSS);
    float* Hf = (float*)(ws + WS_H); bf16* HB = (bf16*)(ws + WS_HB);
    const int lo = A.ph_lo, hi = A.ph_hi;
    volatile LAS unsigned* bst = (volatile LAS unsigned*)(lds + LDS_BYTES - 64);
    if (tid < 2) bst[tid] = 0u;
    __syncthreads();
    XcdBarrier xbar = xcd_barrier_post((unsigned*)(ws + WS_BAR), bst);
    if (lo < 0) grid.sync();
#ifndef PH_MASK
#define PH_MASK 0xffff
#endif
#define IN(k) (((PH_MASK >> (k)) & 1) && lo <= (k) && (k) < hi)
#define SEAM(k) do { if (IN(k) && IN((k) + 1)) xcd_barrier(xbar); } while (0)
    if (IN(0)) { for (int rp = 0; rp < REP0; ++rp) phase_prologue(A, lds, gw, NGW, wave, lane); for (int rp = 0; rp < XSYNC; ++rp) xcd_barrier(xbar); }
    SEAM(0);
    if (IN(1)) for (int rp = 0; rp < REP12; ++rp) { for (int it = gw; it < 2048; it += NGW) s5_item<false>(A, lds + wave * 8704, it, lane); }
    SEAM(1);
    if (IN(2)) for (int rp = 0; rp < REP12; ++rp) { for (int it = gw; it < 4096; it += NGW) s5_item<true>(A, lds + wave * 8704, it, lane); }
    SEAM(2);
    if (IN(3)) { pg8::Gemm g{(const bf16*)(ws + WS_Y), (const bf16*)(ws + W_GLU), NPROMPT, 2048, 1024}; pg8::StaticOrder S; S.init(NPROMPT, 2048, G, (int)blockIdx.x);
        EpiGlu E{A.in[0], A.in[1], Hf, HB, rowss};
        pg8::gemm_phase<EpiGlu, pg8::StaticOrder, true, true>(lds, g, S, E);
        skinny_phase(lds, g.A, g.Bt, 2048, 1024, E, 0, wave, lane); }
    SEAM(3);
    if (IN(4)) { pg8::Gemm g{HB, (const bf16*)(ws + W_UP0), NPROMPT, FF, 1024}; pg8::StaticOrder S; S.init(NPROMPT, FF, G, (int)blockIdx.x);
        EpiUp E{(bf16*)(ws + WS_ACT), rowss};
        pg8::gemm_phase<EpiUp, pg8::StaticOrder, true, true>(lds, g, S, E);
        skinny_phase(lds, g.A, g.Bt, FF, 1024, E, 0, wave, lane);
#if DUP4 == 1
        pg8::gemm_phase<EpiUp, pg8::StaticOrder, true, true>(lds, g, S, E);
#endif
#if DUP4 == 3
        { EpiNull E0{(float*)(ws + WS_OG)};
        skinny_phase(lds, g.A, g.Bt, FF, 1024, E0, 0, wave, lane); skinny_phase(lds, g.A, g.Bt, FF, 1024, E0, 0, wave, lane);
        skinny_phase(lds, g.A, g.Bt, FF, 1024, E0, 0, wave, lane); skinny_phase(lds, g.A, g.Bt, FF, 1024, E0, 0, wave, lane); }
#endif
#if DUP4 == 2
        skinny_phase(lds, g.A, g.Bt, FF, 1024, E, 0, wave, lane);
        skinny_phase(lds, g.A, g.Bt, FF, 1024, E, 0, wave, lane);
        skinny_phase(lds, g.A, g.Bt, FF, 1024, E, 0, wave, lane);
        skinny_phase(lds, g.A, g.Bt, FF, 1024, E, 0, wave, lane);
#endif
    }
    SEAM(4);
    if (IN(5)) { pg8::Gemm g{(const bf16*)(ws + WS_ACT), (const bf16*)(ws + W_DN0), NPROMPT, 1024, FF}; pg8::StaticOrder S; S.init(NPROMPT, 1024, G, (int)blockIdx.x);
        EpiRes E{HB, nullptr, rowss + MP};
        pg8::gemm_phase<EpiRes, pg8::StaticOrder, true, true>(lds, g, S, E);
        skinny_phase(lds, g.A, g.Bt, 1024, FF, E, 0, wave, lane);
#if DUP5 == 2
        { EpiUp E2{(bf16*)(ws + WS_OG), rowss}; pg8::gemm_phase<EpiUp, pg8::StaticOrder, true, true>(lds, g, S, E2); }
#endif
    }
    SEAM(5);
    if (IN(6)) { pg8::Gemm g{HB, (const bf16*)(ws + W_QKV), NPROMPT, NQKV, 1024}; pg8::StaticOrder S; S.init(NPROMPT, NQKV, G, (int)blockIdx.x);
        EpiQKV E{(bf16*)(ws + WS_Q), (bf16*)(ws + WS_KB), (bf16*)(ws + WS_VT), A.out, rowss + MP, (const float*)(ws + WS_ROPE), (const float*)(ws + WS_ROPE) + 8196 * 32, (const float*)(ws + WS_ROPE) + 2 * 8196 * 32, (const float*)(ws + WS_ROPE) + 2 * 8196 * 32 + 8 * 32};
        pg8::gemm_phase<EpiQKV, pg8::StaticOrder, true, true>(lds, g, S, E);
        skinny_phase(lds, g.A, g.Bt, NQKV, 1024, E, G >= 256 ? 128 : 0, wave, lane);
        { const int cf = G >= 256 ? 128 : 0; if ((int)blockIdx.x >= cf) convert_late(A, lds, ((int)blockIdx.x - cf) * NWAVES + wave, (G - cf) * NWAVES, wave, lane); }
#if DUP6 == 1
        pg8::gemm_phase<EpiQKV, pg8::StaticOrder, true, true>(lds, g, S, E);
#endif
#if DUP6 == 2
        { EpiUp E2{(bf16*)(ws + WS_OG), rowss + MP}; pg8::gemm_phase<EpiUp, pg8::StaticOrder, true, true>(lds, g, S, E2); }
#endif
    }
    SEAM(6);
    if (IN(7)) for (int rp = 0; rp < REP7; ++rp) {
        for (int it = gw; it < 2048; it += NGW) attn_sample_item(A, (LAS float*)(lds + 65536 + wave * 2048), it, lane);
        __syncthreads();
        attn_prompt_phase<false>(A, lds, tid, wave, lane, 1024, NATT_ITEMS);
    }
    SEAM(7);
    if (IN(8)) {
#if PROBE8 > 0
        attn_prompt_phase<true, PROBE8>(A, lds, tid, wave, lane, 0, 1024); __syncthreads();
#endif
        attn_prompt_phase<true>(A, lds, tid, wave, lane, 0, 1024); }
    SEAM(8);
    if (IN(9)) { pg8::Gemm g{(const bf16*)(ws + WS_ATT), (const bf16*)(ws + W_O), NPROMPT, 1024, 1024}; pg8::StaticOrder S; S.init(NPROMPT, 1024, G, (int)blockIdx.x);
        EpiRes E{HB, nullptr, rowss + 2 * MP};
        pg8::gemm_phase<EpiRes, pg8::StaticOrder, true, true>(lds, g, S, E);
        skinny_phase(lds, g.A, g.Bt, 1024, 1024, E, 0, wave, lane); }
    SEAM(9);
    if (IN(10)) { pg8::Gemm g{HB, (const bf16*)(ws + W_UP1), NPROMPT, FF, 1024}; pg8::StaticOrder S; S.init(NPROMPT, FF, G, (int)blockIdx.x);
        EpiUp E{(bf16*)(ws + WS_ACT), rowss + 2 * MP};
        pg8::gemm_phase<EpiUp, pg8::StaticOrder, true, true>(lds, g, S, E);
        skinny_phase(lds, g.A, g.Bt, FF, 1024, E, 0, wave, lane); }
    SEAM(10);
    if (IN(11)) { pg8::Gemm g{(const bf16*)(ws + WS_ACT), (const bf16*)(ws + W_DN1), NPROMPT, 1024, FF}; pg8::StaticOrder S; S.init(NPROMPT, 1024, G, (int)blockIdx.x);
        EpiRes E{HB, nullptr, rowss + 3 * MP};
        pg8::gemm_phase<EpiRes, pg8::StaticOrder, true, true>(lds, g, S, E);
        skinny_phase(lds, g.A, g.Bt, 1024, FF, E, 0, wave, lane); }
    SEAM(11);
    if (IN(12)) {
        const float* gfin = A.in[24];
        for (int row0 = 4 * gw; row0 < MREAL; row0 += 4 * NGW) {
            bf16x8 hv[4][2]; float rs[4];
#pragma unroll
            for (int q = 0; q < 4; ++q) { rs[q] = rowss[3 * MP + row0 + q];
#pragma unroll
                for (int j = 0; j < 2; ++j) hv[q][j] = *((const bf16x8*)(HB + (size_t)(row0 + q) * D) + lane + 64 * j); }
#pragma unroll
            for (int j = 0; j < 2; ++j) { const f32x4 g0 = *((const f32x4*)gfin + 2 * (lane + 64 * j)), g1 = *((const f32x4*)gfin + 2 * (lane + 64 * j) + 1);
#pragma unroll
                for (int q = 0; q < 4; ++q) { const float rstd = rsqrtf(rs[q] * (1.f / D) + EPS); float* orow = A.out + (size_t)(row0 + q) * D;
                    f32x4 o0, o1;
#pragma unroll
                    for (int i = 0; i < 4; ++i) { o0[i] = bf2f((unsigned short)hv[q][j][i]) * rstd * g0[i]; o1[i] = bf2f((unsigned short)hv[q][j][4 + i]) * rstd * g1[i]; }
                    *((f32x4*)orow + 2 * (lane + 64 * j)) = o0; *((f32x4*)orow + 2 * (lane + 64 * j) + 1) = o1; } }
        }
    }
#undef IN
#undef SEAM
}

#ifndef N_LAUNCHES
#define N_LAUNCHES 1
#endif
extern "C" void kernel_launch(void* const* d_in, const int* in_sizes, int n_in, void* d_out, int out_size, void* d_ws, size_t ws_size, hipStream_t stream) {
    static int grid = 0;
    if (grid == 0) {
        if (n_in != 25 || ws_size < WS_END) { fprintf(stderr, "kernel_launch: unexpected n_in %d / ws %zu\n", n_in, ws_size); grid = -1; return; }
        int dev = 0, cus = 0, per_cu = 0;
        hipGetDevice(&dev); hipDeviceGetAttribute(&cus, hipDeviceAttributeMultiprocessorCount, dev);
        if (hipFuncSetAttribute((const void*)yoco_fwd, hipFuncAttributeMaxDynamicSharedMemorySize, LDS_BYTES) != hipSuccess) { fprintf(stderr, "hipFuncSetAttribute failed\n"); grid = -1; return; }
        hipOccupancyMaxActiveBlocksPerMultiprocessor(&per_cu, (const void*)yoco_fwd, NTHREADS, LDS_BYTES);
        (void)hipGetLastError();
        if (per_cu < 1) per_cu = 1;
        grid = cus * per_cu;
    }
    if (grid < 0) return;
    Args a{};
    for (int i = 0; i < 25; ++i) a.in[i] = (const float*)d_in[i];
    a.out = (float*)d_out; a.ws = (unsigned char*)d_ws;
    if (hipMemsetAsync((char*)d_ws + WS_BAR, 0, 16384, stream) != hipSuccess) { fprintf(stderr, "memset failed\n"); return; }
    if (N_LAUNCHES == 1) {
        a.ph_lo = 0; a.ph_hi = NPHASE;
        void* args[] = {&a};
        hipError_t e = hipLaunchCooperativeKernel((const void*)yoco_fwd, dim3(grid), dim3(NTHREADS), args, LDS_BYTES, stream);
        if (e != hipSuccess) fprintf(stderr, "cooperative launch failed: %s (grid %d)\n", hipGetErrorString(e), grid);
    } else {
        for (int p = 0; p < NPHASE; ++p) { a.ph_lo = p; a.ph_hi = p + 1; hipLaunchKernelGGL(yoco_fwd, dim3(grid), dim3(NTHREADS), LDS_BYTES, stream, a); }
    }
}
```

```cpp
#include <hip/hip_runtime.h>
#include <hip/hip_cooperative_groups.h>
#include <cstdio>
#include <cstdint>
#include <cmath>
namespace cg = cooperative_groups;
namespace pg8 {
#define PG8_LAS __attribute__((address_space(3)))
typedef unsigned short bf16_t;
typedef short bf16x8 __attribute__((ext_vector_type(8)));
typedef float f32x4 __attribute__((ext_vector_type(4)));
typedef unsigned u32x4 __attribute__((ext_vector_type(4)));
constexpr int BM = 256, BK = 64, HALF = 128, HTB = HALF * BK * 2  , STAGE_BYTES = 8 * HTB, NXCD = 8, WGM = 8;

__host__ __device__ __forceinline__ int lds_byte(int r, int c) { const int st = (r >> 4) * 2 + (c >> 5), rr = r & 15, cc = c & 31, ob = rr * 64 + cc * 2; return st * 1024 + (ob ^ (((ob >> 9) & 1) << 5)); }
__host__ __device__ __forceinline__ void stage_rc(int b, int& R, int& C) { const int st = b / 1024, sb = b % 1024, swz = sb ^ (((sb >> 9) & 1) << 5); R = (st >> 1) * 16 + swz / 64; C = (st & 1) * 32 + (swz % 64) / 2; }
__host__ __device__ __forceinline__ int perm32(int rho) { const int n = rho >> 4, i = rho & 15; return 8 * (i >> 2) + 4 * n + (i & 3); }

struct Unit { int pm, pn; };
struct Gemm { const bf16_t* A; const bf16_t* Bt; int M, N, K; };

struct StaticOrder {
    int nM, nN, nwg, G, c;
    __host__ __device__ void init(int M, int N, int G_, int c_) { nM = M / BM; nN = N / BM; nwg = nM * nN; G = G_; c = c_; }
    __host__ __device__ bool next(int i, Unit& u) const {
        const long L = (long)i * G + c; if (L >= nwg) return false;
        int wgid = (int)L; { const int q = nwg / NXCD, r = nwg % NXCD, xcd = wgid % NXCD, off = wgid / NXCD; wgid = (xcd < r ? xcd * (q + 1) : r * (q + 1) + (xcd - r) * q) + off; }
        const int nig = WGM * nN, gid = wgid / nig, fm = gid * WGM, gsz = (nM - fm) < WGM ? (nM - fm) : WGM;
        u.pm = fm + ((wgid % nig) % gsz); u.pn = (wgid % nig) / gsz; return true;
    }
    __device__ __forceinline__ void a_ready(const Unit&) const {}
    __device__ __forceinline__ void done(const Unit&) const {}
};

__device__ __forceinline__ unsigned cvt_pk_bf16(float lo, float hi) { unsigned r; asm volatile("v_cvt_pk_bf16_f32 %0, %1, %2" : "=v"(r) : "v"(lo), "v"(hi)); return r; }
typedef float f32x2 __attribute__((ext_vector_type(2)));
__device__ __forceinline__ f32x2 gelu_pk(f32x2 v) {
    const f32x2 av = __builtin_elementwise_abs(v), d = av * 0.2316418882f + 1.0f;
    f32x2 t; t.x = __builtin_amdgcn_rcpf(d.x); t.y = __builtin_amdgcn_rcpf(d.y);
    f32x2 q = t * 0.5307027145f + (-0.7265760135f); q = q * t + 0.7107068705f; q = q * t + (-0.142248368f); q = q * t + 0.127414796f; q = q * t;
    const f32x2 s = (v * v) * (-0.72134752044f);
    f32x2 e; e.x = __builtin_amdgcn_exp2f(s.x); e.y = __builtin_amdgcn_exp2f(s.y);
    const f32x2 m = v * (q * e), r = v - m;
    f32x2 o; o.x = v.x < 0.f ? m.x : r.x; o.y = v.y < 0.f ? m.y : r.y; return o;
}


template <class Epi, class Sched, bool ALIGN_EPI = false, bool SP2 = false>
__device__ __forceinline__ void gemm_phase(PG8_LAS unsigned char* lds, const Gemm g, const Sched& S, const Epi& E) {
    const int tid = threadIdx.x, wid = __builtin_amdgcn_readfirstlane(tid >> 6), lane = tid & 63, wr = wid >> 2, wc = wid & 3, fr = lane & 15, fq = lane >> 4;
    const int K = g.K, nt = K / BK;
    unsigned voffA[2], voffB[2];
#pragma unroll
    for (int i = 0; i < 2; ++i) { int R, C; stage_rc(tid * 16 + i * 8192, R, C); const int Rb = Epi::PERM ? ((R & ~31) + perm32(R & 31)) : R;
        voffA[i] = (unsigned)(R * K + C) * 2u; voffB[i] = (unsigned)(Rb * K + C) * 2u; }
    const size_t kstep = (size_t)(BK * 2);
    const size_t hstep = (size_t)HALF * K * 2;
    const size_t tstep = 2 * hstep;
    const unsigned ldsw = (unsigned)wid * 1024u;
    const int aoff = lds_byte(wr * 64 + fr, fq * 8), boff = lds_byte(wc * 32 + fr, fq * 8);
#define PG8_SA(b, h) (((b) * 2 + (h)) * HTB)
#define PG8_SB(b, h) ((4 + (b) * 2 + (h)) * HTB)
#define PG8_STAGE(bufoff, gbase, voff) do { _Pragma("unroll") for (int _i = 0; _i < 2; ++_i) \
        __builtin_amdgcn_global_load_lds((const unsigned*)((const char*)(gbase) + (voff)[_i]), (PG8_LAS unsigned*)(lds + (bufoff) + ldsw + _i * 8192), 16, 0, 0); } while (0)
#define PG8_LDA(dst, b, h) do { _Pragma("unroll") for (int m = 0; m < 4; ++m) _Pragma("unroll") for (int k = 0; k < 2; ++k) dst[m][k] = *(const PG8_LAS bf16x8*)(lds + PG8_SA(b, h) + aoff + m * 2048 + k * 1024); } while (0)
#define PG8_LDB(dst, b, h) do { _Pragma("unroll") for (int n = 0; n < 2; ++n) _Pragma("unroll") for (int k = 0; k < 2; ++k) dst[n][k] = *(const PG8_LAS bf16x8*)(lds + PG8_SB(b, h) + boff + n * 2048 + k * 1024); } while (0)
#define PG8_MMA(ai, bj, At, Bt) do { __builtin_amdgcn_s_setprio(1); _Pragma("unroll") for (int m = 0; m < 4; ++m) _Pragma("unroll") for (int n = 0; n < 2; ++n) _Pragma("unroll") for (int k = 0; k < 2; ++k) \
        acc[ai][bj][m][n] = __builtin_amdgcn_mfma_f32_16x16x32_bf16(Bt[n][k], At[m][k], acc[ai][bj][m][n], 0, 0, 0); __builtin_amdgcn_s_setprio(0); } while (0)
#define PG8_WAIT_V(n) asm volatile("s_waitcnt vmcnt(" #n ")" ::: "memory")
#define PG8_WAIT_L(n) asm volatile("s_waitcnt lgkmcnt(" #n ")" ::: "memory")
#define PG8_BAR __builtin_amdgcn_s_barrier()
#define PG8_SCHED __builtin_amdgcn_sched_barrier(0)
    Unit cur, nxt; int ui = 0;
    if (!S.next(0, cur)) return;
    f32x4 acc[2][2][4][2];
#pragma unroll
    for (int a = 0; a < 2; ++a)
#pragma unroll
        for (int b = 0; b < 2; ++b)
#pragma unroll
            for (int m = 0; m < 4; ++m)
#pragma unroll
                for (int n = 0; n < 2; ++n) acc[a][b][m][n] = (f32x4){0.f, 0.f, 0.f, 0.f};
    bf16x8 At[4][2], B0[2][2], B1[2][2];
    const char* cA = (const char*)g.A + (size_t)cur.pm * tstep; const char* cB = (const char*)g.Bt + (size_t)cur.pn * tstep;
    S.a_ready(cur);
    if constexpr (SP2) {
        PG8_STAGE(PG8_SB(0, 0), cB, voffB); PG8_STAGE(PG8_SB(0, 1), cB + hstep, voffB); PG8_STAGE(PG8_SA(0, 0), cA, voffA); PG8_STAGE(PG8_SA(0, 1), cA + hstep, voffA);
        if (wr == 1) PG8_BAR;
        PG8_WAIT_V(2); PG8_BAR;
        PG8_STAGE(PG8_SB(1, 0), cB + kstep, voffB); PG8_STAGE(PG8_SA(1, 0), cA + kstep, voffA); PG8_STAGE(PG8_SB(1, 1), cB + hstep + kstep, voffB);
        PG8_WAIT_V(6); PG8_BAR;
    } else {
        PG8_STAGE(PG8_SB(0, 0), cB, voffB); PG8_STAGE(PG8_SA(0, 0), cA, voffA); PG8_STAGE(PG8_SB(0, 1), cB + hstep, voffB); PG8_STAGE(PG8_SA(0, 1), cA + hstep, voffA);
        if (wr == 1) PG8_BAR;
        PG8_WAIT_V(4); PG8_BAR;
        PG8_STAGE(PG8_SB(1, 0), cB + kstep, voffB); PG8_STAGE(PG8_SA(1, 0), cA + kstep, voffA); PG8_STAGE(PG8_SB(1, 1), cB + hstep + kstep, voffB);
        PG8_WAIT_V(6); PG8_BAR;
    }
    for (;;) {
        const bool has_next = S.next(ui + 1, nxt);
        const char* nA = has_next ? (const char*)g.A + (size_t)nxt.pm * tstep : cA; const char* nB = has_next ? (const char*)g.Bt + (size_t)nxt.pn * tstep : cB;
        for (int t = 0; t < nt; t += 2) {
            const bool last = (t == nt - 2);
            const char* a1 = cA + (size_t)(t + 1) * kstep;
            const char* a2 = last ? nA : cA + (size_t)(t + 2) * kstep; const char* b2 = last ? nB : cB + (size_t)(t + 2) * kstep;
            const char* a3 = a2 + kstep; const char* b3 = b2 + kstep;
            if (last && has_next) S.a_ready(nxt);
            if constexpr (SP2) {
            PG8_LDB(B0, 0, 0); PG8_LDB(B1, 0, 1); PG8_SCHED; PG8_LDA(At, 0, 0); PG8_STAGE(PG8_SA(1, 1), a1 + hstep, voffA);
            PG8_WAIT_V(8); PG8_WAIT_L(0); PG8_BAR; PG8_MMA(0, 0, At, B0); PG8_MMA(0, 1, At, B1); PG8_BAR; PG8_SCHED;
            PG8_LDA(At, 0, 1); PG8_STAGE(PG8_SB(0, 0), b2, voffB); PG8_STAGE(PG8_SB(0, 1), b2 + hstep, voffB); PG8_STAGE(PG8_SA(0, 0), a2, voffA);
            PG8_WAIT_V(8); PG8_WAIT_L(0); PG8_BAR; PG8_MMA(1, 0, At, B0); PG8_MMA(1, 1, At, B1); PG8_BAR; PG8_SCHED;
            PG8_LDB(B0, 1, 0); PG8_LDB(B1, 1, 1); PG8_SCHED; PG8_LDA(At, 1, 0); PG8_STAGE(PG8_SA(0, 1), a2 + hstep, voffA);
            PG8_WAIT_V(8); PG8_WAIT_L(0); PG8_BAR; PG8_MMA(0, 0, At, B0); PG8_MMA(0, 1, At, B1); PG8_BAR; PG8_SCHED;
            PG8_LDA(At, 1, 1); PG8_STAGE(PG8_SB(1, 0), b3, voffB); PG8_STAGE(PG8_SB(1, 1), b3 + hstep, voffB); PG8_STAGE(PG8_SA(1, 0), a3, voffA);
            PG8_WAIT_V(8); PG8_WAIT_L(0); PG8_BAR; PG8_MMA(1, 0, At, B0); PG8_MMA(1, 1, At, B1); PG8_BAR; PG8_SCHED;
            } else {
            PG8_LDB(B0, 0, 0); PG8_SCHED; PG8_LDA(At, 0, 0); PG8_STAGE(PG8_SA(1, 1), a1 + hstep, voffA);
            PG8_WAIT_L(8); PG8_BAR; PG8_WAIT_L(0); PG8_MMA(0, 0, At, B0); PG8_BAR; PG8_SCHED;
            PG8_LDB(B1, 0, 1); PG8_STAGE(PG8_SB(0, 0), b2, voffB);
            PG8_BAR; PG8_WAIT_L(0); PG8_MMA(0, 1, At, B1); PG8_BAR;
            PG8_LDA(At, 0, 1); PG8_STAGE(PG8_SA(0, 0), a2, voffA);
            PG8_BAR; PG8_WAIT_L(0); PG8_MMA(1, 0, At, B0); PG8_BAR; PG8_SCHED;
            PG8_STAGE(PG8_SB(0, 1), b2 + hstep, voffB);
            PG8_WAIT_V(6); PG8_BAR; PG8_MMA(1, 1, At, B1); PG8_BAR;
            PG8_LDB(B0, 1, 0); PG8_SCHED; PG8_LDA(At, 1, 0); PG8_STAGE(PG8_SA(0, 1), a2 + hstep, voffA);
            PG8_WAIT_L(8); PG8_BAR; PG8_WAIT_L(0); PG8_MMA(0, 0, At, B0); PG8_BAR; PG8_SCHED;
            PG8_LDB(B1, 1, 1); PG8_STAGE(PG8_SB(1, 0), b3, voffB);
            PG8_BAR; PG8_WAIT_L(0); PG8_MMA(0, 1, At, B1); PG8_BAR;
            PG8_LDA(At, 1, 1); PG8_STAGE(PG8_SA(1, 0), a3, voffA);
            PG8_BAR; PG8_WAIT_L(0); PG8_MMA(1, 0, At, B0); PG8_BAR; PG8_SCHED;
            PG8_STAGE(PG8_SB(1, 1), b3 + hstep, voffB);
            PG8_WAIT_V(6); PG8_BAR; PG8_MMA(1, 1, At, B1); PG8_BAR;
            }
        }
        if constexpr (ALIGN_EPI) { if (wr == 0) PG8_BAR; }
        if constexpr (!Epi::AFTER_DRAIN) { E(acc, cur, wr, wc, fr, fq); S.done(cur); }
        if (!has_next) break;
#pragma unroll
        for (int a = 0; a < 2; ++a)
#pragma unroll
            for (int b = 0; b < 2; ++b)
#pragma unroll
                for (int m = 0; m < 4; ++m)
#pragma unroll
                    for (int n = 0; n < 2; ++n) acc[a][b][m][n] = (f32x4){0.f, 0.f, 0.f, 0.f};
        cur = nxt; cA = nA; cB = nB; ++ui;
        if constexpr (ALIGN_EPI) { if (wr == 1) PG8_BAR; }
    }
    PG8_WAIT_V(0);
    if constexpr (!ALIGN_EPI) { if (wr == 0) PG8_BAR; }
    PG8_BAR;
    if constexpr (Epi::AFTER_DRAIN) { E.fused(acc, cur, wr, wc, fr, fq, lds, wid, lane); S.done(cur); }
#undef PG8_SA
#undef PG8_SB
#undef PG8_STAGE
#undef PG8_LDA
#undef PG8_LDB
#undef PG8_MMA
#undef PG8_WAIT_V
#undef PG8_WAIT_L
#undef PG8_BAR
#undef PG8_SCHED
}
}

#define LAS __attribute__((address_space(3)))
typedef unsigned short bf16;
typedef short bf16x8 __attribute__((ext_vector_type(8)));
typedef float f32x4 __attribute__((ext_vector_type(4)));
typedef float f32x16 __attribute__((ext_vector_type(16)));
typedef unsigned u32x4 __attribute__((ext_vector_type(4)));
typedef unsigned u32x2 __attribute__((ext_vector_type(2)));
typedef float f32x2_t __attribute__((ext_vector_type(2)));
typedef __bf16 bf16x2_t __attribute__((ext_vector_type(2)));

constexpr int NWAVES = 8, NTHREADS = 512;
constexpr int D = 1024, SEQ = 8192, NPROMPT = 16384, NSAMP = 128, MREAL = NPROMPT + NSAMP, MP = 16640;
constexpr int FF = 4096, QW = 3072, KVW = 1536, NQKV = QW + KVW;
constexpr float EPS = 1e-6f;
constexpr float QSCALE = 0.125f * 1.4426950408889634f;
constexpr int LDS_BYTES = 147456;

constexpr size_t MiB = 1u << 20;
constexpr size_t WS_ROWSS = 0;
constexpr size_t WS_BAR = 384 * 1024;
constexpr size_t WS_LAM = 512 * 1024;
constexpr size_t WS_BBAR = 576 * 1024;
constexpr size_t WS_CC = 1 * MiB;
constexpr size_t WS_ROPE = 1536 * 1024;
constexpr size_t WS_E = 3840 * 1024;
constexpr size_t WS_W = 8 * MiB;
constexpr size_t W_GLU = WS_W, W_UP0 = W_GLU + 2048ull * 1024 * 2, W_DN0 = W_UP0 + 4096ull * 1024 * 2, W_QKV = W_DN0 + 4096ull * 1024 * 2,
                 W_O = W_QKV + (size_t)NQKV * 1024 * 2, W_UP1 = W_O + 1024ull * 1024 * 2, W_DN1 = W_UP1 + 4096ull * 1024 * 2, W_END = W_DN1 + 4096ull * 1024 * 2;
static_assert(W_END <= 56 * MiB, "weights");
constexpr size_t WS_H = 56 * MiB;
constexpr size_t WS_HB = 121 * MiB;
constexpr size_t WS_HN0 = 154 * MiB;
constexpr size_t WS_VT = WS_HN0;
constexpr size_t WS_Y = 187 * MiB;
constexpr size_t WS_ATT = WS_Y;
constexpr size_t WS_ACT = 220 * MiB;
constexpr size_t WS_Q = WS_ACT;
constexpr size_t WS_KB = WS_Q + (size_t)MP * QW * 2;
static_assert(WS_KB + 3ull * MP * 256 * 2 <= 350 * MiB, "q/k overlay");
constexpr size_t WS_OG = 350 * MiB;
constexpr size_t WS_LSE = 448 * MiB;
constexpr size_t WS_END = 452 * MiB;

constexpr size_t O_YP = 0, O_YS = 16777216, O_KVP0 = 16908288, O_KVP1 = 17039360, O_KVP2 = 17563648,
                 O_KVS0 = 19660800, O_KVS1 = 19726336, O_KVS2 = 19791872, O_SREP = 19857408, O_SIMP = 19865600, O_SRES = 19873792, O_SIMS = 20004864;

__device__ __forceinline__ unsigned pk2(float lo, float hi) { f32x2_t v = {lo, hi}; bf16x2_t b = __builtin_convertvector(v, bf16x2_t); return __builtin_bit_cast(unsigned, b); }
__device__ __forceinline__ float bf2f(unsigned short u) { return __uint_as_float(((unsigned)u) << 16); }
__device__ __forceinline__ float wave_sum(float v) {
#pragma unroll
    for (int o = 1; o < 64; o <<= 1) v += __shfl_xor(v, o);
    return v;
}
__device__ __forceinline__ float wave_max(float v) {
#pragma unroll
    for (int o = 1; o < 64; o <<= 1) v = fmaxf(v, __shfl_xor(v, o));
    return v;
}

struct Args { const float* in[25]; float* out; unsigned char* ws; int ph_lo, ph_hi; };

struct EpiGlu {
    static constexpr bool PERM = true, AFTER_DRAIN = false;
    const float* xp; const float* xs; float* H; bf16* HB; float* rowss;
    __device__ __forceinline__ void operator()(const pg8::f32x4 (&acc)[2][2][4][2], const pg8::Unit& u, int wr, int wc, int fr, int fq) const { run<2>(acc, u, wr, wc, fr, fq); }
    template <int NAI> __device__ __forceinline__ void run(const pg8::f32x4 (&acc)[NAI][2][4][2], const pg8::Unit& u, int wr, int wc, int fr, int fq) const {
        const int col = u.pn * 128 + wc * 32 + 8 * fq;
#pragma unroll
        for (int ai = 0; ai < NAI; ++ai)
#pragma unroll
            for (int m = 0; m < 4; ++m) {
                const int row = u.pm * 256 + ai * 128 + wr * 64 + m * 16 + fr;
                if (row < MREAL) {
                    const float* xr = (row < NPROMPT ? xp + (size_t)row * D : xs + (size_t)(row - NPROMPT) * D) + col;
                    const f32x4 x0 = *(const f32x4*)xr, x1 = *(const f32x4*)(xr + 4);
                    f32x4 h0, h1;
#pragma unroll
                    for (int i = 0; i < 4; ++i) {
                        h0[i] = x0[i] + acc[ai][0][m][0][i] / (1.f + __expf(-acc[ai][1][m][0][i]));
                        h1[i] = x1[i] + acc[ai][0][m][1][i] / (1.f + __expf(-acc[ai][1][m][1][i]));
                    }
                    u32x4 w; w.x = pk2(h0[0], h0[1]); w.y = pk2(h0[2], h0[3]); w.z = pk2(h1[0], h1[1]); w.w = pk2(h1[2], h1[3]);
                    *(u32x4*)(HB + (size_t)row * D + col) = w;
                    float ss = (h0[0] * h0[0] + h0[1] * h0[1]) + (h0[2] * h0[2] + h0[3] * h0[3]) + (h1[0] * h1[0] + h1[1] * h1[1]) + (h1[2] * h1[2] + h1[3] * h1[3]);
                    ss += __shfl_xor(ss, 16); ss += __shfl_xor(ss, 32);
                    if (fq == 0) __hip_atomic_fetch_add(rowss + row, ss, __ATOMIC_RELAXED, __HIP_MEMORY_SCOPE_AGENT);
                } else { float ss = 0.f; ss += __shfl_xor(ss, 16); ss += __shfl_xor(ss, 32); (void)ss; }
            }
    }
};
struct EpiNull {
    static constexpr bool PERM = true, AFTER_DRAIN = false; float* sink;
    __device__ __forceinline__ void operator()(const pg8::f32x4 (&acc)[2][2][4][2], const pg8::Unit& u, int wr, int wc, int fr, int fq) const { run<2>(acc, u, wr, wc, fr, fq); }
    template <int NAI> __device__ __forceinline__ void run(const pg8::f32x4 (&acc)[NAI][2][4][2], const pg8::Unit& u, int wr, int wc, int fr, int fq) const {
        float t = 0.f;
#pragma unroll
        for (int b = 0; b < 2; ++b)
#pragma unroll
            for (int m = 0; m < 4; ++m)
#pragma unroll
                for (int n = 0; n < 2; ++n) t += acc[0][b][m][n][0] + acc[0][b][m][n][3];
        if (t == 1234.5678f) sink[0] = t;
    }
};
struct EpiUp {
    static constexpr bool PERM = true, AFTER_DRAIN = false;
    bf16* O; const float* rowss;
    __device__ __forceinline__ void operator()(const pg8::f32x4 (&acc)[2][2][4][2], const pg8::Unit& u, int wr, int wc, int fr, int fq) const { run<2>(acc, u, wr, wc, fr, fq); }
    template <int NAI> __device__ __forceinline__ void run(const pg8::f32x4 (&acc)[NAI][2][4][2], const pg8::Unit& u, int wr, int wc, int fr, int fq) const {
        const int col = u.pn * 256 + wc * 32 + 8 * fq;
#pragma unroll
        for (int ai = 0; ai < NAI; ++ai)
#pragma unroll
            for (int m = 0; m < 4; ++m) {
                const int row = u.pm * 256 + ai * 128 + wr * 64 + m * 16 + fr;
                if (row < MREAL) {
                    const float rstd = rsqrtf(rowss[row] * (1.f / D) + EPS);
#pragma unroll
                    for (int bj = 0; bj < 2; ++bj) {
                        float v[8];
#pragma unroll
                        for (int i = 0; i < 4; ++i) { float a = fmaxf(acc[ai][bj][m][0][i] * rstd, 0.f), b = fmaxf(acc[ai][bj][m][1][i] * rstd, 0.f); v[i] = a * a; v[4 + i] = b * b; }
                        u32x4 w; w.x = pk2(v[0], v[1]); w.y = pk2(v[2], v[3]); w.z = pk2(v[4], v[5]); w.w = pk2(v[6], v[7]);
                        *(u32x4*)(O + (size_t)row * FF + col + bj * 128) = w;
                    }
                }
            }
    }
};
struct EpiRes {
    static constexpr bool PERM = true, AFTER_DRAIN = false;
    bf16* HB; float* OUT; float* rowss;
    __device__ __forceinline__ void operator()(const pg8::f32x4 (&acc)[2][2][4][2], const pg8::Unit& u, int wr, int wc, int fr, int fq) const { run<2>(acc, u, wr, wc, fr, fq); }
    template <int NAI> __device__ __forceinline__ void run(const pg8::f32x4 (&acc)[NAI][2][4][2], const pg8::Unit& u, int wr, int wc, int fr, int fq) const {
        const int col = u.pn * 256 + wc * 32 + 8 * fq;
#pragma unroll
        for (int ai = 0; ai < NAI; ++ai)
#pragma unroll
            for (int m = 0; m < 4; ++m) {
                const int row = u.pm * 256 + ai * 128 + wr * 64 + m * 16 + fr;
                float ss = 0.f;
                if (row < MREAL) {
#pragma unroll
                    for (int bj = 0; bj < 2; ++bj) {
                        bf16* hp = HB + (size_t)row * D + col + bj * 128;
                        const bf16x8 hv = *(const bf16x8*)hp;
                        f32x4 h0, h1;
#pragma unroll
                        for (int i = 0; i < 4; ++i) { h0[i] = bf2f((unsigned short)hv[i]) + acc[ai][bj][m][0][i]; h1[i] = bf2f((unsigned short)hv[4 + i]) + acc[ai][bj][m][1][i]; }
                        if (OUT) { float* op = OUT + (size_t)row * D + col + bj * 128; *(f32x4*)op = h0; *(f32x4*)(op + 4) = h1; }
                        else { u32x4 w; w.x = pk2(h0[0], h0[1]); w.y = pk2(h0[2], h0[3]); w.z = pk2(h1[0], h1[1]); w.w = pk2(h1[2], h1[3]); *(u32x4*)hp = w; }
                        ss += (h0[0] * h0[0] + h0[1] * h0[1]) + (h0[2] * h0[2] + h0[3] * h0[3]) + (h1[0] * h1[0] + h1[1] * h1[1]) + (h1[2] * h1[2] + h1[3] * h1[3]);
                    }
                }
                ss += __shfl_xor(ss, 16); ss += __shfl_xor(ss, 32);
                if (fq == 0 && row < MREAL) __hip_atomic_fetch_add(rowss + row, ss, __ATOMIC_RELAXED, __HIP_MEMORY_SCOPE_AGENT);
            }
    }
};
struct EpiQKV {
    static constexpr bool PERM = true, AFTER_DRAIN = false;
    bf16* Q; bf16* KB; bf16* VB; float* out; const float* rowss; const float* ropec; const float* ropes; const float* offc; const float* offs;
    __device__ __forceinline__ void operator()(const pg8::f32x4 (&acc)[2][2][4][2], const pg8::Unit& u, int wr, int wc, int fr, int fq) const { run<2>(acc, u, wr, wc, fr, fq); }
    template <int NAI> __device__ __forceinline__ void run(const pg8::f32x4 (&acc)[NAI][2][4][2], const pg8::Unit& u, int wr, int wc, int fr, int fq) const {
        const int pn = u.pn;
        const bool isq = pn < 12; const int kvi = pn - 12; const int g = isq ? (pn >> 2) : (kvi >> 1); const bool isv = (!isq) && (kvi & 1);
        const int sh = 2 * g, W = 128 << sh;
        const bool stile = u.pm == 64;
        const int d0 = 8 * fq;
        const int slb = ((u.pm * 256 + wr * 64 + fr) & (SEQ - 1)) * 32 + d0;
#pragma unroll
        for (int ai = 0; ai < NAI; ++ai)
#pragma unroll
            for (int m = 0; m < 4; ++m) {
                const int row = u.pm * 256 + ai * 128 + wr * 64 + m * 16 + fr;
                if (row >= MREAL) continue;
                const float rstd = rsqrtf(rowss[row] * (1.f / D) + EPS);
                const bool samp = row >= NPROMPT; const int t = samp ? ((row - NPROMPT) & 3) : (row & (SEQ - 1));
                int rowp = row;
                if (!samp) { const int b = row >> 13, r = t & ((1 << sh) - 1), uu = t >> sh; rowp = b * SEQ + r * (SEQ >> sh) + uu; }
                float* ob = nullptr;
                if (!isq) {
                    if (samp) ob = out + (g == 0 ? O_KVS0 : g == 1 ? O_KVS1 : O_KVS2) + (size_t)(row - NPROMPT) * 512;
                    else if (t >= SEQ - W) ob = out + (g == 0 ? O_KVP0 : g == 1 ? O_KVP1 : O_KVP2) + ((size_t)(row >> 13) * W + (t - (SEQ - W))) * 512;
                }
                f32x4 av[2], bv[2];
#pragma unroll
                for (int n = 0; n < 2; ++n) {
                    f32x4 a = acc[ai][0][m][n] * rstd, b = acc[ai][1][m][n] * rstd;
                    if (!isv) {
                        const int sl = (samp ? SEQ + t : t) * 32 + d0 + 4 * n; const f32x4 c = *(const f32x4*)(ropec + sl), sn = *(const f32x4*)(ropes + sl);
                        const f32x4 ra = a * c - b * sn, rb = b * c + a * sn; a = ra; b = rb;
                    }
                    av[n] = a; bv[n] = b;
                }
                if (isq) {
                    bf16* qp = Q + (size_t)row * QW + pn * 256 + wc * 64 + d0;
                    u32x4 w0, w1; w0.x = pk2(av[0][0] * QSCALE, av[0][1] * QSCALE); w0.y = pk2(av[0][2] * QSCALE, av[0][3] * QSCALE); w0.z = pk2(av[1][0] * QSCALE, av[1][1] * QSCALE); w0.w = pk2(av[1][2] * QSCALE, av[1][3] * QSCALE);
                    w1.x = pk2(bv[0][0] * QSCALE, bv[0][1] * QSCALE); w1.y = pk2(bv[0][2] * QSCALE, bv[0][3] * QSCALE); w1.z = pk2(bv[1][0] * QSCALE, bv[1][1] * QSCALE); w1.w = pk2(bv[1][2] * QSCALE, bv[1][3] * QSCALE);
                    *(u32x4*)qp = w0; *(u32x4*)(qp + 32) = w1;
                } else {
                    bf16* kp = (isv ? VB : KB) + ((size_t)g * MP + rowp) * 256 + wc * 64 + d0;
                    u32x4 w0, w1; w0.x = pk2(av[0][0], av[0][1]); w0.y = pk2(av[0][2], av[0][3]); w0.z = pk2(av[1][0], av[1][1]); w0.w = pk2(av[1][2], av[1][3]);
                    w1.x = pk2(bv[0][0], bv[0][1]); w1.y = pk2(bv[0][2], bv[0][3]); w1.z = pk2(bv[1][0], bv[1][1]); w1.w = pk2(bv[1][2], bv[1][3]);
                    *(u32x4*)kp = w0; *(u32x4*)(kp + 32) = w1;
                    if (ob) { float* o2 = ob + (isv ? 256 : 0) + wc * 64 + d0; *(f32x4*)o2 = av[0]; *(f32x4*)(o2 + 4) = av[1]; *(f32x4*)(o2 + 32) = bv[0]; *(f32x4*)(o2 + 36) = bv[1]; }
                }
            }
    }
};

template <class Epi>
__device__ __forceinline__ void skinny_phase(LAS unsigned char* lds, const bf16* Abuf, const bf16* Bt, int N, int K, const Epi& E, int first, int wave, int lane) {
    const int nroles = (N >> 8) * 8, G = gridDim.x;
    const int fr = lane & 15, fq = lane >> 4;
    LAS float* red = (LAS float*)lds;
    const int rstep = first ? G - first : G;
    for (int role = (int)blockIdx.x - first; role < nroles; role += rstep) {
        if (role < 0) break;
        const int pn = role >> 3, wr = (role >> 2) & 1, wc = role & 3;
        pg8::f32x4 acc[1][2][4][2];
#pragma unroll
        for (int b = 0; b < 2; ++b)
#pragma unroll
            for (int m = 0; m < 4; ++m)
#pragma unroll
                for (int n = 0; n < 2; ++n) acc[0][b][m][n] = (pg8::f32x4){0.f, 0.f, 0.f, 0.f};
        const int kper = K >> 3, k0 = wave * kper;
        const bf16* ap = Abuf + (size_t)(NPROMPT + 64 * wr + fr) * K + k0 + 8 * fq;
        const int r0 = Epi::PERM ? (8 * (fr >> 2) + (fr & 3)) : fr, r1 = Epi::PERM ? r0 + 4 : fr + 16;
        const bf16* bp = Bt + (size_t)(256 * pn + 32 * wc) * K + k0 + 8 * fq;
#pragma unroll 4
        for (int ks = 0; ks < kper; ks += 32) {
            bf16x8 af[4], bf_[2][2];
#pragma unroll
            for (int m = 0; m < 4; ++m) af[m] = *(const bf16x8*)(ap + (size_t)(16 * m) * K + ks);
#pragma unroll
            for (int b = 0; b < 2; ++b) { bf_[b][0] = *(const bf16x8*)(bp + (size_t)(128 * b + r0) * K + ks); bf_[b][1] = *(const bf16x8*)(bp + (size_t)(128 * b + r1) * K + ks); }
#pragma unroll
            for (int b = 0; b < 2; ++b)
#pragma unroll
                for (int m = 0; m < 4; ++m)
#pragma unroll
                    for (int n = 0; n < 2; ++n) acc[0][b][m][n] = __builtin_amdgcn_mfma_f32_16x16x32_bf16(bf_[b][n], af[m], acc[0][b][m][n], 0, 0, 0);
        }
        if (wave != 0) {
#pragma unroll
            for (int b = 0; b < 2; ++b)
#pragma unroll
                for (int m = 0; m < 4; ++m)
#pragma unroll
                    for (int n = 0; n < 2; ++n) *(LAS pg8::f32x4*)(red + ((size_t)((wave - 1) * 16 + b * 8 + m * 2 + n) * 64 + lane) * 4) = acc[0][b][m][n];
        }
        __syncthreads();
        if (wave == 0) {
#pragma unroll 1
            for (int w = 0; w < 7; ++w)
#pragma unroll
                for (int b = 0; b < 2; ++b)
#pragma unroll
                    for (int m = 0; m < 4; ++m)
#pragma unroll
                        for (int n = 0; n < 2; ++n) acc[0][b][m][n] += *(const LAS pg8::f32x4*)(red + ((size_t)(w * 16 + b * 8 + m * 2 + n) * 64 + lane) * 4);
            const pg8::Unit u{64, pn};
            E.template run<1>(acc, u, wr, wc, fr, fq);
        }
        __syncthreads();
    }
}
__device__ __forceinline__ int conv_srcc(int mode, int nb) {
    if (mode == 0) return 32 * nb;
    if (mode == 1) { const int pn = nb >> 3, bj = (nb >> 2) & 1, cb = nb & 3; return bj * 1024 + 128 * pn + 32 * cb; }
    const int pn = nb >> 3, bj = (nb >> 2) & 1, wc = nb & 3; return 256 * pn + 64 * wc + 32 * bj;
}
__device__ __forceinline__ void transpose_item(const float* W, int K, int N, bf16* WT, const float* gain, int mode, LAS float* scr, int item, int lane) {
    const int nblk = N >> 6, kb = item / nblk, nb64 = item % nblk, k0 = 64 * kb;
    const int l16 = lane & 15, srcc = conv_srcc(mode, 2 * nb64 + (l16 >> 3)) + 4 * (l16 & 7);
    f32x4 v[16];
#pragma unroll
    for (int i = 0; i < 16; ++i) { const int kk = 4 * i + (lane >> 4); v[i] = *(const f32x4*)(W + (size_t)(k0 + kk) * N + srcc); }
    if (gain) {
#pragma unroll
        for (int i = 0; i < 16; ++i) { const int kk = 4 * i + (lane >> 4); v[i] = v[i] * gain[k0 + kk]; }
    }
#pragma unroll
    for (int i = 0; i < 16; ++i) { const int kk = 4 * i + (lane >> 4); LAS float* d = scr + kk * 65 + 4 * l16; d[0] = v[i][0]; d[1] = v[i][1]; d[2] = v[i][2]; d[3] = v[i][3]; }
    asm volatile("s_waitcnt lgkmcnt(0)" ::: "memory");
    const int c = lane & 7;
#pragma unroll
    for (int j = 0; j < 8; ++j) { const int n = (lane >> 3) + 8 * j; const LAS float* sp = scr + (8 * c) * 65 + n;
        u32x4 o; o.x = pk2(sp[0 * 65], sp[1 * 65]); o.y = pk2(sp[2 * 65], sp[3 * 65]); o.z = pk2(sp[4 * 65], sp[5 * 65]); o.w = pk2(sp[6 * 65], sp[7 * 65]);
        *(u32x4*)(WT + (size_t)(64 * nb64 + n) * K + k0 + 8 * c) = o; }
    asm volatile("s_waitcnt lgkmcnt(0)" ::: "memory");
}
__device__ __forceinline__ void convert_late(const Args& A, LAS unsigned char* lds, int vw, int NVW, int wave, int lane) {
    unsigned char* ws = A.ws;
    LAS float* scr = (LAS float*)(lds + wave * 16640);
    constexpr int I_UP = 16 * 64, I_DN = 64 * 16, I_O = 16 * 16, NIT = I_O + I_UP + I_DN;
    for (int it = vw; it < NIT; it += NVW) {
        int r = it;
        if (r < I_O) { transpose_item(A.in[21], 1024, 1024, (bf16*)(ws + W_O), nullptr, 0, scr, r, lane); continue; } r -= I_O;
        if (r < I_UP) { transpose_item(A.in[22] + 1024ull * 4096, 1024, 4096, (bf16*)(ws + W_UP1), A.in[8] + 1024, 0, scr, r, lane); continue; } r -= I_UP;
        transpose_item(A.in[23] + 4096ull * 1024, 4096, 1024, (bf16*)(ws + W_DN1), nullptr, 0, scr, r, lane);
    }
}

__device__ __forceinline__ void phase_prologue(const Args& A, LAS unsigned char* lds, int gw, int NGW, int wave, int lane) {
    unsigned char* ws = A.ws;
    LAS float* scr = (LAS float*)(lds + wave * 16640);
    constexpr int I_GLU = 16 * 32, I_UP = 16 * 64, I_DN = 64 * 16, I_Q = 16 * 48, I_KV = 16 * 24;
    constexpr int NIT = I_GLU + I_UP + I_DN + I_Q + I_KV;
    for (int it = gw; it < NIT; it += NGW) {
        int r = it;
        if (r < I_GLU) { transpose_item(A.in[17], 1024, 2048, (bf16*)(ws + W_GLU), nullptr, 1, scr, r, lane); continue; } r -= I_GLU;
        if (r < I_UP) { transpose_item(A.in[22], 1024, 4096, (bf16*)(ws + W_UP0), A.in[8], 0, scr, r, lane); continue; } r -= I_UP;
        if (r < I_DN) { transpose_item(A.in[23], 4096, 1024, (bf16*)(ws + W_DN0), nullptr, 0, scr, r, lane); continue; } r -= I_DN;
        if (r < I_Q) { transpose_item(A.in[20], 1024, 3072, (bf16*)(ws + W_QKV), A.in[7] + 1024, 2, scr, r, lane); continue; } r -= I_Q;
        transpose_item(A.in[19], 1024, 1536, (bf16*)(ws + W_QKV) + 3072ull * 1024, A.in[18], 2, scr, r, lane);
    }
    {
        const float* gmix = A.in[7];
        bf16* HN0 = (bf16*)(ws + WS_HN0);
        for (int row0 = 4 * gw; row0 < MREAL; row0 += 4 * NGW) {
            f32x4 v[4][4]; float ssq[4];
#pragma unroll
            for (int q = 0; q < 4; ++q) { const int row = row0 + q; const float* xr = row < NPROMPT ? A.in[0] + (size_t)row * D : A.in[1] + (size_t)(row - NPROMPT) * D;
#pragma unroll
                for (int j = 0; j < 4; ++j) v[q][j] = *((const f32x4*)xr + lane + 64 * j); }
#pragma unroll
            for (int q = 0; q < 4; ++q) { float sq = 0.f;
#pragma unroll
                for (int j = 0; j < 4; ++j) sq += (v[q][j][0] * v[q][j][0] + v[q][j][1] * v[q][j][1]) + (v[q][j][2] * v[q][j][2] + v[q][j][3] * v[q][j][3]);
                ssq[q] = rsqrtf(wave_sum(sq) * (1.f / D) + EPS); }
#pragma unroll
            for (int j = 0; j < 4; ++j) { const f32x4 gg = *((const f32x4*)gmix + lane + 64 * j);
#pragma unroll
                for (int q = 0; q < 4; ++q) { const float rstd = ssq[q];
                    u32x2 w; w.x = pk2(v[q][j][0] * rstd * gg[0], v[q][j][1] * rstd * gg[1]); w.y = pk2(v[q][j][2] * rstd * gg[2], v[q][j][3] * rstd * gg[3]);
                    *((u32x2*)(HN0 + (size_t)(row0 + q) * D) + lane + 64 * j) = w; } }
        }
    }
    const int gt = gw * 64 + lane, NGT = NGW * 64;
    { float* rs = (float*)(ws + WS_ROWSS); for (int i = gt; i < 4 * MP; i += NGT) rs[i] = 0.f; }
    { float* rc = (float*)(ws + WS_ROPE); float* rsn = rc + 8196 * 32;
      for (int i = gt; i < 8196 * 32; i += NGT) { const int slot = i >> 5, d = i & 31; const float pos = slot < SEQ ? (float)slot : (float)(16384 + (slot - SEQ));
          const float inv = powf(10000.0f, -(float)d / 32.0f); const float ang = pos * inv; rc[i] = cosf(ang); rsn[i] = sinf(ang); } }
    { float* oc = (float*)(ws + WS_ROPE) + 2 * 8196 * 32; float* os = oc + 8 * 32;
      for (int i = gt; i < 8 * 32; i += NGT) { const int oi = i >> 5, d = i & 31; const float pos = (float)(128 * (oi >> 2) + 16 * (oi & 3));
          const float inv = powf(10000.0f, -(float)d / 32.0f); const float ang = pos * inv; oc[i] = cosf(ang); os[i] = sinf(ang); } }
    { float* lam = (float*)(ws + WS_LAM); bf16* BB = (bf16*)(ws + WS_BBAR); bf16* CC = (bf16*)(ws + WS_CC);
      const float *are = A.in[9], *aim = A.in[10], *ldt = A.in[11], *bre = A.in[12], *bim = A.in[13], *cre = A.in[14], *cim = A.in[15];
      for (int i = gt; i < 64 * 64 * 16; i += NGT) {
          const int c = i & 15, p = (i >> 4) & 63, g = i >> 10;
          const float dt = expf(ldt[g]); const float ar = are[g * 64 + p], ai = aim[g * 64 + p];
          const float mag = expf(ar * dt); const float lr = mag * cosf(ai * dt), li = mag * sinf(ai * dt);
          const float den = ar * ar + ai * ai, nr = lr - 1.f, ni = li;
          const float zr = (nr * ar + ni * ai) / den, zi = (ni * ar - nr * ai) / den;
          const float br = bre[(g * 64 + p) * 16 + c], bi = bim[(g * 64 + p) * 16 + c];
          const float bbr = zr * br - zi * bi, bbi = zr * bi + zi * br;
          BB[(g * 128 + p) * 16 + c] = (bf16)(pk2(bbr, 0.f) & 0xffffu);
          BB[(g * 128 + 64 + p) * 16 + c] = (bf16)(pk2(bbi, 0.f) & 0xffffu);
          CC[(g * 16 + c) * 128 + 4 * (p & 31) + (p >> 5)] = (bf16)(pk2(cre[(g * 16 + c) * 64 + p], 0.f) & 0xffffu);
          CC[(g * 16 + c) * 128 + 4 * (p & 31) + 2 + (p >> 5)] = (bf16)(pk2(-cim[(g * 16 + c) * 64 + p], 0.f) & 0xffffu);
          if (c == 0) { lam[(g * 64 + p) * 2] = lr; lam[(g * 64 + p) * 2 + 1] = li; }
      } }
}

#define CMUL_ADD(orr, oi, ar_, ai_, br_, bi_, cr_, ci_) do { const float _r = __builtin_fmaf((ar_), (br_), __builtin_fmaf(-(ai_), (bi_), (cr_))); const float _i = __builtin_fmaf((ar_), (bi_), __builtin_fmaf((ai_), (br_), (ci_))); orr = _r; oi = _i; } while (0)
template <bool PASS2>
__device__ __forceinline__ void s5_item(const Args& A, LAS unsigned char* hs, int item, int lane) {
    unsigned char* ws = A.ws;
    const bf16* HN0 = (const bf16*)(ws + WS_HN0);
    const bool samp = item >= 2048;
    const int g = item & 63, ch = samp ? 128 + ((item - 2048) >> 6) : 4 * (item >> 6);
    const int s = lane & 31, hf = lane >> 5;
    bf16x8 Bf[4], Cf[4];
    { const bf16* BB = (const bf16*)(ws + WS_BBAR) + (size_t)g * 128 * 16;
#pragma unroll
      for (int n = 0; n < 4; ++n) Bf[n] = *(const bf16x8*)(BB + (32 * n + s) * 16 + 8 * hf);
      if (PASS2) { const bf16* CC = (const bf16*)(ws + WS_CC) + (size_t)g * 16 * 128;
#pragma unroll
        for (int st = 0; st < 4; ++st) Cf[st] = *(const bf16x8*)(CC + (lane & 15) * 128 + 32 * st + 8 * (lane >> 4)); } }
    const float* lam = (const float*)(ws + WS_LAM) + (size_t)g * 128;
    float lr[2], li[2], l16r[2], l16i[2], l128r[2], l128i[2];
#pragma unroll
    for (int j = 0; j < 2; ++j) { lr[j] = lam[(s + 32 * j) * 2]; li[j] = lam[(s + 32 * j) * 2 + 1];
        float pr = lr[j], pi = li[j];
#pragma unroll
        for (int q = 0; q < 4; ++q) { const float nr = pr * pr - pi * pi, ni = 2.f * pr * pi; pr = nr; pi = ni; }
        l16r[j] = pr; l16i[j] = pi;
#pragma unroll
        for (int q = 0; q < 3; ++q) { const float nr = pr * pr - pi * pi, ni = 2.f * pr * pi; pr = nr; pi = ni; }
        l128r[j] = pr; l128i[j] = pi; }
    float cr[2] = {0.f, 0.f}, ci[2] = {0.f, 0.f};
    const float* E = (const float*)(ws + WS_E);
    if (PASS2) {
        if (samp) { const int n = ch - 128;
#pragma unroll
            for (int j = 0; j < 2; ++j) { cr[j] = A.in[5][((size_t)n * 64 + g) * 64 + s + 32 * j]; ci[j] = A.in[6][((size_t)n * 64 + g) * 64 + s + 32 * j]; } }
        else { const int first = (ch >> 6) << 6;
#pragma unroll 8
            for (int jj = first; jj < ch; ++jj) { const float* e = E + ((size_t)jj * 64 + g) * 128;
#pragma unroll
                for (int j = 0; j < 2; ++j) { const float er = e[j * 32 + s], ei = e[64 + j * 32 + s]; CMUL_ADD(cr[j], ci[j], l128r[j], l128i[j], cr[j], ci[j], er, ei); } } }
    }
    const int nblk = samp ? 1 : 16;
    const int rowbase = samp ? NPROMPT + 4 * (ch - 128) : ch * 128;
    const int tokA = 16 * ((s >> 2) & 1) + 4 * (s >> 3) + (s & 3);
    const float* dsk = A.in[16] + g * 16;
    bf16* Y = (bf16*)(ws + WS_Y);
    bf16x8 afn = *(const bf16x8*)(HN0 + (size_t)(rowbase + tokA) * D + g * 16 + 8 * hf);
    const int uoff = (lane & 15) * D + g * 16 + 4 * (lane >> 4);
    u32x2 un[2];
    if (PASS2) {
#pragma unroll
        for (int q = 0; q < 2; ++q) un[q] = *(const u32x2*)(HN0 + (size_t)(rowbase + 16 * q) * D + uoff);
    }
    const f32x4 dk4 = *(const f32x4*)(dsk + 4 * (lane >> 4));
    for (int blk = 0; blk < nblk; ++blk) {
        const int row0 = rowbase + 32 * blk;
        const bf16x8 af = afn;
        u32x2 uc[2];
        if (PASS2) {
#pragma unroll
            for (int q = 0; q < 2; ++q) uc[q] = un[q];
            if (blk + 1 < nblk) {
#pragma unroll
                for (int q = 0; q < 2; ++q) un[q] = *(const u32x2*)(HN0 + (size_t)(row0 + 32 + 16 * q) * D + uoff);
            }
        }
        if (!PASS2 && (blk & 3) == 0) { cr[0] = 0.f; cr[1] = 0.f; ci[0] = 0.f; ci[1] = 0.f; }
        if (blk + 1 < nblk) afn = *(const bf16x8*)(HN0 + (size_t)(row0 + 32 + tokA) * D + g * 16 + 8 * hf);
        f32x16 X[4];
        const f32x16 z16 = {0.f, 0.f, 0.f, 0.f, 0.f, 0.f, 0.f, 0.f, 0.f, 0.f, 0.f, 0.f, 0.f, 0.f, 0.f, 0.f};
#pragma unroll
        for (int n = 0; n < 4; ++n) X[n] = __builtin_amdgcn_mfma_f32_32x32x16_bf16(af, Bf[n], z16, 0, 0, 0);
        float cinr[2], cini[2];
#pragma unroll
        for (int j = 0; j < 2; ++j) {
            float er = 0.f, ei = 0.f;
#pragma unroll
            for (int r = 0; r < 16; ++r) CMUL_ADD(er, ei, lr[j], li[j], er, ei, X[j][r], X[2 + j][r]);
            const float or_ = __shfl_xor(er, 32), oi_ = __shfl_xor(ei, 32);
            const float e0r = hf ? or_ : er, e0i = hf ? oi_ : ei, e1r = hf ? er : or_, e1i = hf ? ei : oi_;
            float mr, mi; CMUL_ADD(mr, mi, l16r[j], l16i[j], cr[j], ci[j], e0r, e0i);
            cinr[j] = hf ? mr : cr[j]; cini[j] = hf ? mi : ci[j];
            CMUL_ADD(cr[j], ci[j], l16r[j], l16i[j], mr, mi, e1r, e1i);
        }
        if (PASS2) {
#pragma unroll
            for (int j = 0; j < 2; ++j) {
                float hr = cinr[j], hi = cini[j];
#pragma unroll
                for (int r = 0; r < 16; ++r) { CMUL_ADD(hr, hi, lr[j], li[j], hr, hi, X[j][r], X[2 + j][r]);
                    X[j][r] = hr; X[2 + j][r] = hi; }
            }
            if (samp && hf == 0) { const int n = ch - 128;
#pragma unroll
                for (int j = 0; j < 2; ++j) { A.out[O_SRES + ((size_t)n * 64 + g) * 64 + s + 32 * j] = X[j][3]; A.out[O_SIMS + ((size_t)n * 64 + g) * 64 + s + 32 * j] = X[2 + j][3]; } }
#pragma unroll
            for (int r = 0; r < 16; ++r) { LAS unsigned short* hp = (LAS unsigned short*)(hs + (16 * hf + r) * 272);
                u32x2 w; w.x = pk2(X[0][r], X[1][r]); w.y = pk2(X[2][r], X[3][r]);
                *(LAS u32x2*)(hp + 4 * s) = w; }
            asm volatile("s_waitcnt lgkmcnt(0)" ::: "memory");
#pragma unroll
            for (int tb = 0; tb < 2; ++tb) {
                f32x4 y = {0.f, 0.f, 0.f, 0.f};
#pragma unroll
                for (int st = 0; st < 4; ++st) { const bf16x8 hfrag = *(const LAS bf16x8*)(hs + (16 * tb + (lane & 15)) * 272 + 64 * st + 16 * (lane >> 4));
                    y = __builtin_amdgcn_mfma_f32_16x16x32_bf16(Cf[st], hfrag, y, 0, 0, 0); }
                const int tk = 16 * tb + (lane & 15);
                if (!samp || tk < 4) {
                    const float u0 = __uint_as_float(uc[tb].x << 16), u1 = __uint_as_float(uc[tb].x & 0xffff0000u), u2 = __uint_as_float(uc[tb].y << 16), u3 = __uint_as_float(uc[tb].y & 0xffff0000u);
                    f32x4 v = {y[0] + dk4[0] * u0, y[1] + dk4[1] * u1, y[2] + dk4[2] * u2, y[3] + dk4[3] * u3};
                    float ge[4];
#pragma unroll
                    for (int j = 0; j < 4; ++j) { const float z = 0.7978845608f * (v[j] + 0.044715f * v[j] * v[j] * v[j]); ge[j] = v[j] / (1.f + __expf(-2.f * z)); }
                    u32x2 w; w.x = pk2(ge[0], ge[1]); w.y = pk2(ge[2], ge[3]);
                    *(u32x2*)(Y + (size_t)(row0 + tk) * D + g * 16 + 4 * (lane >> 4)) = w;
                }
            }
            asm volatile("s_waitcnt lgkmcnt(0)" ::: "memory");
        }
        if (!PASS2 && (blk & 3) == 3 && hf == 0) { float* e = (float*)(ws + WS_E) + ((size_t)(ch + (blk >> 2)) * 64 + g) * 128;
#pragma unroll
            for (int j = 0; j < 2; ++j) { e[j * 32 + s] = cr[j]; e[64 + j * 32 + s] = ci[j]; } }
    }
    if (PASS2 && !samp && hf == 0 && ((ch + 3) & 63) == 63) { const int b = ch >> 6;
#pragma unroll
        for (int j = 0; j < 2; ++j) { A.out[O_SREP + ((size_t)b * 64 + g) * 64 + s + 32 * j] = cr[j]; A.out[O_SIMP + ((size_t)b * 64 + g) * 64 + s + 32 * j] = ci[j]; } }
}

typedef short v4i16_t __attribute__((ext_vector_type(4)));
constexpr int KIMG_STRIDE = 144, KIMG_BYTES = 192 * KIMG_STRIDE, VIMG_HALF = 192 * 64, NATT_ITEMS = 3072;
struct AttItem { int g, sh, b, r, u0, kvh; };
__device__ __forceinline__ AttItem att_decode(int bi) {
    AttItem I; I.g = bi >> 10; const int rem = bi & 1023; I.kvh = rem & 3; I.b = (rem >> 2) & 1; const int rq = rem >> 3;
    I.sh = 2 * I.g; const int nqb = 128 >> I.sh; I.r = rq / nqb; I.u0 = 64 * (rq % nqb); return I;
}
template <bool COMBINE, int MODE = 0>
__device__ __forceinline__ void attn_prompt_phase(const Args& A, LAS unsigned char* lds, int tid, int wave, int lane, int item_lo, int item_hi) {
    unsigned char* ws = A.ws;
    const bf16* Q = (const bf16*)(ws + WS_Q); const bf16* KB = (const bf16*)(ws + WS_KB); const bf16* VB = (const bf16*)(ws + WS_VT);
    bf16* OG = (bf16*)(ws + WS_OG); float* LSE = (float*)(ws + WS_LSE);
    const int G = gridDim.x, hh = wave & 3, sub = wave >> 2, n = lane & 31, hf = lane >> 5;
    const int kap = (n & 3) + 4 * ((n >> 3) & 1) + 8 * ((n >> 2) & 1) + 16 * (n >> 4);
    int bi = item_lo + blockIdx.x;
    const int NATT_HI = item_hi;
    if (bi >= NATT_HI) return;
    bf16* AT = (bf16*)(ws + WS_ATT);
    u32x4 pk_[3], pv_[3]; bf16x8 qn[4];
#define ATT_ISSUE_KV(bix) do { const AttItem J = att_decode(bix); const int L_ = SEQ >> J.sh; const size_t pb_ = (size_t)J.g * MP + (size_t)J.b * SEQ + (size_t)J.r * L_; \
        _Pragma("unroll") for (int i = 0; i < 3; ++i) { const int c_ = tid + 512 * i, row_ = c_ >> 3, ch_ = c_ & 7; int u_ = J.u0 - 128 + row_; u_ = u_ < 0 ? 0 : u_; \
            pk_[i] = *(const u32x4*)(KB + (pb_ + u_) * 256 + J.kvh * 64 + 8 * ch_); pv_[i] = *(const u32x4*)(VB + (pb_ + u_) * 256 + J.kvh * 64 + 8 * ch_); } } while (0)
#define ATT_ISSUE_Q(bix) do { const AttItem J = att_decode(bix); const int qrow_ = J.b * SEQ + ((J.u0 + 32 * sub + n) << J.sh) + J.r; \
        _Pragma("unroll") for (int ks = 0; ks < 4; ++ks) qn[ks] = *(const bf16x8*)(Q + (size_t)qrow_ * QW + J.g * 1024 + (4 * J.kvh + hh) * 64 + 16 * ks + 8 * hf); } while (0)
#define ATT_WRITE(bufo) do { _Pragma("unroll") for (int i = 0; i < 3; ++i) { const int c = tid + 512 * i, row = c >> 3, ch = c & 7; \
            *(LAS u32x4*)(lds + (bufo) + row * KIMG_STRIDE + 16 * ch) = pk_[i]; \
            *(LAS u32x4*)(lds + (bufo) + KIMG_BYTES + (ch >> 2) * VIMG_HALF + row * 64 + (ch & 3) * 16) = pv_[i]; } } while (0)
    constexpr int ABUF = KIMG_BYTES + 2 * VIMG_HALF;
    bf16x8 qf[4];
    ATT_ISSUE_KV(bi); ATT_ISSUE_Q(bi);
    ATT_WRITE(0);
#pragma unroll
    for (int ks = 0; ks < 4; ++ks) qf[ks] = qn[ks];
    if (bi + G < NATT_HI) ATT_ISSUE_KV(bi + G);
    asm volatile("s_waitcnt lgkmcnt(0)\n\ts_barrier" ::: "memory");
    int par = 0;
    for (; bi < NATT_HI; bi += G, par ^= 1) {
        const AttItem I = att_decode(bi);
        if (bi + G < NATT_HI) { ATT_WRITE((par ^ 1) * ABUF); ATT_ISSUE_Q(bi + G); }
        if (bi + 2 * G < NATT_HI) ATT_ISSUE_KV(bi + 2 * G);
        const LAS unsigned char* lbuf = lds + par * ABUF;
        const int u0w = I.u0 + 32 * sub;
        const int qrow = I.b * SEQ + ((u0w + n) << I.sh) + I.r;
        const int h = 4 * I.kvh + hh;
        f32x16 O0, O1;
#pragma unroll
        for (int i = 0; i < 16; ++i) { O0[i] = 0.f; O1[i] = 0.f; }
        float mrun = -INFINITY, lrun = 0.f;
        const int cc_ = lane & 7, rr0_ = lane >> 3;
        bf16x8 x1[4], x2[4]; float l1 = 0.f, l2 = 0.f;
        if (COMBINE) {
            l1 = LSE[((size_t)1 * MP + qrow) * 16 + h]; l2 = LSE[((size_t)2 * MP + qrow) * 16 + h];
#pragma unroll
            for (int j = 0; j < 4; ++j) { const int qr_ = I.b * SEQ + ((u0w + rr0_ + 8 * j) << I.sh) + I.r;
                x1[j] = *(const bf16x8*)(OG + ((size_t)1 * MP + qr_) * D + h * 64 + 8 * cc_); x2[j] = *(const bf16x8*)(OG + ((size_t)2 * MP + qr_) * D + h * 64 + 8 * cc_); }
        }
        const int kt0 = (MODE == 1 || MODE == 3) ? 5 : (u0w >= 128 ? 0 : (128 - u0w) >> 5);
        const LAS unsigned char* kimg = lbuf + (32 * sub + kap) * KIMG_STRIDE + 16 * hf;
        const LAS unsigned char* vimg = lbuf + KIMG_BYTES + (32 * sub + 8 * hf + ((lane & 15) >> 2)) * 64 + (16 * ((lane >> 4) & 1) + 4 * (lane & 3)) * 2;
        for (int kt = kt0; kt < 5; ++kt) {
            bf16x8 kf[4], vf[2][2];
#pragma unroll
            for (int ks = 0; ks < 4; ++ks) kf[ks] = *(const LAS bf16x8*)(kimg + (32 * kt) * KIMG_STRIDE + 32 * ks);
#pragma unroll
            for (int mb = 0; mb < 2; ++mb)
#pragma unroll
                for (int st = 0; st < 2; ++st) {
                    const LAS unsigned char* vp = vimg + mb * VIMG_HALF + (32 * kt + 16 * st) * 64;
                    const v4i16_t lo = __builtin_amdgcn_ds_read_tr16_b64_v4i16((LAS v4i16_t*)vp);
                    const v4i16_t hi = __builtin_amdgcn_ds_read_tr16_b64_v4i16((LAS v4i16_t*)(vp + 4 * 64));
                    vf[mb][st] = (bf16x8){lo[0], lo[1], lo[2], lo[3], hi[0], hi[1], hi[2], hi[3]};
                }
            f32x16 S;
#pragma unroll
            for (int i = 0; i < 16; ++i) S[i] = 0.f;
#pragma unroll
            for (int ks = 0; ks < 4; ++ks) S = __builtin_amdgcn_mfma_f32_32x32x16_bf16(kf[ks], qf[ks], S, 0, 0, 0);
            if (kt == 0) {
#pragma unroll
                for (int rr = 0; rr < 16; ++rr) { const int kp = (rr & 7) + 8 * hf + 16 * (rr >> 3); if (kp < n) S[rr] = -INFINITY; }
            } else if (kt == 4) {
#pragma unroll
                for (int rr = 0; rr < 16; ++rr) { const int kp = (rr & 7) + 8 * hf + 16 * (rr >> 3); if (kp > n) S[rr] = -INFINITY; }
            }
            float tm = S[0];
#pragma unroll
            for (int rr = 1; rr < 16; ++rr) tm = fmaxf(tm, S[rr]);
            tm = fmaxf(tm, __shfl_xor(tm, 32));
            const float mnew = fmaxf(mrun, tm);
            const float alpha = __builtin_amdgcn_exp2f(mrun - mnew);
            float ps = 0.f; float p[16];
#pragma unroll
            for (int rr = 0; rr < 16; ++rr) { p[rr] = __builtin_amdgcn_exp2f(S[rr] - mnew); ps += p[rr]; }
            lrun = lrun * alpha + ps; mrun = mnew;
            if (__builtin_amdgcn_ballot_w64(alpha != 1.f) != 0ull) {
#pragma unroll
                for (int i = 0; i < 16; ++i) { O0[i] *= alpha; O1[i] *= alpha; }
            }
#pragma unroll
            for (int st = 0; st < 2; ++st) {
                u32x4 pw; pw.x = pk2(p[8 * st + 0], p[8 * st + 1]); pw.y = pk2(p[8 * st + 2], p[8 * st + 3]); pw.z = pk2(p[8 * st + 4], p[8 * st + 5]); pw.w = pk2(p[8 * st + 6], p[8 * st + 7]);
                const bf16x8 pf = __builtin_bit_cast(bf16x8, pw);
                O0 = __builtin_amdgcn_mfma_f32_32x32x16_bf16(vf[0][st], pf, O0, 0, 0, 0);
                O1 = __builtin_amdgcn_mfma_f32_32x32x16_bf16(vf[1][st], pf, O1, 0, 0, 0);
            }
        }
        const float ltot = lrun + __shfl_xor(lrun, 32);
        LAS unsigned char* ost = lds + 2 * ABUF + wave * 4864;
        float sc0;
        if (!COMBINE) { sc0 = 1.f / ltot; if (hf == 0) LSE[((size_t)I.g * MP + qrow) * 16 + h] = mrun + log2f(ltot); }
        else { const float l0 = mrun + log2f(ltot); const float mx = fmaxf(l0, fmaxf(l1, l2));
            const float w0 = __builtin_amdgcn_exp2f(l0 - mx), w1 = __builtin_amdgcn_exp2f(l1 - mx), w2 = __builtin_amdgcn_exp2f(l2 - mx);
            const float invw = 1.f / (w0 + w1 + w2); sc0 = w0 * invw / ltot;
            if (hf == 0) { LAS float* wp = (LAS float*)(ost + 4608) + 2 * n; wp[0] = w1 * invw; wp[1] = w2 * invw; } }
        if (MODE < 2) {
#pragma unroll
            for (int a = 0; a < 4; ++a) {
                u32x2 w0v, w1v; w0v.x = pk2(O0[4 * a] * sc0, O0[4 * a + 1] * sc0); w0v.y = pk2(O0[4 * a + 2] * sc0, O0[4 * a + 3] * sc0);
                w1v.x = pk2(O1[4 * a] * sc0, O1[4 * a + 1] * sc0); w1v.y = pk2(O1[4 * a + 2] * sc0, O1[4 * a + 3] * sc0);
                *(LAS u32x2*)(ost + n * 144 + (8 * a + 4 * hf) * 2) = w0v; *(LAS u32x2*)(ost + n * 144 + 64 + (8 * a + 4 * hf) * 2) = w1v;
            }
            asm volatile("s_waitcnt lgkmcnt(0)" ::: "memory");
#pragma unroll
            for (int j = 0; j < 4; ++j) { const int rr_ = rr0_ + 8 * j; const int qr_ = I.b * SEQ + ((u0w + rr_) << I.sh) + I.r;
                const bf16x8 tv = *(const LAS bf16x8*)(ost + rr_ * 144 + 16 * cc_);
                if (!COMBINE) *(bf16x8*)(OG + ((size_t)I.g * MP + qr_) * D + h * 64 + 8 * cc_) = tv;
                else { const LAS float* wp = (const LAS float*)(ost + 4608) + 2 * rr_; const float w1 = wp[0], w2 = wp[1];
                    float o[8];
#pragma unroll
                    for (int i = 0; i < 8; ++i) o[i] = bf2f((unsigned short)tv[i]) + w1 * bf2f((unsigned short)x1[j][i]) + w2 * bf2f((unsigned short)x2[j][i]);
                    u32x4 y; y.x = pk2(o[0], o[1]); y.y = pk2(o[2], o[3]); y.z = pk2(o[4], o[5]); y.w = pk2(o[6], o[7]);
                    *(u32x4*)(AT + (size_t)qr_ * D + h * 64 + 8 * cc_) = y; }
            }
        } else { if (ltot == 123.456f) LSE[0] = ltot; }
#pragma unroll
        for (int ks = 0; ks < 4; ++ks) qf[ks] = qn[ks];
        asm volatile("s_waitcnt lgkmcnt(0)\n\ts_barrier" ::: "memory");
    }
#undef ATT_ISSUE_KV
#undef ATT_ISSUE_Q
#undef ATT_WRITE
}

__device__ __forceinline__ void attn_sample_item(const Args& A, LAS float* sl, int it, int lane) {
    unsigned char* ws = A.ws;
    const int h = it & 15, t = (it >> 4) & 3, n = it >> 6, kvh = h >> 2;
    const int row = NPROMPT + 4 * n + t;
    const bf16* Q = (const bf16*)(ws + WS_Q) + (size_t)row * QW + h * 64;
    const int kq = lane >> 2, dq = lane & 3;
    float mxl = -INFINITY;
#pragma unroll 1
    for (int g = 0; g < 3; ++g) {
        const int W = 128 << (2 * g), dil = 1 << (2 * g);
        const float* cache = A.in[2 + g] + (size_t)n * W * 512;
        const float* newkv = A.out + (g == 0 ? O_KVS0 : g == 1 ? O_KVS1 : O_KVS2) + (size_t)n * 4 * 512;
        float q[16];
#pragma unroll
        for (int c8 = 0; c8 < 2; ++c8) { const bf16x8 v = *(const bf16x8*)(Q + g * 1024 + 16 * dq + 8 * c8);
#pragma unroll
            for (int i = 0; i < 8; ++i) q[8 * c8 + i] = bf2f((unsigned short)v[i]); }
#pragma unroll 9
        for (int bt = 0; bt < 9; ++bt) {
            const int j = 16 * bt + kq; const bool valid = j <= 128; const int jj = valid ? j : 128;
            const int idx = W + t - dil * jj;
            const float* kp = (idx >= W ? newkv + (size_t)(idx - W) * 512 : cache + (size_t)idx * 512) + kvh * 64 + 16 * dq;
            float s = 0.f;
#pragma unroll
            for (int c4 = 0; c4 < 4; ++c4) { const f32x4 kv = *(const f32x4*)(kp + 4 * c4); s += q[4 * c4] * kv[0] + q[4 * c4 + 1] * kv[1] + q[4 * c4 + 2] * kv[2] + q[4 * c4 + 3] * kv[3]; }
            s += __shfl_xor(s, 1); s += __shfl_xor(s, 2);
            if (valid && dq == 0) sl[g * 132 + j] = s;
            mxl = fmaxf(mxl, valid ? s : -INFINITY);
        }
    }
    const float mx = wave_max(mxl);
    asm volatile("s_waitcnt lgkmcnt(0)" ::: "memory");
    float sum = 0.f;
#pragma unroll 1
    for (int i = lane; i < 396; i += 64) { const int j = i % 132; if (j <= 128) { const float p = exp2f(sl[i] - mx); sl[i] = p; sum += p; } }
    sum = wave_sum(sum);
    asm volatile("s_waitcnt lgkmcnt(0)" ::: "memory");
    f32x4 acc = {0.f, 0.f, 0.f, 0.f};
    const int ksl = lane >> 4, dq4 = lane & 15;
#pragma unroll 1
    for (int g = 0; g < 3; ++g) {
        const int W = 128 << (2 * g), dil = 1 << (2 * g);
        const float* cache = A.in[2 + g] + (size_t)n * W * 512;
        const float* newkv = A.out + (g == 0 ? O_KVS0 : g == 1 ? O_KVS1 : O_KVS2) + (size_t)n * 4 * 512;
#pragma unroll 33
        for (int jb = 0; jb < 33; ++jb) {
            const int j = 4 * jb + ksl; const bool valid = j <= 128; const int jj = valid ? j : 128;
            const int idx = W + t - dil * jj;
            const float* vp = (idx >= W ? newkv + (size_t)(idx - W) * 512 : cache + (size_t)idx * 512) + 256 + kvh * 64 + 4 * dq4;
            const f32x4 v = *(const f32x4*)vp;
            const float pj = valid ? sl[g * 132 + jj] : 0.f;
            acc += v * pj;
        }
    }
#pragma unroll
    for (int i = 0; i < 4; ++i) { acc[i] += __shfl_xor(acc[i], 16); acc[i] += __shfl_xor(acc[i], 32); }
    bf16* AT = (bf16*)(ws + WS_ATT);
    if (lane < 16) { const float inv = 1.f / sum; u32x2 w; w.x = pk2(acc[0] * inv, acc[1] * inv); w.y = pk2(acc[2] * inv, acc[3] * inv);
        *(u32x2*)(AT + (size_t)row * D + h * 64 + 4 * dq4) = w; }
    asm volatile("s_waitcnt lgkmcnt(0)" ::: "memory");
}

__device__ __forceinline__ void attn_combine(const Args& A, int gt, int NGT) {
    unsigned char* ws = A.ws;
    const bf16* OG = (const bf16*)(ws + WS_OG); const float* LSE = (const float*)(ws + WS_LSE); bf16* AT = (bf16*)(ws + WS_ATT);
    for (int i = gt; i < NPROMPT * 128; i += NGT) {
        const int row = i >> 7, c8 = i & 127, h = c8 >> 3;
        const float l0 = LSE[((size_t)0 * MP + row) * 16 + h], l1 = LSE[((size_t)1 * MP + row) * 16 + h], l2 = LSE[((size_t)2 * MP + row) * 16 + h];
        const float mx = fmaxf(l0, fmaxf(l1, l2));
        float w0 = exp2f(l0 - mx), w1 = exp2f(l1 - mx), w2 = exp2f(l2 - mx); const float inv = 1.f / (w0 + w1 + w2); w0 *= inv; w1 *= inv; w2 *= inv;
        const bf16x8 a = *(const bf16x8*)(OG + ((size_t)0 * MP + row) * D + 8 * c8), b = *(const bf16x8*)(OG + ((size_t)1 * MP + row) * D + 8 * c8), c = *(const bf16x8*)(OG + ((size_t)2 * MP + row) * D + 8 * c8);
        float o[8];
#pragma unroll
        for (int k = 0; k < 8; ++k) o[k] = w0 * bf2f((unsigned short)a[k]) + w1 * bf2f((unsigned short)b[k]) + w2 * bf2f((unsigned short)c[k]);
        u32x4 w; w.x = pk2(o[0], o[1]); w.y = pk2(o[2], o[3]); w.z = pk2(o[4], o[5]); w.w = pk2(o[6], o[7]);
        *(u32x4*)(AT + (size_t)row * D + 8 * c8) = w;
    }
}

#define XB_TMO      128
#define XB_XCNT(j)  (256  + 64 * (j))
#define XB_XSUB(j)  (1280 + 64 * (j))
#define XB_XGEN(j)  (2304 + 64 * (j))
#define XB_TOP      3328
#define XB_TOPGEN   3392
#define XCD_BAR_WORDS 3456
#define XB_SPIN_CAP (1u << 18)

__device__ __forceinline__ unsigned xb_ld(unsigned* p)              { return __hip_atomic_load(p, __ATOMIC_RELAXED, __HIP_MEMORY_SCOPE_AGENT); }
__device__ __forceinline__ unsigned xb_add(unsigned* p, unsigned v) { return __hip_atomic_fetch_add(p, v, __ATOMIC_RELAXED, __HIP_MEMORY_SCOPE_AGENT); }
__device__ __forceinline__ unsigned xb_xcc_id() { return (unsigned)__builtin_amdgcn_s_getreg((3 << 11) | 20) & 0xFu; }
#define XB_SPIN(cond, bar) do { unsigned _sp = 0; while (cond) { __builtin_amdgcn_s_sleep(1); \
    if ((++_sp & 255u) == 0u) { if (xb_ld(&(bar)[XB_TMO])) break; if (_sp > XB_SPIN_CAP) { atomicAdd(&(bar)[XB_TMO], 1u); break; } } } } while (0)

struct XcdBarrier {
    unsigned* bar; unsigned x;
    volatile LAS unsigned* st;
};

__device__ __forceinline__ XcdBarrier xcd_barrier_post(unsigned* bar, volatile LAS unsigned* st) {
    XcdBarrier b; b.bar = bar; b.x = xb_xcc_id(); b.st = st;
    if (threadIdx.x == 0) (void)xb_add(&bar[XB_XCNT(b.x)], 1u);
    return b;
}
__device__ __forceinline__ void xcd_barrier_complete(unsigned* bar, unsigned x, unsigned& nloc, unsigned& nx) {
    const unsigned G = gridDim.x * gridDim.y * gridDim.z;
    unsigned sum, cnt, mine, sp = 0u;
    for (;;) {
        sum = 0u; cnt = 0u; mine = 0u;
#pragma unroll
        for (unsigned j = 0; j < 16; ++j) { const unsigned c = xb_ld(&bar[XB_XCNT(j)]); sum += c; cnt += (c > 0u) ? 1u : 0u; mine = (j == x) ? c : mine; }
        if (sum == G) break;
        __builtin_amdgcn_s_sleep(1);
        if ((++sp & 255u) == 0u) { if (xb_ld(&bar[XB_TMO])) break; if (sp > XB_SPIN_CAP) { atomicAdd(&bar[XB_TMO], 1u); break; } }
    }
    nloc = mine > 0u ? mine : 1u; nx = cnt > 0u ? cnt : 1u;
}

__device__ __forceinline__ void xcd_barrier(const XcdBarrier& b) {
    asm volatile("s_waitcnt vmcnt(0)" ::: "memory");
    __syncthreads();
    if (threadIdx.x == 0) {
        unsigned* bar = b.bar;
        __builtin_amdgcn_s_waitcnt(0);
        unsigned nloc = b.st[0], nx = b.st[1];
        if (nloc == 0u) { xcd_barrier_complete(bar, b.x, nloc, nx); b.st[0] = nloc; b.st[1] = nx; }
        const unsigned old = xb_add(&bar[XB_XSUB(b.x)], 1u);
        const unsigned gen = old / nloc;
        if (old + 1u == (gen + 1u) * nloc) {
            __builtin_amdgcn_fence(__ATOMIC_RELEASE, "agent");
            asm volatile("s_waitcnt vmcnt(0)" ::: "memory");
            const unsigned og = xb_add(&bar[XB_TOP], 1u);
            const unsigned tg = og / nx;
            if (og + 1u == (tg + 1u) * nx) xb_add(&bar[XB_TOPGEN], 1u);
            else XB_SPIN(xb_ld(&bar[XB_TOPGEN]) == tg, bar);
            __builtin_amdgcn_fence(__ATOMIC_ACQUIRE, "agent");
            xb_add(&bar[XB_XGEN(b.x)], 1u);
            asm volatile("s_waitcnt vmcnt(0)" ::: "memory");
        } else {
            XB_SPIN(xb_ld(&bar[XB_XGEN(b.x)]) == gen, bar);
            __builtin_amdgcn_fence(__ATOMIC_ACQUIRE, "agent");
            asm volatile("s_waitcnt vmcnt(0)" ::: "memory");
        }
    }
    __syncthreads();
}

constexpr int NPHASE = 13;
#ifndef REP0
#define REP0 1
#endif
#ifndef REP12
#define REP12 1
#endif
#ifndef REP7
#define REP7 1
#endif
#ifndef REP8
#define REP8 1
#endif
#ifndef REP4
#define REP4 1
#endif
#ifndef REP6
#define REP6 1
#endif
#ifndef DUP4
#define DUP4 0
#endif
#ifndef DUP6
#define DUP6 0
#endif
#ifndef DUP5
#define DUP5 0
#endif
#ifndef PROBE8
#define PROBE8 0
#endif
#ifndef XSYNC
#define XSYNC 0
#endif
__global__ void __launch_bounds__(NTHREADS, 2) yoco_fwd(Args A) {
    extern __shared__ __attribute__((aligned(16))) unsigned char lds_raw[];
    LAS unsigned char* lds = (LAS unsigned char*)lds_raw;
    cg::grid_group grid = cg::this_grid();
    const int tid = threadIdx.x, lane = tid & 63, wave = __builtin_amdgcn_readfirstlane(tid >> 6);
    const int G = gridDim.x, gw = blockIdx.x * NWAVES + wave, NGW = G * NWAVES, gt = gw * 64 + lane, NGT = NGW * 64;
    unsigned char* ws = A.ws;
    float* rowss = (float*)(ws + WS_ROWSS);
    float* Hf = (float*)(ws + WS_H); bf16* HB = (bf16*)(ws + WS_HB);
    const int lo = A.ph_lo, hi = A.ph_hi;
    volatile LAS unsigned* bst = (volatile LAS unsigned*)(lds + LDS_BYTES - 64);
    if (tid < 2) bst[tid] = 0u;
    __syncthreads();
    XcdBarrier xbar = xcd_barrier_post((unsigned*)(ws + WS_BAR), bst);
    if (lo < 0) grid.sync();
#ifndef PH_MASK
#define PH_MASK 0xffff
#endif
#define IN(k) (((PH_MASK >> (k)) & 1) && lo <= (k) && (k) < hi)
#define SEAM(k) do { if (IN(k) && IN((k) + 1)) xcd_barrier(xbar); } while (0)
    if (IN(0)) { for (int rp = 0; rp < REP0; ++rp) phase_prologue(A, lds, gw, NGW, wave, lane); for (int rp = 0; rp < XSYNC; ++rp) xcd_barrier(xbar); }
    SEAM(0);
    if (IN(1)) for (int rp = 0; rp < REP12; ++rp) { for (int it = gw; it < 2048; it += NGW) s5_item<false>(A, lds + wave * 8704, it, lane); }
    SEAM(1);
    if (IN(2)) for (int rp = 0; rp < REP12; ++rp) { for (int it = gw; it < 4096; it += NGW) s5_item<true>(A, lds + wave * 8704, it, lane); }
    SEAM(2);
    if (IN(3)) { pg8::Gemm g{(const bf16*)(ws + WS_Y), (const bf16*)(ws + W_GLU), NPROMPT, 2048, 1024}; pg8::StaticOrder S; S.init(NPROMPT, 2048, G, (int)blockIdx.x);
        EpiGlu E{A.in[0], A.in[1], Hf, HB, rowss};
        pg8::gemm_phase<EpiGlu, pg8::StaticOrder, true, true>(lds, g, S, E);
        skinny_phase(lds, g.A, g.Bt, 2048, 1024, E, 0, wave, lane); }
    SEAM(3);
    if (IN(4)) { pg8::Gemm g{HB, (const bf16*)(ws + W_UP0), NPROMPT, FF, 1024}; pg8::StaticOrder S; S.init(NPROMPT, FF, G, (int)blockIdx.x);
        EpiUp E{(bf16*)(ws + WS_ACT), rowss};
        pg8::gemm_phase<EpiUp, pg8::StaticOrder, true, true>(lds, g, S, E);
        skinny_phase(lds, g.A, g.Bt, FF, 1024, E, 0, wave, lane);
#if DUP4 == 1
        pg8::gemm_phase<EpiUp, pg8::StaticOrder, true, true>(lds, g, S, E);
#endif
#if DUP4 == 3
        { EpiNull E0{(float*)(ws + WS_OG)};
        skinny_phase(lds, g.A, g.Bt, FF, 1024, E0, 0, wave, lane); skinny_phase(lds, g.A, g.Bt, FF, 1024, E0, 0, wave, lane);
        skinny_phase(lds, g.A, g.Bt, FF, 1024, E0, 0, wave, lane); skinny_phase(lds, g.A, g.Bt, FF, 1024, E0, 0, wave, lane); }
#endif
#if DUP4 == 2
        skinny_phase(lds, g.A, g.Bt, FF, 1024, E, 0, wave, lane);
        skinny_phase(lds, g.A, g.Bt, FF, 1024, E, 0, wave, lane);
        skinny_phase(lds, g.A, g.Bt, FF, 1024, E, 0, wave, lane);
        skinny_phase(lds, g.A, g.Bt, FF, 1024, E, 0, wave, lane);
#endif
    }
    SEAM(4);
    if (IN(5)) { pg8::Gemm g{(const bf16*)(ws + WS_ACT), (const bf16*)(ws + W_DN0), NPROMPT, 1024, FF}; pg8::StaticOrder S; S.init(NPROMPT, 1024, G, (int)blockIdx.x);
        EpiRes E{HB, nullptr, rowss + MP};
        pg8::gemm_phase<EpiRes, pg8::StaticOrder, true, true>(lds, g, S, E);
        skinny_phase(lds, g.A, g.Bt, 1024, FF, E, 0, wave, lane);
#if DUP5 == 2
        { EpiUp E2{(bf16*)(ws + WS_OG), rowss}; pg8::gemm_phase<EpiUp, pg8::StaticOrder, true, true>(lds, g, S, E2); }
#endif
    }
    SEAM(5);
    if (IN(6)) { pg8::Gemm g{HB, (const bf16*)(ws + W_QKV), NPROMPT, NQKV, 1024}; pg8::StaticOrder S; S.init(NPROMPT, NQKV, G, (int)blockIdx.x);
        EpiQKV E{(bf16*)(ws + WS_Q), (bf16*)(ws + WS_KB), (bf16*)(ws + WS_VT), A.out, rowss + MP, (const float*)(ws + WS_ROPE), (const float*)(ws + WS_ROPE) + 8196 * 32, (const float*)(ws + WS_ROPE) + 2 * 8196 * 32, (const float*)(ws + WS_ROPE) + 2 * 8196 * 32 + 8 * 32};
        pg8::gemm_phase<EpiQKV, pg8::StaticOrder, true, true>(lds, g, S, E);
        skinny_phase(lds, g.A, g.Bt, NQKV, 1024, E, G >= 256 ? 128 : 0, wave, lane);
        { const int cf = G >= 256 ? 128 : 0; if ((int)blockIdx.x >= cf) convert_late(A, lds, ((int)blockIdx.x - cf) * NWAVES + wave, (G - cf) * NWAVES, wave, lane); }
#if DUP6 == 1
        pg8::gemm_phase<EpiQKV, pg8::StaticOrder, true, true>(lds, g, S, E);
#endif
#if DUP6 == 2
        { EpiUp E2{(bf16*)(ws + WS_OG), rowss + MP}; pg8::gemm_phase<EpiUp, pg8::StaticOrder, true, true>(lds, g, S, E2); }
#endif
    }
    SEAM(6);
    if (IN(7)) for (int rp = 0; rp < REP7; ++rp) {
        for (int it = gw; it < 2048; it += NGW) attn_sample_item(A, (LAS float*)(lds + 65536 + wave * 2048), it, lane);
        __syncthreads();
        attn_prompt_phase<false>(A, lds, tid, wave, lane, 1024, NATT_ITEMS);
    }
    SEAM(7);
    if (IN(8)) {
#if PROBE8 > 0
        attn_prompt_phase<true, PROBE8>(A, lds, tid, wave, lane, 0, 1024); __syncthreads();
#endif
        attn_prompt_phase<true>(A, lds, tid, wave, lane, 0, 1024); }
    SEAM(8);
    if (IN(9)) { pg8::Gemm g{(const bf16*)(ws + WS_ATT), (const bf16*)(ws + W_O), NPROMPT, 1024, 1024}; pg8::StaticOrder S; S.init(NPROMPT, 1024, G, (int)blockIdx.x);
        EpiRes E{HB, nullptr, rowss + 2 * MP};
        pg8::gemm_phase<EpiRes, pg8::StaticOrder, true, true>(lds, g, S, E);
        skinny_phase(lds, g.A, g.Bt, 1024, 1024, E, 0, wave, lane); }
    SEAM(9);
    if (IN(10)) { pg8::Gemm g{HB, (const bf16*)(ws + W_UP1), NPROMPT, FF, 1024}; pg8::StaticOrder S; S.init(NPROMPT, FF, G, (int)blockIdx.x);
        EpiUp E{(bf16*)(ws + WS_ACT), rowss + 2 * MP};
        pg8::gemm_phase<EpiUp, pg8::StaticOrder, true, true>(lds, g, S, E);
        skinny_phase(lds, g.A, g.Bt, FF, 1024, E, 0, wave, lane); }
    SEAM(10);
    if (IN(11)) { pg8::Gemm g{(const bf16*)(ws + WS_ACT), (const bf16*)(ws + W_DN1), NPROMPT, 1024, FF}; pg8::StaticOrder S; S.init(NPROMPT, 1024, G, (int)blockIdx.x);
        EpiRes E{HB, nullptr, rowss + 3 * MP};
        pg8::gemm_phase<EpiRes, pg8::StaticOrder, true, true>(lds, g, S, E);
        skinny_phase(lds, g.A, g.Bt, 1024, FF, E, 0, wave, lane); }
    SEAM(11);
    if (IN(12)) {
        const float* gfin = A.in[24];
        for (int row0 = 4 * gw; row0 < MREAL; row0 += 4 * NGW) {
            bf16x8 hv[4][2]; float rs[4];
#pragma unroll
            for (int q = 0; q < 4; ++q) { rs[q] = rowss[3 * MP + row0 + q];
#pragma unroll
                for (int j = 0; j < 2; ++j) hv[q][j] = *((const bf16x8*)(HB + (size_t)(row0 + q) * D) + lane + 64 * j); }
#pragma unroll
            for (int j = 0; j < 2; ++j) { const f32x4 g0 = *((const f32x4*)gfin + 2 * (lane + 64 * j)), g1 = *((const f32x4*)gfin + 2 * (lane + 64 * j) + 1);
#pragma unroll
                for (int q = 0; q < 4; ++q) { const float rstd = rsqrtf(rs[q] * (1.f / D) + EPS); float* orow = A.out + (size_t)(row0 + q) * D;
                    f32x4 o0, o1;
#pragma unroll
                    for (int i = 0; i < 4; ++i) { o0[i] = bf2f((unsigned short)hv[q][j][i]) * rstd * g0[i]; o1[i] = bf2f((unsigned short)hv[q][j][4 + i]) * rstd * g1[i]; }
                    *((f32x4*)orow + 2 * (lane + 64 * j)) = o0; *((f32x4*)orow + 2 * (lane + 64 * j) + 1) = o1; } }
        }
    }
#undef IN
#undef SEAM
}

#ifndef N_LAUNCHES
#define N_LAUNCHES 1
#endif
extern "C" void kernel_launch(void* const* d_in, const int* in_sizes, int n_in, void* d_out, int out_size, void* d_ws, size_t ws_size, hipStream_t stream) {
    static int grid = 0;
    if (grid == 0) {
        if (n_in != 25 || ws_size < WS_END) { fprintf(stderr, "kernel_launch: unexpected n_in %d / ws %zu\n", n_in, ws_size); grid = -1; return; }
        int dev = 0, cus = 0, per_cu = 0;
        hipGetDevice(&dev); hipDeviceGetAttribute(&cus, hipDeviceAttributeMultiprocessorCount, dev);
        if (hipFuncSetAttribute((const void*)yoco_fwd, hipFuncAttributeMaxDynamicSharedMemorySize, LDS_BYTES) != hipSuccess) { fprintf(stderr, "hipFuncSetAttribute failed\n"); grid = -1; return; }
        hipOccupancyMaxActiveBlocksPerMultiprocessor(&per_cu, (const void*)yoco_fwd, NTHREADS, LDS_BYTES);
        (void)hipGetLastError();
        if (per_cu < 1) per_cu = 1;
        grid = cus * per_cu;
    }
    if (grid < 0) return;
    Args a{};
    for (int i = 0; i < 25; ++i) a.in[i] = (const float*)d_in[i];
    a.out = (float*)d_out; a.ws = (unsigned char*)d_ws;
    if (hipMemsetAsync((char*)d_ws + WS_BAR, 0, 16384, stream) != hipSuccess) { fprintf(stderr, "memset failed\n"); return; }
    if (N_LAUNCHES == 1) {
        a.ph_lo = 0; a.ph_hi = NPHASE;
        void* args[] = {&a};
        hipError_t e = hipLaunchCooperativeKernel((const void*)yoco_fwd, dim3(grid), dim3(NTHREADS), args, LDS_BYTES, stream);
        if (e != hipSuccess) fprintf(stderr, "cooperative launch failed: %s (grid %d)\n", hipGetErrorString(e), grid);
    } else {
        for (int p = 0; p < NPHASE; ++p) { a.ph_lo = p; a.ph_hi = p + 1; hipLaunchKernelGGL(yoco_fwd, dim3(grid), dim3(NTHREADS), LDS_BYTES, stream, a); }
    }
}
```

```cpp
#include <hip/hip_runtime.h>
#include <hip/hip_cooperative_groups.h>
#include <cstdio>
#include <cstdint>
#include <cmath>
namespace cg = cooperative_groups;
namespace pg8 {
#define PG8_LAS __attribute__((address_space(3)))
typedef unsigned short bf16_t;
typedef short bf16x8 __attribute__((ext_vector_type(8)));
typedef float f32x4 __attribute__((ext_vector_type(4)));
typedef unsigned u32x4 __attribute__((ext_vector_type(4)));
constexpr int BM = 256, BK = 64, HALF = 128, HTB = HALF * BK * 2  , STAGE_BYTES = 8 * HTB, NXCD = 8, WGM = 8;

__host__ __device__ __forceinline__ int lds_byte(int r, int c) { const int st = (r >> 4) * 2 + (c >> 5), rr = r & 15, cc = c & 31, ob = rr * 64 + cc * 2; return st * 1024 + (ob ^ (((ob >> 9) & 1) << 5)); }
__host__ __device__ __forceinline__ void stage_rc(int b, int& R, int& C) { const int st = b / 1024, sb = b % 1024, swz = sb ^ (((sb >> 9) & 1) << 5); R = (st >> 1) * 16 + swz / 64; C = (st & 1) * 32 + (swz % 64) / 2; }
__host__ __device__ __forceinline__ int perm32(int rho) { const int n = rho >> 4, i = rho & 15; return 8 * (i >> 2) + 4 * n + (i & 3); }

struct Unit { int pm, pn; };
struct Gemm { const bf16_t* A; const bf16_t* Bt; int M, N, K; };

struct StaticOrder {
    int nM, nN, nwg, G, c;
    __host__ __device__ void init(int M, int N, int G_, int c_) { nM = M / BM; nN = N / BM; nwg = nM * nN; G = G_; c = c_; }
    __host__ __device__ bool next(int i, Unit& u) const {
        const long L = (long)i * G + c; if (L >= nwg) return false;
        int wgid = (int)L; { const int q = nwg / NXCD, r = nwg % NXCD, xcd = wgid % NXCD, off = wgid / NXCD; wgid = (xcd < r ? xcd * (q + 1) : r * (q + 1) + (xcd - r) * q) + off; }
        const int nig = WGM * nN, gid = wgid / nig, fm = gid * WGM, gsz = (nM - fm) < WGM ? (nM - fm) : WGM;
        u.pm = fm + ((wgid % nig) % gsz); u.pn = (wgid % nig) / gsz; return true;
    }
    __device__ __forceinline__ void a_ready(const Unit&) const {}
    __device__ __forceinline__ void done(const Unit&) const {}
};

__device__ __forceinline__ unsigned cvt_pk_bf16(float lo, float hi) { unsigned r; asm volatile("v_cvt_pk_bf16_f32 %0, %1, %2" : "=v"(r) : "v"(lo), "v"(hi)); return r; }
typedef float f32x2 __attribute__((ext_vector_type(2)));
__device__ __forceinline__ f32x2 gelu_pk(f32x2 v) {
    const f32x2 av = __builtin_elementwise_abs(v), d = av * 0.2316418882f + 1.0f;
    f32x2 t; t.x = __builtin_amdgcn_rcpf(d.x); t.y = __builtin_amdgcn_rcpf(d.y);
    f32x2 q = t * 0.5307027145f + (-0.7265760135f); q = q * t + 0.7107068705f; q = q * t + (-0.142248368f); q = q * t + 0.127414796f; q = q * t;
    const f32x2 s = (v * v) * (-0.72134752044f);
    f32x2 e; e.x = __builtin_amdgcn_exp2f(s.x); e.y = __builtin_amdgcn_exp2f(s.y);
    const f32x2 m = v * (q * e), r = v - m;
    f32x2 o; o.x = v.x < 0.f ? m.x : r.x; o.y = v.y < 0.f ? m.y : r.y; return o;
}


template <class Epi, class Sched, bool ALIGN_EPI = false, bool SP2 = false>
__device__ __forceinline__ void gemm_phase(PG8_LAS unsigned char* lds, const Gemm g, const Sched& S, const Epi& E) {
    const int tid = threadIdx.x, wid = __builtin_amdgcn_readfirstlane(tid >> 6), lane = tid & 63, wr = wid >> 2, wc = wid & 3, fr = lane & 15, fq = lane >> 4;
    const int K = g.K, nt = K / BK;
    unsigned voffA[2], voffB[2];
#pragma unroll
    for (int i = 0; i < 2; ++i) { int R, C; stage_rc(tid * 16 + i * 8192, R, C); const int Rb = Epi::PERM ? ((R & ~31) + perm32(R & 31)) : R;
        voffA[i] = (unsigned)(R * K + C) * 2u; voffB[i] = (unsigned)(Rb * K + C) * 2u; }
    const size_t kstep = (size_t)(BK * 2);
    const size_t hstep = (size_t)HALF * K * 2;
    const size_t tstep = 2 * hstep;
    const unsigned ldsw = (unsigned)wid * 1024u;
    const int aoff = lds_byte(wr * 64 + fr, fq * 8), boff = lds_byte(wc * 32 + fr, fq * 8);
#define PG8_SA(b, h) (((b) * 2 + (h)) * HTB)
#define PG8_SB(b, h) ((4 + (b) * 2 + (h)) * HTB)
#define PG8_STAGE(bufoff, gbase, voff) do { _Pragma("unroll") for (int _i = 0; _i < 2; ++_i) \
        __builtin_amdgcn_global_load_lds((const unsigned*)((const char*)(gbase) + (voff)[_i]), (PG8_LAS unsigned*)(lds + (bufoff) + ldsw + _i * 8192), 16, 0, 0); } while (0)
#define PG8_LDA(dst, b, h) do { _Pragma("unroll") for (int m = 0; m < 4; ++m) _Pragma("unroll") for (int k = 0; k < 2; ++k) dst[m][k] = *(const PG8_LAS bf16x8*)(lds + PG8_SA(b, h) + aoff + m * 2048 + k * 1024); } while (0)
#define PG8_LDB(dst, b, h) do { _Pragma("unroll") for (int n = 0; n < 2; ++n) _Pragma("unroll") for (int k = 0; k < 2; ++k) dst[n][k] = *(const PG8_LAS bf16x8*)(lds + PG8_SB(b, h) + boff + n * 2048 + k * 1024); } while (0)
#define PG8_MMA(ai, bj, At, Bt) do { __builtin_amdgcn_s_setprio(1); _Pragma("unroll") for (int m = 0; m < 4; ++m) _Pragma("unroll") for (int n = 0; n < 2; ++n) _Pragma("unroll") for (int k = 0; k < 2; ++k) \
        acc[ai][bj][m][n] = __builtin_amdgcn_mfma_f32_16x16x32_bf16(Bt[n][k], At[m][k], acc[ai][bj][m][n], 0, 0, 0); __builtin_amdgcn_s_setprio(0); } while (0)
#define PG8_WAIT_V(n) asm volatile("s_waitcnt vmcnt(" #n ")" ::: "memory")
#define PG8_WAIT_L(n) asm volatile("s_waitcnt lgkmcnt(" #n ")" ::: "memory")
#define PG8_BAR __builtin_amdgcn_s_barrier()
#define PG8_SCHED __builtin_amdgcn_sched_barrier(0)
    Unit cur, nxt; int ui = 0;
    if (!S.next(0, cur)) return;
    f32x4 acc[2][2][4][2];
#pragma unroll
    for (int a = 0; a < 2; ++a)
#pragma unroll
        for (int b = 0; b < 2; ++b)
#pragma unroll
            for (int m = 0; m < 4; ++m)
#pragma unroll
                for (int n = 0; n < 2; ++n) acc[a][b][m][n] = (f32x4){0.f, 0.f, 0.f, 0.f};
    bf16x8 At[4][2], B0[2][2], B1[2][2];
    const char* cA = (const char*)g.A + (size_t)cur.pm * tstep; const char* cB = (const char*)g.Bt + (size_t)cur.pn * tstep;
    S.a_ready(cur);
    if constexpr (SP2) {
        PG8_STAGE(PG8_SB(0, 0), cB, voffB); PG8_STAGE(PG8_SB(0, 1), cB + hstep, voffB); PG8_STAGE(PG8_SA(0, 0), cA, voffA); PG8_STAGE(PG8_SA(0, 1), cA + hstep, voffA);
        if (wr == 1) PG8_BAR;
        PG8_WAIT_V(2); PG8_BAR;
        PG8_STAGE(PG8_SB(1, 0), cB + kstep, voffB); PG8_STAGE(PG8_SA(1, 0), cA + kstep, voffA); PG8_STAGE(PG8_SB(1, 1), cB + hstep + kstep, voffB);
        PG8_WAIT_V(6); PG8_BAR;
    } else {
        PG8_STAGE(PG8_SB(0, 0), cB, voffB); PG8_STAGE(PG8_SA(0, 0), cA, voffA); PG8_STAGE(PG8_SB(0, 1), cB + hstep, voffB); PG8_STAGE(PG8_SA(0, 1), cA + hstep, voffA);
        if (wr == 1) PG8_BAR;
        PG8_WAIT_V(4); PG8_BAR;
        PG8_STAGE(PG8_SB(1, 0), cB + kstep, voffB); PG8_STAGE(PG8_SA(1, 0), cA + kstep, voffA); PG8_STAGE(PG8_SB(1, 1), cB + hstep + kstep, voffB);
        PG8_WAIT_V(6); PG8_BAR;
    }
    for (;;) {
        const bool has_next = S.next(ui + 1, nxt);
        const char* nA = has_next ? (const char*)g.A + (size_t)nxt.pm * tstep : cA; const char* nB = has_next ? (const char*)g.Bt + (size_t)nxt.pn * tstep : cB;
        for (int t = 0; t < nt; t += 2) {
            const bool last = (t == nt - 2);
            const char* a1 = cA + (size_t)(t + 1) * kstep;
            const char* a2 = last ? nA : cA + (size_t)(t + 2) * kstep; const char* b2 = last ? nB : cB + (size_t)(t + 2) * kstep;
            const char* a3 = a2 + kstep; const char* b3 = b2 + kstep;
            if (last && has_next) S.a_ready(nxt);
            if constexpr (SP2) {
            PG8_LDB(B0, 0, 0); PG8_LDB(B1, 0, 1); PG8_SCHED; PG8_LDA(At, 0, 0); PG8_STAGE(PG8_SA(1, 1), a1 + hstep, voffA);
            PG8_WAIT_V(8); PG8_WAIT_L(0); PG8_BAR; PG8_MMA(0, 0, At, B0); PG8_MMA(0, 1, At, B1); PG8_BAR; PG8_SCHED;
            PG8_LDA(At, 0, 1); PG8_STAGE(PG8_SB(0, 0), b2, voffB); PG8_STAGE(PG8_SB(0, 1), b2 + hstep, voffB); PG8_STAGE(PG8_SA(0, 0), a2, voffA);
            PG8_WAIT_V(8); PG8_WAIT_L(0); PG8_BAR; PG8_MMA(1, 0, At, B0); PG8_MMA(1, 1, At, B1); PG8_BAR; PG8_SCHED;
            PG8_LDB(B0, 1, 0); PG8_LDB(B1, 1, 1); PG8_SCHED; PG8_LDA(At, 1, 0); PG8_STAGE(PG8_SA(0, 1), a2 + hstep, voffA);
            PG8_WAIT_V(8); PG8_WAIT_L(0); PG8_BAR; PG8_MMA(0, 0, At, B0); PG8_MMA(0, 1, At, B1); PG8_BAR; PG8_SCHED;
            PG8_LDA(At, 1, 1); PG8_STAGE(PG8_SB(1, 0), b3, voffB); PG8_STAGE(PG8_SB(1, 1), b3 + hstep, voffB); PG8_STAGE(PG8_SA(1, 0), a3, voffA);
            PG8_WAIT_V(8); PG8_WAIT_L(0); PG8_BAR; PG8_MMA(1, 0, At, B0); PG8_MMA(1, 1, At, B1); PG8_BAR; PG8_SCHED;
            } else {
            PG8_LDB(B0, 0, 0); PG8_SCHED; PG8_LDA(At, 0, 0); PG8_STAGE(PG8_SA(1, 1), a1 + hstep, voffA);
            PG8_WAIT_L(8); PG8_BAR; PG8_WAIT_L(0); PG8_MMA(0, 0, At, B0); PG8_BAR; PG8_SCHED;
            PG8_LDB(B1, 0, 1); PG8_STAGE(PG8_SB(0, 0), b2, voffB);
            PG8_BAR; PG8_WAIT_L(0); PG8_MMA(0, 1, At, B1); PG8_BAR;
            PG8_LDA(At, 0, 1); PG8_STAGE(PG8_SA(0, 0), a2, voffA);
            PG8_BAR; PG8_WAIT_L(0); PG8_MMA(1, 0, At, B0); PG8_BAR; PG8_SCHED;
            PG8_STAGE(PG8_SB(0, 1), b2 + hstep, voffB);
            PG8_WAIT_V(6); PG8_BAR; PG8_MMA(1, 1, At, B1); PG8_BAR;
            PG8_LDB(B0, 1, 0); PG8_SCHED; PG8_LDA(At, 1, 0); PG8_STAGE(PG8_SA(0, 1), a2 + hstep, voffA);
            PG8_WAIT_L(8); PG8_BAR; PG8_WAIT_L(0); PG8_MMA(0, 0, At, B0); PG8_BAR; PG8_SCHED;
            PG8_LDB(B1, 1, 1); PG8_STAGE(PG8_SB(1, 0), b3, voffB);
            PG8_BAR; PG8_WAIT_L(0); PG8_MMA(0, 1, At, B1); PG8_BAR;
            PG8_LDA(At, 1, 1); PG8_STAGE(PG8_SA(1, 0), a3, voffA);
            PG8_BAR; PG8_WAIT_L(0); PG8_MMA(1, 0, At, B0); PG8_BAR; PG8_SCHED;
            PG8_STAGE(PG8_SB(1, 1), b3 + hstep, voffB);
            PG8_WAIT_V(6); PG8_BAR; PG8_MMA(1, 1, At, B1); PG8_BAR;
            }
        }
        if constexpr (ALIGN_EPI) { if (wr == 0) PG8_BAR; }
        if constexpr (!Epi::AFTER_DRAIN) { E(acc, cur, wr, wc, fr, fq); S.done(cur); }
        if (!has_next) break;
#pragma unroll
        for (int a = 0; a < 2; ++a)
#pragma unroll
            for (int b = 0; b < 2; ++b)
#pragma unroll
                for (int m = 0; m < 4; ++m)
#pragma unroll
                    for (int n = 0; n < 2; ++n) acc[a][b][m][n] = (f32x4){0.f, 0.f, 0.f, 0.f};
        cur = nxt; cA = nA; cB = nB; ++ui;
        if constexpr (ALIGN_EPI) { if (wr == 1) PG8_BAR; }
    }
    PG8_WAIT_V(0);
    if constexpr (!ALIGN_EPI) { if (wr == 0) PG8_BAR; }
    PG8_BAR;
    if constexpr (Epi::AFTER_DRAIN) { E.fused(acc, cur, wr, wc, fr, fq, lds, wid, lane); S.done(cur); }
#undef PG8_SA
#undef PG8_SB
#undef PG8_STAGE
#undef PG8_LDA
#undef PG8_LDB
#undef PG8_MMA
#undef PG8_WAIT_V
#undef PG8_WAIT_L
#undef PG8_BAR
#undef PG8_SCHED
}
}

#define LAS __attribute__((address_space(3)))
typedef unsigned short bf16;
typedef short bf16x8 __attribute__((ext_vector_type(8)));
typedef float f32x4 __attribute__((ext_vector_type(4)));
typedef float f32x16 __attribute__((ext_vector_type(16)));
typedef unsigned u32x4 __attribute__((ext_vector_type(4)));
typedef unsigned u32x2 __attribute__((ext_vector_type(2)));
typedef float f32x2_t __attribute__((ext_vector_type(2)));
typedef __bf16 bf16x2_t __attribute__((ext_vector_type(2)));

constexpr int NWAVES = 8, NTHREADS = 512;
constexpr int D = 1024, SEQ = 8192, NPROMPT = 16384, NSAMP = 128, MREAL = NPROMPT + NSAMP, MP = 16640;
constexpr int FF = 4096, QW = 3072, KVW = 1536, NQKV = QW + KVW;
constexpr float EPS = 1e-6f;
constexpr float QSCALE = 0.125f * 1.4426950408889634f;
constexpr int LDS_BYTES = 147456;

constexpr size_t MiB = 1u << 20;
constexpr size_t WS_ROWSS = 0;
constexpr size_t WS_BAR = 384 * 1024;
constexpr size_t WS_LAM = 512 * 1024;
constexpr size_t WS_BBAR = 576 * 1024;
constexpr size_t WS_CC = 1 * MiB;
constexpr size_t WS_ROPE = 1536 * 1024;
constexpr size_t WS_E = 3840 * 1024;
constexpr size_t WS_W = 8 * MiB;
constexpr size_t W_GLU = WS_W, W_UP0 = W_GLU + 2048ull * 1024 * 2, W_DN0 = W_UP0 + 4096ull * 1024 * 2, W_QKV = W_DN0 + 4096ull * 1024 * 2,
                 W_O = W_QKV + (size_t)NQKV * 1024 * 2, W_UP1 = W_O + 1024ull * 1024 * 2, W_DN1 = W_UP1 + 4096ull * 1024 * 2, W_END = W_DN1 + 4096ull * 1024 * 2;
static_assert(W_END <= 56 * MiB, "weights");
constexpr size_t WS_H = 56 * MiB;
constexpr size_t WS_HB = 121 * MiB;
constexpr size_t WS_HN0 = 154 * MiB;
constexpr size_t WS_VT = WS_HN0;
constexpr size_t WS_Y = 187 * MiB;
constexpr size_t WS_ATT = WS_Y;
constexpr size_t WS_ACT = 220 * MiB;
constexpr size_t WS_Q = WS_ACT;
constexpr size_t WS_KB = WS_Q + (size_t)MP * QW * 2;
static_assert(WS_KB + 3ull * MP * 256 * 2 <= 350 * MiB, "q/k overlay");
constexpr size_t WS_OG = 350 * MiB;
constexpr size_t WS_LSE = 448 * MiB;
constexpr size_t WS_END = 452 * MiB;

constexpr size_t O_YP = 0, O_YS = 16777216, O_KVP0 = 16908288, O_KVP1 = 17039360, O_KVP2 = 17563648,
                 O_KVS0 = 19660800, O_KVS1 = 19726336, O_KVS2 = 19791872, O_SREP = 19857408, O_SIMP = 19865600, O_SRES = 19873792, O_SIMS = 20004864;

__device__ __forceinline__ unsigned pk2(float lo, float hi) { f32x2_t v = {lo, hi}; bf16x2_t b = __builtin_convertvector(v, bf16x2_t); return __builtin_bit_cast(unsigned, b); }
__device__ __forceinline__ float bf2f(unsigned short u) { return __uint_as_float(((unsigned)u) << 16); }
__device__ __forceinline__ float wave_sum(float v) {
#pragma unroll
    for (int o = 1; o < 64; o <<= 1) v += __shfl_xor(v, o);
    return v;
}
__device__ __forceinline__ float wave_max(float v) {
#pragma unroll
    for (int o = 1; o < 64; o <<= 1) v = fmaxf(v, __shfl_xor(v, o));
    return v;
}

struct Args { const float* in[25]; float* out; unsigned char* ws; int ph_lo, ph_hi; };

struct EpiGlu {
    static constexpr bool PERM = true, AFTER_DRAIN = false;
    const float* xp; const float* xs; float* H; bf16* HB; float* rowss;
    __device__ __forceinline__ void operator()(const pg8::f32x4 (&acc)[2][2][4][2], const pg8::Unit& u, int wr, int wc, int fr, int fq) const { run<2>(acc, u, wr, wc, fr, fq); }
    template <int NAI> __device__ __forceinline__ void run(const pg8::f32x4 (&acc)[NAI][2][4][2], const pg8::Unit& u, int wr, int wc, int fr, int fq) const {
        const int col = u.pn * 128 + wc * 32 + 8 * fq;
#pragma unroll
        for (int ai = 0; ai < NAI; ++ai)
#pragma unroll
            for (int m = 0; m < 4; ++m) {
                const int row = u.pm * 256 + ai * 128 + wr * 64 + m * 16 + fr;
                if (row < MREAL) {
                    const float* xr = (row < NPROMPT ? xp + (size_t)row * D : xs + (size_t)(row - NPROMPT) * D) + col;
                    const f32x4 x0 = *(const f32x4*)xr, x1 = *(const f32x4*)(xr + 4);
                    f32x4 h0, h1;
#pragma unroll
                    for (int i = 0; i < 4; ++i) {
                        h0[i] = x0[i] + acc[ai][0][m][0][i] * __builtin_amdgcn_rcpf(1.f + __expf(-acc[ai][1][m][0][i]));
                        h1[i] = x1[i] + acc[ai][0][m][1][i] * __builtin_amdgcn_rcpf(1.f + __expf(-acc[ai][1][m][1][i]));
                    }
                    u32x4 w; w.x = pk2(h0[0], h0[1]); w.y = pk2(h0[2], h0[3]); w.z = pk2(h1[0], h1[1]); w.w = pk2(h1[2], h1[3]);
                    *(u32x4*)(HB + (size_t)row * D + col) = w;
                    float ss = (h0[0] * h0[0] + h0[1] * h0[1]) + (h0[2] * h0[2] + h0[3] * h0[3]) + (h1[0] * h1[0] + h1[1] * h1[1]) + (h1[2] * h1[2] + h1[3] * h1[3]);
                    ss += __shfl_xor(ss, 16); ss += __shfl_xor(ss, 32);
                    if (fq == 0) __hip_atomic_fetch_add(rowss + row, ss, __ATOMIC_RELAXED, __HIP_MEMORY_SCOPE_AGENT);
                } else { float ss = 0.f; ss += __shfl_xor(ss, 16); ss += __shfl_xor(ss, 32); (void)ss; }
            }
    }
};
struct EpiNull {
    static constexpr bool PERM = true, AFTER_DRAIN = false; float* sink;
    __device__ __forceinline__ void operator()(const pg8::f32x4 (&acc)[2][2][4][2], const pg8::Unit& u, int wr, int wc, int fr, int fq) const { run<2>(acc, u, wr, wc, fr, fq); }
    template <int NAI> __device__ __forceinline__ void run(const pg8::f32x4 (&acc)[NAI][2][4][2], const pg8::Unit& u, int wr, int wc, int fr, int fq) const {
        float t = 0.f;
#pragma unroll
        for (int b = 0; b < 2; ++b)
#pragma unroll
            for (int m = 0; m < 4; ++m)
#pragma unroll
                for (int n = 0; n < 2; ++n) t += acc[0][b][m][n][0] + acc[0][b][m][n][3];
        if (t == 1234.5678f) sink[0] = t;
    }
};
struct EpiUp {
    static constexpr bool PERM = true, AFTER_DRAIN = false;
    bf16* O; const float* rowss;
    __device__ __forceinline__ void operator()(const pg8::f32x4 (&acc)[2][2][4][2], const pg8::Unit& u, int wr, int wc, int fr, int fq) const { run<2>(acc, u, wr, wc, fr, fq); }
    template <int NAI> __device__ __forceinline__ void run(const pg8::f32x4 (&acc)[NAI][2][4][2], const pg8::Unit& u, int wr, int wc, int fr, int fq) const {
        const int col = u.pn * 256 + wc * 32 + 8 * fq;
#pragma unroll
        for (int ai = 0; ai < NAI; ++ai)
#pragma unroll
            for (int m = 0; m < 4; ++m) {
                const int row = u.pm * 256 + ai * 128 + wr * 64 + m * 16 + fr;
                if (row < MREAL) {
                    const float rstd = rsqrtf(rowss[row] * (1.f / D) + EPS);
#pragma unroll
                    for (int bj = 0; bj < 2; ++bj) {
                        float v[8];
#pragma unroll
                        for (int i = 0; i < 4; ++i) { float a = fmaxf(acc[ai][bj][m][0][i] * rstd, 0.f), b = fmaxf(acc[ai][bj][m][1][i] * rstd, 0.f); v[i] = a * a; v[4 + i] = b * b; }
                        u32x4 w; w.x = pk2(v[0], v[1]); w.y = pk2(v[2], v[3]); w.z = pk2(v[4], v[5]); w.w = pk2(v[6], v[7]);
                        *(u32x4*)(O + (size_t)row * FF + col + bj * 128) = w;
                    }
                }
            }
    }
};
struct EpiRes {
    static constexpr bool PERM = true, AFTER_DRAIN = false;
    bf16* HB; float* OUT; float* rowss;
    __device__ __forceinline__ void operator()(const pg8::f32x4 (&acc)[2][2][4][2], const pg8::Unit& u, int wr, int wc, int fr, int fq) const { run<2>(acc, u, wr, wc, fr, fq); }
    template <int NAI> __device__ __forceinline__ void run(const pg8::f32x4 (&acc)[NAI][2][4][2], const pg8::Unit& u, int wr, int wc, int fr, int fq) const {
        const int col = u.pn * 256 + wc * 32 + 8 * fq;
#pragma unroll
        for (int ai = 0; ai < NAI; ++ai)
#pragma unroll
            for (int m = 0; m < 4; ++m) {
                const int row = u.pm * 256 + ai * 128 + wr * 64 + m * 16 + fr;
                float ss = 0.f;
                if (row < MREAL) {
#pragma unroll
                    for (int bj = 0; bj < 2; ++bj) {
                        bf16* hp = HB + (size_t)row * D + col + bj * 128;
                        const bf16x8 hv = *(const bf16x8*)hp;
                        f32x4 h0, h1;
#pragma unroll
                        for (int i = 0; i < 4; ++i) { h0[i] = bf2f((unsigned short)hv[i]) + acc[ai][bj][m][0][i]; h1[i] = bf2f((unsigned short)hv[4 + i]) + acc[ai][bj][m][1][i]; }
                        if (OUT) { float* op = OUT + (size_t)row * D + col + bj * 128; *(f32x4*)op = h0; *(f32x4*)(op + 4) = h1; }
                        else { u32x4 w; w.x = pk2(h0[0], h0[1]); w.y = pk2(h0[2], h0[3]); w.z = pk2(h1[0], h1[1]); w.w = pk2(h1[2], h1[3]); *(u32x4*)hp = w; }
                        ss += (h0[0] * h0[0] + h0[1] * h0[1]) + (h0[2] * h0[2] + h0[3] * h0[3]) + (h1[0] * h1[0] + h1[1] * h1[1]) + (h1[2] * h1[2] + h1[3] * h1[3]);
                    }
                }
                ss += __shfl_xor(ss, 16); ss += __shfl_xor(ss, 32);
                if (fq == 0 && row < MREAL) __hip_atomic_fetch_add(rowss + row, ss, __ATOMIC_RELAXED, __HIP_MEMORY_SCOPE_AGENT);
            }
    }
};
struct EpiQKV {
    static constexpr bool PERM = true, AFTER_DRAIN = false;
    bf16* Q; bf16* KB; bf16* VB; float* out; const float* rowss; const float* ropec; const float* ropes; const float* offc; const float* offs;
    __device__ __forceinline__ void operator()(const pg8::f32x4 (&acc)[2][2][4][2], const pg8::Unit& u, int wr, int wc, int fr, int fq) const { run<2>(acc, u, wr, wc, fr, fq); }
    template <int NAI> __device__ __forceinline__ void run(const pg8::f32x4 (&acc)[NAI][2][4][2], const pg8::Unit& u, int wr, int wc, int fr, int fq) const {
        const int pn = u.pn;
        const bool isq = pn < 12; const int kvi = pn - 12; const int g = isq ? (pn >> 2) : (kvi >> 1); const bool isv = (!isq) && (kvi & 1);
        const int sh = 2 * g, W = 128 << sh;
        const bool stile = u.pm == 64;
        const int d0 = 8 * fq;
        const int slb = ((u.pm * 256 + wr * 64 + fr) & (SEQ - 1)) * 32 + d0;
#pragma unroll
        for (int ai = 0; ai < NAI; ++ai)
#pragma unroll
            for (int m = 0; m < 4; ++m) {
                const int row = u.pm * 256 + ai * 128 + wr * 64 + m * 16 + fr;
                if (row >= MREAL) continue;
                const float rstd = rsqrtf(rowss[row] * (1.f / D) + EPS);
                const bool samp = row >= NPROMPT; const int t = samp ? ((row - NPROMPT) & 3) : (row & (SEQ - 1));
                int rowp = row;
                if (!samp) { const int b = row >> 13, r = t & ((1 << sh) - 1), uu = t >> sh; rowp = b * SEQ + r * (SEQ >> sh) + uu; }
                float* ob = nullptr;
                if (!isq) {
                    if (samp) ob = out + (g == 0 ? O_KVS0 : g == 1 ? O_KVS1 : O_KVS2) + (size_t)(row - NPROMPT) * 512;
                    else if (t >= SEQ - W) ob = out + (g == 0 ? O_KVP0 : g == 1 ? O_KVP1 : O_KVP2) + ((size_t)(row >> 13) * W + (t - (SEQ - W))) * 512;
                }
                f32x4 av[2], bv[2];
#pragma unroll
                for (int n = 0; n < 2; ++n) {
                    f32x4 a = acc[ai][0][m][n] * rstd, b = acc[ai][1][m][n] * rstd;
                    if (!isv) {
                        const int sl = (samp ? SEQ + t : t) * 32 + d0 + 4 * n; const f32x4 c = *(const f32x4*)(ropec + sl), sn = *(const f32x4*)(ropes + sl);
                        const f32x4 ra = a * c - b * sn, rb = b * c + a * sn; a = ra; b = rb;
                    }
                    av[n] = a; bv[n] = b;
                }
                if (isq) {
                    bf16* qp = Q + (size_t)row * QW + pn * 256 + wc * 64 + d0;
                    u32x4 w0, w1; w0.x = pk2(av[0][0] * QSCALE, av[0][1] * QSCALE); w0.y = pk2(av[0][2] * QSCALE, av[0][3] * QSCALE); w0.z = pk2(av[1][0] * QSCALE, av[1][1] * QSCALE); w0.w = pk2(av[1][2] * QSCALE, av[1][3] * QSCALE);
                    w1.x = pk2(bv[0][0] * QSCALE, bv[0][1] * QSCALE); w1.y = pk2(bv[0][2] * QSCALE, bv[0][3] * QSCALE); w1.z = pk2(bv[1][0] * QSCALE, bv[1][1] * QSCALE); w1.w = pk2(bv[1][2] * QSCALE, bv[1][3] * QSCALE);
                    *(u32x4*)qp = w0; *(u32x4*)(qp + 32) = w1;
                } else {
                    bf16* kp = (isv ? VB : KB) + ((size_t)g * MP + rowp) * 256 + wc * 64 + d0;
                    u32x4 w0, w1; w0.x = pk2(av[0][0], av[0][1]); w0.y = pk2(av[0][2], av[0][3]); w0.z = pk2(av[1][0], av[1][1]); w0.w = pk2(av[1][2], av[1][3]);
                    w1.x = pk2(bv[0][0], bv[0][1]); w1.y = pk2(bv[0][2], bv[0][3]); w1.z = pk2(bv[1][0], bv[1][1]); w1.w = pk2(bv[1][2], bv[1][3]);
                    *(u32x4*)kp = w0; *(u32x4*)(kp + 32) = w1;
                    if (ob) { float* o2 = ob + (isv ? 256 : 0) + wc * 64 + d0; *(f32x4*)o2 = av[0]; *(f32x4*)(o2 + 4) = av[1]; *(f32x4*)(o2 + 32) = bv[0]; *(f32x4*)(o2 + 36) = bv[1]; }
                }
            }
    }
};

template <class Epi>
__device__ __forceinline__ void skinny_phase(LAS unsigned char* lds, const bf16* Abuf, const bf16* Bt, int N, int K, const Epi& E, int first, int wave, int lane) {
    const int nroles = (N >> 8) * 8, G = gridDim.x;
    const int fr = lane & 15, fq = lane >> 4;
    LAS float* red = (LAS float*)lds;
    const int rstep = first ? G - first : G;
    for (int role = (int)blockIdx.x - first; role < nroles; role += rstep) {
        if (role < 0) break;
        const int pn = role >> 3, wr = (role >> 2) & 1, wc = role & 3;
        pg8::f32x4 acc[1][2][4][2];
#pragma unroll
        for (int b = 0; b < 2; ++b)
#pragma unroll
            for (int m = 0; m < 4; ++m)
#pragma unroll
                for (int n = 0; n < 2; ++n) acc[0][b][m][n] = (pg8::f32x4){0.f, 0.f, 0.f, 0.f};
        const int kper = K >> 3, k0 = wave * kper;
        const bf16* ap = Abuf + (size_t)(NPROMPT + 64 * wr + fr) * K + k0 + 8 * fq;
        const int r0 = Epi::PERM ? (8 * (fr >> 2) + (fr & 3)) : fr, r1 = Epi::PERM ? r0 + 4 : fr + 16;
        const bf16* bp = Bt + (size_t)(256 * pn + 32 * wc) * K + k0 + 8 * fq;
#pragma unroll 4
        for (int ks = 0; ks < kper; ks += 32) {
            bf16x8 af[4], bf_[2][2];
#pragma unroll
            for (int m = 0; m < 4; ++m) af[m] = *(const bf16x8*)(ap + (size_t)(16 * m) * K + ks);
#pragma unroll
            for (int b = 0; b < 2; ++b) { bf_[b][0] = *(const bf16x8*)(bp + (size_t)(128 * b + r0) * K + ks); bf_[b][1] = *(const bf16x8*)(bp + (size_t)(128 * b + r1) * K + ks); }
#pragma unroll
            for (int b = 0; b < 2; ++b)
#pragma unroll
                for (int m = 0; m < 4; ++m)
#pragma unroll
                    for (int n = 0; n < 2; ++n) acc[0][b][m][n] = __builtin_amdgcn_mfma_f32_16x16x32_bf16(bf_[b][n], af[m], acc[0][b][m][n], 0, 0, 0);
        }
        if (wave != 0) {
#pragma unroll
            for (int b = 0; b < 2; ++b)
#pragma unroll
                for (int m = 0; m < 4; ++m)
#pragma unroll
                    for (int n = 0; n < 2; ++n) *(LAS pg8::f32x4*)(red + ((size_t)((wave - 1) * 16 + b * 8 + m * 2 + n) * 64 + lane) * 4) = acc[0][b][m][n];
        }
        __syncthreads();
        if (wave == 0) {
#pragma unroll 1
            for (int w = 0; w < 7; ++w)
#pragma unroll
                for (int b = 0; b < 2; ++b)
#pragma unroll
                    for (int m = 0; m < 4; ++m)
#pragma unroll
                        for (int n = 0; n < 2; ++n) acc[0][b][m][n] += *(const LAS pg8::f32x4*)(red + ((size_t)(w * 16 + b * 8 + m * 2 + n) * 64 + lane) * 4);
            const pg8::Unit u{64, pn};
            E.template run<1>(acc, u, wr, wc, fr, fq);
        }
        __syncthreads();
    }
}
__device__ __forceinline__ int conv_srcc(int mode, int nb) {
    if (mode == 0) return 32 * nb;
    if (mode == 1) { const int pn = nb >> 3, bj = (nb >> 2) & 1, cb = nb & 3; return bj * 1024 + 128 * pn + 32 * cb; }
    const int pn = nb >> 3, bj = (nb >> 2) & 1, wc = nb & 3; return 256 * pn + 64 * wc + 32 * bj;
}
__device__ __forceinline__ void transpose_item(const float* W, int K, int N, bf16* WT, const float* gain, int mode, LAS float* scr, int item, int lane) {
    const int nblk = N >> 6, kb = item / nblk, nb64 = item % nblk, k0 = 64 * kb;
    const int l16 = lane & 15, srcc = conv_srcc(mode, 2 * nb64 + (l16 >> 3)) + 4 * (l16 & 7);
    f32x4 v[16];
#pragma unroll
    for (int i = 0; i < 16; ++i) { const int kk = 4 * i + (lane >> 4); v[i] = *(const f32x4*)(W + (size_t)(k0 + kk) * N + srcc); }
    if (gain) {
#pragma unroll
        for (int i = 0; i < 16; ++i) { const int kk = 4 * i + (lane >> 4); v[i] = v[i] * gain[k0 + kk]; }
    }
#pragma unroll
    for (int i = 0; i < 16; ++i) { const int kk = 4 * i + (lane >> 4); LAS float* d = scr + kk * 65 + 4 * l16; d[0] = v[i][0]; d[1] = v[i][1]; d[2] = v[i][2]; d[3] = v[i][3]; }
    asm volatile("s_waitcnt lgkmcnt(0)" ::: "memory");
    const int c = lane & 7;
#pragma unroll
    for (int j = 0; j < 8; ++j) { const int n = (lane >> 3) + 8 * j; const LAS float* sp = scr + (8 * c) * 65 + n;
        u32x4 o; o.x = pk2(sp[0 * 65], sp[1 * 65]); o.y = pk2(sp[2 * 65], sp[3 * 65]); o.z = pk2(sp[4 * 65], sp[5 * 65]); o.w = pk2(sp[6 * 65], sp[7 * 65]);
        *(u32x4*)(WT + (size_t)(64 * nb64 + n) * K + k0 + 8 * c) = o; }
    asm volatile("s_waitcnt lgkmcnt(0)" ::: "memory");
}
__device__ __forceinline__ void convert_late(const Args& A, LAS unsigned char* lds, int vw, int NVW, int wave, int lane) {
    unsigned char* ws = A.ws;
    LAS float* scr = (LAS float*)(lds + wave * 16640);
    constexpr int I_UP = 16 * 64, I_DN = 64 * 16, I_O = 16 * 16, NIT = I_O + I_UP + I_DN;
    for (int it = vw; it < NIT; it += NVW) {
        int r = it;
        if (r < I_O) { transpose_item(A.in[21], 1024, 1024, (bf16*)(ws + W_O), nullptr, 0, scr, r, lane); continue; } r -= I_O;
        if (r < I_UP) { transpose_item(A.in[22] + 1024ull * 4096, 1024, 4096, (bf16*)(ws + W_UP1), A.in[8] + 1024, 0, scr, r, lane); continue; } r -= I_UP;
        transpose_item(A.in[23] + 4096ull * 1024, 4096, 1024, (bf16*)(ws + W_DN1), nullptr, 0, scr, r, lane);
    }
}

__device__ __forceinline__ void phase_prologue(const Args& A, LAS unsigned char* lds, int gw, int NGW, int wave, int lane) {
    unsigned char* ws = A.ws;
    LAS float* scr = (LAS float*)(lds + wave * 16640);
    constexpr int I_GLU = 16 * 32, I_UP = 16 * 64, I_DN = 64 * 16, I_Q = 16 * 48, I_KV = 16 * 24;
    constexpr int NIT = I_GLU + I_UP + I_DN + I_Q + I_KV;
    for (int it = gw; it < NIT; it += NGW) {
        int r = it;
        if (r < I_GLU) { transpose_item(A.in[17], 1024, 2048, (bf16*)(ws + W_GLU), nullptr, 1, scr, r, lane); continue; } r -= I_GLU;
        if (r < I_UP) { transpose_item(A.in[22], 1024, 4096, (bf16*)(ws + W_UP0), A.in[8], 0, scr, r, lane); continue; } r -= I_UP;
        if (r < I_DN) { transpose_item(A.in[23], 4096, 1024, (bf16*)(ws + W_DN0), nullptr, 0, scr, r, lane); continue; } r -= I_DN;
        if (r < I_Q) { transpose_item(A.in[20], 1024, 3072, (bf16*)(ws + W_QKV), A.in[7] + 1024, 2, scr, r, lane); continue; } r -= I_Q;
        transpose_item(A.in[19], 1024, 1536, (bf16*)(ws + W_QKV) + 3072ull * 1024, A.in[18], 2, scr, r, lane);
    }
    {
        const float* gmix = A.in[7];
        bf16* HN0 = (bf16*)(ws + WS_HN0);
        for (int row0 = 4 * gw; row0 < MREAL; row0 += 4 * NGW) {
            f32x4 v[4][4]; float ssq[4];
#pragma unroll
            for (int q = 0; q < 4; ++q) { const int row = row0 + q; const float* xr = row < NPROMPT ? A.in[0] + (size_t)row * D : A.in[1] + (size_t)(row - NPROMPT) * D;
#pragma unroll
                for (int j = 0; j < 4; ++j) v[q][j] = *((const f32x4*)xr + lane + 64 * j); }
#pragma unroll
            for (int q = 0; q < 4; ++q) { float sq = 0.f;
#pragma unroll
                for (int j = 0; j < 4; ++j) sq += (v[q][j][0] * v[q][j][0] + v[q][j][1] * v[q][j][1]) + (v[q][j][2] * v[q][j][2] + v[q][j][3] * v[q][j][3]);
                ssq[q] = rsqrtf(wave_sum(sq) * (1.f / D) + EPS); }
#pragma unroll
            for (int j = 0; j < 4; ++j) { const f32x4 gg = *((const f32x4*)gmix + lane + 64 * j);
#pragma unroll
                for (int q = 0; q < 4; ++q) { const float rstd = ssq[q];
                    u32x2 w; w.x = pk2(v[q][j][0] * rstd * gg[0], v[q][j][1] * rstd * gg[1]); w.y = pk2(v[q][j][2] * rstd * gg[2], v[q][j][3] * rstd * gg[3]);
                    *((u32x2*)(HN0 + (size_t)(row0 + q) * D) + lane + 64 * j) = w; } }
        }
    }
    const int gt = gw * 64 + lane, NGT = NGW * 64;
    { float* rs = (float*)(ws + WS_ROWSS); for (int i = gt; i < 4 * MP; i += NGT) rs[i] = 0.f; }
    { float* rc = (float*)(ws + WS_ROPE); float* rsn = rc + 8196 * 32;
      for (int i = gt; i < 8196 * 32; i += NGT) { const int slot = i >> 5, d = i & 31; const float pos = slot < SEQ ? (float)slot : (float)(16384 + (slot - SEQ));
          const float inv = powf(10000.0f, -(float)d / 32.0f); const float ang = pos * inv; rc[i] = cosf(ang); rsn[i] = sinf(ang); } }
    { float* oc = (float*)(ws + WS_ROPE) + 2 * 8196 * 32; float* os = oc + 8 * 32;
      for (int i = gt; i < 8 * 32; i += NGT) { const int oi = i >> 5, d = i & 31; const float pos = (float)(128 * (oi >> 2) + 16 * (oi & 3));
          const float inv = powf(10000.0f, -(float)d / 32.0f); const float ang = pos * inv; oc[i] = cosf(ang); os[i] = sinf(ang); } }
    { float* lam = (float*)(ws + WS_LAM); bf16* BB = (bf16*)(ws + WS_BBAR); bf16* CC = (bf16*)(ws + WS_CC);
      const float *are = A.in[9], *aim = A.in[10], *ldt = A.in[11], *bre = A.in[12], *bim = A.in[13], *cre = A.in[14], *cim = A.in[15];
      for (int i = gt; i < 64 * 64 * 16; i += NGT) {
          const int c = i & 15, p = (i >> 4) & 63, g = i >> 10;
          const float dt = expf(ldt[g]); const float ar = are[g * 64 + p], ai = aim[g * 64 + p];
          const float mag = expf(ar * dt); const float lr = mag * cosf(ai * dt), li = mag * sinf(ai * dt);
          const float den = ar * ar + ai * ai, nr = lr - 1.f, ni = li;
          const float zr = (nr * ar + ni * ai) / den, zi = (ni * ar - nr * ai) / den;
          const float br = bre[(g * 64 + p) * 16 + c], bi = bim[(g * 64 + p) * 16 + c];
          const float bbr = zr * br - zi * bi, bbi = zr * bi + zi * br;
          BB[(g * 128 + p) * 16 + c] = (bf16)(pk2(bbr, 0.f) & 0xffffu);
          BB[(g * 128 + 64 + p) * 16 + c] = (bf16)(pk2(bbi, 0.f) & 0xffffu);
          CC[(g * 16 + c) * 128 + 4 * (p & 31) + (p >> 5)] = (bf16)(pk2(cre[(g * 16 + c) * 64 + p], 0.f) & 0xffffu);
          CC[(g * 16 + c) * 128 + 4 * (p & 31) + 2 + (p >> 5)] = (bf16)(pk2(-cim[(g * 16 + c) * 64 + p], 0.f) & 0xffffu);
          if (c == 0) { lam[(g * 64 + p) * 2] = lr; lam[(g * 64 + p) * 2 + 1] = li; }
      } }
}

#define CMUL_ADD(orr, oi, ar_, ai_, br_, bi_, cr_, ci_) do { const float _r = __builtin_fmaf((ar_), (br_), __builtin_fmaf(-(ai_), (bi_), (cr_))); const float _i = __builtin_fmaf((ar_), (bi_), __builtin_fmaf((ai_), (br_), (ci_))); orr = _r; oi = _i; } while (0)
template <bool PASS2>
__device__ __forceinline__ void s5_item(const Args& A, LAS unsigned char* hs, int item, int lane) {
    unsigned char* ws = A.ws;
    const bf16* HN0 = (const bf16*)(ws + WS_HN0);
    const bool samp = item >= 2048;
    const int g = item & 63, ch = samp ? 128 + ((item - 2048) >> 6) : 4 * (item >> 6);
    const int s = lane & 31, hf = lane >> 5;
    bf16x8 Bf[4], Cf[4];
    { const bf16* BB = (const bf16*)(ws + WS_BBAR) + (size_t)g * 128 * 16;
#pragma unroll
      for (int n = 0; n < 4; ++n) Bf[n] = *(const bf16x8*)(BB + (32 * n + s) * 16 + 8 * hf);
      if (PASS2) { const bf16* CC = (const bf16*)(ws + WS_CC) + (size_t)g * 16 * 128;
#pragma unroll
        for (int st = 0; st < 4; ++st) Cf[st] = *(const bf16x8*)(CC + (lane & 15) * 128 + 32 * st + 8 * (lane >> 4)); } }
    const float* lam = (const float*)(ws + WS_LAM) + (size_t)g * 128;
    float lr[2], li[2], l16r[2], l16i[2], l128r[2], l128i[2];
#pragma unroll
    for (int j = 0; j < 2; ++j) { lr[j] = lam[(s + 32 * j) * 2]; li[j] = lam[(s + 32 * j) * 2 + 1];
        float pr = lr[j], pi = li[j];
#pragma unroll
        for (int q = 0; q < 4; ++q) { const float nr = pr * pr - pi * pi, ni = 2.f * pr * pi; pr = nr; pi = ni; }
        l16r[j] = pr; l16i[j] = pi;
#pragma unroll
        for (int q = 0; q < 3; ++q) { const float nr = pr * pr - pi * pi, ni = 2.f * pr * pi; pr = nr; pi = ni; }
        l128r[j] = pr; l128i[j] = pi; }
    float cr[2] = {0.f, 0.f}, ci[2] = {0.f, 0.f};
    const float* E = (const float*)(ws + WS_E);
    if (PASS2) {
        if (samp) { const int n = ch - 128;
#pragma unroll
            for (int j = 0; j < 2; ++j) { cr[j] = A.in[5][((size_t)n * 64 + g) * 64 + s + 32 * j]; ci[j] = A.in[6][((size_t)n * 64 + g) * 64 + s + 32 * j]; } }
        else { const int first = (ch >> 6) << 6;
#pragma unroll 8
            for (int jj = first; jj < ch; ++jj) { const float* e = E + ((size_t)jj * 64 + g) * 128;
#pragma unroll
                for (int j = 0; j < 2; ++j) { const float er = e[j * 32 + s], ei = e[64 + j * 32 + s]; CMUL_ADD(cr[j], ci[j], l128r[j], l128i[j], cr[j], ci[j], er, ei); } } }
    }
    const int nblk = samp ? 1 : 16;
    const int rowbase = samp ? NPROMPT + 4 * (ch - 128) : ch * 128;
    const int tokA = 16 * ((s >> 2) & 1) + 4 * (s >> 3) + (s & 3);
    const float* dsk = A.in[16] + g * 16;
    bf16* Y = (bf16*)(ws + WS_Y);
    bf16x8 afn = *(const bf16x8*)(HN0 + (size_t)(rowbase + tokA) * D + g * 16 + 8 * hf);
    const int uoff = (lane & 15) * D + g * 16 + 4 * (lane >> 4);
    u32x2 un[2];
    if (PASS2) {
#pragma unroll
        for (int q = 0; q < 2; ++q) un[q] = *(const u32x2*)(HN0 + (size_t)(rowbase + 16 * q) * D + uoff);
    }
    const f32x4 dk4 = *(const f32x4*)(dsk + 4 * (lane >> 4));
    for (int blk = 0; blk < nblk; ++blk) {
        const int row0 = rowbase + 32 * blk;
        const bf16x8 af = afn;
        u32x2 uc[2];
        if (PASS2) {
#pragma unroll
            for (int q = 0; q < 2; ++q) uc[q] = un[q];
            if (blk + 1 < nblk) {
#pragma unroll
                for (int q = 0; q < 2; ++q) un[q] = *(const u32x2*)(HN0 + (size_t)(row0 + 32 + 16 * q) * D + uoff);
            }
        }
        if (!PASS2 && (blk & 3) == 0) { cr[0] = 0.f; cr[1] = 0.f; ci[0] = 0.f; ci[1] = 0.f; }
        if (blk + 1 < nblk) afn = *(const bf16x8*)(HN0 + (size_t)(row0 + 32 + tokA) * D + g * 16 + 8 * hf);
        f32x16 X[4];
        const f32x16 z16 = {0.f, 0.f, 0.f, 0.f, 0.f, 0.f, 0.f, 0.f, 0.f, 0.f, 0.f, 0.f, 0.f, 0.f, 0.f, 0.f};
#pragma unroll
        for (int n = 0; n < 4; ++n) X[n] = __builtin_amdgcn_mfma_f32_32x32x16_bf16(af, Bf[n], z16, 0, 0, 0);
        float cinr[2], cini[2];
#pragma unroll
        for (int j = 0; j < 2; ++j) {
            float er = 0.f, ei = 0.f;
#pragma unroll
            for (int r = 0; r < 16; ++r) CMUL_ADD(er, ei, lr[j], li[j], er, ei, X[j][r], X[2 + j][r]);
            const float or_ = __shfl_xor(er, 32), oi_ = __shfl_xor(ei, 32);
            const float e0r = hf ? or_ : er, e0i = hf ? oi_ : ei, e1r = hf ? er : or_, e1i = hf ? ei : oi_;
            float mr, mi; CMUL_ADD(mr, mi, l16r[j], l16i[j], cr[j], ci[j], e0r, e0i);
            cinr[j] = hf ? mr : cr[j]; cini[j] = hf ? mi : ci[j];
            CMUL_ADD(cr[j], ci[j], l16r[j], l16i[j], mr, mi, e1r, e1i);
        }
        if (PASS2) {
#pragma unroll
            for (int j = 0; j < 2; ++j) {
                float hr = cinr[j], hi = cini[j];
#pragma unroll
                for (int r = 0; r < 16; ++r) { CMUL_ADD(hr, hi, lr[j], li[j], hr, hi, X[j][r], X[2 + j][r]);
                    X[j][r] = hr; X[2 + j][r] = hi; }
            }
            if (samp && hf == 0) { const int n = ch - 128;
#pragma unroll
                for (int j = 0; j < 2; ++j) { A.out[O_SRES + ((size_t)n * 64 + g) * 64 + s + 32 * j] = X[j][3]; A.out[O_SIMS + ((size_t)n * 64 + g) * 64 + s + 32 * j] = X[2 + j][3]; } }
#pragma unroll
            for (int r = 0; r < 16; ++r) { LAS unsigned short* hp = (LAS unsigned short*)(hs + (16 * hf + r) * 272);
                u32x2 w; w.x = pk2(X[0][r], X[1][r]); w.y = pk2(X[2][r], X[3][r]);
                *(LAS u32x2*)(hp + 4 * s) = w; }
            asm volatile("s_waitcnt lgkmcnt(0)" ::: "memory");
#pragma unroll
            for (int tb = 0; tb < 2; ++tb) {
                f32x4 y = {0.f, 0.f, 0.f, 0.f};
#pragma unroll
                for (int st = 0; st < 4; ++st) { const bf16x8 hfrag = *(const LAS bf16x8*)(hs + (16 * tb + (lane & 15)) * 272 + 64 * st + 16 * (lane >> 4));
                    y = __builtin_amdgcn_mfma_f32_16x16x32_bf16(Cf[st], hfrag, y, 0, 0, 0); }
                const int tk = 16 * tb + (lane & 15);
                if (!samp || tk < 4) {
                    const float u0 = __uint_as_float(uc[tb].x << 16), u1 = __uint_as_float(uc[tb].x & 0xffff0000u), u2 = __uint_as_float(uc[tb].y << 16), u3 = __uint_as_float(uc[tb].y & 0xffff0000u);
                    f32x4 v = {y[0] + dk4[0] * u0, y[1] + dk4[1] * u1, y[2] + dk4[2] * u2, y[3] + dk4[3] * u3};
                    float ge[4];
#pragma unroll
                    for (int j = 0; j < 4; ++j) { const float z = 0.7978845608f * (v[j] + 0.044715f * v[j] * v[j] * v[j]); ge[j] = v[j] * __builtin_amdgcn_rcpf(1.f + __expf(-2.f * z)); }
                    u32x2 w; w.x = pk2(ge[0], ge[1]); w.y = pk2(ge[2], ge[3]);
                    *(u32x2*)(Y + (size_t)(row0 + tk) * D + g * 16 + 4 * (lane >> 4)) = w;
                }
            }
            asm volatile("s_waitcnt lgkmcnt(0)" ::: "memory");
        }
        if (!PASS2 && (blk & 3) == 3 && hf == 0) { float* e = (float*)(ws + WS_E) + ((size_t)(ch + (blk >> 2)) * 64 + g) * 128;
#pragma unroll
            for (int j = 0; j < 2; ++j) { e[j * 32 + s] = cr[j]; e[64 + j * 32 + s] = ci[j]; } }
    }
    if (PASS2 && !samp && hf == 0 && ((ch + 3) & 63) == 63) { const int b = ch >> 6;
#pragma unroll
        for (int j = 0; j < 2; ++j) { A.out[O_SREP + ((size_t)b * 64 + g) * 64 + s + 32 * j] = cr[j]; A.out[O_SIMP + ((size_t)b * 64 + g) * 64 + s + 32 * j] = ci[j]; } }
}

typedef short v4i16_t __attribute__((ext_vector_type(4)));
constexpr int KIMG_STRIDE = 144, KIMG_BYTES = 192 * KIMG_STRIDE, VIMG_HALF = 192 * 64, NATT_ITEMS = 3072;
struct AttItem { int g, sh, b, r, u0, kvh; };
__device__ __forceinline__ AttItem att_decode(int bi) {
    AttItem I; I.g = bi >> 10; const int rem = bi & 1023; I.kvh = rem & 3; I.b = (rem >> 2) & 1; const int rq = rem >> 3;
    I.sh = 2 * I.g; const int nqb = 128 >> I.sh; I.r = rq / nqb; I.u0 = 64 * (rq % nqb); return I;
}
template <bool COMBINE, int MODE = 0>
__device__ __forceinline__ void attn_prompt_phase(const Args& A, LAS unsigned char* lds, int tid, int wave, int lane, int item_lo, int item_hi) {
    unsigned char* ws = A.ws;
    const bf16* Q = (const bf16*)(ws + WS_Q); const bf16* KB = (const bf16*)(ws + WS_KB); const bf16* VB = (const bf16*)(ws + WS_VT);
    bf16* OG = (bf16*)(ws + WS_OG); float* LSE = (float*)(ws + WS_LSE);
    const int G = gridDim.x, hh = wave & 3, sub = wave >> 2, n = lane & 31, hf = lane >> 5;
    const int kap = (n & 3) + 4 * ((n >> 3) & 1) + 8 * ((n >> 2) & 1) + 16 * (n >> 4);
    int bi = item_lo + blockIdx.x;
    const int NATT_HI = item_hi;
    if (bi >= NATT_HI) return;
    bf16* AT = (bf16*)(ws + WS_ATT);
    u32x4 pk_[3], pv_[3]; bf16x8 qn[4];
#define ATT_ISSUE_KV(bix) do { const AttItem J = att_decode(bix); const int L_ = SEQ >> J.sh; const size_t pb_ = (size_t)J.g * MP + (size_t)J.b * SEQ + (size_t)J.r * L_; \
        _Pragma("unroll") for (int i = 0; i < 3; ++i) { const int c_ = tid + 512 * i, row_ = c_ >> 3, ch_ = c_ & 7; int u_ = J.u0 - 128 + row_; u_ = u_ < 0 ? 0 : u_; \
            pk_[i] = *(const u32x4*)(KB + (pb_ + u_) * 256 + J.kvh * 64 + 8 * ch_); pv_[i] = *(const u32x4*)(VB + (pb_ + u_) * 256 + J.kvh * 64 + 8 * ch_); } } while (0)
#define ATT_ISSUE_Q(bix) do { const AttItem J = att_decode(bix); const int qrow_ = J.b * SEQ + ((J.u0 + 32 * sub + n) << J.sh) + J.r; \
        _Pragma("unroll") for (int ks = 0; ks < 4; ++ks) qn[ks] = *(const bf16x8*)(Q + (size_t)qrow_ * QW + J.g * 1024 + (4 * J.kvh + hh) * 64 + 16 * ks + 8 * hf); } while (0)
#define ATT_WRITE(bufo) do { _Pragma("unroll") for (int i = 0; i < 3; ++i) { const int c = tid + 512 * i, row = c >> 3, ch = c & 7; \
            *(LAS u32x4*)(lds + (bufo) + row * KIMG_STRIDE + 16 * ch) = pk_[i]; \
            *(LAS u32x4*)(lds + (bufo) + KIMG_BYTES + (ch >> 2) * VIMG_HALF + row * 64 + (ch & 3) * 16) = pv_[i]; } } while (0)
    constexpr int ABUF = KIMG_BYTES + 2 * VIMG_HALF;
    bf16x8 qf[4];
    ATT_ISSUE_KV(bi); ATT_ISSUE_Q(bi);
    ATT_WRITE(0);
#pragma unroll
    for (int ks = 0; ks < 4; ++ks) qf[ks] = qn[ks];
    if (bi + G < NATT_HI) ATT_ISSUE_KV(bi + G);
    asm volatile("s_waitcnt lgkmcnt(0)\n\ts_barrier" ::: "memory");
    int par = 0;
    for (; bi < NATT_HI; bi += G, par ^= 1) {
        const AttItem I = att_decode(bi);
        if (bi + G < NATT_HI) { ATT_WRITE((par ^ 1) * ABUF); ATT_ISSUE_Q(bi + G); }
        if (bi + 2 * G < NATT_HI) ATT_ISSUE_KV(bi + 2 * G);
        const LAS unsigned char* lbuf = lds + par * ABUF;
        const int u0w = I.u0 + 32 * sub;
        const int qrow = I.b * SEQ + ((u0w + n) << I.sh) + I.r;
        const int h = 4 * I.kvh + hh;
        f32x16 O0, O1;
#pragma unroll
        for (int i = 0; i < 16; ++i) { O0[i] = 0.f; O1[i] = 0.f; }
        float mrun = -INFINITY, lrun = 0.f;
        const int cc_ = lane & 7, rr0_ = lane >> 3;
        bf16x8 x1[4], x2[4]; float l1 = 0.f, l2 = 0.f;
        if (COMBINE) {
            l1 = LSE[((size_t)1 * MP + qrow) * 16 + h]; l2 = LSE[((size_t)2 * MP + qrow) * 16 + h];
#pragma unroll
            for (int j = 0; j < 4; ++j) { const int qr_ = I.b * SEQ + ((u0w + rr0_ + 8 * j) << I.sh) + I.r;
                x1[j] = *(const bf16x8*)(OG + ((size_t)1 * MP + qr_) * D + h * 64 + 8 * cc_); x2[j] = *(const bf16x8*)(OG + ((size_t)2 * MP + qr_) * D + h * 64 + 8 * cc_); }
        }
        const int kt0 = (MODE == 1 || MODE == 3) ? 5 : (u0w >= 128 ? 0 : (128 - u0w) >> 5);
        const LAS unsigned char* kimg = lbuf + (32 * sub + kap) * KIMG_STRIDE + 16 * hf;
        const LAS unsigned char* vimg = lbuf + KIMG_BYTES + (32 * sub + 8 * hf + ((lane & 15) >> 2)) * 64 + (16 * ((lane >> 4) & 1) + 4 * (lane & 3)) * 2;
        for (int kt = kt0; kt < 5; ++kt) {
            bf16x8 kf[4], vf[2][2];
#pragma unroll
            for (int ks = 0; ks < 4; ++ks) kf[ks] = *(const LAS bf16x8*)(kimg + (32 * kt) * KIMG_STRIDE + 32 * ks);
#pragma unroll
            for (int mb = 0; mb < 2; ++mb)
#pragma unroll
                for (int st = 0; st < 2; ++st) {
                    const LAS unsigned char* vp = vimg + mb * VIMG_HALF + (32 * kt + 16 * st) * 64;
                    const v4i16_t lo = __builtin_amdgcn_ds_read_tr16_b64_v4i16((LAS v4i16_t*)vp);
                    const v4i16_t hi = __builtin_amdgcn_ds_read_tr16_b64_v4i16((LAS v4i16_t*)(vp + 4 * 64));
                    vf[mb][st] = (bf16x8){lo[0], lo[1], lo[2], lo[3], hi[0], hi[1], hi[2], hi[3]};
                }
            f32x16 S;
#pragma unroll
            for (int i = 0; i < 16; ++i) S[i] = 0.f;
#pragma unroll
            for (int ks = 0; ks < 4; ++ks) S = __builtin_amdgcn_mfma_f32_32x32x16_bf16(kf[ks], qf[ks], S, 0, 0, 0);
            if (kt == 0) {
#pragma unroll
                for (int rr = 0; rr < 16; ++rr) { const int kp = (rr & 7) + 8 * hf + 16 * (rr >> 3); if (kp < n) S[rr] = -INFINITY; }
            } else if (kt == 4) {
#pragma unroll
                for (int rr = 0; rr < 16; ++rr) { const int kp = (rr & 7) + 8 * hf + 16 * (rr >> 3); if (kp > n) S[rr] = -INFINITY; }
            }
            float tm = S[0];
#pragma unroll
            for (int rr = 1; rr < 16; ++rr) tm = fmaxf(tm, S[rr]);
            tm = fmaxf(tm, __shfl_xor(tm, 32));
            const float mnew = fmaxf(mrun, tm);
            const float alpha = __builtin_amdgcn_exp2f(mrun - mnew);
            float ps = 0.f; float p[16];
#pragma unroll
            for (int rr = 0; rr < 16; ++rr) { p[rr] = __builtin_amdgcn_exp2f(S[rr] - mnew); ps += p[rr]; }
            lrun = lrun * alpha + ps; mrun = mnew;
            if (__builtin_amdgcn_ballot_w64(alpha != 1.f) != 0ull) {
#pragma unroll
                for (int i = 0; i < 16; ++i) { O0[i] *= alpha; O1[i] *= alpha; }
            }
#pragma unroll
            for (int st = 0; st < 2; ++st) {
                u32x4 pw; pw.x = pk2(p[8 * st + 0], p[8 * st + 1]); pw.y = pk2(p[8 * st + 2], p[8 * st + 3]); pw.z = pk2(p[8 * st + 4], p[8 * st + 5]); pw.w = pk2(p[8 * st + 6], p[8 * st + 7]);
                const bf16x8 pf = __builtin_bit_cast(bf16x8, pw);
                O0 = __builtin_amdgcn_mfma_f32_32x32x16_bf16(vf[0][st], pf, O0, 0, 0, 0);
                O1 = __builtin_amdgcn_mfma_f32_32x32x16_bf16(vf[1][st], pf, O1, 0, 0, 0);
            }
        }
        const float ltot = lrun + __shfl_xor(lrun, 32);
        LAS unsigned char* ost = lds + 2 * ABUF + wave * 4864;
        float sc0;
        if (!COMBINE) { sc0 = 1.f / ltot; if (hf == 0) LSE[((size_t)I.g * MP + qrow) * 16 + h] = mrun + log2f(ltot); }
        else { const float l0 = mrun + log2f(ltot); const float mx = fmaxf(l0, fmaxf(l1, l2));
            const float w0 = __builtin_amdgcn_exp2f(l0 - mx), w1 = __builtin_amdgcn_exp2f(l1 - mx), w2 = __builtin_amdgcn_exp2f(l2 - mx);
            const float invw = 1.f / (w0 + w1 + w2); sc0 = w0 * invw / ltot;
            if (hf == 0) { LAS float* wp = (LAS float*)(ost + 4608) + 2 * n; wp[0] = w1 * invw; wp[1] = w2 * invw; } }
        if (MODE < 2) {
#pragma unroll
            for (int a = 0; a < 4; ++a) {
                u32x2 w0v, w1v; w0v.x = pk2(O0[4 * a] * sc0, O0[4 * a + 1] * sc0); w0v.y = pk2(O0[4 * a + 2] * sc0, O0[4 * a + 3] * sc0);
                w1v.x = pk2(O1[4 * a] * sc0, O1[4 * a + 1] * sc0); w1v.y = pk2(O1[4 * a + 2] * sc0, O1[4 * a + 3] * sc0);
                *(LAS u32x2*)(ost + n * 144 + (8 * a + 4 * hf) * 2) = w0v; *(LAS u32x2*)(ost + n * 144 + 64 + (8 * a + 4 * hf) * 2) = w1v;
            }
            asm volatile("s_waitcnt lgkmcnt(0)" ::: "memory");
#pragma unroll
            for (int j = 0; j < 4; ++j) { const int rr_ = rr0_ + 8 * j; const int qr_ = I.b * SEQ + ((u0w + rr_) << I.sh) + I.r;
                const bf16x8 tv = *(const LAS bf16x8*)(ost + rr_ * 144 + 16 * cc_);
                if (!COMBINE) *(bf16x8*)(OG + ((size_t)I.g * MP + qr_) * D + h * 64 + 8 * cc_) = tv;
                else { const LAS float* wp = (const LAS float*)(ost + 4608) + 2 * rr_; const float w1 = wp[0], w2 = wp[1];
                    float o[8];
#pragma unroll
                    for (int i = 0; i < 8; ++i) o[i] = bf2f((unsigned short)tv[i]) + w1 * bf2f((unsigned short)x1[j][i]) + w2 * bf2f((unsigned short)x2[j][i]);
                    u32x4 y; y.x = pk2(o[0], o[1]); y.y = pk2(o[2], o[3]); y.z = pk2(o[4], o[5]); y.w = pk2(o[6], o[7]);
                    *(u32x4*)(AT + (size_t)qr_ * D + h * 64 + 8 * cc_) = y; }
            }
        } else { if (ltot == 123.456f) LSE[0] = ltot; }
#pragma unroll
        for (int ks = 0; ks < 4; ++ks) qf[ks] = qn[ks];
        asm volatile("s_waitcnt lgkmcnt(0)\n\ts_barrier" ::: "memory");
    }
#undef ATT_ISSUE_KV
#undef ATT_ISSUE_Q
#undef ATT_WRITE
}

__device__ __forceinline__ void attn_sample_item(const Args& A, LAS float* sl, int it, int lane) {
    unsigned char* ws = A.ws;
    const int h = it & 15, t = (it >> 4) & 3, n = it >> 6, kvh = h >> 2;
    const int row = NPROMPT + 4 * n + t;
    const bf16* Q = (const bf16*)(ws + WS_Q) + (size_t)row * QW + h * 64;
    const int kq = lane >> 2, dq = lane & 3;
    float mxl = -INFINITY;
#pragma unroll 1
    for (int g = 0; g < 3; ++g) {
        const int W = 128 << (2 * g), dil = 1 << (2 * g);
        const float* cache = A.in[2 + g] + (size_t)n * W * 512;
        const float* newkv = A.out + (g == 0 ? O_KVS0 : g == 1 ? O_KVS1 : O_KVS2) + (size_t)n * 4 * 512;
        float q[16];
#pragma unroll
        for (int c8 = 0; c8 < 2; ++c8) { const bf16x8 v = *(const bf16x8*)(Q + g * 1024 + 16 * dq + 8 * c8);
#pragma unroll
            for (int i = 0; i < 8; ++i) q[8 * c8 + i] = bf2f((unsigned short)v[i]); }
#pragma unroll 9
        for (int bt = 0; bt < 9; ++bt) {
            const int j = 16 * bt + kq; const bool valid = j <= 128; const int jj = valid ? j : 128;
            const int idx = W + t - dil * jj;
            const float* kp = (idx >= W ? newkv + (size_t)(idx - W) * 512 : cache + (size_t)idx * 512) + kvh * 64 + 16 * dq;
            float s = 0.f;
#pragma unroll
            for (int c4 = 0; c4 < 4; ++c4) { const f32x4 kv = *(const f32x4*)(kp + 4 * c4); s += q[4 * c4] * kv[0] + q[4 * c4 + 1] * kv[1] + q[4 * c4 + 2] * kv[2] + q[4 * c4 + 3] * kv[3]; }
            s += __shfl_xor(s, 1); s += __shfl_xor(s, 2);
            if (valid && dq == 0) sl[g * 132 + j] = s;
            mxl = fmaxf(mxl, valid ? s : -INFINITY);
        }
    }
    const float mx = wave_max(mxl);
    asm volatile("s_waitcnt lgkmcnt(0)" ::: "memory");
    float sum = 0.f;
#pragma unroll 1
    for (int i = lane; i < 396; i += 64) { const int j = i % 132; if (j <= 128) { const float p = exp2f(sl[i] - mx); sl[i] = p; sum += p; } }
    sum = wave_sum(sum);
    asm volatile("s_waitcnt lgkmcnt(0)" ::: "memory");
    f32x4 acc = {0.f, 0.f, 0.f, 0.f};
    const int ksl = lane >> 4, dq4 = lane & 15;
#pragma unroll 1
    for (int g = 0; g < 3; ++g) {
        const int W = 128 << (2 * g), dil = 1 << (2 * g);
        const float* cache = A.in[2 + g] + (size_t)n * W * 512;
        const float* newkv = A.out + (g == 0 ? O_KVS0 : g == 1 ? O_KVS1 : O_KVS2) + (size_t)n * 4 * 512;
#pragma unroll 33
        for (int jb = 0; jb < 33; ++jb) {
            const int j = 4 * jb + ksl; const bool valid = j <= 128; const int jj = valid ? j : 128;
            const int idx = W + t - dil * jj;
            const float* vp = (idx >= W ? newkv + (size_t)(idx - W) * 512 : cache + (size_t)idx * 512) + 256 + kvh * 64 + 4 * dq4;
            const f32x4 v = *(const f32x4*)vp;
            const float pj = valid ? sl[g * 132 + jj] : 0.f;
            acc += v * pj;
        }
    }
#pragma unroll
    for (int i = 0; i < 4; ++i) { acc[i] += __shfl_xor(acc[i], 16); acc[i] += __shfl_xor(acc[i], 32); }
    bf16* AT = (bf16*)(ws + WS_ATT);
    if (lane < 16) { const float inv = 1.f / sum; u32x2 w; w.x = pk2(acc[0] * inv, acc[1] * inv); w.y = pk2(acc[2] * inv, acc[3] * inv);
        *(u32x2*)(AT + (size_t)row * D + h * 64 + 4 * dq4) = w; }
    asm volatile("s_waitcnt lgkmcnt(0)" ::: "memory");
}

__device__ __forceinline__ void attn_combine(const Args& A, int gt, int NGT) {
    unsigned char* ws = A.ws;
    const bf16* OG = (const bf16*)(ws + WS_OG); const float* LSE = (const float*)(ws + WS_LSE); bf16* AT = (bf16*)(ws + WS_ATT);
    for (int i = gt; i < NPROMPT * 128; i += NGT) {
        const int row = i >> 7, c8 = i & 127, h = c8 >> 3;
        const float l0 = LSE[((size_t)0 * MP + row) * 16 + h], l1 = LSE[((size_t)1 * MP + row) * 16 + h], l2 = LSE[((size_t)2 * MP + row) * 16 + h];
        const float mx = fmaxf(l0, fmaxf(l1, l2));
        float w0 = exp2f(l0 - mx), w1 = exp2f(l1 - mx), w2 = exp2f(l2 - mx); const float inv = 1.f / (w0 + w1 + w2); w0 *= inv; w1 *= inv; w2 *= inv;
        const bf16x8 a = *(const bf16x8*)(OG + ((size_t)0 * MP + row) * D + 8 * c8), b = *(const bf16x8*)(OG + ((size_t)1 * MP + row) * D + 8 * c8), c = *(const bf16x8*)(OG + ((size_t)2 * MP + row) * D + 8 * c8);
        float o[8];
#pragma unroll
        for (int k = 0; k < 8; ++k) o[k] = w0 * bf2f((unsigned short)a[k]) + w1 * bf2f((unsigned short)b[k]) + w2 * bf2f((unsigned short)c[k]);
        u32x4 w; w.x = pk2(o[0], o[1]); w.y = pk2(o[2], o[3]); w.z = pk2(o[4], o[5]); w.w = pk2(o[6], o[7]);
        *(u32x4*)(AT + (size_t)row * D + 8 * c8) = w;
    }
}

#define XB_TMO      128
#define XB_XCNT(j)  (256  + 64 * (j))
#define XB_XSUB(j)  (1280 + 64 * (j))
#define XB_XGEN(j)  (2304 + 64 * (j))
#define XB_TOP      3328
#define XB_TOPGEN   3392
#define XCD_BAR_WORDS 3456
#define XB_SPIN_CAP (1u << 18)

__device__ __forceinline__ unsigned xb_ld(unsigned* p)              { return __hip_atomic_load(p, __ATOMIC_RELAXED, __HIP_MEMORY_SCOPE_AGENT); }
__device__ __forceinline__ unsigned xb_add(unsigned* p, unsigned v) { return __hip_atomic_fetch_add(p, v, __ATOMIC_RELAXED, __HIP_MEMORY_SCOPE_AGENT); }
__device__ __forceinline__ unsigned xb_xcc_id() { return (unsigned)__builtin_amdgcn_s_getreg((3 << 11) | 20) & 0xFu; }
#define XB_SPIN(cond, bar) do { unsigned _sp = 0; while (cond) { __builtin_amdgcn_s_sleep(1); \
    if ((++_sp & 255u) == 0u) { if (xb_ld(&(bar)[XB_TMO])) break; if (_sp > XB_SPIN_CAP) { atomicAdd(&(bar)[XB_TMO], 1u); break; } } } } while (0)

struct XcdBarrier {
    unsigned* bar; unsigned x;
    volatile LAS unsigned* st;
};

__device__ __forceinline__ XcdBarrier xcd_barrier_post(unsigned* bar, volatile LAS unsigned* st) {
    XcdBarrier b; b.bar = bar; b.x = xb_xcc_id(); b.st = st;
    if (threadIdx.x == 0) (void)xb_add(&bar[XB_XCNT(b.x)], 1u);
    return b;
}
__device__ __forceinline__ void xcd_barrier_complete(unsigned* bar, unsigned x, unsigned& nloc, unsigned& nx) {
    const unsigned G = gridDim.x * gridDim.y * gridDim.z;
    unsigned sum, cnt, mine, sp = 0u;
    for (;;) {
        sum = 0u; cnt = 0u; mine = 0u;
#pragma unroll
        for (unsigned j = 0; j < 16; ++j) { const unsigned c = xb_ld(&bar[XB_XCNT(j)]); sum += c; cnt += (c > 0u) ? 1u : 0u; mine = (j == x) ? c : mine; }
        if (sum == G) break;
        __builtin_amdgcn_s_sleep(1);
        if ((++sp & 255u) == 0u) { if (xb_ld(&bar[XB_TMO])) break; if (sp > XB_SPIN_CAP) { atomicAdd(&bar[XB_TMO], 1u); break; } }
    }
    nloc = mine > 0u ? mine : 1u; nx = cnt > 0u ? cnt : 1u;
}

__device__ __forceinline__ void xcd_barrier(const XcdBarrier& b) {
    asm volatile("s_waitcnt vmcnt(0)" ::: "memory");
    __syncthreads();
    if (threadIdx.x == 0) {
        unsigned* bar = b.bar;
        __builtin_amdgcn_s_waitcnt(0);
        unsigned nloc = b.st[0], nx = b.st[1];
        if (nloc == 0u) { xcd_barrier_complete(bar, b.x, nloc, nx); b.st[0] = nloc; b.st[1] = nx; }
        const unsigned old = xb_add(&bar[XB_XSUB(b.x)], 1u);
        const unsigned gen = old / nloc;
        if (old + 1u == (gen + 1u) * nloc) {
            __builtin_amdgcn_fence(__ATOMIC_RELEASE, "agent");
            asm volatile("s_waitcnt vmcnt(0)" ::: "memory");
            const unsigned og = xb_add(&bar[XB_TOP], 1u);
            const unsigned tg = og / nx;
            if (og + 1u == (tg + 1u) * nx) xb_add(&bar[XB_TOPGEN], 1u);
            else XB_SPIN(xb_ld(&bar[XB_TOPGEN]) == tg, bar);
            __builtin_amdgcn_fence(__ATOMIC_ACQUIRE, "agent");
            xb_add(&bar[XB_XGEN(b.x)], 1u);
            asm volatile("s_waitcnt vmcnt(0)" ::: "memory");
        } else {
            XB_SPIN(xb_ld(&bar[XB_XGEN(b.x)]) == gen, bar);
            __builtin_amdgcn_fence(__ATOMIC_ACQUIRE, "agent");
            asm volatile("s_waitcnt vmcnt(0)" ::: "memory");
        }
    }
    __syncthreads();
}

constexpr int NPHASE = 13;
#ifndef REP0
#define REP0 1
#endif
#ifndef REP12
#define REP12 1
#endif
#ifndef REP7
#define REP7 1
#endif
#ifndef REP8
#define REP8 1
#endif
#ifndef REP4
#define REP4 1
#endif
#ifndef REP6
#define REP6 1
#endif
#ifndef DUP4
#define DUP4 0
#endif
#ifndef DUP6
#define DUP6 0
#endif
#ifndef DUP5
#define DUP5 0
#endif
#ifndef PROBE8
#define PROBE8 0
#endif
#ifndef XSYNC
#define XSYNC 0
#endif
__global__ void __launch_bounds__(NTHREADS, 2) yoco_fwd(Args A) {
    extern __shared__ __attribute__((aligned(16))) unsigned char lds_raw[];
    LAS unsigned char* lds = (LAS unsigned char*)lds_raw;
    cg::grid_group grid = cg::this_grid();
    const int tid = threadIdx.x, lane = tid & 63, wave = __builtin_amdgcn_readfirstlane(tid >> 6);
    const int G = gridDim.x, gw = blockIdx.x * NWAVES + wave, NGW = G * NWAVES, gt = gw * 64 + lane, NGT = NGW * 64;
    unsigned char* ws = A.ws;
    float* rowss = (float*)(ws + WS_ROWSS);
    float* Hf = (float*)(ws + WS_H); bf16* HB = (bf16*)(ws + WS_HB);
    const int lo = A.ph_lo, hi = A.ph_hi;
    volatile LAS unsigned* bst = (volatile LAS unsigned*)(lds + LDS_BYTES - 64);
    if (tid < 2) bst[tid] = 0u;
    __syncthreads();
    XcdBarrier xbar = xcd_barrier_post((unsigned*)(ws + WS_BAR), bst);
    if (lo < 0) grid.sync();
#ifndef PH_MASK
#define PH_MASK 0xffff
#endif
#define IN(k) (((PH_MASK >> (k)) & 1) && lo <= (k) && (k) < hi)
#define SEAM(k) do { if (IN(k) && IN((k) + 1)) xcd_barrier(xbar); } while (0)
    if (IN(0)) { for (int rp = 0; rp < REP0; ++rp) phase_prologue(A, lds, gw, NGW, wave, lane); for (int rp = 0; rp < XSYNC; ++rp) xcd_barrier(xbar); }
    SEAM(0);
    if (IN(1)) for (int rp = 0; rp < REP12; ++rp) { for (int it = gw; it < 2048; it += NGW) s5_item<false>(A, lds + wave * 8704, it, lane); }
    SEAM(1);
    if (IN(2)) for (int rp = 0; rp < REP12; ++rp) { for (int it = gw; it < 4096; it += NGW) s5_item<true>(A, lds + wave * 8704, it, lane); }
    SEAM(2);
    if (IN(3)) { pg8::Gemm g{(const bf16*)(ws + WS_Y), (const bf16*)(ws + W_GLU), NPROMPT, 2048, 1024}; pg8::StaticOrder S; S.init(NPROMPT, 2048, G, (int)blockIdx.x);
        EpiGlu E{A.in[0], A.in[1], Hf, HB, rowss};
        pg8::gemm_phase<EpiGlu, pg8::StaticOrder, true, true>(lds, g, S, E);
        skinny_phase(lds, g.A, g.Bt, 2048, 1024, E, 0, wave, lane); }
    SEAM(3);
    if (IN(4)) { pg8::Gemm g{HB, (const bf16*)(ws + W_UP0), NPROMPT, FF, 1024}; pg8::StaticOrder S; S.init(NPROMPT, FF, G, (int)blockIdx.x);
        EpiUp E{(bf16*)(ws + WS_ACT), rowss};
        pg8::gemm_phase<EpiUp, pg8::StaticOrder, true, true>(lds, g, S, E);
        skinny_phase(lds, g.A, g.Bt, FF, 1024, E, 0, wave, lane);
#if DUP4 == 1
        pg8::gemm_phase<EpiUp, pg8::StaticOrder, true, true>(lds, g, S, E);
#endif
#if DUP4 == 3
        { EpiNull E0{(float*)(ws + WS_OG)};
        skinny_phase(lds, g.A, g.Bt, FF, 1024, E0, 0, wave, lane); skinny_phase(lds, g.A, g.Bt, FF, 1024, E0, 0, wave, lane);
        skinny_phase(lds, g.A, g.Bt, FF, 1024, E0, 0, wave, lane); skinny_phase(lds, g.A, g.Bt, FF, 1024, E0, 0, wave, lane); }
#endif
#if DUP4 == 2
        skinny_phase(lds, g.A, g.Bt, FF, 1024, E, 0, wave, lane);
        skinny_phase(lds, g.A, g.Bt, FF, 1024, E, 0, wave, lane);
        skinny_phase(lds, g.A, g.Bt, FF, 1024, E, 0, wave, lane);
        skinny_phase(lds, g.A, g.Bt, FF, 1024, E, 0, wave, lane);
#endif
    }
    SEAM(4);
    if (IN(5)) { pg8::Gemm g{(const bf16*)(ws + WS_ACT), (const bf16*)(ws + W_DN0), NPROMPT, 1024, FF}; pg8::StaticOrder S; S.init(NPROMPT, 1024, G, (int)blockIdx.x);
        EpiRes E{HB, nullptr, rowss + MP};
        pg8::gemm_phase<EpiRes, pg8::StaticOrder, true, true>(lds, g, S, E);
        skinny_phase(lds, g.A, g.Bt, 1024, FF, E, 0, wave, lane);
#if DUP5 == 2
        { EpiUp E2{(bf16*)(ws + WS_OG), rowss}; pg8::gemm_phase<EpiUp, pg8::StaticOrder, true, true>(lds, g, S, E2); }
#endif
    }
    SEAM(5);
    if (IN(6)) { pg8::Gemm g{HB, (const bf16*)(ws + W_QKV), NPROMPT, NQKV, 1024}; pg8::StaticOrder S; S.init(NPROMPT, NQKV, G, (int)blockIdx.x);
        EpiQKV E{(bf16*)(ws + WS_Q), (bf16*)(ws + WS_KB), (bf16*)(ws + WS_VT), A.out, rowss + MP, (const float*)(ws + WS_ROPE), (const float*)(ws + WS_ROPE) + 8196 * 32, (const float*)(ws + WS_ROPE) + 2 * 8196 * 32, (const float*)(ws + WS_ROPE) + 2 * 8196 * 32 + 8 * 32};
        pg8::gemm_phase<EpiQKV, pg8::StaticOrder, true, true>(lds, g, S, E);
        skinny_phase(lds, g.A, g.Bt, NQKV, 1024, E, G >= 256 ? 128 : 0, wave, lane);
        { const int cf = G >= 256 ? 128 : 0; if ((int)blockIdx.x >= cf) convert_late(A, lds, ((int)blockIdx.x - cf) * NWAVES + wave, (G - cf) * NWAVES, wave, lane); }
#if DUP6 == 1
        pg8::gemm_phase<EpiQKV, pg8::StaticOrder, true, true>(lds, g, S, E);
#endif
#if DUP6 == 2
        { EpiUp E2{(bf16*)(ws + WS_OG), rowss + MP}; pg8::gemm_phase<EpiUp, pg8::StaticOrder, true, true>(lds, g, S, E2); }
#endif
    }
    SEAM(6);
    if (IN(7)) for (int rp = 0; rp < REP7; ++rp) {
        for (int it = gw; it < 2048; it += NGW) attn_sample_item(A, (LAS float*)(lds + 65536 + wave * 2048), it, lane);
        __syncthreads();
        attn_prompt_phase<false>(A, lds, tid, wave, lane, 1024, NATT_ITEMS);
    }
    SEAM(7);
    if (IN(8)) {
#if PROBE8 > 0
        attn_prompt_phase<true, PROBE8>(A, lds, tid, wave, lane, 0, 1024); __syncthreads();
#endif
        attn_prompt_phase<true>(A, lds, tid, wave, lane, 0, 1024); }
    SEAM(8);
    if (IN(9)) { pg8::Gemm g{(const bf16*)(ws + WS_ATT), (const bf16*)(ws + W_O), NPROMPT, 1024, 1024}; pg8::StaticOrder S; S.init(NPROMPT, 1024, G, (int)blockIdx.x);
        EpiRes E{HB, nullptr, rowss + 2 * MP};
        pg8::gemm_phase<EpiRes, pg8::StaticOrder, true, true>(lds, g, S, E);
        skinny_phase(lds, g.A, g.Bt, 1024, 1024, E, 0, wave, lane); }
    SEAM(9);
    if (IN(10)) { pg8::Gemm g{HB, (const bf16*)(ws + W_UP1), NPROMPT, FF, 1024}; pg8::StaticOrder S; S.init(NPROMPT, FF, G, (int)blockIdx.x);
        EpiUp E{(bf16*)(ws + WS_ACT), rowss + 2 * MP};
        pg8::gemm_phase<EpiUp, pg8::StaticOrder, true, true>(lds, g, S, E);
        skinny_phase(lds, g.A, g.Bt, FF, 1024, E, 0, wave, lane); }
    SEAM(10);
    if (IN(11)) { pg8::Gemm g{(const bf16*)(ws + WS_ACT), (const bf16*)(ws + W_DN1), NPROMPT, 1024, FF}; pg8::StaticOrder S; S.init(NPROMPT, 1024, G, (int)blockIdx.x);
        EpiRes E{HB, nullptr, rowss + 3 * MP};
        pg8::gemm_phase<EpiRes, pg8::StaticOrder, true, true>(lds, g, S, E);
        skinny_phase(lds, g.A, g.Bt, 1024, FF, E, 0, wave, lane); }
    SEAM(11);
    if (IN(12)) {
        const float* gfin = A.in[24];
        for (int row0 = 4 * gw; row0 < MREAL; row0 += 4 * NGW) {
            bf16x8 hv[4][2]; float rs[4];
#pragma unroll
            for (int q = 0; q < 4; ++q) { rs[q] = rowss[3 * MP + row0 + q];
#pragma unroll
                for (int j = 0; j < 2; ++j) hv[q][j] = *((const bf16x8*)(HB + (size_t)(row0 + q) * D) + lane + 64 * j); }
#pragma unroll
            for (int j = 0; j < 2; ++j) { const f32x4 g0 = *((const f32x4*)gfin + 2 * (lane + 64 * j)), g1 = *((const f32x4*)gfin + 2 * (lane + 64 * j) + 1);
#pragma unroll
                for (int q = 0; q < 4; ++q) { const float rstd = rsqrtf(rs[q] * (1.f / D) + EPS); float* orow = A.out + (size_t)(row0 + q) * D;
                    f32x4 o0, o1;
#pragma unroll
                    for (int i = 0; i < 4; ++i) { o0[i] = bf2f((unsigned short)hv[q][j][i]) * rstd * g0[i]; o1[i] = bf2f((unsigned short)hv[q][j][4 + i]) * rstd * g1[i]; }
                    *((f32x4*)orow + 2 * (lane + 64 * j)) = o0; *((f32x4*)orow + 2 * (lane + 64 * j) + 1) = o1; } }
        }
    }
#undef IN
#undef SEAM
}

#ifndef N_LAUNCHES
#define N_LAUNCHES 1
#endif
extern "C" void kernel_launch(void* const* d_in, const int* in_sizes, int n_in, void* d_out, int out_size, void* d_ws, size_t ws_size, hipStream_t stream) {
    static int grid = 0;
    if (grid == 0) {
        if (n_in != 25 || ws_size < WS_END) { fprintf(stderr, "kernel_launch: unexpected n_in %d / ws %zu\n", n_in, ws_size); grid = -1; return; }
        int dev = 0, cus = 0, per_cu = 0;
        hipGetDevice(&dev); hipDeviceGetAttribute(&cus, hipDeviceAttributeMultiprocessorCount, dev);
        if (hipFuncSetAttribute((const void*)yoco_fwd, hipFuncAttributeMaxDynamicSharedMemorySize, LDS_BYTES) != hipSuccess) { fprintf(stderr, "hipFuncSetAttribute failed\n"); grid = -1; return; }
        hipOccupancyMaxActiveBlocksPerMultiprocessor(&per_cu, (const void*)yoco_fwd, NTHREADS, LDS_BYTES);
        (void)hipGetLastError();
        if (per_cu < 1) per_cu = 1;
        grid = cus * per_cu;
    }
    if (grid < 0) return;
    Args a{};
    for (int i = 0; i < 25; ++i) a.in[i] = (const float*)d_in[i];
    a.out = (float*)d_out; a.ws = (unsigned char*)d_ws;
    if (hipMemsetAsync((char*)d_ws + WS_BAR, 0, 16384, stream) != hipSuccess) { fprintf(stderr, "memset failed\n"); return; }
    if (N_LAUNCHES == 1) {
        a.ph_lo = 0; a.ph_hi = NPHASE;
        void* args[] = {&a};
        hipError_t e = hipLaunchCooperativeKernel((const void*)yoco_fwd, dim3(grid), dim3(NTHREADS), args, LDS_BYTES, stream);
        if (e != hipSuccess) fprintf(stderr, "cooperative launch failed: %s (grid %d)\n", hipGetErrorString(e), grid);
    } else {
        for (int p = 0; p < NPHASE; ++p) { a.ph_lo = p; a.ph_hi = p + 1; hipLaunchKernelGGL(yoco_fwd, dim3(grid), dim3(NTHREADS), LDS_BYTES, stream, a); }
    }
}
```

```cpp
#include <hip/hip_runtime.h>
#include <hip/hip_cooperative_groups.h>
#include <cstdio>
#include <cstdint>
#include <cmath>
namespace cg = cooperative_groups;
namespace pg8 {
#define PG8_LAS __attribute__((address_space(3)))
typedef unsigned short bf16_t;
typedef short bf16x8 __attribute__((ext_vector_type(8)));
typedef float f32x4 __attribute__((ext_vector_type(4)));
typedef unsigned u32x4 __attribute__((ext_vector_type(4)));
constexpr int BM = 256, BK = 64, HALF = 128, HTB = HALF * BK * 2  , STAGE_BYTES = 8 * HTB, NXCD = 8, WGM = 8;

__host__ __device__ __forceinline__ int lds_byte(int r, int c) { const int st = (r >> 4) * 2 + (c >> 5), rr = r & 15, cc = c & 31, ob = rr * 64 + cc * 2; return st * 1024 + (ob ^ (((ob >> 9) & 1) << 5)); }
__host__ __device__ __forceinline__ void stage_rc(int b, int& R, int& C) { const int st = b / 1024, sb = b % 1024, swz = sb ^ (((sb >> 9) & 1) << 5); R = (st >> 1) * 16 + swz / 64; C = (st & 1) * 32 + (swz % 64) / 2; }
__host__ __device__ __forceinline__ int perm32(int rho) { const int n = rho >> 4, i = rho & 15; return 8 * (i >> 2) + 4 * n + (i & 3); }

struct Unit { int pm, pn; };
struct Gemm { const bf16_t* A; const bf16_t* Bt; int M, N, K; };

struct StaticOrder {
    int nM, nN, nwg, G, c;
    __host__ __device__ void init(int M, int N, int G_, int c_) { nM = M / BM; nN = N / BM; nwg = nM * nN; G = G_; c = c_; }
    __host__ __device__ bool next(int i, Unit& u) const {
        const long L = (long)i * G + c; if (L >= nwg) return false;
        int wgid = (int)L; { const int q = nwg / NXCD, r = nwg % NXCD, xcd = wgid % NXCD, off = wgid / NXCD; wgid = (xcd < r ? xcd * (q + 1) : r * (q + 1) + (xcd - r) * q) + off; }
        const int nig = WGM * nN, gid = wgid / nig, fm = gid * WGM, gsz = (nM - fm) < WGM ? (nM - fm) : WGM;
        u.pm = fm + ((wgid % nig) % gsz); u.pn = (wgid % nig) / gsz; return true;
    }
    __device__ __forceinline__ void a_ready(const Unit&) const {}
    __device__ __forceinline__ void done(const Unit&) const {}
};

__device__ __forceinline__ unsigned cvt_pk_bf16(float lo, float hi) { unsigned r; asm volatile("v_cvt_pk_bf16_f32 %0, %1, %2" : "=v"(r) : "v"(lo), "v"(hi)); return r; }
typedef float f32x2 __attribute__((ext_vector_type(2)));
__device__ __forceinline__ f32x2 gelu_pk(f32x2 v) {
    const f32x2 av = __builtin_elementwise_abs(v), d = av * 0.2316418882f + 1.0f;
    f32x2 t; t.x = __builtin_amdgcn_rcpf(d.x); t.y = __builtin_amdgcn_rcpf(d.y);
    f32x2 q = t * 0.5307027145f + (-0.7265760135f); q = q * t + 0.7107068705f; q = q * t + (-0.142248368f); q = q * t + 0.127414796f; q = q * t;
    const f32x2 s = (v * v) * (-0.72134752044f);
    f32x2 e; e.x = __builtin_amdgcn_exp2f(s.x); e.y = __builtin_amdgcn_exp2f(s.y);
    const f32x2 m = v * (q * e), r = v - m;
    f32x2 o; o.x = v.x < 0.f ? m.x : r.x; o.y = v.y < 0.f ? m.y : r.y; return o;
}


template <class Epi, class Sched, bool ALIGN_EPI = false, bool SP2 = false>
__device__ __forceinline__ void gemm_phase(PG8_LAS unsigned char* lds, const Gemm g, const Sched& S, const Epi& E) {
    const int tid = threadIdx.x, wid = __builtin_amdgcn_readfirstlane(tid >> 6), lane = tid & 63, wr = wid >> 2, wc = wid & 3, fr = lane & 15, fq = lane >> 4;
    const int K = g.K, nt = K / BK;
    unsigned voffA[2], voffB[2];
#pragma unroll
    for (int i = 0; i < 2; ++i) { int R, C; stage_rc(tid * 16 + i * 8192, R, C); const int Rb = Epi::PERM ? ((R & ~31) + perm32(R & 31)) : R;
        voffA[i] = (unsigned)(R * K + C) * 2u; voffB[i] = (unsigned)(Rb * K + C) * 2u; }
    const size_t kstep = (size_t)(BK * 2);
    const size_t hstep = (size_t)HALF * K * 2;
    const size_t tstep = 2 * hstep;
    const unsigned ldsw = (unsigned)wid * 1024u;
    const int aoff = lds_byte(wr * 64 + fr, fq * 8), boff = lds_byte(wc * 32 + fr, fq * 8);
#define PG8_SA(b, h) (((b) * 2 + (h)) * HTB)
#define PG8_SB(b, h) ((4 + (b) * 2 + (h)) * HTB)
#define PG8_STAGE(bufoff, gbase, voff) do { _Pragma("unroll") for (int _i = 0; _i < 2; ++_i) \
        __builtin_amdgcn_global_load_lds((const unsigned*)((const char*)(gbase) + (voff)[_i]), (PG8_LAS unsigned*)(lds + (bufoff) + ldsw + _i * 8192), 16, 0, 0); } while (0)
#define PG8_LDA(dst, b, h) do { _Pragma("unroll") for (int m = 0; m < 4; ++m) _Pragma("unroll") for (int k = 0; k < 2; ++k) dst[m][k] = *(const PG8_LAS bf16x8*)(lds + PG8_SA(b, h) + aoff + m * 2048 + k * 1024); } while (0)
#define PG8_LDB(dst, b, h) do { _Pragma("unroll") for (int n = 0; n < 2; ++n) _Pragma("unroll") for (int k = 0; k < 2; ++k) dst[n][k] = *(const PG8_LAS bf16x8*)(lds + PG8_SB(b, h) + boff + n * 2048 + k * 1024); } while (0)
#define PG8_MMA(ai, bj, At, Bt) do { __builtin_amdgcn_s_setprio(1); _Pragma("unroll") for (int m = 0; m < 4; ++m) _Pragma("unroll") for (int n = 0; n < 2; ++n) _Pragma("unroll") for (int k = 0; k < 2; ++k) \
        acc[ai][bj][m][n] = __builtin_amdgcn_mfma_f32_16x16x32_bf16(Bt[n][k], At[m][k], acc[ai][bj][m][n], 0, 0, 0); __builtin_amdgcn_s_setprio(0); } while (0)
#define PG8_WAIT_V(n) asm volatile("s_waitcnt vmcnt(" #n ")" ::: "memory")
#define PG8_WAIT_L(n) asm volatile("s_waitcnt lgkmcnt(" #n ")" ::: "memory")
#define PG8_BAR __builtin_amdgcn_s_barrier()
#define PG8_SCHED __builtin_amdgcn_sched_barrier(0)
    Unit cur, nxt; int ui = 0;
    if (!S.next(0, cur)) return;
    f32x4 acc[2][2][4][2];
#pragma unroll
    for (int a = 0; a < 2; ++a)
#pragma unroll
        for (int b = 0; b < 2; ++b)
#pragma unroll
            for (int m = 0; m < 4; ++m)
#pragma unroll
                for (int n = 0; n < 2; ++n) acc[a][b][m][n] = (f32x4){0.f, 0.f, 0.f, 0.f};
    bf16x8 At[4][2], B0[2][2], B1[2][2];
    const char* cA = (const char*)g.A + (size_t)cur.pm * tstep; const char* cB = (const char*)g.Bt + (size_t)cur.pn * tstep;
    S.a_ready(cur);
    if constexpr (SP2) {
        PG8_STAGE(PG8_SB(0, 0), cB, voffB); PG8_STAGE(PG8_SB(0, 1), cB + hstep, voffB); PG8_STAGE(PG8_SA(0, 0), cA, voffA); PG8_STAGE(PG8_SA(0, 1), cA + hstep, voffA);
        if (wr == 1) PG8_BAR;
        PG8_WAIT_V(2); PG8_BAR;
        PG8_STAGE(PG8_SB(1, 0), cB + kstep, voffB); PG8_STAGE(PG8_SA(1, 0), cA + kstep, voffA); PG8_STAGE(PG8_SB(1, 1), cB + hstep + kstep, voffB);
        PG8_WAIT_V(6); PG8_BAR;
    } else {
        PG8_STAGE(PG8_SB(0, 0), cB, voffB); PG8_STAGE(PG8_SA(0, 0), cA, voffA); PG8_STAGE(PG8_SB(0, 1), cB + hstep, voffB); PG8_STAGE(PG8_SA(0, 1), cA + hstep, voffA);
        if (wr == 1) PG8_BAR;
        PG8_WAIT_V(4); PG8_BAR;
        PG8_STAGE(PG8_SB(1, 0), cB + kstep, voffB); PG8_STAGE(PG8_SA(1, 0), cA + kstep, voffA); PG8_STAGE(PG8_SB(1, 1), cB + hstep + kstep, voffB);
        PG8_WAIT_V(6); PG8_BAR;
    }
    for (;;) {
        const bool has_next = S.next(ui + 1, nxt);
        const char* nA = has_next ? (const char*)g.A + (size_t)nxt.pm * tstep : cA; const char* nB = has_next ? (const char*)g.Bt + (size_t)nxt.pn * tstep : cB;
        for (int t = 0; t < nt; t += 2) {
            const bool last = (t == nt - 2);
            const char* a1 = cA + (size_t)(t + 1) * kstep;
            const char* a2 = last ? nA : cA + (size_t)(t + 2) * kstep; const char* b2 = last ? nB : cB + (size_t)(t + 2) * kstep;
            const char* a3 = a2 + kstep; const char* b3 = b2 + kstep;
            if (last && has_next) S.a_ready(nxt);
            if constexpr (SP2) {
            PG8_LDB(B0, 0, 0); PG8_LDB(B1, 0, 1); PG8_SCHED; PG8_LDA(At, 0, 0); PG8_STAGE(PG8_SA(1, 1), a1 + hstep, voffA);
            PG8_WAIT_V(8); PG8_WAIT_L(0); PG8_BAR; PG8_MMA(0, 0, At, B0); PG8_MMA(0, 1, At, B1); PG8_BAR; PG8_SCHED;
            PG8_LDA(At, 0, 1); PG8_STAGE(PG8_SB(0, 0), b2, voffB); PG8_STAGE(PG8_SB(0, 1), b2 + hstep, voffB); PG8_STAGE(PG8_SA(0, 0), a2, voffA);
            PG8_WAIT_V(8); PG8_WAIT_L(0); PG8_BAR; PG8_MMA(1, 0, At, B0); PG8_MMA(1, 1, At, B1); PG8_BAR; PG8_SCHED;
            PG8_LDB(B0, 1, 0); PG8_LDB(B1, 1, 1); PG8_SCHED; PG8_LDA(At, 1, 0); PG8_STAGE(PG8_SA(0, 1), a2 + hstep, voffA);
            PG8_WAIT_V(8); PG8_WAIT_L(0); PG8_BAR; PG8_MMA(0, 0, At, B0); PG8_MMA(0, 1, At, B1); PG8_BAR; PG8_SCHED;
            PG8_LDA(At, 1, 1); PG8_STAGE(PG8_SB(1, 0), b3, voffB); PG8_STAGE(PG8_SB(1, 1), b3 + hstep, voffB); PG8_STAGE(PG8_SA(1, 0), a3, voffA);
            PG8_WAIT_V(8); PG8_WAIT_L(0); PG8_BAR; PG8_MMA(1, 0, At, B0); PG8_MMA(1, 1, At, B1); PG8_BAR; PG8_SCHED;
            } else {
            PG8_LDB(B0, 0, 0); PG8_SCHED; PG8_LDA(At, 0, 0); PG8_STAGE(PG8_SA(1, 1), a1 + hstep, voffA);
            PG8_WAIT_L(8); PG8_BAR; PG8_WAIT_L(0); PG8_MMA(0, 0, At, B0); PG8_BAR; PG8_SCHED;
            PG8_LDB(B1, 0, 1); PG8_STAGE(PG8_SB(0, 0), b2, voffB);
            PG8_BAR; PG8_WAIT_L(0); PG8_MMA(0, 1, At, B1); PG8_BAR;
            PG8_LDA(At, 0, 1); PG8_STAGE(PG8_SA(0, 0), a2, voffA);
            PG8_BAR; PG8_WAIT_L(0); PG8_MMA(1, 0, At, B0); PG8_BAR; PG8_SCHED;
            PG8_STAGE(PG8_SB(0, 1), b2 + hstep, voffB);
            PG8_WAIT_V(6); PG8_BAR; PG8_MMA(1, 1, At, B1); PG8_BAR;
            PG8_LDB(B0, 1, 0); PG8_SCHED; PG8_LDA(At, 1, 0); PG8_STAGE(PG8_SA(0, 1), a2 + hstep, voffA);
            PG8_WAIT_L(8); PG8_BAR; PG8_WAIT_L(0); PG8_MMA(0, 0, At, B0); PG8_BAR; PG8_SCHED;
            PG8_LDB(B1, 1, 1); PG8_STAGE(PG8_SB(1, 0), b3, voffB);
            PG8_BAR; PG8_WAIT_L(0); PG8_MMA(0, 1, At, B1); PG8_BAR;
            PG8_LDA(At, 1, 1); PG8_STAGE(PG8_SA(1, 0), a3, voffA);
            PG8_BAR; PG8_WAIT_L(0); PG8_MMA(1, 0, At, B0); PG8_BAR; PG8_SCHED;
            PG8_STAGE(PG8_SB(1, 1), b3 + hstep, voffB);
            PG8_WAIT_V(6); PG8_BAR; PG8_MMA(1, 1, At, B1); PG8_BAR;
            }
        }
        if constexpr (ALIGN_EPI) { if (wr == 0) PG8_BAR; }
        if constexpr (!Epi::AFTER_DRAIN) { E(acc, cur, wr, wc, fr, fq); S.done(cur); }
        if (!has_next) break;
#pragma unroll
        for (int a = 0; a < 2; ++a)
#pragma unroll
            for (int b = 0; b < 2; ++b)
#pragma unroll
                for (int m = 0; m < 4; ++m)
#pragma unroll
                    for (int n = 0; n < 2; ++n) acc[a][b][m][n] = (f32x4){0.f, 0.f, 0.f, 0.f};
        cur = nxt; cA = nA; cB = nB; ++ui;
        if constexpr (ALIGN_EPI) { if (wr == 1) PG8_BAR; }
    }
    PG8_WAIT_V(0);
    if constexpr (!ALIGN_EPI) { if (wr == 0) PG8_BAR; }
    PG8_BAR;
    if constexpr (Epi::AFTER_DRAIN) { E.fused(acc, cur, wr, wc, fr, fq, lds, wid, lane); S.done(cur); }
#undef PG8_SA
#undef PG8_SB
#undef PG8_STAGE
#undef PG8_LDA
#undef PG8_LDB
#undef PG8_MMA
#undef PG8_WAIT_V
#undef PG8_WAIT_L
#undef PG8_BAR
#undef PG8_SCHED
}
}

#define LAS __attribute__((address_space(3)))
typedef unsigned short bf16;
typedef short bf16x8 __attribute__((ext_vector_type(8)));
typedef float f32x4 __attribute__((ext_vector_type(4)));
typedef float f32x16 __attribute__((ext_vector_type(16)));
typedef unsigned u32x4 __attribute__((ext_vector_type(4)));
typedef unsigned u32x2 __attribute__((ext_vector_type(2)));
typedef float f32x2_t __attribute__((ext_vector_type(2)));
typedef __bf16 bf16x2_t __attribute__((ext_vector_type(2)));

constexpr int NWAVES = 8, NTHREADS = 512;
constexpr int D = 1024, SEQ = 8192, NPROMPT = 16384, NSAMP = 128, MREAL = NPROMPT + NSAMP, MP = 16640;
constexpr int FF = 4096, QW = 3072, KVW = 1536, NQKV = QW + KVW;
constexpr float EPS = 1e-6f;
constexpr float QSCALE = 0.125f * 1.4426950408889634f;
constexpr int LDS_BYTES = 147456;

constexpr size_t MiB = 1u << 20;
constexpr size_t WS_ROWSS = 0;
constexpr size_t WS_BAR = 384 * 1024;
constexpr size_t WS_LAM = 512 * 1024;
constexpr size_t WS_BBAR = 576 * 1024;
constexpr size_t WS_CC = 1 * MiB;
constexpr size_t WS_ROPE = 1536 * 1024;
constexpr size_t WS_E = 3840 * 1024;
constexpr size_t WS_W = 8 * MiB;
constexpr size_t W_GLU = WS_W, W_UP0 = W_GLU + 2048ull * 1024 * 2, W_DN0 = W_UP0 + 4096ull * 1024 * 2, W_QKV = W_DN0 + 4096ull * 1024 * 2,
                 W_O = W_QKV + (size_t)NQKV * 1024 * 2, W_UP1 = W_O + 1024ull * 1024 * 2, W_DN1 = W_UP1 + 4096ull * 1024 * 2, W_END = W_DN1 + 4096ull * 1024 * 2;
static_assert(W_END <= 56 * MiB, "weights");
constexpr size_t WS_H = 56 * MiB;
constexpr size_t WS_HB = 121 * MiB;
constexpr size_t WS_HN0 = 154 * MiB;
constexpr size_t WS_VT = WS_HN0;
constexpr size_t WS_Y = 187 * MiB;
constexpr size_t WS_ATT = WS_Y;
constexpr size_t WS_ACT = 220 * MiB;
constexpr size_t WS_Q = WS_ACT;
constexpr size_t WS_KB = WS_Q + (size_t)MP * QW * 2;
static_assert(WS_KB + 3ull * MP * 256 * 2 <= 350 * MiB, "q/k overlay");
constexpr size_t WS_OG = 350 * MiB;
constexpr size_t WS_LSE = 448 * MiB;
constexpr size_t WS_END = 452 * MiB;

constexpr size_t O_YP = 0, O_YS = 16777216, O_KVP0 = 16908288, O_KVP1 = 17039360, O_KVP2 = 17563648,
                 O_KVS0 = 19660800, O_KVS1 = 19726336, O_KVS2 = 19791872, O_SREP = 19857408, O_SIMP = 19865600, O_SRES = 19873792, O_SIMS = 20004864;

__device__ __forceinline__ unsigned pk2(float lo, float hi) { f32x2_t v = {lo, hi}; bf16x2_t b = __builtin_convertvector(v, bf16x2_t); return __builtin_bit_cast(unsigned, b); }
__device__ __forceinline__ float bf2f(unsigned short u) { return __uint_as_float(((unsigned)u) << 16); }
__device__ __forceinline__ float wave_sum(float v) {
#pragma unroll
    for (int o = 1; o < 64; o <<= 1) v += __shfl_xor(v, o);
    return v;
}
__device__ __forceinline__ float wave_max(float v) {
#pragma unroll
    for (int o = 1; o < 64; o <<= 1) v = fmaxf(v, __shfl_xor(v, o));
    return v;
}

struct Args { const float* in[25]; float* out; unsigned char* ws; int ph_lo, ph_hi; };

struct EpiGlu {
    static constexpr bool PERM = true, AFTER_DRAIN = false;
    const float* xp; const float* xs; float* H; bf16* HB; float* rowss;
    __device__ __forceinline__ void operator()(const pg8::f32x4 (&acc)[2][2][4][2], const pg8::Unit& u, int wr, int wc, int fr, int fq) const { run<2>(acc, u, wr, wc, fr, fq); }
    template <int NAI> __device__ __forceinline__ void run(const pg8::f32x4 (&acc)[NAI][2][4][2], const pg8::Unit& u, int wr, int wc, int fr, int fq) const {
        const int col = u.pn * 128 + wc * 32 + 8 * fq;
#pragma unroll
        for (int ai = 0; ai < NAI; ++ai)
#pragma unroll
            for (int m = 0; m < 4; ++m) {
                const int row = u.pm * 256 + ai * 128 + wr * 64 + m * 16 + fr;
                if (row < MREAL) {
                    const float* xr = (row < NPROMPT ? xp + (size_t)row * D : xs + (size_t)(row - NPROMPT) * D) + col;
                    const f32x4 x0 = *(const f32x4*)xr, x1 = *(const f32x4*)(xr + 4);
                    f32x4 h0, h1;
#pragma unroll
                    for (int i = 0; i < 4; ++i) {
                        h0[i] = x0[i] + acc[ai][0][m][0][i] * __builtin_amdgcn_rcpf(1.f + __expf(-acc[ai][1][m][0][i]));
                        h1[i] = x1[i] + acc[ai][0][m][1][i] * __builtin_amdgcn_rcpf(1.f + __expf(-acc[ai][1][m][1][i]));
                    }
                    u32x4 w; w.x = pk2(h0[0], h0[1]); w.y = pk2(h0[2], h0[3]); w.z = pk2(h1[0], h1[1]); w.w = pk2(h1[2], h1[3]);
                    *(u32x4*)(HB + (size_t)row * D + col) = w;
                    float ss = (h0[0] * h0[0] + h0[1] * h0[1]) + (h0[2] * h0[2] + h0[3] * h0[3]) + (h1[0] * h1[0] + h1[1] * h1[1]) + (h1[2] * h1[2] + h1[3] * h1[3]);
                    ss += __shfl_xor(ss, 16); ss += __shfl_xor(ss, 32);
                    if (fq == 0) __hip_atomic_fetch_add(rowss + row, ss, __ATOMIC_RELAXED, __HIP_MEMORY_SCOPE_AGENT);
                } else { float ss = 0.f; ss += __shfl_xor(ss, 16); ss += __shfl_xor(ss, 32); (void)ss; }
            }
    }
};
struct EpiNull {
    static constexpr bool PERM = true, AFTER_DRAIN = false; float* sink;
    __device__ __forceinline__ void operator()(const pg8::f32x4 (&acc)[2][2][4][2], const pg8::Unit& u, int wr, int wc, int fr, int fq) const { run<2>(acc, u, wr, wc, fr, fq); }
    template <int NAI> __device__ __forceinline__ void run(const pg8::f32x4 (&acc)[NAI][2][4][2], const pg8::Unit& u, int wr, int wc, int fr, int fq) const {
        float t = 0.f;
#pragma unroll
        for (int b = 0; b < 2; ++b)
#pragma unroll
            for (int m = 0; m < 4; ++m)
#pragma unroll
                for (int n = 0; n < 2; ++n) t += acc[0][b][m][n][0] + acc[0][b][m][n][3];
        if (t == 1234.5678f) sink[0] = t;
    }
};
struct EpiUp {
    static constexpr bool PERM = true, AFTER_DRAIN = false;
    bf16* O; const float* rowss;
    __device__ __forceinline__ void operator()(const pg8::f32x4 (&acc)[2][2][4][2], const pg8::Unit& u, int wr, int wc, int fr, int fq) const { run<2>(acc, u, wr, wc, fr, fq); }
    template <int NAI> __device__ __forceinline__ void run(const pg8::f32x4 (&acc)[NAI][2][4][2], const pg8::Unit& u, int wr, int wc, int fr, int fq) const {
        const int col = u.pn * 256 + wc * 32 + 8 * fq;
#pragma unroll
        for (int ai = 0; ai < NAI; ++ai)
#pragma unroll
            for (int m = 0; m < 4; ++m) {
                const int row = u.pm * 256 + ai * 128 + wr * 64 + m * 16 + fr;
                if (row < MREAL) {
                    const float rstd = __builtin_amdgcn_rsqf(rowss[row] * (1.f / D) + EPS);
#pragma unroll
                    for (int bj = 0; bj < 2; ++bj) {
                        float v[8];
#pragma unroll
                        for (int i = 0; i < 4; ++i) { float a = fmaxf(acc[ai][bj][m][0][i] * rstd, 0.f), b = fmaxf(acc[ai][bj][m][1][i] * rstd, 0.f); v[i] = a * a; v[4 + i] = b * b; }
                        u32x4 w; w.x = pk2(v[0], v[1]); w.y = pk2(v[2], v[3]); w.z = pk2(v[4], v[5]); w.w = pk2(v[6], v[7]);
                        *(u32x4*)(O + (size_t)row * FF + col + bj * 128) = w;
                    }
                }
            }
    }
};
struct EpiRes {
    static constexpr bool PERM = true, AFTER_DRAIN = false;
    bf16* HB; float* OUT; float* rowss;
    __device__ __forceinline__ void operator()(const pg8::f32x4 (&acc)[2][2][4][2], const pg8::Unit& u, int wr, int wc, int fr, int fq) const { run<2>(acc, u, wr, wc, fr, fq); }
    template <int NAI> __device__ __forceinline__ void run(const pg8::f32x4 (&acc)[NAI][2][4][2], const pg8::Unit& u, int wr, int wc, int fr, int fq) const {
        const int col = u.pn * 256 + wc * 32 + 8 * fq;
#pragma unroll
        for (int ai = 0; ai < NAI; ++ai)
#pragma unroll
            for (int m = 0; m < 4; ++m) {
                const int row = u.pm * 256 + ai * 128 + wr * 64 + m * 16 + fr;
                float ss = 0.f;
                if (row < MREAL) {
#pragma unroll
                    for (int bj = 0; bj < 2; ++bj) {
                        bf16* hp = HB + (size_t)row * D + col + bj * 128;
                        const bf16x8 hv = *(const bf16x8*)hp;
                        f32x4 h0, h1;
#pragma unroll
                        for (int i = 0; i < 4; ++i) { h0[i] = bf2f((unsigned short)hv[i]) + acc[ai][bj][m][0][i]; h1[i] = bf2f((unsigned short)hv[4 + i]) + acc[ai][bj][m][1][i]; }
                        if (OUT) { float* op = OUT + (size_t)row * D + col + bj * 128; *(f32x4*)op = h0; *(f32x4*)(op + 4) = h1; }
                        else { u32x4 w; w.x = pk2(h0[0], h0[1]); w.y = pk2(h0[2], h0[3]); w.z = pk2(h1[0], h1[1]); w.w = pk2(h1[2], h1[3]); *(u32x4*)hp = w; }
                        ss += (h0[0] * h0[0] + h0[1] * h0[1]) + (h0[2] * h0[2] + h0[3] * h0[3]) + (h1[0] * h1[0] + h1[1] * h1[1]) + (h1[2] * h1[2] + h1[3] * h1[3]);
                    }
                }
                ss += __shfl_xor(ss, 16); ss += __shfl_xor(ss, 32);
                if (fq == 0 && row < MREAL) __hip_atomic_fetch_add(rowss + row, ss, __ATOMIC_RELAXED, __HIP_MEMORY_SCOPE_AGENT);
            }
    }
};
struct EpiQKV {
    static constexpr bool PERM = true, AFTER_DRAIN = false;
    bf16* Q; bf16* KB; bf16* VB; float* out; const float* rowss; const float* ropec; const float* ropes; const float* offc; const float* offs;
    __device__ __forceinline__ void operator()(const pg8::f32x4 (&acc)[2][2][4][2], const pg8::Unit& u, int wr, int wc, int fr, int fq) const { run<2>(acc, u, wr, wc, fr, fq); }
    template <int NAI> __device__ __forceinline__ void run(const pg8::f32x4 (&acc)[NAI][2][4][2], const pg8::Unit& u, int wr, int wc, int fr, int fq) const {
        const int pn = u.pn;
        const bool isq = pn < 12; const int kvi = pn - 12; const int g = isq ? (pn >> 2) : (kvi >> 1); const bool isv = (!isq) && (kvi & 1);
        const int sh = 2 * g, W = 128 << sh;
        const bool stile = u.pm == 64;
        const int d0 = 8 * fq;
        const int slb = ((u.pm * 256 + wr * 64 + fr) & (SEQ - 1)) * 32 + d0;
#pragma unroll
        for (int ai = 0; ai < NAI; ++ai)
#pragma unroll
            for (int m = 0; m < 4; ++m) {
                const int row = u.pm * 256 + ai * 128 + wr * 64 + m * 16 + fr;
                if (row >= MREAL) continue;
                const float rstd = __builtin_amdgcn_rsqf(rowss[row] * (1.f / D) + EPS) * (isq ? QSCALE : 1.f);
                const bool samp = row >= NPROMPT; const int t = samp ? ((row - NPROMPT) & 3) : (row & (SEQ - 1));
                int rowp = row;
                if (!samp) { const int b = row >> 13, r = t & ((1 << sh) - 1), uu = t >> sh; rowp = b * SEQ + r * (SEQ >> sh) + uu; }
                float* ob = nullptr;
                if (!isq) {
                    if (samp) ob = out + (g == 0 ? O_KVS0 : g == 1 ? O_KVS1 : O_KVS2) + (size_t)(row - NPROMPT) * 512;
                    else if (t >= SEQ - W) ob = out + (g == 0 ? O_KVP0 : g == 1 ? O_KVP1 : O_KVP2) + ((size_t)(row >> 13) * W + (t - (SEQ - W))) * 512;
                }
                f32x4 av[2], bv[2];
#pragma unroll
                for (int n = 0; n < 2; ++n) {
                    f32x4 a = acc[ai][0][m][n] * rstd, b = acc[ai][1][m][n] * rstd;
                    if (!isv) {
                        const int sl = (samp ? SEQ + t : t) * 32 + d0 + 4 * n; const f32x4 c = *(const f32x4*)(ropec + sl), sn = *(const f32x4*)(ropes + sl);
                        const f32x4 ra = a * c - b * sn, rb = b * c + a * sn; a = ra; b = rb;
                    }
                    av[n] = a; bv[n] = b;
                }
                if (isq) {
                    bf16* qp = Q + (size_t)row * QW + pn * 256 + wc * 64 + d0;
                    u32x4 w0, w1; w0.x = pk2(av[0][0], av[0][1]); w0.y = pk2(av[0][2], av[0][3]); w0.z = pk2(av[1][0], av[1][1]); w0.w = pk2(av[1][2], av[1][3]);
                    w1.x = pk2(bv[0][0], bv[0][1]); w1.y = pk2(bv[0][2], bv[0][3]); w1.z = pk2(bv[1][0], bv[1][1]); w1.w = pk2(bv[1][2], bv[1][3]);
                    *(u32x4*)qp = w0; *(u32x4*)(qp + 32) = w1;
                } else {
                    bf16* kp = (isv ? VB : KB) + ((size_t)g * MP + rowp) * 256 + wc * 64 + d0;
                    u32x4 w0, w1; w0.x = pk2(av[0][0], av[0][1]); w0.y = pk2(av[0][2], av[0][3]); w0.z = pk2(av[1][0], av[1][1]); w0.w = pk2(av[1][2], av[1][3]);
                    w1.x = pk2(bv[0][0], bv[0][1]); w1.y = pk2(bv[0][2], bv[0][3]); w1.z = pk2(bv[1][0], bv[1][1]); w1.w = pk2(bv[1][2], bv[1][3]);
                    *(u32x4*)kp = w0; *(u32x4*)(kp + 32) = w1;
                    if (ob) { float* o2 = ob + (isv ? 256 : 0) + wc * 64 + d0; *(f32x4*)o2 = av[0]; *(f32x4*)(o2 + 4) = av[1]; *(f32x4*)(o2 + 32) = bv[0]; *(f32x4*)(o2 + 36) = bv[1]; }
                }
            }
    }
};

template <class Epi>
__device__ __forceinline__ void skinny_phase(LAS unsigned char* lds, const bf16* Abuf, const bf16* Bt, int N, int K, const Epi& E, int first, int wave, int lane) {
    const int nroles = (N >> 8) * 8, G = gridDim.x;
    const int fr = lane & 15, fq = lane >> 4;
    LAS float* red = (LAS float*)lds;
    const int rstep = first ? G - first : G;
    for (int role = (int)blockIdx.x - first; role < nroles; role += rstep) {
        if (role < 0) break;
        const int pn = role >> 3, wr = (role >> 2) & 1, wc = role & 3;
        pg8::f32x4 acc[1][2][4][2];
#pragma unroll
        for (int b = 0; b < 2; ++b)
#pragma unroll
            for (int m = 0; m < 4; ++m)
#pragma unroll
                for (int n = 0; n < 2; ++n) acc[0][b][m][n] = (pg8::f32x4){0.f, 0.f, 0.f, 0.f};
        const int kper = K >> 3, k0 = wave * kper;
        const bf16* ap = Abuf + (size_t)(NPROMPT + 64 * wr + fr) * K + k0 + 8 * fq;
        const int r0 = Epi::PERM ? (8 * (fr >> 2) + (fr & 3)) : fr, r1 = Epi::PERM ? r0 + 4 : fr + 16;
        const bf16* bp = Bt + (size_t)(256 * pn + 32 * wc) * K + k0 + 8 * fq;
#pragma unroll 4
        for (int ks = 0; ks < kper; ks += 32) {
            bf16x8 af[4], bf_[2][2];
#pragma unroll
            for (int m = 0; m < 4; ++m) af[m] = *(const bf16x8*)(ap + (size_t)(16 * m) * K + ks);
#pragma unroll
            for (int b = 0; b < 2; ++b) { bf_[b][0] = *(const bf16x8*)(bp + (size_t)(128 * b + r0) * K + ks); bf_[b][1] = *(const bf16x8*)(bp + (size_t)(128 * b + r1) * K + ks); }
#pragma unroll
            for (int b = 0; b < 2; ++b)
#pragma unroll
                for (int m = 0; m < 4; ++m)
#pragma unroll
                    for (int n = 0; n < 2; ++n) acc[0][b][m][n] = __builtin_amdgcn_mfma_f32_16x16x32_bf16(bf_[b][n], af[m], acc[0][b][m][n], 0, 0, 0);
        }
        if (wave != 0) {
#pragma unroll
            for (int b = 0; b < 2; ++b)
#pragma unroll
                for (int m = 0; m < 4; ++m)
#pragma unroll
                    for (int n = 0; n < 2; ++n) *(LAS pg8::f32x4*)(red + ((size_t)((wave - 1) * 16 + b * 8 + m * 2 + n) * 64 + lane) * 4) = acc[0][b][m][n];
        }
        __syncthreads();
        if (wave == 0) {
#pragma unroll 1
            for (int w = 0; w < 7; ++w)
#pragma unroll
                for (int b = 0; b < 2; ++b)
#pragma unroll
                    for (int m = 0; m < 4; ++m)
#pragma unroll
                        for (int n = 0; n < 2; ++n) acc[0][b][m][n] += *(const LAS pg8::f32x4*)(red + ((size_t)(w * 16 + b * 8 + m * 2 + n) * 64 + lane) * 4);
            const pg8::Unit u{64, pn};
            E.template run<1>(acc, u, wr, wc, fr, fq);
        }
        __syncthreads();
    }
}
__device__ __forceinline__ int conv_srcc(int mode, int nb) {
    if (mode == 0) return 32 * nb;
    if (mode == 1) { const int pn = nb >> 3, bj = (nb >> 2) & 1, cb = nb & 3; return bj * 1024 + 128 * pn + 32 * cb; }
    const int pn = nb >> 3, bj = (nb >> 2) & 1, wc = nb & 3; return 256 * pn + 64 * wc + 32 * bj;
}
__device__ __forceinline__ void transpose_item(const float* W, int K, int N, bf16* WT, const float* gain, int mode, LAS float* scr, int item, int lane) {
    const int nblk = N >> 6, kb = item / nblk, nb64 = item % nblk, k0 = 64 * kb;
    const int l16 = lane & 15, srcc = conv_srcc(mode, 2 * nb64 + (l16 >> 3)) + 4 * (l16 & 7);
    f32x4 v[16];
#pragma unroll
    for (int i = 0; i < 16; ++i) { const int kk = 4 * i + (lane >> 4); v[i] = *(const f32x4*)(W + (size_t)(k0 + kk) * N + srcc); }
    if (gain) {
#pragma unroll
        for (int i = 0; i < 16; ++i) { const int kk = 4 * i + (lane >> 4); v[i] = v[i] * gain[k0 + kk]; }
    }
#pragma unroll
    for (int i = 0; i < 16; ++i) { const int kk = 4 * i + (lane >> 4); LAS float* d = scr + kk * 65 + 4 * l16; d[0] = v[i][0]; d[1] = v[i][1]; d[2] = v[i][2]; d[3] = v[i][3]; }
    asm volatile("s_waitcnt lgkmcnt(0)" ::: "memory");
    const int c = lane & 7;
#pragma unroll
    for (int j = 0; j < 8; ++j) { const int n = (lane >> 3) + 8 * j; const LAS float* sp = scr + (8 * c) * 65 + n;
        u32x4 o; o.x = pk2(sp[0 * 65], sp[1 * 65]); o.y = pk2(sp[2 * 65], sp[3 * 65]); o.z = pk2(sp[4 * 65], sp[5 * 65]); o.w = pk2(sp[6 * 65], sp[7 * 65]);
        *(u32x4*)(WT + (size_t)(64 * nb64 + n) * K + k0 + 8 * c) = o; }
    asm volatile("s_waitcnt lgkmcnt(0)" ::: "memory");
}
__device__ __forceinline__ void convert_late(const Args& A, LAS unsigned char* lds, int vw, int NVW, int wave, int lane) {
    unsigned char* ws = A.ws;
    LAS float* scr = (LAS float*)(lds + wave * 16640);
    constexpr int I_UP = 16 * 64, I_DN = 64 * 16, I_O = 16 * 16, NIT = I_O + I_UP + I_DN;
    for (int it = vw; it < NIT; it += NVW) {
        int r = it;
        if (r < I_O) { transpose_item(A.in[21], 1024, 1024, (bf16*)(ws + W_O), nullptr, 0, scr, r, lane); continue; } r -= I_O;
        if (r < I_UP) { transpose_item(A.in[22] + 1024ull * 4096, 1024, 4096, (bf16*)(ws + W_UP1), A.in[8] + 1024, 0, scr, r, lane); continue; } r -= I_UP;
        transpose_item(A.in[23] + 4096ull * 1024, 4096, 1024, (bf16*)(ws + W_DN1), nullptr, 0, scr, r, lane);
    }
}

__device__ __forceinline__ void phase_prologue(const Args& A, LAS unsigned char* lds, int gw, int NGW, int wave, int lane) {
    unsigned char* ws = A.ws;
    LAS float* scr = (LAS float*)(lds + wave * 16640);
    constexpr int I_GLU = 16 * 32, I_UP = 16 * 64, I_DN = 64 * 16, I_Q = 16 * 48, I_KV = 16 * 24;
    constexpr int NIT = I_GLU + I_UP + I_DN + I_Q + I_KV;
    for (int it = gw; it < NIT; it += NGW) {
        int r = it;
        if (r < I_GLU) { transpose_item(A.in[17], 1024, 2048, (bf16*)(ws + W_GLU), nullptr, 1, scr, r, lane); continue; } r -= I_GLU;
        if (r < I_UP) { transpose_item(A.in[22], 1024, 4096, (bf16*)(ws + W_UP0), A.in[8], 0, scr, r, lane); continue; } r -= I_UP;
        if (r < I_DN) { transpose_item(A.in[23], 4096, 1024, (bf16*)(ws + W_DN0), nullptr, 0, scr, r, lane); continue; } r -= I_DN;
        if (r < I_Q) { transpose_item(A.in[20], 1024, 3072, (bf16*)(ws + W_QKV), A.in[7] + 1024, 2, scr, r, lane); continue; } r -= I_Q;
        transpose_item(A.in[19], 1024, 1536, (bf16*)(ws + W_QKV) + 3072ull * 1024, A.in[18], 2, scr, r, lane);
    }
    {
        const float* gmix = A.in[7];
        bf16* HN0 = (bf16*)(ws + WS_HN0);
        for (int row0 = 4 * gw; row0 < MREAL; row0 += 4 * NGW) {
            f32x4 v[4][4]; float ssq[4];
#pragma unroll
            for (int q = 0; q < 4; ++q) { const int row = row0 + q; const float* xr = row < NPROMPT ? A.in[0] + (size_t)row * D : A.in[1] + (size_t)(row - NPROMPT) * D;
#pragma unroll
                for (int j = 0; j < 4; ++j) v[q][j] = *((const f32x4*)xr + lane + 64 * j); }
#pragma unroll
            for (int q = 0; q < 4; ++q) { float sq = 0.f;
#pragma unroll
                for (int j = 0; j < 4; ++j) sq += (v[q][j][0] * v[q][j][0] + v[q][j][1] * v[q][j][1]) + (v[q][j][2] * v[q][j][2] + v[q][j][3] * v[q][j][3]);
                ssq[q] = __builtin_amdgcn_rsqf(wave_sum(sq) * (1.f / D) + EPS); }
#pragma unroll
            for (int j = 0; j < 4; ++j) { const f32x4 gg = *((const f32x4*)gmix + lane + 64 * j);
#pragma unroll
                for (int q = 0; q < 4; ++q) { const float rstd = ssq[q];
                    u32x2 w; w.x = pk2(v[q][j][0] * rstd * gg[0], v[q][j][1] * rstd * gg[1]); w.y = pk2(v[q][j][2] * rstd * gg[2], v[q][j][3] * rstd * gg[3]);
                    *((u32x2*)(HN0 + (size_t)(row0 + q) * D) + lane + 64 * j) = w; } }
        }
    }
    const int gt = gw * 64 + lane, NGT = NGW * 64;
    { float* rs = (float*)(ws + WS_ROWSS); for (int i = gt; i < 4 * MP; i += NGT) rs[i] = 0.f; }
    { float* rc = (float*)(ws + WS_ROPE); float* rsn = rc + 8196 * 32;
      for (int i = gt; i < 8196 * 32; i += NGT) { const int slot = i >> 5, d = i & 31; const float pos = slot < SEQ ? (float)slot : (float)(16384 + (slot - SEQ));
          const float inv = powf(10000.0f, -(float)d / 32.0f); const float ang = pos * inv; rc[i] = cosf(ang); rsn[i] = sinf(ang); } }
    { float* oc = (float*)(ws + WS_ROPE) + 2 * 8196 * 32; float* os = oc + 8 * 32;
      for (int i = gt; i < 8 * 32; i += NGT) { const int oi = i >> 5, d = i & 31; const float pos = (float)(128 * (oi >> 2) + 16 * (oi & 3));
          const float inv = powf(10000.0f, -(float)d / 32.0f); const float ang = pos * inv; oc[i] = cosf(ang); os[i] = sinf(ang); } }
    { float* lam = (float*)(ws + WS_LAM); bf16* BB = (bf16*)(ws + WS_BBAR); bf16* CC = (bf16*)(ws + WS_CC);
      const float *are = A.in[9], *aim = A.in[10], *ldt = A.in[11], *bre = A.in[12], *bim = A.in[13], *cre = A.in[14], *cim = A.in[15];
      for (int i = gt; i < 64 * 64 * 16; i += NGT) {
          const int c = i & 15, p = (i >> 4) & 63, g = i >> 10;
          const float dt = expf(ldt[g]); const float ar = are[g * 64 + p], ai = aim[g * 64 + p];
          const float mag = expf(ar * dt); const float lr = mag * cosf(ai * dt), li = mag * sinf(ai * dt);
          const float den = ar * ar + ai * ai, nr = lr - 1.f, ni = li;
          const float zr = (nr * ar + ni * ai) / den, zi = (ni * ar - nr * ai) / den;
          const float br = bre[(g * 64 + p) * 16 + c], bi = bim[(g * 64 + p) * 16 + c];
          const float bbr = zr * br - zi * bi, bbi = zr * bi + zi * br;
          BB[(g * 128 + p) * 16 + c] = (bf16)(pk2(bbr, 0.f) & 0xffffu);
          BB[(g * 128 + 64 + p) * 16 + c] = (bf16)(pk2(bbi, 0.f) & 0xffffu);
          CC[(g * 16 + c) * 128 + 4 * (p & 31) + (p >> 5)] = (bf16)(pk2(cre[(g * 16 + c) * 64 + p], 0.f) & 0xffffu);
          CC[(g * 16 + c) * 128 + 4 * (p & 31) + 2 + (p >> 5)] = (bf16)(pk2(-cim[(g * 16 + c) * 64 + p], 0.f) & 0xffffu);
          if (c == 0) { lam[(g * 64 + p) * 2] = lr; lam[(g * 64 + p) * 2 + 1] = li; }
      } }
}

#define CMUL_ADD(orr, oi, ar_, ai_, br_, bi_, cr_, ci_) do { const float _r = __builtin_fmaf((ar_), (br_), __builtin_fmaf(-(ai_), (bi_), (cr_))); const float _i = __builtin_fmaf((ar_), (bi_), __builtin_fmaf((ai_), (br_), (ci_))); orr = _r; oi = _i; } while (0)
template <bool PASS2>
__device__ __forceinline__ void s5_item(const Args& A, LAS unsigned char* hs, int item, int lane) {
    unsigned char* ws = A.ws;
    const bf16* HN0 = (const bf16*)(ws + WS_HN0);
    const bool samp = item >= 2048;
    const int g = item & 63, ch = samp ? 128 + ((item - 2048) >> 6) : 4 * (item >> 6);
    const int s = lane & 31, hf = lane >> 5;
    bf16x8 Bf[4], Cf[4];
    { const bf16* BB = (const bf16*)(ws + WS_BBAR) + (size_t)g * 128 * 16;
#pragma unroll
      for (int n = 0; n < 4; ++n) Bf[n] = *(const bf16x8*)(BB + (32 * n + s) * 16 + 8 * hf);
      if (PASS2) { const bf16* CC = (const bf16*)(ws + WS_CC) + (size_t)g * 16 * 128;
#pragma unroll
        for (int st = 0; st < 4; ++st) Cf[st] = *(const bf16x8*)(CC + (lane & 15) * 128 + 32 * st + 8 * (lane >> 4)); } }
    const float* lam = (const float*)(ws + WS_LAM) + (size_t)g * 128;
    float lr[2], li[2], l16r[2], l16i[2], l128r[2], l128i[2];
#pragma unroll
    for (int j = 0; j < 2; ++j) { lr[j] = lam[(s + 32 * j) * 2]; li[j] = lam[(s + 32 * j) * 2 + 1];
        float pr = lr[j], pi = li[j];
#pragma unroll
        for (int q = 0; q < 4; ++q) { const float nr = pr * pr - pi * pi, ni = 2.f * pr * pi; pr = nr; pi = ni; }
        l16r[j] = pr; l16i[j] = pi;
#pragma unroll
        for (int q = 0; q < 3; ++q) { const float nr = pr * pr - pi * pi, ni = 2.f * pr * pi; pr = nr; pi = ni; }
        l128r[j] = pr; l128i[j] = pi; }
    float cr[2] = {0.f, 0.f}, ci[2] = {0.f, 0.f};
    const float* E = (const float*)(ws + WS_E);
    if (PASS2) {
        if (samp) { const int n = ch - 128;
#pragma unroll
            for (int j = 0; j < 2; ++j) { cr[j] = A.in[5][((size_t)n * 64 + g) * 64 + s + 32 * j]; ci[j] = A.in[6][((size_t)n * 64 + g) * 64 + s + 32 * j]; } }
        else { const int first = (ch >> 6) << 6;
#pragma unroll 8
            for (int jj = first; jj < ch; ++jj) { const float* e = E + ((size_t)jj * 64 + g) * 128;
#pragma unroll
                for (int j = 0; j < 2; ++j) { const float er = e[j * 32 + s], ei = e[64 + j * 32 + s]; CMUL_ADD(cr[j], ci[j], l128r[j], l128i[j], cr[j], ci[j], er, ei); } } }
    }
    const int nblk = samp ? 1 : 16;
    const int rowbase = samp ? NPROMPT + 4 * (ch - 128) : ch * 128;
    const int tokA = 16 * ((s >> 2) & 1) + 4 * (s >> 3) + (s & 3);
    const float* dsk = A.in[16] + g * 16;
    bf16* Y = (bf16*)(ws + WS_Y);
    bf16x8 afn = *(const bf16x8*)(HN0 + (size_t)(rowbase + tokA) * D + g * 16 + 8 * hf);
    const int uoff = (lane & 15) * D + g * 16 + 4 * (lane >> 4);
    u32x2 un[2];
    if (PASS2) {
#pragma unroll
        for (int q = 0; q < 2; ++q) un[q] = *(const u32x2*)(HN0 + (size_t)(rowbase + 16 * q) * D + uoff);
    }
    const f32x4 dk4 = *(const f32x4*)(dsk + 4 * (lane >> 4));
    for (int blk = 0; blk < nblk; ++blk) {
        const int row0 = rowbase + 32 * blk;
        const bf16x8 af = afn;
        u32x2 uc[2];
        if (PASS2) {
#pragma unroll
            for (int q = 0; q < 2; ++q) uc[q] = un[q];
            if (blk + 1 < nblk) {
#pragma unroll
                for (int q = 0; q < 2; ++q) un[q] = *(const u32x2*)(HN0 + (size_t)(row0 + 32 + 16 * q) * D + uoff);
            }
        }
        if (!PASS2 && (blk & 3) == 0) { cr[0] = 0.f; cr[1] = 0.f; ci[0] = 0.f; ci[1] = 0.f; }
        if (blk + 1 < nblk) afn = *(const bf16x8*)(HN0 + (size_t)(row0 + 32 + tokA) * D + g * 16 + 8 * hf);
        f32x16 X[4];
        const f32x16 z16 = {0.f, 0.f, 0.f, 0.f, 0.f, 0.f, 0.f, 0.f, 0.f, 0.f, 0.f, 0.f, 0.f, 0.f, 0.f, 0.f};
#pragma unroll
        for (int n = 0; n < 4; ++n) X[n] = __builtin_amdgcn_mfma_f32_32x32x16_bf16(af, Bf[n], z16, 0, 0, 0);
        float cinr[2], cini[2];
#pragma unroll
        for (int j = 0; j < 2; ++j) {
            float er = 0.f, ei = 0.f;
#pragma unroll
            for (int r = 0; r < 16; ++r) CMUL_ADD(er, ei, lr[j], li[j], er, ei, X[j][r], X[2 + j][r]);
            const float or_ = __shfl_xor(er, 32), oi_ = __shfl_xor(ei, 32);
            const float e0r = hf ? or_ : er, e0i = hf ? oi_ : ei, e1r = hf ? er : or_, e1i = hf ? ei : oi_;
            float mr, mi; CMUL_ADD(mr, mi, l16r[j], l16i[j], cr[j], ci[j], e0r, e0i);
            cinr[j] = hf ? mr : cr[j]; cini[j] = hf ? mi : ci[j];
            CMUL_ADD(cr[j], ci[j], l16r[j], l16i[j], mr, mi, e1r, e1i);
        }
        if (PASS2) {
#pragma unroll
            for (int j = 0; j < 2; ++j) {
                float hr = cinr[j], hi = cini[j];
#pragma unroll
                for (int r = 0; r < 16; ++r) { CMUL_ADD(hr, hi, lr[j], li[j], hr, hi, X[j][r], X[2 + j][r]);
                    X[j][r] = hr; X[2 + j][r] = hi; }
            }
            if (samp && hf == 0) { const int n = ch - 128;
#pragma unroll
                for (int j = 0; j < 2; ++j) { A.out[O_SRES + ((size_t)n * 64 + g) * 64 + s + 32 * j] = X[j][3]; A.out[O_SIMS + ((size_t)n * 64 + g) * 64 + s + 32 * j] = X[2 + j][3]; } }
#pragma unroll
            for (int r = 0; r < 16; ++r) { LAS unsigned short* hp = (LAS unsigned short*)(hs + (16 * hf + r) * 272);
                u32x2 w; w.x = pk2(X[0][r], X[1][r]); w.y = pk2(X[2][r], X[3][r]);
                *(LAS u32x2*)(hp + 4 * s) = w; }
            asm volatile("s_waitcnt lgkmcnt(0)" ::: "memory");
#pragma unroll
            for (int tb = 0; tb < 2; ++tb) {
                f32x4 y = {0.f, 0.f, 0.f, 0.f};
#pragma unroll
                for (int st = 0; st < 4; ++st) { const bf16x8 hfrag = *(const LAS bf16x8*)(hs + (16 * tb + (lane & 15)) * 272 + 64 * st + 16 * (lane >> 4));
                    y = __builtin_amdgcn_mfma_f32_16x16x32_bf16(Cf[st], hfrag, y, 0, 0, 0); }
                const int tk = 16 * tb + (lane & 15);
                if (!samp || tk < 4) {
                    const float u0 = __uint_as_float(uc[tb].x << 16), u1 = __uint_as_float(uc[tb].x & 0xffff0000u), u2 = __uint_as_float(uc[tb].y << 16), u3 = __uint_as_float(uc[tb].y & 0xffff0000u);
                    f32x4 v = {y[0] + dk4[0] * u0, y[1] + dk4[1] * u1, y[2] + dk4[2] * u2, y[3] + dk4[3] * u3};
                    float ge[4];
#pragma unroll
                    for (int j = 0; j < 4; ++j) { const float z = 0.7978845608f * (v[j] + 0.044715f * v[j] * v[j] * v[j]); ge[j] = v[j] * __builtin_amdgcn_rcpf(1.f + __expf(-2.f * z)); }
                    u32x2 w; w.x = pk2(ge[0], ge[1]); w.y = pk2(ge[2], ge[3]);
                    *(u32x2*)(Y + (size_t)(row0 + tk) * D + g * 16 + 4 * (lane >> 4)) = w;
                }
            }
            asm volatile("s_waitcnt lgkmcnt(0)" ::: "memory");
        }
        if (!PASS2 && (blk & 3) == 3 && hf == 0) { float* e = (float*)(ws + WS_E) + ((size_t)(ch + (blk >> 2)) * 64 + g) * 128;
#pragma unroll
            for (int j = 0; j < 2; ++j) { e[j * 32 + s] = cr[j]; e[64 + j * 32 + s] = ci[j]; } }
    }
    if (PASS2 && !samp && hf == 0 && ((ch + 3) & 63) == 63) { const int b = ch >> 6;
#pragma unroll
        for (int j = 0; j < 2; ++j) { A.out[O_SREP + ((size_t)b * 64 + g) * 64 + s + 32 * j] = cr[j]; A.out[O_SIMP + ((size_t)b * 64 + g) * 64 + s + 32 * j] = ci[j]; } }
}

typedef short v4i16_t __attribute__((ext_vector_type(4)));
constexpr int KIMG_STRIDE = 144, KIMG_BYTES = 192 * KIMG_STRIDE, VIMG_HALF = 192 * 64, NATT_ITEMS = 3072;
struct AttItem { int g, sh, b, r, u0, kvh; };
__device__ __forceinline__ AttItem att_decode(int bi) {
    AttItem I; I.g = bi >> 10; const int rem = bi & 1023; I.kvh = rem & 3; I.b = (rem >> 2) & 1; const int rq = rem >> 3;
    I.sh = 2 * I.g; const int nqb = 128 >> I.sh; I.r = rq / nqb; I.u0 = 64 * (rq % nqb); return I;
}
template <bool COMBINE, int MODE = 0>
__device__ __forceinline__ void attn_prompt_phase(const Args& A, LAS unsigned char* lds, int tid, int wave, int lane, int item_lo, int item_hi) {
    unsigned char* ws = A.ws;
    const bf16* Q = (const bf16*)(ws + WS_Q); const bf16* KB = (const bf16*)(ws + WS_KB); const bf16* VB = (const bf16*)(ws + WS_VT);
    bf16* OG = (bf16*)(ws + WS_OG); float* LSE = (float*)(ws + WS_LSE);
    const int G = gridDim.x, hh = wave & 3, sub = wave >> 2, n = lane & 31, hf = lane >> 5;
    const int kap = (n & 3) + 4 * ((n >> 3) & 1) + 8 * ((n >> 2) & 1) + 16 * (n >> 4);
    int bi = item_lo + blockIdx.x;
    const int NATT_HI = item_hi;
    if (bi >= NATT_HI) return;
    bf16* AT = (bf16*)(ws + WS_ATT);
    u32x4 pk_[3], pv_[3]; bf16x8 qn[4];
#define ATT_ISSUE_KV(bix) do { const AttItem J = att_decode(bix); const int L_ = SEQ >> J.sh; const size_t pb_ = (size_t)J.g * MP + (size_t)J.b * SEQ + (size_t)J.r * L_; \
        _Pragma("unroll") for (int i = 0; i < 3; ++i) { const int c_ = tid + 512 * i, row_ = c_ >> 3, ch_ = c_ & 7; int u_ = J.u0 - 128 + row_; u_ = u_ < 0 ? 0 : u_; \
            pk_[i] = *(const u32x4*)(KB + (pb_ + u_) * 256 + J.kvh * 64 + 8 * ch_); pv_[i] = *(const u32x4*)(VB + (pb_ + u_) * 256 + J.kvh * 64 + 8 * ch_); } } while (0)
#define ATT_ISSUE_Q(bix) do { const AttItem J = att_decode(bix); const int qrow_ = J.b * SEQ + ((J.u0 + 32 * sub + n) << J.sh) + J.r; \
        _Pragma("unroll") for (int ks = 0; ks < 4; ++ks) qn[ks] = *(const bf16x8*)(Q + (size_t)qrow_ * QW + J.g * 1024 + (4 * J.kvh + hh) * 64 + 16 * ks + 8 * hf); } while (0)
#define ATT_WRITE(bufo) do { _Pragma("unroll") for (int i = 0; i < 3; ++i) { const int c = tid + 512 * i, row = c >> 3, ch = c & 7; \
            *(LAS u32x4*)(lds + (bufo) + row * KIMG_STRIDE + 16 * ch) = pk_[i]; \
            *(LAS u32x4*)(lds + (bufo) + KIMG_BYTES + (ch >> 2) * VIMG_HALF + row * 64 + (ch & 3) * 16) = pv_[i]; } } while (0)
    constexpr int ABUF = KIMG_BYTES + 2 * VIMG_HALF;
    bf16x8 qf[4];
    ATT_ISSUE_KV(bi); ATT_ISSUE_Q(bi);
    ATT_WRITE(0);
#pragma unroll
    for (int ks = 0; ks < 4; ++ks) qf[ks] = qn[ks];
    if (bi + G < NATT_HI) ATT_ISSUE_KV(bi + G);
    asm volatile("s_waitcnt lgkmcnt(0)\n\ts_barrier" ::: "memory");
    int par = 0;
    for (; bi < NATT_HI; bi += G, par ^= 1) {
        const AttItem I = att_decode(bi);
        if (bi + G < NATT_HI) { ATT_WRITE((par ^ 1) * ABUF); ATT_ISSUE_Q(bi + G); }
        if (bi + 2 * G < NATT_HI) ATT_ISSUE_KV(bi + 2 * G);
        const LAS unsigned char* lbuf = lds + par * ABUF;
        const int u0w = I.u0 + 32 * sub;
        const int qrow = I.b * SEQ + ((u0w + n) << I.sh) + I.r;
        const int h = 4 * I.kvh + hh;
        f32x16 O0, O1;
#pragma unroll
        for (int i = 0; i < 16; ++i) { O0[i] = 0.f; O1[i] = 0.f; }
        float mrun = -INFINITY, lrun = 0.f;
        const int cc_ = lane & 7, rr0_ = lane >> 3;
        bf16x8 x1[4], x2[4]; float l1 = 0.f, l2 = 0.f;
        if (COMBINE) {
            l1 = LSE[((size_t)1 * MP + qrow) * 16 + h]; l2 = LSE[((size_t)2 * MP + qrow) * 16 + h];
#pragma unroll
            for (int j = 0; j < 4; ++j) { const int qr_ = I.b * SEQ + ((u0w + rr0_ + 8 * j) << I.sh) + I.r;
                x1[j] = *(const bf16x8*)(OG + ((size_t)1 * MP + qr_) * D + h * 64 + 8 * cc_); x2[j] = *(const bf16x8*)(OG + ((size_t)2 * MP + qr_) * D + h * 64 + 8 * cc_); }
        }
        const int kt0 = (MODE == 1 || MODE == 3) ? 5 : (u0w >= 128 ? 0 : (128 - u0w) >> 5);
        const LAS unsigned char* kimg = lbuf + (32 * sub + kap) * KIMG_STRIDE + 16 * hf;
        const LAS unsigned char* vimg = lbuf + KIMG_BYTES + (32 * sub + 8 * hf + ((lane & 15) >> 2)) * 64 + (16 * ((lane >> 4) & 1) + 4 * (lane & 3)) * 2;
        for (int kt = kt0; kt < 5; ++kt) {
            bf16x8 kf[4], vf[2][2];
#pragma unroll
            for (int ks = 0; ks < 4; ++ks) kf[ks] = *(const LAS bf16x8*)(kimg + (32 * kt) * KIMG_STRIDE + 32 * ks);
#pragma unroll
            for (int mb = 0; mb < 2; ++mb)
#pragma unroll
                for (int st = 0; st < 2; ++st) {
                    const LAS unsigned char* vp = vimg + mb * VIMG_HALF + (32 * kt + 16 * st) * 64;
                    const v4i16_t lo = __builtin_amdgcn_ds_read_tr16_b64_v4i16((LAS v4i16_t*)vp);
                    const v4i16_t hi = __builtin_amdgcn_ds_read_tr16_b64_v4i16((LAS v4i16_t*)(vp + 4 * 64));
                    vf[mb][st] = (bf16x8){lo[0], lo[1], lo[2], lo[3], hi[0], hi[1], hi[2], hi[3]};
                }
            f32x16 S;
#pragma unroll
            for (int i = 0; i < 16; ++i) S[i] = 0.f;
#pragma unroll
            for (int ks = 0; ks < 4; ++ks) S = __builtin_amdgcn_mfma_f32_32x32x16_bf16(kf[ks], qf[ks], S, 0, 0, 0);
            if (kt == 0) {
#pragma unroll
                for (int rr = 0; rr < 16; ++rr) { const int kp = (rr & 7) + 8 * hf + 16 * (rr >> 3); if (kp < n) S[rr] = -INFINITY; }
            } else if (kt == 4) {
#pragma unroll
                for (int rr = 0; rr < 16; ++rr) { const int kp = (rr & 7) + 8 * hf + 16 * (rr >> 3); if (kp > n) S[rr] = -INFINITY; }
            }
            float tm = S[0];
#pragma unroll
            for (int rr = 1; rr < 16; ++rr) tm = fmaxf(tm, S[rr]);
            tm = fmaxf(tm, __shfl_xor(tm, 32));
            const float mnew = fmaxf(mrun, tm);
            const float alpha = __builtin_amdgcn_exp2f(mrun - mnew);
            float ps = 0.f; float p[16];
#pragma unroll
            for (int rr = 0; rr < 16; ++rr) { p[rr] = __builtin_amdgcn_exp2f(S[rr] - mnew); ps += p[rr]; }
            lrun = lrun * alpha + ps; mrun = mnew;
            if (__builtin_amdgcn_ballot_w64(alpha != 1.f) != 0ull) {
#pragma unroll
                for (int i = 0; i < 16; ++i) { O0[i] *= alpha; O1[i] *= alpha; }
            }
#pragma unroll
            for (int st = 0; st < 2; ++st) {
                u32x4 pw; pw.x = pk2(p[8 * st + 0], p[8 * st + 1]); pw.y = pk2(p[8 * st + 2], p[8 * st + 3]); pw.z = pk2(p[8 * st + 4], p[8 * st + 5]); pw.w = pk2(p[8 * st + 6], p[8 * st + 7]);
                const bf16x8 pf = __builtin_bit_cast(bf16x8, pw);
                O0 = __builtin_amdgcn_mfma_f32_32x32x16_bf16(vf[0][st], pf, O0, 0, 0, 0);
                O1 = __builtin_amdgcn_mfma_f32_32x32x16_bf16(vf[1][st], pf, O1, 0, 0, 0);
            }
        }
        const float ltot = lrun + __shfl_xor(lrun, 32);
        LAS unsigned char* ost = lds + 2 * ABUF + wave * 4864;
        float sc0;
        if (!COMBINE) { sc0 = 1.f / ltot; if (hf == 0) LSE[((size_t)I.g * MP + qrow) * 16 + h] = mrun + log2f(ltot); }
        else { const float l0 = mrun + log2f(ltot); const float mx = fmaxf(l0, fmaxf(l1, l2));
            const float w0 = __builtin_amdgcn_exp2f(l0 - mx), w1 = __builtin_amdgcn_exp2f(l1 - mx), w2 = __builtin_amdgcn_exp2f(l2 - mx);
            const float invw = 1.f / (w0 + w1 + w2); sc0 = w0 * invw / ltot;
            if (hf == 0) { LAS float* wp = (LAS float*)(ost + 4608) + 2 * n; wp[0] = w1 * invw; wp[1] = w2 * invw; } }
        if (MODE < 2) {
#pragma unroll
            for (int a = 0; a < 4; ++a) {
                u32x2 w0v, w1v; w0v.x = pk2(O0[4 * a] * sc0, O0[4 * a + 1] * sc0); w0v.y = pk2(O0[4 * a + 2] * sc0, O0[4 * a + 3] * sc0);
                w1v.x = pk2(O1[4 * a] * sc0, O1[4 * a + 1] * sc0); w1v.y = pk2(O1[4 * a + 2] * sc0, O1[4 * a + 3] * sc0);
                *(LAS u32x2*)(ost + n * 144 + (8 * a + 4 * hf) * 2) = w0v; *(LAS u32x2*)(ost + n * 144 + 64 + (8 * a + 4 * hf) * 2) = w1v;
            }
            asm volatile("s_waitcnt lgkmcnt(0)" ::: "memory");
#pragma unroll
            for (int j = 0; j < 4; ++j) { const int rr_ = rr0_ + 8 * j; const int qr_ = I.b * SEQ + ((u0w + rr_) << I.sh) + I.r;
                const bf16x8 tv = *(const LAS bf16x8*)(ost + rr_ * 144 + 16 * cc_);
                if (!COMBINE) *(bf16x8*)(OG + ((size_t)I.g * MP + qr_) * D + h * 64 + 8 * cc_) = tv;
                else { const LAS float* wp = (const LAS float*)(ost + 4608) + 2 * rr_; const float w1 = wp[0], w2 = wp[1];
                    float o[8];
#pragma unroll
                    for (int i = 0; i < 8; ++i) o[i] = bf2f((unsigned short)tv[i]) + w1 * bf2f((unsigned short)x1[j][i]) + w2 * bf2f((unsigned short)x2[j][i]);
                    u32x4 y; y.x = pk2(o[0], o[1]); y.y = pk2(o[2], o[3]); y.z = pk2(o[4], o[5]); y.w = pk2(o[6], o[7]);
                    *(u32x4*)(AT + (size_t)qr_ * D + h * 64 + 8 * cc_) = y; }
            }
        } else { if (ltot == 123.456f) LSE[0] = ltot; }
#pragma unroll
        for (int ks = 0; ks < 4; ++ks) qf[ks] = qn[ks];
        asm volatile("s_waitcnt lgkmcnt(0)\n\ts_barrier" ::: "memory");
    }
#undef ATT_ISSUE_KV
#undef ATT_ISSUE_Q
#undef ATT_WRITE
}

__device__ __forceinline__ void attn_sample_item(const Args& A, LAS float* sl, int it, int lane) {
    unsigned char* ws = A.ws;
    const int h = it & 15, t = (it >> 4) & 3, n = it >> 6, kvh = h >> 2;
    const int row = NPROMPT + 4 * n + t;
    const bf16* Q = (const bf16*)(ws + WS_Q) + (size_t)row * QW + h * 64;
    const int kq = lane >> 2, dq = lane & 3;
    float mxl = -INFINITY;
#pragma unroll 1
    for (int g = 0; g < 3; ++g) {
        const int W = 128 << (2 * g), dil = 1 << (2 * g);
        const float* cache = A.in[2 + g] + (size_t)n * W * 512;
        const float* newkv = A.out + (g == 0 ? O_KVS0 : g == 1 ? O_KVS1 : O_KVS2) + (size_t)n * 4 * 512;
        float q[16];
#pragma unroll
        for (int c8 = 0; c8 < 2; ++c8) { const bf16x8 v = *(const bf16x8*)(Q + g * 1024 + 16 * dq + 8 * c8);
#pragma unroll
            for (int i = 0; i < 8; ++i) q[8 * c8 + i] = bf2f((unsigned short)v[i]); }
#pragma unroll 9
        for (int bt = 0; bt < 9; ++bt) {
            const int j = 16 * bt + kq; const bool valid = j <= 128; const int jj = valid ? j : 128;
            const int idx = W + t - dil * jj;
            const float* kp = (idx >= W ? newkv + (size_t)(idx - W) * 512 : cache + (size_t)idx * 512) + kvh * 64 + 16 * dq;
            float s = 0.f;
#pragma unroll
            for (int c4 = 0; c4 < 4; ++c4) { const f32x4 kv = *(const f32x4*)(kp + 4 * c4); s += q[4 * c4] * kv[0] + q[4 * c4 + 1] * kv[1] + q[4 * c4 + 2] * kv[2] + q[4 * c4 + 3] * kv[3]; }
            s += __shfl_xor(s, 1); s += __shfl_xor(s, 2);
            if (valid && dq == 0) sl[g * 132 + j] = s;
            mxl = fmaxf(mxl, valid ? s : -INFINITY);
        }
    }
    const float mx = wave_max(mxl);
    asm volatile("s_waitcnt lgkmcnt(0)" ::: "memory");
    float sum = 0.f;
#pragma unroll 1
    for (int i = lane; i < 396; i += 64) { const int j = i % 132; if (j <= 128) { const float p = exp2f(sl[i] - mx); sl[i] = p; sum += p; } }
    sum = wave_sum(sum);
    asm volatile("s_waitcnt lgkmcnt(0)" ::: "memory");
    f32x4 acc = {0.f, 0.f, 0.f, 0.f};
    const int ksl = lane >> 4, dq4 = lane & 15;
#pragma unroll 1
    for (int g = 0; g < 3; ++g) {
        const int W = 128 << (2 * g), dil = 1 << (2 * g);
        const float* cache = A.in[2 + g] + (size_t)n * W * 512;
        const float* newkv = A.out + (g == 0 ? O_KVS0 : g == 1 ? O_KVS1 : O_KVS2) + (size_t)n * 4 * 512;
#pragma unroll 33
        for (int jb = 0; jb < 33; ++jb) {
            const int j = 4 * jb + ksl; const bool valid = j <= 128; const int jj = valid ? j : 128;
            const int idx = W + t - dil * jj;
            const float* vp = (idx >= W ? newkv + (size_t)(idx - W) * 512 : cache + (size_t)idx * 512) + 256 + kvh * 64 + 4 * dq4;
            const f32x4 v = *(const f32x4*)vp;
            const float pj = valid ? sl[g * 132 + jj] : 0.f;
            acc += v * pj;
        }
    }
#pragma unroll
    for (int i = 0; i < 4; ++i) { acc[i] += __shfl_xor(acc[i], 16); acc[i] += __shfl_xor(acc[i], 32); }
    bf16* AT = (bf16*)(ws + WS_ATT);
    if (lane < 16) { const float inv = 1.f / sum; u32x2 w; w.x = pk2(acc[0] * inv, acc[1] * inv); w.y = pk2(acc[2] * inv, acc[3] * inv);
        *(u32x2*)(AT + (size_t)row * D + h * 64 + 4 * dq4) = w; }
    asm volatile("s_waitcnt lgkmcnt(0)" ::: "memory");
}

__device__ __forceinline__ void attn_combine(const Args& A, int gt, int NGT) {
    unsigned char* ws = A.ws;
    const bf16* OG = (const bf16*)(ws + WS_OG); const float* LSE = (const float*)(ws + WS_LSE); bf16* AT = (bf16*)(ws + WS_ATT);
    for (int i = gt; i < NPROMPT * 128; i += NGT) {
        const int row = i >> 7, c8 = i & 127, h = c8 >> 3;
        const float l0 = LSE[((size_t)0 * MP + row) * 16 + h], l1 = LSE[((size_t)1 * MP + row) * 16 + h], l2 = LSE[((size_t)2 * MP + row) * 16 + h];
        const float mx = fmaxf(l0, fmaxf(l1, l2));
        float w0 = exp2f(l0 - mx), w1 = exp2f(l1 - mx), w2 = exp2f(l2 - mx); const float inv = 1.f / (w0 + w1 + w2); w0 *= inv; w1 *= inv; w2 *= inv;
        const bf16x8 a = *(const bf16x8*)(OG + ((size_t)0 * MP + row) * D + 8 * c8), b = *(const bf16x8*)(OG + ((size_t)1 * MP + row) * D + 8 * c8), c = *(const bf16x8*)(OG + ((size_t)2 * MP + row) * D + 8 * c8);
        float o[8];
#pragma unroll
        for (int k = 0; k < 8; ++k) o[k] = w0 * bf2f((unsigned short)a[k]) + w1 * bf2f((unsigned short)b[k]) + w2 * bf2f((unsigned short)c[k]);
        u32x4 w; w.x = pk2(o[0], o[1]); w.y = pk2(o[2], o[3]); w.z = pk2(o[4], o[5]); w.w = pk2(o[6], o[7]);
        *(u32x4*)(AT + (size_t)row * D + 8 * c8) = w;
    }
}

#define XB_TMO      128
#define XB_XCNT(j)  (256  + 64 * (j))
#define XB_XSUB(j)  (1280 + 64 * (j))
#define XB_XGEN(j)  (2304 + 64 * (j))
#define XB_TOP      3328
#define XB_TOPGEN   3392
#define XCD_BAR_WORDS 3456
#define XB_SPIN_CAP (1u << 18)

__device__ __forceinline__ unsigned xb_ld(unsigned* p)              { return __hip_atomic_load(p, __ATOMIC_RELAXED, __HIP_MEMORY_SCOPE_AGENT); }
__device__ __forceinline__ unsigned xb_add(unsigned* p, unsigned v) { return __hip_atomic_fetch_add(p, v, __ATOMIC_RELAXED, __HIP_MEMORY_SCOPE_AGENT); }
__device__ __forceinline__ unsigned xb_xcc_id() { return (unsigned)__builtin_amdgcn_s_getreg((3 << 11) | 20) & 0xFu; }
#define XB_SPIN(cond, bar) do { unsigned _sp = 0; while (cond) { __builtin_amdgcn_s_sleep(1); \
    if ((++_sp & 255u) == 0u) { if (xb_ld(&(bar)[XB_TMO])) break; if (_sp > XB_SPIN_CAP) { atomicAdd(&(bar)[XB_TMO], 1u); break; } } } } while (0)

struct XcdBarrier {
    unsigned* bar; unsigned x;
    volatile LAS unsigned* st;
};

__device__ __forceinline__ XcdBarrier xcd_barrier_post(unsigned* bar, volatile LAS unsigned* st) {
    XcdBarrier b; b.bar = bar; b.x = xb_xcc_id(); b.st = st;
    if (threadIdx.x == 0) (void)xb_add(&bar[XB_XCNT(b.x)], 1u);
    return b;
}
__device__ __forceinline__ void xcd_barrier_complete(unsigned* bar, unsigned x, unsigned& nloc, unsigned& nx) {
    const unsigned G = gridDim.x * gridDim.y * gridDim.z;
    unsigned sum, cnt, mine, sp = 0u;
    for (;;) {
        sum = 0u; cnt = 0u; mine = 0u;
#pragma unroll
        for (unsigned j = 0; j < 16; ++j) { const unsigned c = xb_ld(&bar[XB_XCNT(j)]); sum += c; cnt += (c > 0u) ? 1u : 0u; mine = (j == x) ? c : mine; }
        if (sum == G) break;
        __builtin_amdgcn_s_sleep(1);
        if ((++sp & 255u) == 0u) { if (xb_ld(&bar[XB_TMO])) break; if (sp > XB_SPIN_CAP) { atomicAdd(&bar[XB_TMO], 1u); break; } }
    }
    nloc = mine > 0u ? mine : 1u; nx = cnt > 0u ? cnt : 1u;
}

__device__ __forceinline__ void xcd_barrier(const XcdBarrier& b) {
    asm volatile("s_waitcnt vmcnt(0)" ::: "memory");
    __syncthreads();
    if (threadIdx.x == 0) {
        unsigned* bar = b.bar;
        __builtin_amdgcn_s_waitcnt(0);
        unsigned nloc = b.st[0], nx = b.st[1];
        if (nloc == 0u) { xcd_barrier_complete(bar, b.x, nloc, nx); b.st[0] = nloc; b.st[1] = nx; }
        const unsigned old = xb_add(&bar[XB_XSUB(b.x)], 1u);
        const unsigned gen = old / nloc;
        if (old + 1u == (gen + 1u) * nloc) {
            __builtin_amdgcn_fence(__ATOMIC_RELEASE, "agent");
            asm volatile("s_waitcnt vmcnt(0)" ::: "memory");
            const unsigned og = xb_add(&bar[XB_TOP], 1u);
            const unsigned tg = og / nx;
            if (og + 1u == (tg + 1u) * nx) xb_add(&bar[XB_TOPGEN], 1u);
            else XB_SPIN(xb_ld(&bar[XB_TOPGEN]) == tg, bar);
            __builtin_amdgcn_fence(__ATOMIC_ACQUIRE, "agent");
            xb_add(&bar[XB_XGEN(b.x)], 1u);
            asm volatile("s_waitcnt vmcnt(0)" ::: "memory");
        } else {
            XB_SPIN(xb_ld(&bar[XB_XGEN(b.x)]) == gen, bar);
            __builtin_amdgcn_fence(__ATOMIC_ACQUIRE, "agent");
            asm volatile("s_waitcnt vmcnt(0)" ::: "memory");
        }
    }
    __syncthreads();
}

constexpr int NPHASE = 13;
#ifndef REP0
#define REP0 1
#endif
#ifndef REP12
#define REP12 1
#endif
#ifndef REP7
#define REP7 1
#endif
#ifndef REP8
#define REP8 1
#endif
#ifndef REP4
#define REP4 1
#endif
#ifndef REP6
#define REP6 1
#endif
#ifndef DUP4
#define DUP4 0
#endif
#ifndef DUP6
#define DUP6 0
#endif
#ifndef DUP5
#define DUP5 0
#endif
#ifndef PROBE8
#define PROBE8 0
#endif
#ifndef XSYNC
#define XSYNC 0
#endif
__global__ void __launch_bounds__(NTHREADS, 2) yoco_fwd(Args A) {
    extern __shared__ __attribute__((aligned(16))) unsigned char lds_raw[];
    LAS unsigned char* lds = (LAS unsigned char*)lds_raw;
    cg::grid_group grid = cg::this_grid();
    const int tid = threadIdx.x, lane = tid & 63, wave = __builtin_amdgcn_readfirstlane(tid >> 6);
    const int G = gridDim.x, gw = blockIdx.x * NWAVES + wave, NGW = G * NWAVES, gt = gw * 64 + lane, NGT = NGW * 64;
    unsigned char* ws = A.ws;
    float* rowss = (float*)(ws + WS_ROWSS);
    float* Hf = (float*)(ws + WS_H); bf16* HB = (bf16*)(ws + WS_HB);
    const int lo = A.ph_lo, hi = A.ph_hi;
    volatile LAS unsigned* bst = (volatile LAS unsigned*)(lds + LDS_BYTES - 64);
    if (tid < 2) bst[tid] = 0u;
    __syncthreads();
    XcdBarrier xbar = xcd_barrier_post((unsigned*)(ws + WS_BAR), bst);
    if (lo < 0) grid.sync();
#ifndef PH_MASK
#define PH_MASK 0xffff
#endif
#define IN(k) (((PH_MASK >> (k)) & 1) && lo <= (k) && (k) < hi)
#define SEAM(k) do { if (IN(k) && IN((k) + 1)) xcd_barrier(xbar); } while (0)
    if (IN(0)) { for (int rp = 0; rp < REP0; ++rp) phase_prologue(A, lds, gw, NGW, wave, lane); for (int rp = 0; rp < XSYNC; ++rp) xcd_barrier(xbar); }
    SEAM(0);
    if (IN(1)) for (int rp = 0; rp < REP12; ++rp) { for (int it = gw; it < 2048; it += NGW) s5_item<false>(A, lds + wave * 8704, it, lane); }
    SEAM(1);
    if (IN(2)) for (int rp = 0; rp < REP12; ++rp) { for (int it = gw; it < 4096; it += NGW) s5_item<true>(A, lds + wave * 8704, it, lane); }
    SEAM(2);
    if (IN(3)) { pg8::Gemm g{(const bf16*)(ws + WS_Y), (const bf16*)(ws + W_GLU), NPROMPT, 2048, 1024}; pg8::StaticOrder S; S.init(NPROMPT, 2048, G, (int)blockIdx.x);
        EpiGlu E{A.in[0], A.in[1], Hf, HB, rowss};
        pg8::gemm_phase<EpiGlu, pg8::StaticOrder, true, true>(lds, g, S, E);
        skinny_phase(lds, g.A, g.Bt, 2048, 1024, E, 0, wave, lane); }
    SEAM(3);
    if (IN(4)) { pg8::Gemm g{HB, (const bf16*)(ws + W_UP0), NPROMPT, FF, 1024}; pg8::StaticOrder S; S.init(NPROMPT, FF, G, (int)blockIdx.x);
        EpiUp E{(bf16*)(ws + WS_ACT), rowss};
        pg8::gemm_phase<EpiUp, pg8::StaticOrder, true, true>(lds, g, S, E);
        skinny_phase(lds, g.A, g.Bt, FF, 1024, E, 0, wave, lane);
#if DUP4 == 1
        pg8::gemm_phase<EpiUp, pg8::StaticOrder, true, true>(lds, g, S, E);
#endif
#if DUP4 == 3
        { EpiNull E0{(float*)(ws + WS_OG)};
        skinny_phase(lds, g.A, g.Bt, FF, 1024, E0, 0, wave, lane); skinny_phase(lds, g.A, g.Bt, FF, 1024, E0, 0, wave, lane);
        skinny_phase(lds, g.A, g.Bt, FF, 1024, E0, 0, wave, lane); skinny_phase(lds, g.A, g.Bt, FF, 1024, E0, 0, wave, lane); }
#endif
#if DUP4 == 2
        skinny_phase(lds, g.A, g.Bt, FF, 1024, E, 0, wave, lane);
        skinny_phase(lds, g.A, g.Bt, FF, 1024, E, 0, wave, lane);
        skinny_phase(lds, g.A, g.Bt, FF, 1024, E, 0, wave, lane);
        skinny_phase(lds, g.A, g.Bt, FF, 1024, E, 0, wave, lane);
#endif
    }
    SEAM(4);
    if (IN(5)) { pg8::Gemm g{(const bf16*)(ws + WS_ACT), (const bf16*)(ws + W_DN0), NPROMPT, 1024, FF}; pg8::StaticOrder S; S.init(NPROMPT, 1024, G, (int)blockIdx.x);
        EpiRes E{HB, nullptr, rowss + MP};
        pg8::gemm_phase<EpiRes, pg8::StaticOrder, true, true>(lds, g, S, E);
        skinny_phase(lds, g.A, g.Bt, 1024, FF, E, 0, wave, lane);
#if DUP5 == 2
        { EpiUp E2{(bf16*)(ws + WS_OG), rowss}; pg8::gemm_phase<EpiUp, pg8::StaticOrder, true, true>(lds, g, S, E2); }
#endif
    }
    SEAM(5);
    if (IN(6)) { pg8::Gemm g{HB, (const bf16*)(ws + W_QKV), NPROMPT, NQKV, 1024}; pg8::StaticOrder S; S.init(NPROMPT, NQKV, G, (int)blockIdx.x);
        EpiQKV E{(bf16*)(ws + WS_Q), (bf16*)(ws + WS_KB), (bf16*)(ws + WS_VT), A.out, rowss + MP, (const float*)(ws + WS_ROPE), (const float*)(ws + WS_ROPE) + 8196 * 32, (const float*)(ws + WS_ROPE) + 2 * 8196 * 32, (const float*)(ws + WS_ROPE) + 2 * 8196 * 32 + 8 * 32};
        pg8::gemm_phase<EpiQKV, pg8::StaticOrder, true, true>(lds, g, S, E);
        skinny_phase(lds, g.A, g.Bt, NQKV, 1024, E, G >= 256 ? 128 : 0, wave, lane);
        { const int cf = G >= 256 ? 128 : 0; if ((int)blockIdx.x >= cf) convert_late(A, lds, ((int)blockIdx.x - cf) * NWAVES + wave, (G - cf) * NWAVES, wave, lane); }
#if DUP6 == 1
        pg8::gemm_phase<EpiQKV, pg8::StaticOrder, true, true>(lds, g, S, E);
#endif
#if DUP6 == 2
        { EpiUp E2{(bf16*)(ws + WS_OG), rowss + MP}; pg8::gemm_phase<EpiUp, pg8::StaticOrder, true, true>(lds, g, S, E2); }
#endif
    }
    SEAM(6);
    if (IN(7)) for (int rp = 0; rp < REP7; ++rp) {
        for (int it = gw; it < 2048; it += NGW) attn_sample_item(A, (LAS float*)(lds + 65536 + wave * 2048), it, lane);
        __syncthreads();
        attn_prompt_phase<false>(A, lds, tid, wave, lane, 1024, NATT_ITEMS);
    }
    SEAM(7);
    if (IN(8)) {
#if PROBE8 > 0
        attn_prompt_phase<true, PROBE8>(A, lds, tid, wave, lane, 0, 1024); __syncthreads();
#endif
        attn_prompt_phase<true>(A, lds, tid, wave, lane, 0, 1024); }
    SEAM(8);
    if (IN(9)) { pg8::Gemm g{(const bf16*)(ws + WS_ATT), (const bf16*)(ws + W_O), NPROMPT, 1024, 1024}; pg8::StaticOrder S; S.init(NPROMPT, 1024, G, (int)blockIdx.x);
        EpiRes E{HB, nullptr, rowss + 2 * MP};
        pg8::gemm_phase<EpiRes, pg8::StaticOrder, true, true>(lds, g, S, E);
        skinny_phase(lds, g.A, g.Bt, 1024, 1024, E, 0, wave, lane); }
    SEAM(9);
    if (IN(10)) { pg8::Gemm g{HB, (const bf16*)(ws + W_UP1), NPROMPT, FF, 1024}; pg8::StaticOrder S; S.init(NPROMPT, FF, G, (int)blockIdx.x);
        EpiUp E{(bf16*)(ws + WS_ACT), rowss + 2 * MP};
        pg8::gemm_phase<EpiUp, pg8::StaticOrder, true, true>(lds, g, S, E);
        skinny_phase(lds, g.A, g.Bt, FF, 1024, E, 0, wave, lane); }
    SEAM(10);
    if (IN(11)) { pg8::Gemm g{(const bf16*)(ws + WS_ACT), (const bf16*)(ws + W_DN1), NPROMPT, 1024, FF}; pg8::StaticOrder S; S.init(NPROMPT, 1024, G, (int)blockIdx.x);
        EpiRes E{HB, nullptr, rowss + 3 * MP};
        pg8::gemm_phase<EpiRes, pg8::StaticOrder, true, true>(lds, g, S, E);
        skinny_phase(lds, g.A, g.Bt, 1024, FF, E, 0, wave, lane); }
    SEAM(11);
    if (IN(12)) {
        const float* gfin = A.in[24];
        for (int row0 = 4 * gw; row0 < MREAL; row0 += 4 * NGW) {
            bf16x8 hv[4][2]; float rs[4];
#pragma unroll
            for (int q = 0; q < 4; ++q) { rs[q] = rowss[3 * MP + row0 + q];
#pragma unroll
                for (int j = 0; j < 2; ++j) hv[q][j] = *((const bf16x8*)(HB + (size_t)(row0 + q) * D) + lane + 64 * j); }
#pragma unroll
            for (int j = 0; j < 2; ++j) { const f32x4 g0 = *((const f32x4*)gfin + 2 * (lane + 64 * j)), g1 = *((const f32x4*)gfin + 2 * (lane + 64 * j) + 1);
#pragma unroll
                for (int q = 0; q < 4; ++q) { const float rstd = __builtin_amdgcn_rsqf(rs[q] * (1.f / D) + EPS); float* orow = A.out + (size_t)(row0 + q) * D;
                    f32x4 o0, o1;
#pragma unroll
                    for (int i = 0; i < 4; ++i) { o0[i] = bf2f((unsigned short)hv[q][j][i]) * rstd * g0[i]; o1[i] = bf2f((unsigned short)hv[q][j][4 + i]) * rstd * g1[i]; }
                    *((f32x4*)orow + 2 * (lane + 64 * j)) = o0; *((f32x4*)orow + 2 * (lane + 64 * j) + 1) = o1; } }
        }
    }
#undef IN
#undef SEAM
}

#ifndef N_LAUNCHES
#define N_LAUNCHES 1
#endif
extern "C" void kernel_launch(void* const* d_in, const int* in_sizes, int n_in, void* d_out, int out_size, void* d_ws, size_t ws_size, hipStream_t stream) {
    static int grid = 0;
    if (grid == 0) {
        if (n_in != 25 || ws_size < WS_END) { fprintf(stderr, "kernel_launch: unexpected n_in %d / ws %zu\n", n_in, ws_size); grid = -1; return; }
        int dev = 0, cus = 0, per_cu = 0;
        hipGetDevice(&dev); hipDeviceGetAttribute(&cus, hipDeviceAttributeMultiprocessorCount, dev);
        if (hipFuncSetAttribute((const void*)yoco_fwd, hipFuncAttributeMaxDynamicSharedMemorySize, LDS_BYTES) != hipSuccess) { fprintf(stderr, "hipFuncSetAttribute failed\n"); grid = -1; return; }
        hipOccupancyMaxActiveBlocksPerMultiprocessor(&per_cu, (const void*)yoco_fwd, NTHREADS, LDS_BYTES);
        (void)hipGetLastError();
        if (per_cu < 1) per_cu = 1;
        grid = cus * per_cu;
    }
    if (grid < 0) return;
    Args a{};
    for (int i = 0; i < 25; ++i) a.in[i] = (const float*)d_in[i];
    a.out = (float*)d_out; a.ws = (unsigned char*)d_ws;
    if (hipMemsetAsync((char*)d_ws + WS_BAR, 0, 16384, stream) != hipSuccess) { fprintf(stderr, "memset failed\n"); return; }
    if (N_LAUNCHES == 1) {
        a.ph_lo = 0; a.ph_hi = NPHASE;
        void* args[] = {&a};
        hipError_t e = hipLaunchCooperativeKernel((const void*)yoco_fwd, dim3(grid), dim3(NTHREADS), args, LDS_BYTES, stream);
        if (e != hipSuccess) fprintf(stderr, "cooperative launch failed: %s (grid %d)\n", hipGetErrorString(e), grid);
    } else {
        for (int p = 0; p < NPHASE; ++p) { a.ph_lo = p; a.ph_hi = p + 1; hipLaunchKernelGGL(yoco_fwd, dim3(grid), dim3(NTHREADS), LDS_BYTES, stream, a); }
    }
}
```

```cpp
#include <hip/hip_runtime.h>
#include <hip/hip_cooperative_groups.h>
#include <cstdio>
#include <cstdint>
#include <cmath>
namespace cg = cooperative_groups;
namespace pg8 {
#define PG8_LAS __attribute__((address_space(3)))
typedef unsigned short bf16_t;
typedef short bf16x8 __attribute__((ext_vector_type(8)));
typedef float f32x4 __attribute__((ext_vector_type(4)));
typedef unsigned u32x4 __attribute__((ext_vector_type(4)));
constexpr int BM = 256, BK = 64, HALF = 128, HTB = HALF * BK * 2  , STAGE_BYTES = 8 * HTB, NXCD = 8, WGM = 8;

__host__ __device__ __forceinline__ int lds_byte(int r, int c) { const int st = (r >> 4) * 2 + (c >> 5), rr = r & 15, cc = c & 31, ob = rr * 64 + cc * 2; return st * 1024 + (ob ^ (((ob >> 9) & 1) << 5)); }
__host__ __device__ __forceinline__ void stage_rc(int b, int& R, int& C) { const int st = b / 1024, sb = b % 1024, swz = sb ^ (((sb >> 9) & 1) << 5); R = (st >> 1) * 16 + swz / 64; C = (st & 1) * 32 + (swz % 64) / 2; }
__host__ __device__ __forceinline__ int perm32(int rho) { const int n = rho >> 4, i = rho & 15; return 8 * (i >> 2) + 4 * n + (i & 3); }

struct Unit { int pm, pn; };
struct Gemm { const bf16_t* A; const bf16_t* Bt; int M, N, K; };

struct StaticOrder {
    int nM, nN, nwg, G, c;
    __host__ __device__ void init(int M, int N, int G_, int c_) { nM = M / BM; nN = N / BM; nwg = nM * nN; G = G_; c = c_; }
    __host__ __device__ bool next(int i, Unit& u) const {
        const long L = (long)i * G + c; if (L >= nwg) return false;
        int wgid = (int)L; { const int q = nwg / NXCD, r = nwg % NXCD, xcd = wgid % NXCD, off = wgid / NXCD; wgid = (xcd < r ? xcd * (q + 1) : r * (q + 1) + (xcd - r) * q) + off; }
        const int nig = WGM * nN, gid = wgid / nig, fm = gid * WGM, gsz = (nM - fm) < WGM ? (nM - fm) : WGM;
        u.pm = fm + ((wgid % nig) % gsz); u.pn = (wgid % nig) / gsz; return true;
    }
    __device__ __forceinline__ void a_ready(const Unit&) const {}
    __device__ __forceinline__ void done(const Unit&) const {}
};

__device__ __forceinline__ unsigned cvt_pk_bf16(float lo, float hi) { unsigned r; asm volatile("v_cvt_pk_bf16_f32 %0, %1, %2" : "=v"(r) : "v"(lo), "v"(hi)); return r; }
typedef float f32x2 __attribute__((ext_vector_type(2)));
__device__ __forceinline__ f32x2 gelu_pk(f32x2 v) {
    const f32x2 av = __builtin_elementwise_abs(v), d = av * 0.2316418882f + 1.0f;
    f32x2 t; t.x = __builtin_amdgcn_rcpf(d.x); t.y = __builtin_amdgcn_rcpf(d.y);
    f32x2 q = t * 0.5307027145f + (-0.7265760135f); q = q * t + 0.7107068705f; q = q * t + (-0.142248368f); q = q * t + 0.127414796f; q = q * t;
    const f32x2 s = (v * v) * (-0.72134752044f);
    f32x2 e; e.x = __builtin_amdgcn_exp2f(s.x); e.y = __builtin_amdgcn_exp2f(s.y);
    const f32x2 m = v * (q * e), r = v - m;
    f32x2 o; o.x = v.x < 0.f ? m.x : r.x; o.y = v.y < 0.f ? m.y : r.y; return o;
}


template <class Epi, class Sched, bool ALIGN_EPI = false, bool SP2 = false>
__device__ __forceinline__ void gemm_phase(PG8_LAS unsigned char* lds, const Gemm g, const Sched& S, const Epi& E) {
    const int tid = threadIdx.x, wid = __builtin_amdgcn_readfirstlane(tid >> 6), lane = tid & 63, wr = wid >> 2, wc = wid & 3, fr = lane & 15, fq = lane >> 4;
    const int K = g.K, nt = K / BK;
    unsigned voffA[2], voffB[2];
#pragma unroll
    for (int i = 0; i < 2; ++i) { int R, C; stage_rc(tid * 16 + i * 8192, R, C); const int Rb = Epi::PERM ? ((R & ~31) + perm32(R & 31)) : R;
        voffA[i] = (unsigned)(R * K + C) * 2u; voffB[i] = (unsigned)(Rb * K + C) * 2u; }
    const size_t kstep = (size_t)(BK * 2);
    const size_t hstep = (size_t)HALF * K * 2;
    const size_t tstep = 2 * hstep;
    const unsigned ldsw = (unsigned)wid * 1024u;
    const int aoff = lds_byte(wr * 64 + fr, fq * 8), boff = lds_byte(wc * 32 + fr, fq * 8);
#define PG8_SA(b, h) (((b) * 2 + (h)) * HTB)
#define PG8_SB(b, h) ((4 + (b) * 2 + (h)) * HTB)
#define PG8_STAGE(bufoff, gbase, voff) do { _Pragma("unroll") for (int _i = 0; _i < 2; ++_i) \
        __builtin_amdgcn_global_load_lds((const unsigned*)((const char*)(gbase) + (voff)[_i]), (PG8_LAS unsigned*)(lds + (bufoff) + ldsw + _i * 8192), 16, 0, 0); } while (0)
#define PG8_LDA(dst, b, h) do { _Pragma("unroll") for (int m = 0; m < 4; ++m) _Pragma("unroll") for (int k = 0; k < 2; ++k) dst[m][k] = *(const PG8_LAS bf16x8*)(lds + PG8_SA(b, h) + aoff + m * 2048 + k * 1024); } while (0)
#define PG8_LDB(dst, b, h) do { _Pragma("unroll") for (int n = 0; n < 2; ++n) _Pragma("unroll") for (int k = 0; k < 2; ++k) dst[n][k] = *(const PG8_LAS bf16x8*)(lds + PG8_SB(b, h) + boff + n * 2048 + k * 1024); } while (0)
#define PG8_MMA(ai, bj, At, Bt) do { __builtin_amdgcn_s_setprio(1); _Pragma("unroll") for (int m = 0; m < 4; ++m) _Pragma("unroll") for (int n = 0; n < 2; ++n) _Pragma("unroll") for (int k = 0; k < 2; ++k) \
        acc[ai][bj][m][n] = __builtin_amdgcn_mfma_f32_16x16x32_bf16(Bt[n][k], At[m][k], acc[ai][bj][m][n], 0, 0, 0); __builtin_amdgcn_s_setprio(0); } while (0)
#define PG8_WAIT_V(n) asm volatile("s_waitcnt vmcnt(" #n ")" ::: "memory")
#define PG8_WAIT_L(n) asm volatile("s_waitcnt lgkmcnt(" #n ")" ::: "memory")
#define PG8_BAR __builtin_amdgcn_s_barrier()
#define PG8_SCHED __builtin_amdgcn_sched_barrier(0)
    Unit cur, nxt; int ui = 0;
    if (!S.next(0, cur)) return;
    f32x4 acc[2][2][4][2];
#pragma unroll
    for (int a = 0; a < 2; ++a)
#pragma unroll
        for (int b = 0; b < 2; ++b)
#pragma unroll
            for (int m = 0; m < 4; ++m)
#pragma unroll
                for (int n = 0; n < 2; ++n) acc[a][b][m][n] = (f32x4){0.f, 0.f, 0.f, 0.f};
    bf16x8 At[4][2], B0[2][2], B1[2][2];
    const char* cA = (const char*)g.A + (size_t)cur.pm * tstep; const char* cB = (const char*)g.Bt + (size_t)cur.pn * tstep;
    S.a_ready(cur);
    if constexpr (SP2) {
        PG8_STAGE(PG8_SB(0, 0), cB, voffB); PG8_STAGE(PG8_SB(0, 1), cB + hstep, voffB); PG8_STAGE(PG8_SA(0, 0), cA, voffA); PG8_STAGE(PG8_SA(0, 1), cA + hstep, voffA);
        if (wr == 1) PG8_BAR;
        PG8_WAIT_V(2); PG8_BAR;
        PG8_STAGE(PG8_SB(1, 0), cB + kstep, voffB); PG8_STAGE(PG8_SA(1, 0), cA + kstep, voffA); PG8_STAGE(PG8_SB(1, 1), cB + hstep + kstep, voffB);
        PG8_WAIT_V(6); PG8_BAR;
    } else {
        PG8_STAGE(PG8_SB(0, 0), cB, voffB); PG8_STAGE(PG8_SA(0, 0), cA, voffA); PG8_STAGE(PG8_SB(0, 1), cB + hstep, voffB); PG8_STAGE(PG8_SA(0, 1), cA + hstep, voffA);
        if (wr == 1) PG8_BAR;
        PG8_WAIT_V(4); PG8_BAR;
        PG8_STAGE(PG8_SB(1, 0), cB + kstep, voffB); PG8_STAGE(PG8_SA(1, 0), cA + kstep, voffA); PG8_STAGE(PG8_SB(1, 1), cB + hstep + kstep, voffB);
        PG8_WAIT_V(6); PG8_BAR;
    }
    for (;;) {
        const bool has_next = S.next(ui + 1, nxt);
        const char* nA = has_next ? (const char*)g.A + (size_t)nxt.pm * tstep : cA; const char* nB = has_next ? (const char*)g.Bt + (size_t)nxt.pn * tstep : cB;
        for (int t = 0; t < nt; t += 2) {
            const bool last = (t == nt - 2);
            const char* a1 = cA + (size_t)(t + 1) * kstep;
            const char* a2 = last ? nA : cA + (size_t)(t + 2) * kstep; const char* b2 = last ? nB : cB + (size_t)(t + 2) * kstep;
            const char* a3 = a2 + kstep; const char* b3 = b2 + kstep;
            if (last && has_next) S.a_ready(nxt);
            if constexpr (SP2) {
            PG8_LDB(B0, 0, 0); PG8_LDB(B1, 0, 1); PG8_SCHED; PG8_LDA(At, 0, 0); PG8_STAGE(PG8_SA(1, 1), a1 + hstep, voffA);
            PG8_WAIT_V(8); PG8_WAIT_L(0); PG8_BAR; PG8_MMA(0, 0, At, B0); PG8_MMA(0, 1, At, B1); PG8_BAR; PG8_SCHED;
            PG8_LDA(At, 0, 1); PG8_STAGE(PG8_SB(0, 0), b2, voffB); PG8_STAGE(PG8_SB(0, 1), b2 + hstep, voffB); PG8_STAGE(PG8_SA(0, 0), a2, voffA);
            PG8_WAIT_V(8); PG8_WAIT_L(0); PG8_BAR; PG8_MMA(1, 0, At, B0); PG8_MMA(1, 1, At, B1); PG8_BAR; PG8_SCHED;
            PG8_LDB(B0, 1, 0); PG8_LDB(B1, 1, 1); PG8_SCHED; PG8_LDA(At, 1, 0); PG8_STAGE(PG8_SA(0, 1), a2 + hstep, voffA);
            PG8_WAIT_V(8); PG8_WAIT_L(0); PG8_BAR; PG8_MMA(0, 0, At, B0); PG8_MMA(0, 1, At, B1); PG8_BAR; PG8_SCHED;
            PG8_LDA(At, 1, 1); PG8_STAGE(PG8_SB(1, 0), b3, voffB); PG8_STAGE(PG8_SB(1, 1), b3 + hstep, voffB); PG8_STAGE(PG8_SA(1, 0), a3, voffA);
            PG8_WAIT_V(8); PG8_WAIT_L(0); PG8_BAR; PG8_MMA(1, 0, At, B0); PG8_MMA(1, 1, At, B1); PG8_BAR; PG8_SCHED;
            } else {
            PG8_LDB(B0, 0, 0); PG8_SCHED; PG8_LDA(At, 0, 0); PG8_STAGE(PG8_SA(1, 1), a1 + hstep, voffA);
            PG8_WAIT_L(8); PG8_BAR; PG8_WAIT_L(0); PG8_MMA(0, 0, At, B0); PG8_BAR; PG8_SCHED;
            PG8_LDB(B1, 0, 1); PG8_STAGE(PG8_SB(0, 0), b2, voffB);
            PG8_BAR; PG8_WAIT_L(0); PG8_MMA(0, 1, At, B1); PG8_BAR;
            PG8_LDA(At, 0, 1); PG8_STAGE(PG8_SA(0, 0), a2, voffA);
            PG8_BAR; PG8_WAIT_L(0); PG8_MMA(1, 0, At, B0); PG8_BAR; PG8_SCHED;
            PG8_STAGE(PG8_SB(0, 1), b2 + hstep, voffB);
            PG8_WAIT_V(6); PG8_BAR; PG8_MMA(1, 1, At, B1); PG8_BAR;
            PG8_LDB(B0, 1, 0); PG8_SCHED; PG8_LDA(At, 1, 0); PG8_STAGE(PG8_SA(0, 1), a2 + hstep, voffA);
            PG8_WAIT_L(8); PG8_BAR; PG8_WAIT_L(0); PG8_MMA(0, 0, At, B0); PG8_BAR; PG8_SCHED;
            PG8_LDB(B1, 1, 1); PG8_STAGE(PG8_SB(1, 0), b3, voffB);
            PG8_BAR; PG8_WAIT_L(0); PG8_MMA(0, 1, At, B1); PG8_BAR;
            PG8_LDA(At, 1, 1); PG8_STAGE(PG8_SA(1, 0), a3, voffA);
            PG8_BAR; PG8_WAIT_L(0); PG8_MMA(1, 0, At, B0); PG8_BAR; PG8_SCHED;
            PG8_STAGE(PG8_SB(1, 1), b3 + hstep, voffB);
            PG8_WAIT_V(6); PG8_BAR; PG8_MMA(1, 1, At, B1); PG8_BAR;
            }
        }
        if constexpr (ALIGN_EPI) { if (wr == 0) PG8_BAR; }
        if constexpr (!Epi::AFTER_DRAIN) { E(acc, cur, wr, wc, fr, fq); S.done(cur); }
        if (!has_next) break;
#pragma unroll
        for (int a = 0; a < 2; ++a)
#pragma unroll
            for (int b = 0; b < 2; ++b)
#pragma unroll
                for (int m = 0; m < 4; ++m)
#pragma unroll
                    for (int n = 0; n < 2; ++n) acc[a][b][m][n] = (f32x4){0.f, 0.f, 0.f, 0.f};
        cur = nxt; cA = nA; cB = nB; ++ui;
        if constexpr (ALIGN_EPI) { if (wr == 1) PG8_BAR; }
    }
    PG8_WAIT_V(0);
    if constexpr (!ALIGN_EPI) { if (wr == 0) PG8_BAR; }
    PG8_BAR;
    if constexpr (Epi::AFTER_DRAIN) { E.fused(acc, cur, wr, wc, fr, fq, lds, wid, lane); S.done(cur); }
#undef PG8_SA
#undef PG8_SB
#undef PG8_STAGE
#undef PG8_LDA
#undef PG8_LDB
#undef PG8_MMA
#undef PG8_WAIT_V
#undef PG8_WAIT_L
#undef PG8_BAR
#undef PG8_SCHED
}
}

#define LAS __attribute__((address_space(3)))
typedef unsigned short bf16;
typedef short bf16x8 __attribute__((ext_vector_type(8)));
typedef float f32x4 __attribute__((ext_vector_type(4)));
typedef float f32x16 __attribute__((ext_vector_type(16)));
typedef unsigned u32x4 __attribute__((ext_vector_type(4)));
typedef unsigned u32x2 __attribute__((ext_vector_type(2)));
typedef float f32x2_t __attribute__((ext_vector_type(2)));
typedef __bf16 bf16x2_t __attribute__((ext_vector_type(2)));

constexpr int NWAVES = 8, NTHREADS = 512;
constexpr int D = 1024, SEQ = 8192, NPROMPT = 16384, NSAMP = 128, MREAL = NPROMPT + NSAMP, MP = 16640;
constexpr int FF = 4096, QW = 3072, KVW = 1536, NQKV = QW + KVW;
constexpr float EPS = 1e-6f;
constexpr float QSCALE = 0.125f * 1.4426950408889634f;
constexpr int LDS_BYTES = 147456;

constexpr size_t MiB = 1u << 20;
constexpr size_t WS_ROWSS = 0;
constexpr size_t WS_BAR = 384 * 1024;
constexpr size_t WS_LAM = 512 * 1024;
constexpr size_t WS_BBAR = 576 * 1024;
constexpr size_t WS_CC = 1 * MiB;
constexpr size_t WS_ROPE = 1536 * 1024;
constexpr size_t WS_E = 3840 * 1024;
constexpr size_t WS_W = 8 * MiB;
constexpr size_t W_GLU = WS_W, W_UP0 = W_GLU + 2048ull * 1024 * 2, W_DN0 = W_UP0 + 4096ull * 1024 * 2, W_QKV = W_DN0 + 4096ull * 1024 * 2,
                 W_O = W_QKV + (size_t)NQKV * 1024 * 2, W_UP1 = W_O + 1024ull * 1024 * 2, W_DN1 = W_UP1 + 4096ull * 1024 * 2, W_END = W_DN1 + 4096ull * 1024 * 2;
static_assert(W_END <= 56 * MiB, "weights");
constexpr size_t WS_H = 56 * MiB;
constexpr size_t WS_HB = 121 * MiB;
constexpr size_t WS_HN0 = 154 * MiB;
constexpr size_t WS_VT = WS_HN0;
constexpr size_t WS_Y = 187 * MiB;
constexpr size_t WS_ATT = WS_Y;
constexpr size_t WS_ACT = 220 * MiB;
constexpr size_t WS_Q = WS_ACT;
constexpr size_t WS_KB = WS_Q + (size_t)MP * QW * 2;
static_assert(WS_KB + 3ull * MP * 256 * 2 <= 350 * MiB, "q/k overlay");
constexpr size_t WS_OG = 350 * MiB;
constexpr size_t WS_LSE = 448 * MiB;
constexpr size_t WS_END = 452 * MiB;

constexpr size_t O_YP = 0, O_YS = 16777216, O_KVP0 = 16908288, O_KVP1 = 17039360, O_KVP2 = 17563648,
                 O_KVS0 = 19660800, O_KVS1 = 19726336, O_KVS2 = 19791872, O_SREP = 19857408, O_SIMP = 19865600, O_SRES = 19873792, O_SIMS = 20004864;

__device__ __forceinline__ unsigned pk2(float lo, float hi) { f32x2_t v = {lo, hi}; bf16x2_t b = __builtin_convertvector(v, bf16x2_t); return __builtin_bit_cast(unsigned, b); }
__device__ __forceinline__ float bf2f(unsigned short u) { return __uint_as_float(((unsigned)u) << 16); }
__device__ __forceinline__ float wave_sum(float v) {
#pragma unroll
    for (int o = 1; o < 64; o <<= 1) v += __shfl_xor(v, o);
    return v;
}
__device__ __forceinline__ float wave_max(float v) {
#pragma unroll
    for (int o = 1; o < 64; o <<= 1) v = fmaxf(v, __shfl_xor(v, o));
    return v;
}

struct Args { const float* in[25]; float* out; unsigned char* ws; int ph_lo, ph_hi; };

struct EpiGlu {
    static constexpr bool PERM = true, AFTER_DRAIN = false;
    const float* xp; const float* xs; float* H; bf16* HB; float* rowss;
    __device__ __forceinline__ void operator()(const pg8::f32x4 (&acc)[2][2][4][2], const pg8::Unit& u, int wr, int wc, int fr, int fq) const { run<2>(acc, u, wr, wc, fr, fq); }
    template <int NAI> __device__ __forceinline__ void run(const pg8::f32x4 (&acc)[NAI][2][4][2], const pg8::Unit& u, int wr, int wc, int fr, int fq) const {
        const int col = u.pn * 128 + wc * 32 + 8 * fq;
#pragma unroll
        for (int ai = 0; ai < NAI; ++ai)
#pragma unroll
            for (int m = 0; m < 4; ++m) {
                const int row = u.pm * 256 + ai * 128 + wr * 64 + m * 16 + fr;
                if (row < MREAL) {
                    const float* xr = (row < NPROMPT ? xp + (size_t)row * D : xs + (size_t)(row - NPROMPT) * D) + col;
                    const f32x4 x0 = *(const f32x4*)xr, x1 = *(const f32x4*)(xr + 4);
                    f32x4 h0, h1;
#pragma unroll
                    for (int i = 0; i < 4; ++i) {
                        h0[i] = x0[i] + acc[ai][0][m][0][i] * __builtin_amdgcn_rcpf(1.f + __expf(-acc[ai][1][m][0][i]));
                        h1[i] = x1[i] + acc[ai][0][m][1][i] * __builtin_amdgcn_rcpf(1.f + __expf(-acc[ai][1][m][1][i]));
                    }
                    u32x4 w; w.x = pk2(h0[0], h0[1]); w.y = pk2(h0[2], h0[3]); w.z = pk2(h1[0], h1[1]); w.w = pk2(h1[2], h1[3]);
                    *(u32x4*)(HB + (size_t)row * D + col) = w;
                    float ss = (h0[0] * h0[0] + h0[1] * h0[1]) + (h0[2] * h0[2] + h0[3] * h0[3]) + (h1[0] * h1[0] + h1[1] * h1[1]) + (h1[2] * h1[2] + h1[3] * h1[3]);
                    ss += __shfl_xor(ss, 16); ss += __shfl_xor(ss, 32);
                    if (fq == 0) __hip_atomic_fetch_add(rowss + row, ss, __ATOMIC_RELAXED, __HIP_MEMORY_SCOPE_AGENT);
                } else { float ss = 0.f; ss += __shfl_xor(ss, 16); ss += __shfl_xor(ss, 32); (void)ss; }
            }
    }
};
struct EpiNull {
    static constexpr bool PERM = true, AFTER_DRAIN = false; float* sink;
    __device__ __forceinline__ void operator()(const pg8::f32x4 (&acc)[2][2][4][2], const pg8::Unit& u, int wr, int wc, int fr, int fq) const { run<2>(acc, u, wr, wc, fr, fq); }
    template <int NAI> __device__ __forceinline__ void run(const pg8::f32x4 (&acc)[NAI][2][4][2], const pg8::Unit& u, int wr, int wc, int fr, int fq) const {
        float t = 0.f;
#pragma unroll
        for (int b = 0; b < 2; ++b)
#pragma unroll
            for (int m = 0; m < 4; ++m)
#pragma unroll
                for (int n = 0; n < 2; ++n) t += acc[0][b][m][n][0] + acc[0][b][m][n][3];
        if (t == 1234.5678f) sink[0] = t;
    }
};
struct EpiUp {
    static constexpr bool PERM = true, AFTER_DRAIN = false;
    bf16* O; const float* rowss;
    __device__ __forceinline__ void operator()(const pg8::f32x4 (&acc)[2][2][4][2], const pg8::Unit& u, int wr, int wc, int fr, int fq) const { run<2>(acc, u, wr, wc, fr, fq); }
    template <int NAI> __device__ __forceinline__ void run(const pg8::f32x4 (&acc)[NAI][2][4][2], const pg8::Unit& u, int wr, int wc, int fr, int fq) const {
        const int col = u.pn * 256 + wc * 32 + 8 * fq;
#pragma unroll
        for (int ai = 0; ai < NAI; ++ai)
#pragma unroll
            for (int m = 0; m < 4; ++m) {
                const int row = u.pm * 256 + ai * 128 + wr * 64 + m * 16 + fr;
                if (row < MREAL) {
                    const float rstd = __builtin_amdgcn_rsqf(rowss[row] * (1.f / D) + EPS);
#pragma unroll
                    for (int bj = 0; bj < 2; ++bj) {
                        float v[8];
#pragma unroll
                        for (int i = 0; i < 4; ++i) { float a = fmaxf(acc[ai][bj][m][0][i] * rstd, 0.f), b = fmaxf(acc[ai][bj][m][1][i] * rstd, 0.f); v[i] = a * a; v[4 + i] = b * b; }
                        u32x4 w; w.x = pk2(v[0], v[1]); w.y = pk2(v[2], v[3]); w.z = pk2(v[4], v[5]); w.w = pk2(v[6], v[7]);
                        *(u32x4*)(O + (size_t)row * FF + col + bj * 128) = w;
                    }
                }
            }
    }
};
struct EpiRes {
    static constexpr bool PERM = true, AFTER_DRAIN = false;
    bf16* HB; float* OUT; float* rowss;
    __device__ __forceinline__ void operator()(const pg8::f32x4 (&acc)[2][2][4][2], const pg8::Unit& u, int wr, int wc, int fr, int fq) const { run<2>(acc, u, wr, wc, fr, fq); }
    template <int NAI> __device__ __forceinline__ void run(const pg8::f32x4 (&acc)[NAI][2][4][2], const pg8::Unit& u, int wr, int wc, int fr, int fq) const {
        const int col = u.pn * 256 + wc * 32 + 8 * fq;
#pragma unroll
        for (int ai = 0; ai < NAI; ++ai)
#pragma unroll
            for (int m = 0; m < 4; ++m) {
                const int row = u.pm * 256 + ai * 128 + wr * 64 + m * 16 + fr;
                float ss = 0.f;
                if (row < MREAL) {
#pragma unroll
                    for (int bj = 0; bj < 2; ++bj) {
                        bf16* hp = HB + (size_t)row * D + col + bj * 128;
                        const bf16x8 hv = *(const bf16x8*)hp;
                        f32x4 h0, h1;
#pragma unroll
                        for (int i = 0; i < 4; ++i) { h0[i] = bf2f((unsigned short)hv[i]) + acc[ai][bj][m][0][i]; h1[i] = bf2f((unsigned short)hv[4 + i]) + acc[ai][bj][m][1][i]; }
                        if (OUT) { float* op = OUT + (size_t)row * D + col + bj * 128; *(f32x4*)op = h0; *(f32x4*)(op + 4) = h1; }
                        else { u32x4 w; w.x = pk2(h0[0], h0[1]); w.y = pk2(h0[2], h0[3]); w.z = pk2(h1[0], h1[1]); w.w = pk2(h1[2], h1[3]); *(u32x4*)hp = w; }
                        ss += (h0[0] * h0[0] + h0[1] * h0[1]) + (h0[2] * h0[2] + h0[3] * h0[3]) + (h1[0] * h1[0] + h1[1] * h1[1]) + (h1[2] * h1[2] + h1[3] * h1[3]);
                    }
                }
                ss += __shfl_xor(ss, 16); ss += __shfl_xor(ss, 32);
                if (fq == 0 && row < MREAL) __hip_atomic_fetch_add(rowss + row, ss, __ATOMIC_RELAXED, __HIP_MEMORY_SCOPE_AGENT);
            }
    }
};
struct EpiQKV {
    static constexpr bool PERM = true, AFTER_DRAIN = false;
    bf16* Q; bf16* KB; bf16* VB; float* out; const float* rowss; const float* ropec; const float* ropes; const float* offc; const float* offs;
    __device__ __forceinline__ void operator()(const pg8::f32x4 (&acc)[2][2][4][2], const pg8::Unit& u, int wr, int wc, int fr, int fq) const { run<2>(acc, u, wr, wc, fr, fq); }
    template <int NAI> __device__ __forceinline__ void run(const pg8::f32x4 (&acc)[NAI][2][4][2], const pg8::Unit& u, int wr, int wc, int fr, int fq) const {
        const int pn = u.pn;
        const bool isq = pn < 12; const int kvi = pn - 12; const int g = isq ? (pn >> 2) : (kvi >> 1); const bool isv = (!isq) && (kvi & 1);
        const int sh = 2 * g, W = 128 << sh;
        const bool stile = u.pm == 64;
        const int d0 = 8 * fq;
        const int slb = ((u.pm * 256 + wr * 64 + fr) & (SEQ - 1)) * 32 + d0;
#pragma unroll
        for (int ai = 0; ai < NAI; ++ai)
#pragma unroll
            for (int m = 0; m < 4; ++m) {
                const int row = u.pm * 256 + ai * 128 + wr * 64 + m * 16 + fr;
                if (row >= MREAL) continue;
                const float rstd = __builtin_amdgcn_rsqf(rowss[row] * (1.f / D) + EPS) * (isq ? QSCALE : 1.f);
                const bool samp = row >= NPROMPT; const int t = samp ? ((row - NPROMPT) & 3) : (row & (SEQ - 1));
                int rowp = row;
                if (!samp) { const int b = row >> 13, r = t & ((1 << sh) - 1), uu = t >> sh; rowp = b * SEQ + r * (SEQ >> sh) + uu; }
                float* ob = nullptr;
                if (!isq) {
                    if (samp) ob = out + (g == 0 ? O_KVS0 : g == 1 ? O_KVS1 : O_KVS2) + (size_t)(row - NPROMPT) * 512;
                    else if (t >= SEQ - W) ob = out + (g == 0 ? O_KVP0 : g == 1 ? O_KVP1 : O_KVP2) + ((size_t)(row >> 13) * W + (t - (SEQ - W))) * 512;
                }
                f32x4 av[2], bv[2];
#pragma unroll
                for (int n = 0; n < 2; ++n) {
                    f32x4 a = acc[ai][0][m][n] * rstd, b = acc[ai][1][m][n] * rstd;
                    if (!isv) {
                        const int sl = (samp ? SEQ + t : t) * 32 + d0 + 4 * n; const f32x4 c = *(const f32x4*)(ropec + sl), sn = *(const f32x4*)(ropes + sl);
                        const f32x4 ra = a * c - b * sn, rb = b * c + a * sn; a = ra; b = rb;
                    }
                    av[n] = a; bv[n] = b;
                }
                if (isq) {
                    bf16* qp = Q + (size_t)row * QW + pn * 256 + wc * 64 + d0;
                    u32x4 w0, w1; w0.x = pk2(av[0][0], av[0][1]); w0.y = pk2(av[0][2], av[0][3]); w0.z = pk2(av[1][0], av[1][1]); w0.w = pk2(av[1][2], av[1][3]);
                    w1.x = pk2(bv[0][0], bv[0][1]); w1.y = pk2(bv[0][2], bv[0][3]); w1.z = pk2(bv[1][0], bv[1][1]); w1.w = pk2(bv[1][2], bv[1][3]);
                    *(u32x4*)qp = w0; *(u32x4*)(qp + 32) = w1;
                } else {
                    bf16* kp = (isv ? VB : KB) + ((size_t)g * MP + rowp) * 256 + wc * 64 + d0;
                    u32x4 w0, w1; w0.x = pk2(av[0][0], av[0][1]); w0.y = pk2(av[0][2], av[0][3]); w0.z = pk2(av[1][0], av[1][1]); w0.w = pk2(av[1][2], av[1][3]);
                    w1.x = pk2(bv[0][0], bv[0][1]); w1.y = pk2(bv[0][2], bv[0][3]); w1.z = pk2(bv[1][0], bv[1][1]); w1.w = pk2(bv[1][2], bv[1][3]);
                    *(u32x4*)kp = w0; *(u32x4*)(kp + 32) = w1;
                    if (ob) { float* o2 = ob + (isv ? 256 : 0) + wc * 64 + d0; *(f32x4*)o2 = av[0]; *(f32x4*)(o2 + 4) = av[1]; *(f32x4*)(o2 + 32) = bv[0]; *(f32x4*)(o2 + 36) = bv[1]; }
                }
            }
    }
};

template <class Epi>
__device__ __forceinline__ void skinny_phase(LAS unsigned char* lds, const bf16* Abuf, const bf16* Bt, int N, int K, const Epi& E, int first, int wave, int lane) {
    const int nroles = (N >> 8) * 8, G = gridDim.x;
    const int fr = lane & 15, fq = lane >> 4;
    LAS float* red = (LAS float*)lds;
    const int rstep = first ? G - first : G;
    for (int role = (int)blockIdx.x - first; role < nroles; role += rstep) {
        if (role < 0) break;
        const int pn = role >> 3, wr = (role >> 2) & 1, wc = role & 3;
        pg8::f32x4 acc[1][2][4][2];
#pragma unroll
        for (int b = 0; b < 2; ++b)
#pragma unroll
            for (int m = 0; m < 4; ++m)
#pragma unroll
                for (int n = 0; n < 2; ++n) acc[0][b][m][n] = (pg8::f32x4){0.f, 0.f, 0.f, 0.f};
        const int kper = K >> 3, k0 = wave * kper;
        const bf16* ap = Abuf + (size_t)(NPROMPT + 64 * wr + fr) * K + k0 + 8 * fq;
        const int r0 = Epi::PERM ? (8 * (fr >> 2) + (fr & 3)) : fr, r1 = Epi::PERM ? r0 + 4 : fr + 16;
        const bf16* bp = Bt + (size_t)(256 * pn + 32 * wc) * K + k0 + 8 * fq;
#pragma unroll 4
        for (int ks = 0; ks < kper; ks += 32) {
            bf16x8 af[4], bf_[2][2];
#pragma unroll
            for (int m = 0; m < 4; ++m) af[m] = *(const bf16x8*)(ap + (size_t)(16 * m) * K + ks);
#pragma unroll
            for (int b = 0; b < 2; ++b) { bf_[b][0] = *(const bf16x8*)(bp + (size_t)(128 * b + r0) * K + ks); bf_[b][1] = *(const bf16x8*)(bp + (size_t)(128 * b + r1) * K + ks); }
#pragma unroll
            for (int b = 0; b < 2; ++b)
#pragma unroll
                for (int m = 0; m < 4; ++m)
#pragma unroll
                    for (int n = 0; n < 2; ++n) acc[0][b][m][n] = __builtin_amdgcn_mfma_f32_16x16x32_bf16(bf_[b][n], af[m], acc[0][b][m][n], 0, 0, 0);
        }
        if (wave != 0) {
#pragma unroll
            for (int b = 0; b < 2; ++b)
#pragma unroll
                for (int m = 0; m < 4; ++m)
#pragma unroll
                    for (int n = 0; n < 2; ++n) *(LAS pg8::f32x4*)(red + ((size_t)((wave - 1) * 16 + b * 8 + m * 2 + n) * 64 + lane) * 4) = acc[0][b][m][n];
        }
        __syncthreads();
        if (wave == 0) {
#pragma unroll 1
            for (int w = 0; w < 7; ++w)
#pragma unroll
                for (int b = 0; b < 2; ++b)
#pragma unroll
                    for (int m = 0; m < 4; ++m)
#pragma unroll
                        for (int n = 0; n < 2; ++n) acc[0][b][m][n] += *(const LAS pg8::f32x4*)(red + ((size_t)(w * 16 + b * 8 + m * 2 + n) * 64 + lane) * 4);
            const pg8::Unit u{64, pn};
            E.template run<1>(acc, u, wr, wc, fr, fq);
        }
        __syncthreads();
    }
}
__device__ __forceinline__ int conv_srcc(int mode, int nb) {
    if (mode == 0) return 32 * nb;
    if (mode == 1) { const int pn = nb >> 3, bj = (nb >> 2) & 1, cb = nb & 3; return bj * 1024 + 128 * pn + 32 * cb; }
    const int pn = nb >> 3, bj = (nb >> 2) & 1, wc = nb & 3; return 256 * pn + 64 * wc + 32 * bj;
}
__device__ __forceinline__ void transpose_item(const float* W, int K, int N, bf16* WT, const float* gain, int mode, LAS float* scr, int item, int lane) {
    const int nblk = N >> 6, kb = item / nblk, nb64 = item % nblk, k0 = 64 * kb;
    const int l16 = lane & 15, srcc = conv_srcc(mode, 2 * nb64 + (l16 >> 3)) + 4 * (l16 & 7);
    f32x4 v[16];
#pragma unroll
    for (int i = 0; i < 16; ++i) { const int kk = 4 * i + (lane >> 4); v[i] = *(const f32x4*)(W + (size_t)(k0 + kk) * N + srcc); }
    if (gain) {
#pragma unroll
        for (int i = 0; i < 16; ++i) { const int kk = 4 * i + (lane >> 4); v[i] = v[i] * gain[k0 + kk]; }
    }
#pragma unroll
    for (int i = 0; i < 16; ++i) { const int kk = 4 * i + (lane >> 4); LAS float* d = scr + kk * 65 + 4 * l16; d[0] = v[i][0]; d[1] = v[i][1]; d[2] = v[i][2]; d[3] = v[i][3]; }
    asm volatile("s_waitcnt lgkmcnt(0)" ::: "memory");
    const int c = lane & 7;
#pragma unroll
    for (int j = 0; j < 8; ++j) { const int n = (lane >> 3) + 8 * j; const LAS float* sp = scr + (8 * c) * 65 + n;
        u32x4 o; o.x = pk2(sp[0 * 65], sp[1 * 65]); o.y = pk2(sp[2 * 65], sp[3 * 65]); o.z = pk2(sp[4 * 65], sp[5 * 65]); o.w = pk2(sp[6 * 65], sp[7 * 65]);
        *(u32x4*)(WT + (size_t)(64 * nb64 + n) * K + k0 + 8 * c) = o; }
    asm volatile("s_waitcnt lgkmcnt(0)" ::: "memory");
}
__device__ __forceinline__ void convert_late(const Args& A, LAS unsigned char* lds, int vw, int NVW, int wave, int lane) {
    unsigned char* ws = A.ws;
    LAS float* scr = (LAS float*)(lds + wave * 16640);
    constexpr int I_UP = 16 * 64, I_DN = 64 * 16, I_O = 16 * 16, NIT = I_O + I_UP + I_DN;
    for (int it = vw; it < NIT; it += NVW) {
        int r = it;
        if (r < I_O) { transpose_item(A.in[21], 1024, 1024, (bf16*)(ws + W_O), nullptr, 0, scr, r, lane); continue; } r -= I_O;
        if (r < I_UP) { transpose_item(A.in[22] + 1024ull * 4096, 1024, 4096, (bf16*)(ws + W_UP1), A.in[8] + 1024, 0, scr, r, lane); continue; } r -= I_UP;
        transpose_item(A.in[23] + 4096ull * 1024, 4096, 1024, (bf16*)(ws + W_DN1), nullptr, 0, scr, r, lane);
    }
}

__device__ __forceinline__ void phase_prologue(const Args& A, LAS unsigned char* lds, int gw, int NGW, int wave, int lane) {
    unsigned char* ws = A.ws;
    LAS float* scr = (LAS float*)(lds + wave * 16640);
    constexpr int I_GLU = 16 * 32, I_UP = 16 * 64, I_DN = 64 * 16, I_Q = 16 * 48, I_KV = 16 * 24;
    constexpr int NIT = I_GLU + I_UP + I_DN + I_Q + I_KV;
    for (int it = gw; it < NIT; it += NGW) {
        int r = it;
        if (r < I_GLU) { transpose_item(A.in[17], 1024, 2048, (bf16*)(ws + W_GLU), nullptr, 1, scr, r, lane); continue; } r -= I_GLU;
        if (r < I_UP) { transpose_item(A.in[22], 1024, 4096, (bf16*)(ws + W_UP0), A.in[8], 0, scr, r, lane); continue; } r -= I_UP;
        if (r < I_DN) { transpose_item(A.in[23], 4096, 1024, (bf16*)(ws + W_DN0), nullptr, 0, scr, r, lane); continue; } r -= I_DN;
        if (r < I_Q) { transpose_item(A.in[20], 1024, 3072, (bf16*)(ws + W_QKV), A.in[7] + 1024, 2, scr, r, lane); continue; } r -= I_Q;
        transpose_item(A.in[19], 1024, 1536, (bf16*)(ws + W_QKV) + 3072ull * 1024, A.in[18], 2, scr, r, lane);
    }
    {
        const float* gmix = A.in[7];
        bf16* HN0 = (bf16*)(ws + WS_HN0);
        for (int row0 = 4 * gw; row0 < MREAL; row0 += 4 * NGW) {
            f32x4 v[4][4]; float ssq[4];
#pragma unroll
            for (int q = 0; q < 4; ++q) { const int row = row0 + q; const float* xr = row < NPROMPT ? A.in[0] + (size_t)row * D : A.in[1] + (size_t)(row - NPROMPT) * D;
#pragma unroll
                for (int j = 0; j < 4; ++j) v[q][j] = *((const f32x4*)xr + lane + 64 * j); }
#pragma unroll
            for (int q = 0; q < 4; ++q) { float sq = 0.f;
#pragma unroll
                for (int j = 0; j < 4; ++j) sq += (v[q][j][0] * v[q][j][0] + v[q][j][1] * v[q][j][1]) + (v[q][j][2] * v[q][j][2] + v[q][j][3] * v[q][j][3]);
                ssq[q] = __builtin_amdgcn_rsqf(wave_sum(sq) * (1.f / D) + EPS); }
#pragma unroll
            for (int j = 0; j < 4; ++j) { const f32x4 gg = *((const f32x4*)gmix + lane + 64 * j);
#pragma unroll
                for (int q = 0; q < 4; ++q) { const float rstd = ssq[q];
                    u32x2 w; w.x = pk2(v[q][j][0] * rstd * gg[0], v[q][j][1] * rstd * gg[1]); w.y = pk2(v[q][j][2] * rstd * gg[2], v[q][j][3] * rstd * gg[3]);
                    *((u32x2*)(HN0 + (size_t)(row0 + q) * D) + lane + 64 * j) = w; } }
        }
    }
    const int gt = gw * 64 + lane, NGT = NGW * 64;
    { float* rs = (float*)(ws + WS_ROWSS); for (int i = gt; i < 4 * MP; i += NGT) rs[i] = 0.f; }
    { float* rc = (float*)(ws + WS_ROPE); float* rsn = rc + 8196 * 32;
      for (int i = gt; i < 8196 * 32; i += NGT) { const int slot = i >> 5, d = i & 31; const float pos = slot < SEQ ? (float)slot : (float)(16384 + (slot - SEQ));
          const float inv = powf(10000.0f, -(float)d / 32.0f); const float ang = pos * inv; rc[i] = cosf(ang); rsn[i] = sinf(ang); } }
    { float* oc = (float*)(ws + WS_ROPE) + 2 * 8196 * 32; float* os = oc + 8 * 32;
      for (int i = gt; i < 8 * 32; i += NGT) { const int oi = i >> 5, d = i & 31; const float pos = (float)(128 * (oi >> 2) + 16 * (oi & 3));
          const float inv = powf(10000.0f, -(float)d / 32.0f); const float ang = pos * inv; oc[i] = cosf(ang); os[i] = sinf(ang); } }
    { float* lam = (float*)(ws + WS_LAM); bf16* BB = (bf16*)(ws + WS_BBAR); bf16* CC = (bf16*)(ws + WS_CC);
      const float *are = A.in[9], *aim = A.in[10], *ldt = A.in[11], *bre = A.in[12], *bim = A.in[13], *cre = A.in[14], *cim = A.in[15];
      for (int i = gt; i < 64 * 64 * 16; i += NGT) {
          const int c = i & 15, p = (i >> 4) & 63, g = i >> 10;
          const float dt = expf(ldt[g]); const float ar = are[g * 64 + p], ai = aim[g * 64 + p];
          const float mag = expf(ar * dt); const float lr = mag * cosf(ai * dt), li = mag * sinf(ai * dt);
          const float den = ar * ar + ai * ai, nr = lr - 1.f, ni = li;
          const float zr = (nr * ar + ni * ai) / den, zi = (ni * ar - nr * ai) / den;
          const float br = bre[(g * 64 + p) * 16 + c], bi = bim[(g * 64 + p) * 16 + c];
          const float bbr = zr * br - zi * bi, bbi = zr * bi + zi * br;
          BB[(g * 128 + p) * 16 + c] = (bf16)(pk2(bbr, 0.f) & 0xffffu);
          BB[(g * 128 + 64 + p) * 16 + c] = (bf16)(pk2(bbi, 0.f) & 0xffffu);
          CC[(g * 16 + c) * 128 + 4 * (p & 31) + (p >> 5)] = (bf16)(pk2(cre[(g * 16 + c) * 64 + p], 0.f) & 0xffffu);
          CC[(g * 16 + c) * 128 + 4 * (p & 31) + 2 + (p >> 5)] = (bf16)(pk2(-cim[(g * 16 + c) * 64 + p], 0.f) & 0xffffu);
          if (c == 0) { lam[(g * 64 + p) * 2] = lr; lam[(g * 64 + p) * 2 + 1] = li; }
      } }
}

#define CMUL_ADD(orr, oi, ar_, ai_, br_, bi_, cr_, ci_) do { const float _r = __builtin_fmaf((ar_), (br_), __builtin_fmaf(-(ai_), (bi_), (cr_))); const float _i = __builtin_fmaf((ar_), (bi_), __builtin_fmaf((ai_), (br_), (ci_))); orr = _r; oi = _i; } while (0)
template <bool PASS2>
__device__ __forceinline__ void s5_item(const Args& A, LAS unsigned char* hs, int item, int lane) {
    unsigned char* ws = A.ws;
    const bf16* HN0 = (const bf16*)(ws + WS_HN0);
    const bool samp = item >= 2048;
    const int g = item & 63, ch = samp ? 128 + ((item - 2048) >> 6) : 4 * (item >> 6);
    const int s = lane & 31, hf = lane >> 5;
    bf16x8 Bf[4], Cf[4];
    { const bf16* BB = (const bf16*)(ws + WS_BBAR) + (size_t)g * 128 * 16;
#pragma unroll
      for (int n = 0; n < 4; ++n) Bf[n] = *(const bf16x8*)(BB + (32 * n + s) * 16 + 8 * hf);
      if (PASS2) { const bf16* CC = (const bf16*)(ws + WS_CC) + (size_t)g * 16 * 128;
#pragma unroll
        for (int st = 0; st < 4; ++st) Cf[st] = *(const bf16x8*)(CC + (lane & 15) * 128 + 32 * st + 8 * (lane >> 4)); } }
    const float* lam = (const float*)(ws + WS_LAM) + (size_t)g * 128;
    float lr[2], li[2], l16r[2], l16i[2], l128r[2], l128i[2];
#pragma unroll
    for (int j = 0; j < 2; ++j) { lr[j] = lam[(s + 32 * j) * 2]; li[j] = lam[(s + 32 * j) * 2 + 1];
        float pr = lr[j], pi = li[j];
#pragma unroll
        for (int q = 0; q < 4; ++q) { const float nr = pr * pr - pi * pi, ni = 2.f * pr * pi; pr = nr; pi = ni; }
        l16r[j] = pr; l16i[j] = pi;
#pragma unroll
        for (int q = 0; q < 3; ++q) { const float nr = pr * pr - pi * pi, ni = 2.f * pr * pi; pr = nr; pi = ni; }
        l128r[j] = pr; l128i[j] = pi; }
    float cr[2] = {0.f, 0.f}, ci[2] = {0.f, 0.f};
    const float* E = (const float*)(ws + WS_E);
    if (PASS2) {
        if (samp) { const int n = ch - 128;
#pragma unroll
            for (int j = 0; j < 2; ++j) { cr[j] = A.in[5][((size_t)n * 64 + g) * 64 + s + 32 * j]; ci[j] = A.in[6][((size_t)n * 64 + g) * 64 + s + 32 * j]; } }
        else { const int first = (ch >> 6) << 6;
#pragma unroll 8
            for (int jj = first; jj < ch; ++jj) { const float* e = E + ((size_t)jj * 64 + g) * 128;
#pragma unroll
                for (int j = 0; j < 2; ++j) { const float er = e[j * 32 + s], ei = e[64 + j * 32 + s]; CMUL_ADD(cr[j], ci[j], l128r[j], l128i[j], cr[j], ci[j], er, ei); } } }
    }
    const int nblk = samp ? 1 : 16;
    const int rowbase = samp ? NPROMPT + 4 * (ch - 128) : ch * 128;
    const int tokA = 16 * ((s >> 2) & 1) + 4 * (s >> 3) + (s & 3);
    const float* dsk = A.in[16] + g * 16;
    bf16* Y = (bf16*)(ws + WS_Y);
    bf16x8 afn = *(const bf16x8*)(HN0 + (size_t)(rowbase + tokA) * D + g * 16 + 8 * hf);
    const int uoff = (lane & 15) * D + g * 16 + 4 * (lane >> 4);
    u32x2 un[2];
    if (PASS2) {
#pragma unroll
        for (int q = 0; q < 2; ++q) un[q] = *(const u32x2*)(HN0 + (size_t)(rowbase + 16 * q) * D + uoff);
    }
    const f32x4 dk4 = *(const f32x4*)(dsk + 4 * (lane >> 4));
    for (int blk = 0; blk < nblk; ++blk) {
        const int row0 = rowbase + 32 * blk;
        const bf16x8 af = afn;
        u32x2 uc[2];
        if (PASS2) {
#pragma unroll
            for (int q = 0; q < 2; ++q) uc[q] = un[q];
            if (blk + 1 < nblk) {
#pragma unroll
                for (int q = 0; q < 2; ++q) un[q] = *(const u32x2*)(HN0 + (size_t)(row0 + 32 + 16 * q) * D + uoff);
            }
        }
        if (!PASS2 && (blk & 3) == 0) { cr[0] = 0.f; cr[1] = 0.f; ci[0] = 0.f; ci[1] = 0.f; }
        if (blk + 1 < nblk) afn = *(const bf16x8*)(HN0 + (size_t)(row0 + 32 + tokA) * D + g * 16 + 8 * hf);
        f32x16 X[4];
        const f32x16 z16 = {0.f, 0.f, 0.f, 0.f, 0.f, 0.f, 0.f, 0.f, 0.f, 0.f, 0.f, 0.f, 0.f, 0.f, 0.f, 0.f};
#pragma unroll
        for (int n = 0; n < 4; ++n) X[n] = __builtin_amdgcn_mfma_f32_32x32x16_bf16(af, Bf[n], z16, 0, 0, 0);
        float cinr[2], cini[2];
#pragma unroll
        for (int j = 0; j < 2; ++j) {
            float er = 0.f, ei = 0.f;
#pragma unroll
            for (int r = 0; r < 16; ++r) CMUL_ADD(er, ei, lr[j], li[j], er, ei, X[j][r], X[2 + j][r]);
            const float or_ = __shfl_xor(er, 32), oi_ = __shfl_xor(ei, 32);
            const float e0r = hf ? or_ : er, e0i = hf ? oi_ : ei, e1r = hf ? er : or_, e1i = hf ? ei : oi_;
            float mr, mi; CMUL_ADD(mr, mi, l16r[j], l16i[j], cr[j], ci[j], e0r, e0i);
            cinr[j] = hf ? mr : cr[j]; cini[j] = hf ? mi : ci[j];
            CMUL_ADD(cr[j], ci[j], l16r[j], l16i[j], mr, mi, e1r, e1i);
        }
        if (PASS2) {
#pragma unroll
            for (int j = 0; j < 2; ++j) {
                float hr = cinr[j], hi = cini[j];
#pragma unroll
                for (int r = 0; r < 16; ++r) { CMUL_ADD(hr, hi, lr[j], li[j], hr, hi, X[j][r], X[2 + j][r]);
                    X[j][r] = hr; X[2 + j][r] = hi; }
            }
            if (samp && hf == 0) { const int n = ch - 128;
#pragma unroll
                for (int j = 0; j < 2; ++j) { A.out[O_SRES + ((size_t)n * 64 + g) * 64 + s + 32 * j] = X[j][3]; A.out[O_SIMS + ((size_t)n * 64 + g) * 64 + s + 32 * j] = X[2 + j][3]; } }
#pragma unroll
            for (int r = 0; r < 16; ++r) { LAS unsigned short* hp = (LAS unsigned short*)(hs + (16 * hf + r) * 272);
                u32x2 w; w.x = pk2(X[0][r], X[1][r]); w.y = pk2(X[2][r], X[3][r]);
                *(LAS u32x2*)(hp + 4 * s) = w; }
            asm volatile("s_waitcnt lgkmcnt(0)" ::: "memory");
#pragma unroll
            for (int tb = 0; tb < 2; ++tb) {
                f32x4 y = {0.f, 0.f, 0.f, 0.f};
#pragma unroll
                for (int st = 0; st < 4; ++st) { const bf16x8 hfrag = *(const LAS bf16x8*)(hs + (16 * tb + (lane & 15)) * 272 + 64 * st + 16 * (lane >> 4));
                    y = __builtin_amdgcn_mfma_f32_16x16x32_bf16(Cf[st], hfrag, y, 0, 0, 0); }
                const int tk = 16 * tb + (lane & 15);
                if (!samp || tk < 4) {
                    const float u0 = __uint_as_float(uc[tb].x << 16), u1 = __uint_as_float(uc[tb].x & 0xffff0000u), u2 = __uint_as_float(uc[tb].y << 16), u3 = __uint_as_float(uc[tb].y & 0xffff0000u);
                    f32x4 v = {y[0] + dk4[0] * u0, y[1] + dk4[1] * u1, y[2] + dk4[2] * u2, y[3] + dk4[3] * u3};
                    float ge[4];
#pragma unroll
                    for (int j = 0; j < 4; ++j) { const float vv = v[j] * v[j]; const float ex = __builtin_amdgcn_exp2f(v[j] * __builtin_fmaf(vv, -0.10294324f, -2.30220820f)); ge[j] = v[j] * __builtin_amdgcn_rcpf(1.f + ex); }
                    u32x2 w; w.x = pk2(ge[0], ge[1]); w.y = pk2(ge[2], ge[3]);
                    *(u32x2*)(Y + (size_t)(row0 + tk) * D + g * 16 + 4 * (lane >> 4)) = w;
                }
            }
            asm volatile("s_waitcnt lgkmcnt(0)" ::: "memory");
        }
        if (!PASS2 && (blk & 3) == 3 && hf == 0) { float* e = (float*)(ws + WS_E) + ((size_t)(ch + (blk >> 2)) * 64 + g) * 128;
#pragma unroll
            for (int j = 0; j < 2; ++j) { e[j * 32 + s] = cr[j]; e[64 + j * 32 + s] = ci[j]; } }
    }
    if (PASS2 && !samp && hf == 0 && ((ch + 3) & 63) == 63) { const int b = ch >> 6;
#pragma unroll
        for (int j = 0; j < 2; ++j) { A.out[O_SREP + ((size_t)b * 64 + g) * 64 + s + 32 * j] = cr[j]; A.out[O_SIMP + ((size_t)b * 64 + g) * 64 + s + 32 * j] = ci[j]; } }
}

typedef short v4i16_t __attribute__((ext_vector_type(4)));
constexpr int KIMG_STRIDE = 144, KIMG_BYTES = 192 * KIMG_STRIDE, VIMG_HALF = 192 * 64, NATT_ITEMS = 3072;
struct AttItem { int g, sh, b, r, u0, kvh; };
__device__ __forceinline__ AttItem att_decode(int bi) {
    AttItem I; I.g = bi >> 10; const int rem = bi & 1023; I.kvh = rem & 3; I.b = (rem >> 2) & 1; const int rq = rem >> 3;
    I.sh = 2 * I.g; const int nqb = 128 >> I.sh; I.r = rq / nqb; I.u0 = 64 * (rq % nqb); return I;
}
template <bool COMBINE, int MODE = 0>
__device__ __forceinline__ void attn_prompt_phase(const Args& A, LAS unsigned char* lds, int tid, int wave, int lane, int item_lo, int item_hi) {
    unsigned char* ws = A.ws;
    const bf16* Q = (const bf16*)(ws + WS_Q); const bf16* KB = (const bf16*)(ws + WS_KB); const bf16* VB = (const bf16*)(ws + WS_VT);
    bf16* OG = (bf16*)(ws + WS_OG); float* LSE = (float*)(ws + WS_LSE);
    const int G = gridDim.x, hh = wave & 3, sub = wave >> 2, n = lane & 31, hf = lane >> 5;
    const int kap = (n & 3) + 4 * ((n >> 3) & 1) + 8 * ((n >> 2) & 1) + 16 * (n >> 4);
    int bi = item_lo + blockIdx.x;
    const int NATT_HI = item_hi;
    if (bi >= NATT_HI) return;
    bf16* AT = (bf16*)(ws + WS_ATT);
    u32x4 pk_[3], pv_[3]; bf16x8 qn[4];
#define ATT_ISSUE_KV(bix) do { const AttItem J = att_decode(bix); const int L_ = SEQ >> J.sh; const size_t pb_ = (size_t)J.g * MP + (size_t)J.b * SEQ + (size_t)J.r * L_; \
        _Pragma("unroll") for (int i = 0; i < 3; ++i) { const int c_ = tid + 512 * i, row_ = c_ >> 3, ch_ = c_ & 7; int u_ = J.u0 - 128 + row_; u_ = u_ < 0 ? 0 : u_; \
            pk_[i] = *(const u32x4*)(KB + (pb_ + u_) * 256 + J.kvh * 64 + 8 * ch_); pv_[i] = *(const u32x4*)(VB + (pb_ + u_) * 256 + J.kvh * 64 + 8 * ch_); } } while (0)
#define ATT_ISSUE_Q(bix) do { const AttItem J = att_decode(bix); const int qrow_ = J.b * SEQ + ((J.u0 + 32 * sub + n) << J.sh) + J.r; \
        _Pragma("unroll") for (int ks = 0; ks < 4; ++ks) qn[ks] = *(const bf16x8*)(Q + (size_t)qrow_ * QW + J.g * 1024 + (4 * J.kvh + hh) * 64 + 16 * ks + 8 * hf); } while (0)
#define ATT_WRITE(bufo) do { _Pragma("unroll") for (int i = 0; i < 3; ++i) { const int c = tid + 512 * i, row = c >> 3, ch = c & 7; \
            *(LAS u32x4*)(lds + (bufo) + row * KIMG_STRIDE + 16 * ch) = pk_[i]; \
            *(LAS u32x4*)(lds + (bufo) + KIMG_BYTES + (ch >> 2) * VIMG_HALF + row * 64 + (ch & 3) * 16) = pv_[i]; } } while (0)
    constexpr int ABUF = KIMG_BYTES + 2 * VIMG_HALF;
    bf16x8 qf[4];
    ATT_ISSUE_KV(bi); ATT_ISSUE_Q(bi);
    ATT_WRITE(0);
#pragma unroll
    for (int ks = 0; ks < 4; ++ks) qf[ks] = qn[ks];
    if (bi + G < NATT_HI) ATT_ISSUE_KV(bi + G);
    asm volatile("s_waitcnt lgkmcnt(0)\n\ts_barrier" ::: "memory");
    int par = 0;
    for (; bi < NATT_HI; bi += G, par ^= 1) {
        const AttItem I = att_decode(bi);
        if (bi + G < NATT_HI) { ATT_WRITE((par ^ 1) * ABUF); ATT_ISSUE_Q(bi + G); }
        if (bi + 2 * G < NATT_HI) ATT_ISSUE_KV(bi + 2 * G);
        const LAS unsigned char* lbuf = lds + par * ABUF;
        const int u0w = I.u0 + 32 * sub;
        const int qrow = I.b * SEQ + ((u0w + n) << I.sh) + I.r;
        const int h = 4 * I.kvh + hh;
        f32x16 O0, O1;
#pragma unroll
        for (int i = 0; i < 16; ++i) { O0[i] = 0.f; O1[i] = 0.f; }
        float mrun = -INFINITY, lrun = 0.f;
        const int cc_ = lane & 7, rr0_ = lane >> 3;
        bf16x8 x1[4], x2[4]; float l1 = 0.f, l2 = 0.f;
        if (COMBINE) {
            l1 = LSE[((size_t)1 * MP + qrow) * 16 + h]; l2 = LSE[((size_t)2 * MP + qrow) * 16 + h];
#pragma unroll
            for (int j = 0; j < 4; ++j) { const int qr_ = I.b * SEQ + ((u0w + rr0_ + 8 * j) << I.sh) + I.r;
                x1[j] = *(const bf16x8*)(OG + ((size_t)1 * MP + qr_) * D + h * 64 + 8 * cc_); x2[j] = *(const bf16x8*)(OG + ((size_t)2 * MP + qr_) * D + h * 64 + 8 * cc_); }
        }
        const int kt0 = (MODE == 1 || MODE == 3) ? 5 : (u0w >= 128 ? 0 : (128 - u0w) >> 5);
        const LAS unsigned char* kimg = lbuf + (32 * sub + kap) * KIMG_STRIDE + 16 * hf;
        const LAS unsigned char* vimg = lbuf + KIMG_BYTES + (32 * sub + 8 * hf + ((lane & 15) >> 2)) * 64 + (16 * ((lane >> 4) & 1) + 4 * (lane & 3)) * 2;
        for (int kt = kt0; kt < 5; ++kt) {
            bf16x8 kf[4], vf[2][2];
#pragma unroll
            for (int ks = 0; ks < 4; ++ks) kf[ks] = *(const LAS bf16x8*)(kimg + (32 * kt) * KIMG_STRIDE + 32 * ks);
#pragma unroll
            for (int mb = 0; mb < 2; ++mb)
#pragma unroll
                for (int st = 0; st < 2; ++st) {
                    const LAS unsigned char* vp = vimg + mb * VIMG_HALF + (32 * kt + 16 * st) * 64;
                    const v4i16_t lo = __builtin_amdgcn_ds_read_tr16_b64_v4i16((LAS v4i16_t*)vp);
                    const v4i16_t hi = __builtin_amdgcn_ds_read_tr16_b64_v4i16((LAS v4i16_t*)(vp + 4 * 64));
                    vf[mb][st] = (bf16x8){lo[0], lo[1], lo[2], lo[3], hi[0], hi[1], hi[2], hi[3]};
                }
            f32x16 S;
#pragma unroll
            for (int i = 0; i < 16; ++i) S[i] = 0.f;
#pragma unroll
            for (int ks = 0; ks < 4; ++ks) S = __builtin_amdgcn_mfma_f32_32x32x16_bf16(kf[ks], qf[ks], S, 0, 0, 0);
            if (kt == 0) {
#pragma unroll
                for (int rr = 0; rr < 16; ++rr) { const int kp = (rr & 7) + 8 * hf + 16 * (rr >> 3); if (kp < n) S[rr] = -INFINITY; }
            } else if (kt == 4) {
#pragma unroll
                for (int rr = 0; rr < 16; ++rr) { const int kp = (rr & 7) + 8 * hf + 16 * (rr >> 3); if (kp > n) S[rr] = -INFINITY; }
            }
            float tm = S[0];
#pragma unroll
            for (int rr = 1; rr < 16; ++rr) tm = fmaxf(tm, S[rr]);
            tm = fmaxf(tm, __shfl_xor(tm, 32));
            const float mnew = fmaxf(mrun, tm);
            const float alpha = __builtin_amdgcn_exp2f(mrun - mnew);
            float ps = 0.f; float p[16];
#pragma unroll
            for (int rr = 0; rr < 16; ++rr) { p[rr] = __builtin_amdgcn_exp2f(S[rr] - mnew); ps += p[rr]; }
            lrun = lrun * alpha + ps; mrun = mnew;
            if (__builtin_amdgcn_ballot_w64(alpha != 1.f) != 0ull) {
#pragma unroll
                for (int i = 0; i < 16; ++i) { O0[i] *= alpha; O1[i] *= alpha; }
            }
#pragma unroll
            for (int st = 0; st < 2; ++st) {
                u32x4 pw; pw.x = pk2(p[8 * st + 0], p[8 * st + 1]); pw.y = pk2(p[8 * st + 2], p[8 * st + 3]); pw.z = pk2(p[8 * st + 4], p[8 * st + 5]); pw.w = pk2(p[8 * st + 6], p[8 * st + 7]);
                const bf16x8 pf = __builtin_bit_cast(bf16x8, pw);
                O0 = __builtin_amdgcn_mfma_f32_32x32x16_bf16(vf[0][st], pf, O0, 0, 0, 0);
                O1 = __builtin_amdgcn_mfma_f32_32x32x16_bf16(vf[1][st], pf, O1, 0, 0, 0);
            }
        }
        const float ltot = lrun + __shfl_xor(lrun, 32);
        LAS unsigned char* ost = lds + 2 * ABUF + wave * 4864;
        float sc0;
        if (!COMBINE) { sc0 = 1.f / ltot; if (hf == 0) LSE[((size_t)I.g * MP + qrow) * 16 + h] = mrun + log2f(ltot); }
        else { const float l0 = mrun + log2f(ltot); const float mx = fmaxf(l0, fmaxf(l1, l2));
            const float w0 = __builtin_amdgcn_exp2f(l0 - mx), w1 = __builtin_amdgcn_exp2f(l1 - mx), w2 = __builtin_amdgcn_exp2f(l2 - mx);
            const float invw = 1.f / (w0 + w1 + w2); sc0 = w0 * invw / ltot;
            if (hf == 0) { LAS float* wp = (LAS float*)(ost + 4608) + 2 * n; wp[0] = w1 * invw; wp[1] = w2 * invw; } }
        if (MODE < 2) {
#pragma unroll
            for (int a = 0; a < 4; ++a) {
                u32x2 w0v, w1v; w0v.x = pk2(O0[4 * a] * sc0, O0[4 * a + 1] * sc0); w0v.y = pk2(O0[4 * a + 2] * sc0, O0[4 * a + 3] * sc0);
                w1v.x = pk2(O1[4 * a] * sc0, O1[4 * a + 1] * sc0); w1v.y = pk2(O1[4 * a + 2] * sc0, O1[4 * a + 3] * sc0);
                *(LAS u32x2*)(ost + n * 144 + (8 * a + 4 * hf) * 2) = w0v; *(LAS u32x2*)(ost + n * 144 + 64 + (8 * a + 4 * hf) * 2) = w1v;
            }
            asm volatile("s_waitcnt lgkmcnt(0)" ::: "memory");
#pragma unroll
            for (int j = 0; j < 4; ++j) { const int rr_ = rr0_ + 8 * j; const int qr_ = I.b * SEQ + ((u0w + rr_) << I.sh) + I.r;
                const bf16x8 tv = *(const LAS bf16x8*)(ost + rr_ * 144 + 16 * cc_);
                if (!COMBINE) *(bf16x8*)(OG + ((size_t)I.g * MP + qr_) * D + h * 64 + 8 * cc_) = tv;
                else { const LAS float* wp = (const LAS float*)(ost + 4608) + 2 * rr_; const float w1 = wp[0], w2 = wp[1];
                    float o[8];
#pragma unroll
                    for (int i = 0; i < 8; ++i) o[i] = bf2f((unsigned short)tv[i]) + w1 * bf2f((unsigned short)x1[j][i]) + w2 * bf2f((unsigned short)x2[j][i]);
                    u32x4 y; y.x = pk2(o[0], o[1]); y.y = pk2(o[2], o[3]); y.z = pk2(o[4], o[5]); y.w = pk2(o[6], o[7]);
                    *(u32x4*)(AT + (size_t)qr_ * D + h * 64 + 8 * cc_) = y; }
            }
        } else { if (ltot == 123.456f) LSE[0] = ltot; }
#pragma unroll
        for (int ks = 0; ks < 4; ++ks) qf[ks] = qn[ks];
        asm volatile("s_waitcnt lgkmcnt(0)\n\ts_barrier" ::: "memory");
    }
#undef ATT_ISSUE_KV
#undef ATT_ISSUE_Q
#undef ATT_WRITE
}

__device__ __forceinline__ void attn_sample_item(const Args& A, LAS float* sl, int it, int lane) {
    unsigned char* ws = A.ws;
    const int h = it & 15, t = (it >> 4) & 3, n = it >> 6, kvh = h >> 2;
    const int row = NPROMPT + 4 * n + t;
    const bf16* Q = (const bf16*)(ws + WS_Q) + (size_t)row * QW + h * 64;
    const int kq = lane >> 2, dq = lane & 3;
    float mxl = -INFINITY;
#pragma unroll 1
    for (int g = 0; g < 3; ++g) {
        const int W = 128 << (2 * g), dil = 1 << (2 * g);
        const float* cache = A.in[2 + g] + (size_t)n * W * 512;
        const float* newkv = A.out + (g == 0 ? O_KVS0 : g == 1 ? O_KVS1 : O_KVS2) + (size_t)n * 4 * 512;
        float q[16];
#pragma unroll
        for (int c8 = 0; c8 < 2; ++c8) { const bf16x8 v = *(const bf16x8*)(Q + g * 1024 + 16 * dq + 8 * c8);
#pragma unroll
            for (int i = 0; i < 8; ++i) q[8 * c8 + i] = bf2f((unsigned short)v[i]); }
#pragma unroll 9
        for (int bt = 0; bt < 9; ++bt) {
            const int j = 16 * bt + kq; const bool valid = j <= 128; const int jj = valid ? j : 128;
            const int idx = W + t - dil * jj;
            const float* kp = (idx >= W ? newkv + (size_t)(idx - W) * 512 : cache + (size_t)idx * 512) + kvh * 64 + 16 * dq;
            float s = 0.f;
#pragma unroll
            for (int c4 = 0; c4 < 4; ++c4) { const f32x4 kv = *(const f32x4*)(kp + 4 * c4); s += q[4 * c4] * kv[0] + q[4 * c4 + 1] * kv[1] + q[4 * c4 + 2] * kv[2] + q[4 * c4 + 3] * kv[3]; }
            s += __shfl_xor(s, 1); s += __shfl_xor(s, 2);
            if (valid && dq == 0) sl[g * 132 + j] = s;
            mxl = fmaxf(mxl, valid ? s : -INFINITY);
        }
    }
    const float mx = wave_max(mxl);
    asm volatile("s_waitcnt lgkmcnt(0)" ::: "memory");
    float sum = 0.f;
#pragma unroll 1
    for (int i = lane; i < 396; i += 64) { const int j = i % 132; if (j <= 128) { const float p = exp2f(sl[i] - mx); sl[i] = p; sum += p; } }
    sum = wave_sum(sum);
    asm volatile("s_waitcnt lgkmcnt(0)" ::: "memory");
    f32x4 acc = {0.f, 0.f, 0.f, 0.f};
    const int ksl = lane >> 4, dq4 = lane & 15;
#pragma unroll 1
    for (int g = 0; g < 3; ++g) {
        const int W = 128 << (2 * g), dil = 1 << (2 * g);
        const float* cache = A.in[2 + g] + (size_t)n * W * 512;
        const float* newkv = A.out + (g == 0 ? O_KVS0 : g == 1 ? O_KVS1 : O_KVS2) + (size_t)n * 4 * 512;
#pragma unroll 33
        for (int jb = 0; jb < 33; ++jb) {
            const int j = 4 * jb + ksl; const bool valid = j <= 128; const int jj = valid ? j : 128;
            const int idx = W + t - dil * jj;
            const float* vp = (idx >= W ? newkv + (size_t)(idx - W) * 512 : cache + (size_t)idx * 512) + 256 + kvh * 64 + 4 * dq4;
            const f32x4 v = *(const f32x4*)vp;
            const float pj = valid ? sl[g * 132 + jj] : 0.f;
            acc += v * pj;
        }
    }
#pragma unroll
    for (int i = 0; i < 4; ++i) { acc[i] += __shfl_xor(acc[i], 16); acc[i] += __shfl_xor(acc[i], 32); }
    bf16* AT = (bf16*)(ws + WS_ATT);
    if (lane < 16) { const float inv = 1.f / sum; u32x2 w; w.x = pk2(acc[0] * inv, acc[1] * inv); w.y = pk2(acc[2] * inv, acc[3] * inv);
        *(u32x2*)(AT + (size_t)row * D + h * 64 + 4 * dq4) = w; }
    asm volatile("s_waitcnt lgkmcnt(0)" ::: "memory");
}

__device__ __forceinline__ void attn_combine(const Args& A, int gt, int NGT) {
    unsigned char* ws = A.ws;
    const bf16* OG = (const bf16*)(ws + WS_OG); const float* LSE = (const float*)(ws + WS_LSE); bf16* AT = (bf16*)(ws + WS_ATT);
    for (int i = gt; i < NPROMPT * 128; i += NGT) {
        const int row = i >> 7, c8 = i & 127, h = c8 >> 3;
        const float l0 = LSE[((size_t)0 * MP + row) * 16 + h], l1 = LSE[((size_t)1 * MP + row) * 16 + h], l2 = LSE[((size_t)2 * MP + row) * 16 + h];
        const float mx = fmaxf(l0, fmaxf(l1, l2));
        float w0 = exp2f(l0 - mx), w1 = exp2f(l1 - mx), w2 = exp2f(l2 - mx); const float inv = 1.f / (w0 + w1 + w2); w0 *= inv; w1 *= inv; w2 *= inv;
        const bf16x8 a = *(const bf16x8*)(OG + ((size_t)0 * MP + row) * D + 8 * c8), b = *(const bf16x8*)(OG + ((size_t)1 * MP + row) * D + 8 * c8), c = *(const bf16x8*)(OG + ((size_t)2 * MP + row) * D + 8 * c8);
        float o[8];
#pragma unroll
        for (int k = 0; k < 8; ++k) o[k] = w0 * bf2f((unsigned short)a[k]) + w1 * bf2f((unsigned short)b[k]) + w2 * bf2f((unsigned short)c[k]);
        u32x4 w; w.x = pk2(o[0], o[1]); w.y = pk2(o[2], o[3]); w.z = pk2(o[4], o[5]); w.w = pk2(o[6], o[7]);
        *(u32x4*)(AT + (size_t)row * D + 8 * c8) = w;
    }
}

#define XB_TMO      128
#define XB_XCNT(j)  (256  + 64 * (j))
#define XB_XSUB(j)  (1280 + 64 * (j))
#define XB_XGEN(j)  (2304 + 64 * (j))
#define XB_TOP      3328
#define XB_TOPGEN   3392
#define XCD_BAR_WORDS 3456
#define XB_SPIN_CAP (1u << 18)

__device__ __forceinline__ unsigned xb_ld(unsigned* p)              { return __hip_atomic_load(p, __ATOMIC_RELAXED, __HIP_MEMORY_SCOPE_AGENT); }
__device__ __forceinline__ unsigned xb_add(unsigned* p, unsigned v) { return __hip_atomic_fetch_add(p, v, __ATOMIC_RELAXED, __HIP_MEMORY_SCOPE_AGENT); }
__device__ __forceinline__ unsigned xb_xcc_id() { return (unsigned)__builtin_amdgcn_s_getreg((3 << 11) | 20) & 0xFu; }
#define XB_SPIN(cond, bar) do { unsigned _sp = 0; while (cond) { __builtin_amdgcn_s_sleep(1); \
    if ((++_sp & 255u) == 0u) { if (xb_ld(&(bar)[XB_TMO])) break; if (_sp > XB_SPIN_CAP) { atomicAdd(&(bar)[XB_TMO], 1u); break; } } } } while (0)

struct XcdBarrier {
    unsigned* bar; unsigned x;
    volatile LAS unsigned* st;
};

__device__ __forceinline__ XcdBarrier xcd_barrier_post(unsigned* bar, volatile LAS unsigned* st) {
    XcdBarrier b; b.bar = bar; b.x = xb_xcc_id(); b.st = st;
    if (threadIdx.x == 0) (void)xb_add(&bar[XB_XCNT(b.x)], 1u);
    return b;
}
__device__ __forceinline__ void xcd_barrier_complete(unsigned* bar, unsigned x, unsigned& nloc, unsigned& nx) {
    const unsigned G = gridDim.x * gridDim.y * gridDim.z;
    unsigned sum, cnt, mine, sp = 0u;
    for (;;) {
        sum = 0u; cnt = 0u; mine = 0u;
#pragma unroll
        for (unsigned j = 0; j < 16; ++j) { const unsigned c = xb_ld(&bar[XB_XCNT(j)]); sum += c; cnt += (c > 0u) ? 1u : 0u; mine = (j == x) ? c : mine; }
        if (sum == G) break;
        __builtin_amdgcn_s_sleep(1);
        if ((++sp & 255u) == 0u) { if (xb_ld(&bar[XB_TMO])) break; if (sp > XB_SPIN_CAP) { atomicAdd(&bar[XB_TMO], 1u); break; } }
    }
    nloc = mine > 0u ? mine : 1u; nx = cnt > 0u ? cnt : 1u;
}

__device__ __forceinline__ void xcd_barrier(const XcdBarrier& b) {
    asm volatile("s_waitcnt vmcnt(0)" ::: "memory");
    __syncthreads();
    if (threadIdx.x == 0) {
        unsigned* bar = b.bar;
        __builtin_amdgcn_s_waitcnt(0);
        unsigned nloc = b.st[0], nx = b.st[1];
        if (nloc == 0u) { xcd_barrier_complete(bar, b.x, nloc, nx); b.st[0] = nloc; b.st[1] = nx; }
        const unsigned old = xb_add(&bar[XB_XSUB(b.x)], 1u);
        const unsigned gen = old / nloc;
        if (old + 1u == (gen + 1u) * nloc) {
            __builtin_amdgcn_fence(__ATOMIC_RELEASE, "agent");
            asm volatile("s_waitcnt vmcnt(0)" ::: "memory");
            const unsigned og = xb_add(&bar[XB_TOP], 1u);
            const unsigned tg = og / nx;
            if (og + 1u == (tg + 1u) * nx) xb_add(&bar[XB_TOPGEN], 1u);
            else XB_SPIN(xb_ld(&bar[XB_TOPGEN]) == tg, bar);
            __builtin_amdgcn_fence(__ATOMIC_ACQUIRE, "agent");
            xb_add(&bar[XB_XGEN(b.x)], 1u);
            asm volatile("s_waitcnt vmcnt(0)" ::: "memory");
        } else {
            XB_SPIN(xb_ld(&bar[XB_XGEN(b.x)]) == gen, bar);
            __builtin_amdgcn_fence(__ATOMIC_ACQUIRE, "agent");
            asm volatile("s_waitcnt vmcnt(0)" ::: "memory");
        }
    }
    __syncthreads();
}

constexpr int NPHASE = 13;
#ifndef REP0
#define REP0 1
#endif
#ifndef REP12
#define REP12 1
#endif
#ifndef REP7
#define REP7 1
#endif
#ifndef REP8
#define REP8 1
#endif
#ifndef REP4
#define REP4 1
#endif
#ifndef REP6
#define REP6 1
#endif
#ifndef DUP4
#define DUP4 0
#endif
#ifndef DUP6
#define DUP6 0
#endif
#ifndef DUP5
#define DUP5 0
#endif
#ifndef PROBE8
#define PROBE8 0
#endif
#ifndef XSYNC
#define XSYNC 0
#endif
__global__ void __launch_bounds__(NTHREADS, 2) yoco_fwd(Args A) {
    extern __shared__ __attribute__((aligned(16))) unsigned char lds_raw[];
    LAS unsigned char* lds = (LAS unsigned char*)lds_raw;
    cg::grid_group grid = cg::this_grid();
    const int tid = threadIdx.x, lane = tid & 63, wave = __builtin_amdgcn_readfirstlane(tid >> 6);
    const int G = gridDim.x, gw = blockIdx.x * NWAVES + wave, NGW = G * NWAVES, gt = gw * 64 + lane, NGT = NGW * 64;
    unsigned char* ws = A.ws;
    float* rowss = (float*)(ws + WS_ROWSS);
    float* Hf = (float*)(ws + WS_H); bf16* HB = (bf16*)(ws + WS_HB);
    const int lo = A.ph_lo, hi = A.ph_hi;
    volatile LAS unsigned* bst = (volatile LAS unsigned*)(lds + LDS_BYTES - 64);
    if (tid < 2) bst[tid] = 0u;
    __syncthreads();
    XcdBarrier xbar = xcd_barrier_post((unsigned*)(ws + WS_BAR), bst);
    if (lo < 0) grid.sync();
#ifndef PH_MASK
#define PH_MASK 0xffff
#endif
#define IN(k) (((PH_MASK >> (k)) & 1) && lo <= (k) && (k) < hi)
#define SEAM(k) do { if (IN(k) && IN((k) + 1)) xcd_barrier(xbar); } while (0)
    if (IN(0)) { for (int rp = 0; rp < REP0; ++rp) phase_prologue(A, lds, gw, NGW, wave, lane); for (int rp = 0; rp < XSYNC; ++rp) xcd_barrier(xbar); }
    SEAM(0);
    if (IN(1)) for (int rp = 0; rp < REP12; ++rp) { for (int it = gw; it < 2048; it += NGW) s5_item<false>(A, lds + wave * 8704, it, lane); }
    SEAM(1);
    if (IN(2)) for (int rp = 0; rp < REP12; ++rp) { for (int it = gw; it < 4096; it += NGW) s5_item<true>(A, lds + wave * 8704, it, lane); }
    SEAM(2);
    if (IN(3)) { pg8::Gemm g{(const bf16*)(ws + WS_Y), (const bf16*)(ws + W_GLU), NPROMPT, 2048, 1024}; pg8::StaticOrder S; S.init(NPROMPT, 2048, G, (int)blockIdx.x);
        EpiGlu E{A.in[0], A.in[1], Hf, HB, rowss};
        pg8::gemm_phase<EpiGlu, pg8::StaticOrder, true, true>(lds, g, S, E);
        skinny_phase(lds, g.A, g.Bt, 2048, 1024, E, 0, wave, lane); }
    SEAM(3);
    if (IN(4)) { pg8::Gemm g{HB, (const bf16*)(ws + W_UP0), NPROMPT, FF, 1024}; pg8::StaticOrder S; S.init(NPROMPT, FF, G, (int)blockIdx.x);
        EpiUp E{(bf16*)(ws + WS_ACT), rowss};
        pg8::gemm_phase<EpiUp, pg8::StaticOrder, true, true>(lds, g, S, E);
        skinny_phase(lds, g.A, g.Bt, FF, 1024, E, 0, wave, lane);
#if DUP4 == 1
        pg8::gemm_phase<EpiUp, pg8::StaticOrder, true, true>(lds, g, S, E);
#endif
#if DUP4 == 3
        { EpiNull E0{(float*)(ws + WS_OG)};
        skinny_phase(lds, g.A, g.Bt, FF, 1024, E0, 0, wave, lane); skinny_phase(lds, g.A, g.Bt, FF, 1024, E0, 0, wave, lane);
        skinny_phase(lds, g.A, g.Bt, FF, 1024, E0, 0, wave, lane); skinny_phase(lds, g.A, g.Bt, FF, 1024, E0, 0, wave, lane); }
#endif
#if DUP4 == 2
        skinny_phase(lds, g.A, g.Bt, FF, 1024, E, 0, wave, lane);
        skinny_phase(lds, g.A, g.Bt, FF, 1024, E, 0, wave, lane);
        skinny_phase(lds, g.A, g.Bt, FF, 1024, E, 0, wave, lane);
        skinny_phase(lds, g.A, g.Bt, FF, 1024, E, 0, wave, lane);
#endif
    }
    SEAM(4);
    if (IN(5)) { pg8::Gemm g{(const bf16*)(ws + WS_ACT), (const bf16*)(ws + W_DN0), NPROMPT, 1024, FF}; pg8::StaticOrder S; S.init(NPROMPT, 1024, G, (int)blockIdx.x);
        EpiRes E{HB, nullptr, rowss + MP};
        pg8::gemm_phase<EpiRes, pg8::StaticOrder, true, true>(lds, g, S, E);
        skinny_phase(lds, g.A, g.Bt, 1024, FF, E, 0, wave, lane);
#if DUP5 == 2
        { EpiUp E2{(bf16*)(ws + WS_OG), rowss}; pg8::gemm_phase<EpiUp, pg8::StaticOrder, true, true>(lds, g, S, E2); }
#endif
    }
    SEAM(5);
    if (IN(6)) { pg8::Gemm g{HB, (const bf16*)(ws + W_QKV), NPROMPT, NQKV, 1024}; pg8::StaticOrder S; S.init(NPROMPT, NQKV, G, (int)blockIdx.x);
        EpiQKV E{(bf16*)(ws + WS_Q), (bf16*)(ws + WS_KB), (bf16*)(ws + WS_VT), A.out, rowss + MP, (const float*)(ws + WS_ROPE), (const float*)(ws + WS_ROPE) + 8196 * 32, (const float*)(ws + WS_ROPE) + 2 * 8196 * 32, (const float*)(ws + WS_ROPE) + 2 * 8196 * 32 + 8 * 32};
        pg8::gemm_phase<EpiQKV, pg8::StaticOrder, true, true>(lds, g, S, E);
        skinny_phase(lds, g.A, g.Bt, NQKV, 1024, E, G >= 256 ? 128 : 0, wave, lane);
        { const int cf = G >= 256 ? 128 : 0; if ((int)blockIdx.x >= cf) convert_late(A, lds, ((int)blockIdx.x - cf) * NWAVES + wave, (G - cf) * NWAVES, wave, lane); }
#if DUP6 == 1
        pg8::gemm_phase<EpiQKV, pg8::StaticOrder, true, true>(lds, g, S, E);
#endif
#if DUP6 == 2
        { EpiUp E2{(bf16*)(ws + WS_OG), rowss + MP}; pg8::gemm_phase<EpiUp, pg8::StaticOrder, true, true>(lds, g, S, E2); }
#endif
    }
    SEAM(6);
    if (IN(7)) for (int rp = 0; rp < REP7; ++rp) {
        for (int it = gw; it < 2048; it += NGW) attn_sample_item(A, (LAS float*)(lds + 65536 + wave * 2048), it, lane);
        __syncthreads();
        attn_prompt_phase<false>(A, lds, tid, wave, lane, 1024, NATT_ITEMS);
    }
    SEAM(7);
    if (IN(8)) {
#if PROBE8 > 0
        attn_prompt_phase<true, PROBE8>(A, lds, tid, wave, lane, 0, 1024); __syncthreads();
#endif
        attn_prompt_phase<true>(A, lds, tid, wave, lane, 0, 1024); }
    SEAM(8);
    if (IN(9)) { pg8::Gemm g{(const bf16*)(ws + WS_ATT), (const bf16*)(ws + W_O), NPROMPT, 1024, 1024}; pg8::StaticOrder S; S.init(NPROMPT, 1024, G, (int)blockIdx.x);
        EpiRes E{HB, nullptr, rowss + 2 * MP};
        pg8::gemm_phase<EpiRes, pg8::StaticOrder, true, true>(lds, g, S, E);
        skinny_phase(lds, g.A, g.Bt, 1024, 1024, E, 0, wave, lane); }
    SEAM(9);
    if (IN(10)) { pg8::Gemm g{HB, (const bf16*)(ws + W_UP1), NPROMPT, FF, 1024}; pg8::StaticOrder S; S.init(NPROMPT, FF, G, (int)blockIdx.x);
        EpiUp E{(bf16*)(ws + WS_ACT), rowss + 2 * MP};
        pg8::gemm_phase<EpiUp, pg8::StaticOrder, true, true>(lds, g, S, E);
        skinny_phase(lds, g.A, g.Bt, FF, 1024, E, 0, wave, lane); }
    SEAM(10);
    if (IN(11)) { pg8::Gemm g{(const bf16*)(ws + WS_ACT), (const bf16*)(ws + W_DN1), NPROMPT, 1024, FF}; pg8::StaticOrder S; S.init(NPROMPT, 1024, G, (int)blockIdx.x);
        EpiRes E{HB, nullptr, rowss + 3 * MP};
        pg8::gemm_phase<EpiRes, pg8::StaticOrder, true, true>(lds, g, S, E);
        skinny_phase(lds, g.A, g.Bt, 1024, FF, E, 0, wave, lane); }
    SEAM(11);
    if (IN(12)) {
        const float* gfin = A.in[24];
        for (int row0 = 4 * gw; row0 < MREAL; row0 += 4 * NGW) {
            bf16x8 hv[4][2]; float rs[4];
#pragma unroll
            for (int q = 0; q < 4; ++q) { rs[q] = rowss[3 * MP + row0 + q];
#pragma unroll
                for (int j = 0; j < 2; ++j) hv[q][j] = *((const bf16x8*)(HB + (size_t)(row0 + q) * D) + lane + 64 * j); }
#pragma unroll
            for (int j = 0; j < 2; ++j) { const f32x4 g0 = *((const f32x4*)gfin + 2 * (lane + 64 * j)), g1 = *((const f32x4*)gfin + 2 * (lane + 64 * j) + 1);
#pragma unroll
                for (int q = 0; q < 4; ++q) { const float rstd = __builtin_amdgcn_rsqf(rs[q] * (1.f / D) + EPS); float* orow = A.out + (size_t)(row0 + q) * D;
                    f32x4 o0, o1;
#pragma unroll
                    for (int i = 0; i < 4; ++i) { o0[i] = bf2f((unsigned short)hv[q][j][i]) * rstd * g0[i]; o1[i] = bf2f((unsigned short)hv[q][j][4 + i]) * rstd * g1[i]; }
                    *((f32x4*)orow + 2 * (lane + 64 * j)) = o0; *((f32x4*)orow + 2 * (lane + 64 * j) + 1) = o1; } }
        }
    }
#undef IN
#undef SEAM
}

#ifndef N_LAUNCHES
#define N_LAUNCHES 1
#endif
extern "C" void kernel_launch(void* const* d_in, const int* in_sizes, int n_in, void* d_out, int out_size, void* d_ws, size_t ws_size, hipStream_t stream) {
    static int grid = 0;
    if (grid == 0) {
        if (n_in != 25 || ws_size < WS_END) { fprintf(stderr, "kernel_launch: unexpected n_in %d / ws %zu\n", n_in, ws_size); grid = -1; return; }
        int dev = 0, cus = 0, per_cu = 0;
        hipGetDevice(&dev); hipDeviceGetAttribute(&cus, hipDeviceAttributeMultiprocessorCount, dev);
        if (hipFuncSetAttribute((const void*)yoco_fwd, hipFuncAttributeMaxDynamicSharedMemorySize, LDS_BYTES) != hipSuccess) { fprintf(stderr, "hipFuncSetAttribute failed\n"); grid = -1; return; }
        hipOccupancyMaxActiveBlocksPerMultiprocessor(&per_cu, (const void*)yoco_fwd, NTHREADS, LDS_BYTES);
        (void)hipGetLastError();
        if (per_cu < 1) per_cu = 1;
        grid = cus * per_cu;
    }
    if (grid < 0) return;
    Args a{};
    for (int i = 0; i < 25; ++i) a.in[i] = (const float*)d_in[i];
    a.out = (float*)d_out; a.ws = (unsigned char*)d_ws;
    if (hipMemsetAsync((char*)d_ws + WS_BAR, 0, 16384, stream) != hipSuccess) { fprintf(stderr, "memset failed\n"); return; }
    if (N_LAUNCHES == 1) {
        a.ph_lo = 0; a.ph_hi = NPHASE;
        void* args[] = {&a};
        hipError_t e = hipLaunchCooperativeKernel((const void*)yoco_fwd, dim3(grid), dim3(NTHREADS), args, LDS_BYTES, stream);
        if (e != hipSuccess) fprintf(stderr, "cooperative launch failed: %s (grid %d)\n", hipGetErrorString(e), grid);
    } else {
        for (int p = 0; p < NPHASE; ++p) { a.ph_lo = p; a.ph_hi = p + 1; hipLaunchKernelGGL(yoco_fwd, dim3(grid), dim3(NTHREADS), LDS_BYTES, stream, a); }
    }
}
```

```cpp
#include <hip/hip_runtime.h>
#include <hip/hip_cooperative_groups.h>
#include <cstdio>
#include <cstdint>
#include <cmath>
namespace cg = cooperative_groups;
namespace pg8 {
#define PG8_LAS __attribute__((address_space(3)))
typedef unsigned short bf16_t;
typedef short bf16x8 __attribute__((ext_vector_type(8)));
typedef float f32x4 __attribute__((ext_vector_type(4)));
typedef unsigned u32x4 __attribute__((ext_vector_type(4)));
constexpr int BM = 256, BK = 64, HALF = 128, HTB = HALF * BK * 2  , STAGE_BYTES = 8 * HTB, NXCD = 8, WGM = 8;

__host__ __device__ __forceinline__ int lds_byte(int r, int c) { const int st = (r >> 4) * 2 + (c >> 5), rr = r & 15, cc = c & 31, ob = rr * 64 + cc * 2; return st * 1024 + (ob ^ (((ob >> 9) & 1) << 5)); }
__host__ __device__ __forceinline__ void stage_rc(int b, int& R, int& C) { const int st = b / 1024, sb = b % 1024, swz = sb ^ (((sb >> 9) & 1) << 5); R = (st >> 1) * 16 + swz / 64; C = (st & 1) * 32 + (swz % 64) / 2; }
__host__ __device__ __forceinline__ int perm32(int rho) { const int n = rho >> 4, i = rho & 15; return 8 * (i >> 2) + 4 * n + (i & 3); }

struct Unit { int pm, pn; };
struct Gemm { const bf16_t* A; const bf16_t* Bt; int M, N, K; };

struct StaticOrder {
    int nM, nN, nwg, G, c;
    __host__ __device__ void init(int M, int N, int G_, int c_) { nM = M / BM; nN = N / BM; nwg = nM * nN; G = G_; c = c_; }
    __host__ __device__ bool next(int i, Unit& u) const {
        const long L = (long)i * G + c; if (L >= nwg) return false;
        int wgid = (int)L; { const int q = nwg / NXCD, r = nwg % NXCD, xcd = wgid % NXCD, off = wgid / NXCD; wgid = (xcd < r ? xcd * (q + 1) : r * (q + 1) + (xcd - r) * q) + off; }
        const int nig = WGM * nN, gid = wgid / nig, fm = gid * WGM, gsz = (nM - fm) < WGM ? (nM - fm) : WGM;
        u.pm = fm + ((wgid % nig) % gsz); u.pn = (wgid % nig) / gsz; return true;
    }
    __device__ __forceinline__ void a_ready(const Unit&) const {}
    __device__ __forceinline__ void done(const Unit&) const {}
};

__device__ __forceinline__ unsigned cvt_pk_bf16(float lo, float hi) { unsigned r; asm volatile("v_cvt_pk_bf16_f32 %0, %1, %2" : "=v"(r) : "v"(lo), "v"(hi)); return r; }
typedef float f32x2 __attribute__((ext_vector_type(2)));
__device__ __forceinline__ f32x2 gelu_pk(f32x2 v) {
    const f32x2 av = __builtin_elementwise_abs(v), d = av * 0.2316418882f + 1.0f;
    f32x2 t; t.x = __builtin_amdgcn_rcpf(d.x); t.y = __builtin_amdgcn_rcpf(d.y);
    f32x2 q = t * 0.5307027145f + (-0.7265760135f); q = q * t + 0.7107068705f; q = q * t + (-0.142248368f); q = q * t + 0.127414796f; q = q * t;
    const f32x2 s = (v * v) * (-0.72134752044f);
    f32x2 e; e.x = __builtin_amdgcn_exp2f(s.x); e.y = __builtin_amdgcn_exp2f(s.y);
    const f32x2 m = v * (q * e), r = v - m;
    f32x2 o; o.x = v.x < 0.f ? m.x : r.x; o.y = v.y < 0.f ? m.y : r.y; return o;
}


template <class Epi, class Sched, bool ALIGN_EPI = false, bool SP2 = false>
__device__ __forceinline__ void gemm_phase(PG8_LAS unsigned char* lds, const Gemm g, const Sched& S, const Epi& E) {
    const int tid = threadIdx.x, wid = __builtin_amdgcn_readfirstlane(tid >> 6), lane = tid & 63, wr = wid >> 2, wc = wid & 3, fr = lane & 15, fq = lane >> 4;
    const int K = g.K, nt = K / BK;
    unsigned voffA[2], voffB[2];
#pragma unroll
    for (int i = 0; i < 2; ++i) { int R, C; stage_rc(tid * 16 + i * 8192, R, C); const int Rb = Epi::PERM ? ((R & ~31) + perm32(R & 31)) : R;
        voffA[i] = (unsigned)(R * K + C) * 2u; voffB[i] = (unsigned)(Rb * K + C) * 2u; }
    const size_t kstep = (size_t)(BK * 2);
    const size_t hstep = (size_t)HALF * K * 2;
    const size_t tstep = 2 * hstep;
    const unsigned ldsw = (unsigned)wid * 1024u;
    const int aoff = lds_byte(wr * 64 + fr, fq * 8), boff = lds_byte(wc * 32 + fr, fq * 8);
#define PG8_SA(b, h) (((b) * 2 + (h)) * HTB)
#define PG8_SB(b, h) ((4 + (b) * 2 + (h)) * HTB)
#define PG8_STAGE(bufoff, gbase, voff) do { _Pragma("unroll") for (int _i = 0; _i < 2; ++_i) \
        __builtin_amdgcn_global_load_lds((const unsigned*)((const char*)(gbase) + (voff)[_i]), (PG8_LAS unsigned*)(lds + (bufoff) + ldsw + _i * 8192), 16, 0, 0); } while (0)
#define PG8_LDA(dst, b, h) do { _Pragma("unroll") for (int m = 0; m < 4; ++m) _Pragma("unroll") for (int k = 0; k < 2; ++k) dst[m][k] = *(const PG8_LAS bf16x8*)(lds + PG8_SA(b, h) + aoff + m * 2048 + k * 1024); } while (0)
#define PG8_LDB(dst, b, h) do { _Pragma("unroll") for (int n = 0; n < 2; ++n) _Pragma("unroll") for (int k = 0; k < 2; ++k) dst[n][k] = *(const PG8_LAS bf16x8*)(lds + PG8_SB(b, h) + boff + n * 2048 + k * 1024); } while (0)
#define PG8_MMA(ai, bj, At, Bt) do { __builtin_amdgcn_s_setprio(1); _Pragma("unroll") for (int m = 0; m < 4; ++m) _Pragma("unroll") for (int n = 0; n < 2; ++n) _Pragma("unroll") for (int k = 0; k < 2; ++k) \
        acc[ai][bj][m][n] = __builtin_amdgcn_mfma_f32_16x16x32_bf16(Bt[n][k], At[m][k], acc[ai][bj][m][n], 0, 0, 0); __builtin_amdgcn_s_setprio(0); } while (0)
#define PG8_WAIT_V(n) asm volatile("s_waitcnt vmcnt(" #n ")" ::: "memory")
#define PG8_WAIT_L(n) asm volatile("s_waitcnt lgkmcnt(" #n ")" ::: "memory")
#define PG8_BAR __builtin_amdgcn_s_barrier()
#define PG8_SCHED __builtin_amdgcn_sched_barrier(0)
    Unit cur, nxt; int ui = 0;
    if (!S.next(0, cur)) return;
    f32x4 acc[2][2][4][2];
#pragma unroll
    for (int a = 0; a < 2; ++a)
#pragma unroll
        for (int b = 0; b < 2; ++b)
#pragma unroll
            for (int m = 0; m < 4; ++m)
#pragma unroll
                for (int n = 0; n < 2; ++n) acc[a][b][m][n] = (f32x4){0.f, 0.f, 0.f, 0.f};
    bf16x8 At[4][2], B0[2][2], B1[2][2];
    const char* cA = (const char*)g.A + (size_t)cur.pm * tstep; const char* cB = (const char*)g.Bt + (size_t)cur.pn * tstep;
    S.a_ready(cur);
    if constexpr (SP2) {
        PG8_STAGE(PG8_SB(0, 0), cB, voffB); PG8_STAGE(PG8_SB(0, 1), cB + hstep, voffB); PG8_STAGE(PG8_SA(0, 0), cA, voffA); PG8_STAGE(PG8_SA(0, 1), cA + hstep, voffA);
        if (wr == 1) PG8_BAR;
        PG8_WAIT_V(2); PG8_BAR;
        PG8_STAGE(PG8_SB(1, 0), cB + kstep, voffB); PG8_STAGE(PG8_SA(1, 0), cA + kstep, voffA); PG8_STAGE(PG8_SB(1, 1), cB + hstep + kstep, voffB);
        PG8_WAIT_V(6); PG8_BAR;
    } else {
        PG8_STAGE(PG8_SB(0, 0), cB, voffB); PG8_STAGE(PG8_SA(0, 0), cA, voffA); PG8_STAGE(PG8_SB(0, 1), cB + hstep, voffB); PG8_STAGE(PG8_SA(0, 1), cA + hstep, voffA);
        if (wr == 1) PG8_BAR;
        PG8_WAIT_V(4); PG8_BAR;
        PG8_STAGE(PG8_SB(1, 0), cB + kstep, voffB); PG8_STAGE(PG8_SA(1, 0), cA + kstep, voffA); PG8_STAGE(PG8_SB(1, 1), cB + hstep + kstep, voffB);
        PG8_WAIT_V(6); PG8_BAR;
    }
    for (;;) {
        const bool has_next = S.next(ui + 1, nxt);
        const char* nA = has_next ? (const char*)g.A + (size_t)nxt.pm * tstep : cA; const char* nB = has_next ? (const char*)g.Bt + (size_t)nxt.pn * tstep : cB;
        for (int t = 0; t < nt; t += 2) {
            const bool last = (t == nt - 2);
            const char* a1 = cA + (size_t)(t + 1) * kstep;
            const char* a2 = last ? nA : cA + (size_t)(t + 2) * kstep; const char* b2 = last ? nB : cB + (size_t)(t + 2) * kstep;
            const char* a3 = a2 + kstep; const char* b3 = b2 + kstep;
            if (last && has_next) S.a_ready(nxt);
            if constexpr (SP2) {
            PG8_LDB(B0, 0, 0); PG8_LDB(B1, 0, 1); PG8_SCHED; PG8_LDA(At, 0, 0); PG8_STAGE(PG8_SA(1, 1), a1 + hstep, voffA);
            PG8_WAIT_V(8); PG8_WAIT_L(0); PG8_BAR; PG8_MMA(0, 0, At, B0); PG8_MMA(0, 1, At, B1); PG8_BAR; PG8_SCHED;
            PG8_LDA(At, 0, 1); PG8_STAGE(PG8_SB(0, 0), b2, voffB); PG8_STAGE(PG8_SB(0, 1), b2 + hstep, voffB); PG8_STAGE(PG8_SA(0, 0), a2, voffA);
            PG8_WAIT_V(8); PG8_WAIT_L(0); PG8_BAR; PG8_MMA(1, 0, At, B0); PG8_MMA(1, 1, At, B1); PG8_BAR; PG8_SCHED;
            PG8_LDB(B0, 1, 0); PG8_LDB(B1, 1, 1); PG8_SCHED; PG8_LDA(At, 1, 0); PG8_STAGE(PG8_SA(0, 1), a2 + hstep, voffA);
            PG8_WAIT_V(8); PG8_WAIT_L(0); PG8_BAR; PG8_MMA(0, 0, At, B0); PG8_MMA(0, 1, At, B1); PG8_BAR; PG8_SCHED;
            PG8_LDA(At, 1, 1); PG8_STAGE(PG8_SB(1, 0), b3, voffB); PG8_STAGE(PG8_SB(1, 1), b3 + hstep, voffB); PG8_STAGE(PG8_SA(1, 0), a3, voffA);
            PG8_WAIT_V(8); PG8_WAIT_L(0); PG8_BAR; PG8_MMA(1, 0, At, B0); PG8_MMA(1, 1, At, B1); PG8_BAR; PG8_SCHED;
            } else {
            PG8_LDB(B0, 0, 0); PG8_SCHED; PG8_LDA(At, 0, 0); PG8_STAGE(PG8_SA(1, 1), a1 + hstep, voffA);
            PG8_WAIT_L(8); PG8_BAR; PG8_WAIT_L(0); PG8_MMA(0, 0, At, B0); PG8_BAR; PG8_SCHED;
            PG8_LDB(B1, 0, 1); PG8_STAGE(PG8_SB(0, 0), b2, voffB);
            PG8_BAR; PG8_WAIT_L(0); PG8_MMA(0, 1, At, B1); PG8_BAR;
            PG8_LDA(At, 0, 1); PG8_STAGE(PG8_SA(0, 0), a2, voffA);
            PG8_BAR; PG8_WAIT_L(0); PG8_MMA(1, 0, At, B0); PG8_BAR; PG8_SCHED;
            PG8_STAGE(PG8_SB(0, 1), b2 + hstep, voffB);
            PG8_WAIT_V(6); PG8_BAR; PG8_MMA(1, 1, At, B1); PG8_BAR;
            PG8_LDB(B0, 1, 0); PG8_SCHED; PG8_LDA(At, 1, 0); PG8_STAGE(PG8_SA(0, 1), a2 + hstep, voffA);
            PG8_WAIT_L(8); PG8_BAR; PG8_WAIT_L(0); PG8_MMA(0, 0, At, B0); PG8_BAR; PG8_SCHED;
            PG8_LDB(B1, 1, 1); PG8_STAGE(PG8_SB(1, 0), b3, voffB);
            PG8_BAR; PG8_WAIT_L(0); PG8_MMA(0, 1, At, B1); PG8_BAR;
            PG8_LDA(At, 1, 1); PG8_STAGE(PG8_SA(1, 0), a3, voffA);
            PG8_BAR; PG8_WAIT_L(0); PG8_MMA(1, 0, At, B0); PG8_BAR; PG8_SCHED;
            PG8_STAGE(PG8_SB(1, 1), b3 + hstep, voffB);
            PG8_WAIT_V(6); PG8_BAR; PG8_MMA(1, 1, At, B1); PG8_BAR;
            }
        }
        if constexpr (ALIGN_EPI) { if (wr == 0) PG8_BAR; }
        if constexpr (!Epi::AFTER_DRAIN) { E(acc, cur, wr, wc, fr, fq); S.done(cur); }
        if (!has_next) break;
#pragma unroll
        for (int a = 0; a < 2; ++a)
#pragma unroll
            for (int b = 0; b < 2; ++b)
#pragma unroll
                for (int m = 0; m < 4; ++m)
#pragma unroll
                    for (int n = 0; n < 2; ++n) acc[a][b][m][n] = (f32x4){0.f, 0.f, 0.f, 0.f};
        cur = nxt; cA = nA; cB = nB; ++ui;
        if constexpr (ALIGN_EPI) { if (wr == 1) PG8_BAR; }
    }
    PG8_WAIT_V(0);
    if constexpr (!ALIGN_EPI) { if (wr == 0) PG8_BAR; }
    PG8_BAR;
    if constexpr (Epi::AFTER_DRAIN) { E.fused(acc, cur, wr, wc, fr, fq, lds, wid, lane); S.done(cur); }
#undef PG8_SA
#undef PG8_SB
#undef PG8_STAGE
#undef PG8_LDA
#undef PG8_LDB
#undef PG8_MMA
#undef PG8_WAIT_V
#undef PG8_WAIT_L
#undef PG8_BAR
#undef PG8_SCHED
}
}

#define LAS __attribute__((address_space(3)))
typedef unsigned short bf16;
typedef short bf16x8 __attribute__((ext_vector_type(8)));
typedef float f32x4 __attribute__((ext_vector_type(4)));
typedef float f32x16 __attribute__((ext_vector_type(16)));
typedef unsigned u32x4 __attribute__((ext_vector_type(4)));
typedef unsigned u32x2 __attribute__((ext_vector_type(2)));
typedef float f32x2_t __attribute__((ext_vector_type(2)));
typedef __bf16 bf16x2_t __attribute__((ext_vector_type(2)));

constexpr int NWAVES = 8, NTHREADS = 512;
constexpr int D = 1024, SEQ = 8192, NPROMPT = 16384, NSAMP = 128, MREAL = NPROMPT + NSAMP, MP = 16640;
constexpr int FF = 4096, QW = 3072, KVW = 1536, NQKV = QW + KVW;
constexpr float EPS = 1e-6f;
constexpr float QSCALE = 0.125f * 1.4426950408889634f;
constexpr int LDS_BYTES = 147456;

constexpr size_t MiB = 1u << 20;
constexpr size_t WS_ROWSS = 0;
constexpr size_t WS_BAR = 384 * 1024;
constexpr size_t WS_LAM = 512 * 1024;
constexpr size_t WS_BBAR = 576 * 1024;
constexpr size_t WS_CC = 1 * MiB;
constexpr size_t WS_ROPE = 1536 * 1024;
constexpr size_t WS_E = 3840 * 1024;
constexpr size_t WS_W = 8 * MiB;
constexpr size_t W_GLU = WS_W, W_UP0 = W_GLU + 2048ull * 1024 * 2, W_DN0 = W_UP0 + 4096ull * 1024 * 2, W_QKV = W_DN0 + 4096ull * 1024 * 2,
                 W_O = W_QKV + (size_t)NQKV * 1024 * 2, W_UP1 = W_O + 1024ull * 1024 * 2, W_DN1 = W_UP1 + 4096ull * 1024 * 2, W_END = W_DN1 + 4096ull * 1024 * 2;
static_assert(W_END <= 56 * MiB, "weights");
constexpr size_t WS_H = 56 * MiB;
constexpr size_t WS_HB = 121 * MiB;
constexpr size_t WS_HN0 = 154 * MiB;
constexpr size_t WS_VT = WS_HN0;
constexpr size_t WS_Y = 187 * MiB;
constexpr size_t WS_ATT = WS_Y;
constexpr size_t WS_ACT = 220 * MiB;
constexpr size_t WS_Q = WS_ACT;
constexpr size_t WS_KB = WS_Q + (size_t)MP * QW * 2;
static_assert(WS_KB + 3ull * MP * 256 * 2 <= 350 * MiB, "q/k overlay");
constexpr size_t WS_OG = 350 * MiB;
constexpr size_t WS_LSE = 448 * MiB;
constexpr size_t WS_END = 452 * MiB;

constexpr size_t O_YP = 0, O_YS = 16777216, O_KVP0 = 16908288, O_KVP1 = 17039360, O_KVP2 = 17563648,
                 O_KVS0 = 19660800, O_KVS1 = 19726336, O_KVS2 = 19791872, O_SREP = 19857408, O_SIMP = 19865600, O_SRES = 19873792, O_SIMS = 20004864;

__device__ __forceinline__ unsigned pk2(float lo, float hi) { f32x2_t v = {lo, hi}; bf16x2_t b = __builtin_convertvector(v, bf16x2_t); return __builtin_bit_cast(unsigned, b); }
__device__ __forceinline__ float bf2f(unsigned short u) { return __uint_as_float(((unsigned)u) << 16); }
__device__ __forceinline__ float wave_sum(float v) {
#pragma unroll
    for (int o = 1; o < 64; o <<= 1) v += __shfl_xor(v, o);
    return v;
}
__device__ __forceinline__ float wave_max(float v) {
#pragma unroll
    for (int o = 1; o < 64; o <<= 1) v = fmaxf(v, __shfl_xor(v, o));
    return v;
}

struct Args { const float* in[25]; float* out; unsigned char* ws; int ph_lo, ph_hi; };

struct EpiGlu {
    static constexpr bool PERM = true, AFTER_DRAIN = false;
    const float* xp; const float* xs; float* H; bf16* HB; float* rowss;
    __device__ __forceinline__ void operator()(const pg8::f32x4 (&acc)[2][2][4][2], const pg8::Unit& u, int wr, int wc, int fr, int fq) const { run<2>(acc, u, wr, wc, fr, fq); }
    template <int NAI> __device__ __forceinline__ void run(const pg8::f32x4 (&acc)[NAI][2][4][2], const pg8::Unit& u, int wr, int wc, int fr, int fq) const {
        const int col = u.pn * 128 + wc * 32 + 8 * fq;
#pragma unroll
        for (int ai = 0; ai < NAI; ++ai)
#pragma unroll
            for (int m = 0; m < 4; ++m) {
                const int row = u.pm * 256 + ai * 128 + wr * 64 + m * 16 + fr;
                if (row < MREAL) {
                    const float* xr = (row < NPROMPT ? xp + (size_t)row * D : xs + (size_t)(row - NPROMPT) * D) + col;
                    const f32x4 x0 = *(const f32x4*)xr, x1 = *(const f32x4*)(xr + 4);
                    f32x4 h0, h1;
#pragma unroll
                    for (int i = 0; i < 4; ++i) {
                        h0[i] = x0[i] + acc[ai][0][m][0][i] * __builtin_amdgcn_rcpf(1.f + __expf(-acc[ai][1][m][0][i]));
                        h1[i] = x1[i] + acc[ai][0][m][1][i] * __builtin_amdgcn_rcpf(1.f + __expf(-acc[ai][1][m][1][i]));
                    }
                    u32x4 w; w.x = pk2(h0[0], h0[1]); w.y = pk2(h0[2], h0[3]); w.z = pk2(h1[0], h1[1]); w.w = pk2(h1[2], h1[3]);
                    *(u32x4*)(HB + (size_t)row * D + col) = w;
                    float ss = (h0[0] * h0[0] + h0[1] * h0[1]) + (h0[2] * h0[2] + h0[3] * h0[3]) + (h1[0] * h1[0] + h1[1] * h1[1]) + (h1[2] * h1[2] + h1[3] * h1[3]);
                    ss += __shfl_xor(ss, 16); ss += __shfl_xor(ss, 32);
                    if (fq == 0) __hip_atomic_fetch_add(rowss + row, ss, __ATOMIC_RELAXED, __HIP_MEMORY_SCOPE_AGENT);
                } else { float ss = 0.f; ss += __shfl_xor(ss, 16); ss += __shfl_xor(ss, 32); (void)ss; }
            }
    }
};
struct EpiNull {
    static constexpr bool PERM = true, AFTER_DRAIN = false; float* sink;
    __device__ __forceinline__ void operator()(const pg8::f32x4 (&acc)[2][2][4][2], const pg8::Unit& u, int wr, int wc, int fr, int fq) const { run<2>(acc, u, wr, wc, fr, fq); }
    template <int NAI> __device__ __forceinline__ void run(const pg8::f32x4 (&acc)[NAI][2][4][2], const pg8::Unit& u, int wr, int wc, int fr, int fq) const {
        float t = 0.f;
#pragma unroll
        for (int b = 0; b < 2; ++b)
#pragma unroll
            for (int m = 0; m < 4; ++m)
#pragma unroll
                for (int n = 0; n < 2; ++n) t += acc[0][b][m][n][0] + acc[0][b][m][n][3];
        if (t == 1234.5678f) sink[0] = t;
    }
};
struct EpiUp {
    static constexpr bool PERM = true, AFTER_DRAIN = false;
    bf16* O; const float* rowss;
    __device__ __forceinline__ void operator()(const pg8::f32x4 (&acc)[2][2][4][2], const pg8::Unit& u, int wr, int wc, int fr, int fq) const { run<2>(acc, u, wr, wc, fr, fq); }
    template <int NAI> __device__ __forceinline__ void run(const pg8::f32x4 (&acc)[NAI][2][4][2], const pg8::Unit& u, int wr, int wc, int fr, int fq) const {
        const int col = u.pn * 256 + wc * 32 + 8 * fq;
#pragma unroll
        for (int ai = 0; ai < NAI; ++ai)
#pragma unroll
            for (int m = 0; m < 4; ++m) {
                const int row = u.pm * 256 + ai * 128 + wr * 64 + m * 16 + fr;
                if (row < MREAL) {
                    const float rstd = __builtin_amdgcn_rsqf(rowss[row] * (1.f / D) + EPS);
#pragma unroll
                    for (int bj = 0; bj < 2; ++bj) {
                        float v[8];
#pragma unroll
                        for (int i = 0; i < 4; ++i) { float a = fmaxf(acc[ai][bj][m][0][i] * rstd, 0.f), b = fmaxf(acc[ai][bj][m][1][i] * rstd, 0.f); v[i] = a * a; v[4 + i] = b * b; }
                        u32x4 w; w.x = pk2(v[0], v[1]); w.y = pk2(v[2], v[3]); w.z = pk2(v[4], v[5]); w.w = pk2(v[6], v[7]);
                        *(u32x4*)(O + (size_t)row * FF + col + bj * 128) = w;
                    }
                }
            }
    }
};
struct EpiRes {
    static constexpr bool PERM = true, AFTER_DRAIN = false;
    bf16* HB; float* OUT; float* rowss;
    __device__ __forceinline__ void operator()(const pg8::f32x4 (&acc)[2][2][4][2], const pg8::Unit& u, int wr, int wc, int fr, int fq) const { run<2>(acc, u, wr, wc, fr, fq); }
    template <int NAI> __device__ __forceinline__ void run(const pg8::f32x4 (&acc)[NAI][2][4][2], const pg8::Unit& u, int wr, int wc, int fr, int fq) const {
        const int col = u.pn * 256 + wc * 32 + 8 * fq;
#pragma unroll
        for (int ai = 0; ai < NAI; ++ai)
#pragma unroll
            for (int m = 0; m < 4; ++m) {
                const int row = u.pm * 256 + ai * 128 + wr * 64 + m * 16 + fr;
                float ss = 0.f;
                if (row < MREAL) {
#pragma unroll
                    for (int bj = 0; bj < 2; ++bj) {
                        bf16* hp = HB + (size_t)row * D + col + bj * 128;
                        const bf16x8 hv = *(const bf16x8*)hp;
                        f32x4 h0, h1;
#pragma unroll
                        for (int i = 0; i < 4; ++i) { h0[i] = bf2f((unsigned short)hv[i]) + acc[ai][bj][m][0][i]; h1[i] = bf2f((unsigned short)hv[4 + i]) + acc[ai][bj][m][1][i]; }
                        if (OUT) { float* op = OUT + (size_t)row * D + col + bj * 128; *(f32x4*)op = h0; *(f32x4*)(op + 4) = h1; }
                        else { u32x4 w; w.x = pk2(h0[0], h0[1]); w.y = pk2(h0[2], h0[3]); w.z = pk2(h1[0], h1[1]); w.w = pk2(h1[2], h1[3]); *(u32x4*)hp = w; }
                        ss += (h0[0] * h0[0] + h0[1] * h0[1]) + (h0[2] * h0[2] + h0[3] * h0[3]) + (h1[0] * h1[0] + h1[1] * h1[1]) + (h1[2] * h1[2] + h1[3] * h1[3]);
                    }
                }
                ss += __shfl_xor(ss, 16); ss += __shfl_xor(ss, 32);
                if (fq == 0 && row < MREAL) __hip_atomic_fetch_add(rowss + row, ss, __ATOMIC_RELAXED, __HIP_MEMORY_SCOPE_AGENT);
            }
    }
};
struct EpiQKV {
    static constexpr bool PERM = true, AFTER_DRAIN = false;
    bf16* Q; bf16* KB; bf16* VB; float* out; const float* rowss; const float* ropec; const float* ropes; const float* offc; const float* offs;
    __device__ __forceinline__ void operator()(const pg8::f32x4 (&acc)[2][2][4][2], const pg8::Unit& u, int wr, int wc, int fr, int fq) const { run<2>(acc, u, wr, wc, fr, fq); }
    template <int NAI> __device__ __forceinline__ void run(const pg8::f32x4 (&acc)[NAI][2][4][2], const pg8::Unit& u, int wr, int wc, int fr, int fq) const {
        const int pn = u.pn;
        const bool isq = pn < 12; const int kvi = pn - 12; const int g = isq ? (pn >> 2) : (kvi >> 1); const bool isv = (!isq) && (kvi & 1);
        const int sh = 2 * g, W = 128 << sh;
        const bool stile = u.pm == 64;
        const int d0 = 8 * fq;
        const int slb = ((u.pm * 256 + wr * 64 + fr) & (SEQ - 1)) * 32 + d0;
#pragma unroll
        for (int ai = 0; ai < NAI; ++ai)
#pragma unroll
            for (int m = 0; m < 4; ++m) {
                const int row = u.pm * 256 + ai * 128 + wr * 64 + m * 16 + fr;
                if (row >= MREAL) continue;
                const float rstd = __builtin_amdgcn_rsqf(rowss[row] * (1.f / D) + EPS) * (isq ? QSCALE : 1.f);
                const bool samp = row >= NPROMPT; const int t = samp ? ((row - NPROMPT) & 3) : (row & (SEQ - 1));
                int rowp = row;
                if (!samp) { const int b = row >> 13, r = t & ((1 << sh) - 1), uu = t >> sh; rowp = b * SEQ + r * (SEQ >> sh) + uu; }
                float* ob = nullptr;
                if (!isq) {
                    if (samp) ob = out + (g == 0 ? O_KVS0 : g == 1 ? O_KVS1 : O_KVS2) + (size_t)(row - NPROMPT) * 512;
                    else if (t >= SEQ - W) ob = out + (g == 0 ? O_KVP0 : g == 1 ? O_KVP1 : O_KVP2) + ((size_t)(row >> 13) * W + (t - (SEQ - W))) * 512;
                }
                f32x4 av[2], bv[2];
#pragma unroll
                for (int n = 0; n < 2; ++n) {
                    f32x4 a = acc[ai][0][m][n] * rstd, b = acc[ai][1][m][n] * rstd;
                    if (!isv) {
                        const int sl = (samp ? SEQ + t : t) * 32 + d0 + 4 * n; const f32x4 c = *(const f32x4*)(ropec + sl), sn = *(const f32x4*)(ropes + sl);
                        const f32x4 ra = a * c - b * sn, rb = b * c + a * sn; a = ra; b = rb;
                    }
                    av[n] = a; bv[n] = b;
                }
                if (isq) {
                    bf16* qp = Q + (size_t)row * QW + pn * 256 + wc * 64 + d0;
                    u32x4 w0, w1; w0.x = pk2(av[0][0], av[0][1]); w0.y = pk2(av[0][2], av[0][3]); w0.z = pk2(av[1][0], av[1][1]); w0.w = pk2(av[1][2], av[1][3]);
                    w1.x = pk2(bv[0][0], bv[0][1]); w1.y = pk2(bv[0][2], bv[0][3]); w1.z = pk2(bv[1][0], bv[1][1]); w1.w = pk2(bv[1][2], bv[1][3]);
                    *(u32x4*)qp = w0; *(u32x4*)(qp + 32) = w1;
                } else {
                    bf16* kp = (isv ? VB : KB) + ((size_t)g * MP + rowp) * 256 + wc * 64 + d0;
                    u32x4 w0, w1; w0.x = pk2(av[0][0], av[0][1]); w0.y = pk2(av[0][2], av[0][3]); w0.z = pk2(av[1][0], av[1][1]); w0.w = pk2(av[1][2], av[1][3]);
                    w1.x = pk2(bv[0][0], bv[0][1]); w1.y = pk2(bv[0][2], bv[0][3]); w1.z = pk2(bv[1][0], bv[1][1]); w1.w = pk2(bv[1][2], bv[1][3]);
                    *(u32x4*)kp = w0; *(u32x4*)(kp + 32) = w1;
                    if (ob) { float* o2 = ob + (isv ? 256 : 0) + wc * 64 + d0; *(f32x4*)o2 = av[0]; *(f32x4*)(o2 + 4) = av[1]; *(f32x4*)(o2 + 32) = bv[0]; *(f32x4*)(o2 + 36) = bv[1]; }
                }
            }
    }
};

template <class Epi>
__device__ __forceinline__ void skinny_phase(LAS unsigned char* lds, const bf16* Abuf, const bf16* Bt, int N, int K, const Epi& E, int first, int wave, int lane) {
    const int nroles = (N >> 8) * 8, G = gridDim.x;
    const int fr = lane & 15, fq = lane >> 4;
    LAS float* red = (LAS float*)lds;
    const int rstep = first ? G - first : G;
    for (int role = (int)blockIdx.x - first; role < nroles; role += rstep) {
        if (role < 0) break;
        const int pn = role >> 3, wr = (role >> 2) & 1, wc = role & 3;
        pg8::f32x4 acc[1][2][4][2];
#pragma unroll
        for (int b = 0; b < 2; ++b)
#pragma unroll
            for (int m = 0; m < 4; ++m)
#pragma unroll
                for (int n = 0; n < 2; ++n) acc[0][b][m][n] = (pg8::f32x4){0.f, 0.f, 0.f, 0.f};
        const int kper = K >> 3, k0 = wave * kper;
        const bf16* ap = Abuf + (size_t)(NPROMPT + 64 * wr + fr) * K + k0 + 8 * fq;
        const int r0 = Epi::PERM ? (8 * (fr >> 2) + (fr & 3)) : fr, r1 = Epi::PERM ? r0 + 4 : fr + 16;
        const bf16* bp = Bt + (size_t)(256 * pn + 32 * wc) * K + k0 + 8 * fq;
#pragma unroll 4
        for (int ks = 0; ks < kper; ks += 32) {
            bf16x8 af[4], bf_[2][2];
#pragma unroll
            for (int m = 0; m < 4; ++m) af[m] = *(const bf16x8*)(ap + (size_t)(16 * m) * K + ks);
#pragma unroll
            for (int b = 0; b < 2; ++b) { bf_[b][0] = *(const bf16x8*)(bp + (size_t)(128 * b + r0) * K + ks); bf_[b][1] = *(const bf16x8*)(bp + (size_t)(128 * b + r1) * K + ks); }
#pragma unroll
            for (int b = 0; b < 2; ++b)
#pragma unroll
                for (int m = 0; m < 4; ++m)
#pragma unroll
                    for (int n = 0; n < 2; ++n) acc[0][b][m][n] = __builtin_amdgcn_mfma_f32_16x16x32_bf16(bf_[b][n], af[m], acc[0][b][m][n], 0, 0, 0);
        }
        if (wave != 0) {
#pragma unroll
            for (int b = 0; b < 2; ++b)
#pragma unroll
                for (int m = 0; m < 4; ++m)
#pragma unroll
                    for (int n = 0; n < 2; ++n) *(LAS pg8::f32x4*)(red + ((size_t)((wave - 1) * 16 + b * 8 + m * 2 + n) * 64 + lane) * 4) = acc[0][b][m][n];
        }
        __syncthreads();
        if (wave == 0) {
#pragma unroll 1
            for (int w = 0; w < 7; ++w)
#pragma unroll
                for (int b = 0; b < 2; ++b)
#pragma unroll
                    for (int m = 0; m < 4; ++m)
#pragma unroll
                        for (int n = 0; n < 2; ++n) acc[0][b][m][n] += *(const LAS pg8::f32x4*)(red + ((size_t)(w * 16 + b * 8 + m * 2 + n) * 64 + lane) * 4);
            const pg8::Unit u{64, pn};
            E.template run<1>(acc, u, wr, wc, fr, fq);
        }
        __syncthreads();
    }
}
__device__ __forceinline__ int conv_srcc(int mode, int nb) {
    if (mode == 0) return 32 * nb;
    if (mode == 1) { const int pn = nb >> 3, bj = (nb >> 2) & 1, cb = nb & 3; return bj * 1024 + 128 * pn + 32 * cb; }
    const int pn = nb >> 3, bj = (nb >> 2) & 1, wc = nb & 3; return 256 * pn + 64 * wc + 32 * bj;
}
__device__ __forceinline__ void transpose_item(const float* W, int K, int N, bf16* WT, const float* gain, int mode, LAS float* scr, int item, int lane) {
    const int nblk = N >> 6, kb = item / nblk, nb64 = item % nblk, k0 = 64 * kb;
    const int l16 = lane & 15, srcc = conv_srcc(mode, 2 * nb64 + (l16 >> 3)) + 4 * (l16 & 7);
    f32x4 v[16];
#pragma unroll
    for (int i = 0; i < 16; ++i) { const int kk = 4 * i + (lane >> 4); v[i] = *(const f32x4*)(W + (size_t)(k0 + kk) * N + srcc); }
    if (gain) {
#pragma unroll
        for (int i = 0; i < 16; ++i) { const int kk = 4 * i + (lane >> 4); v[i] = v[i] * gain[k0 + kk]; }
    }
#pragma unroll
    for (int i = 0; i < 16; ++i) { const int kk = 4 * i + (lane >> 4); LAS float* d = scr + kk * 65 + 4 * l16; d[0] = v[i][0]; d[1] = v[i][1]; d[2] = v[i][2]; d[3] = v[i][3]; }
    asm volatile("s_waitcnt lgkmcnt(0)" ::: "memory");
    const int c = lane & 7;
#pragma unroll
    for (int j = 0; j < 8; ++j) { const int n = (lane >> 3) + 8 * j; const LAS float* sp = scr + (8 * c) * 65 + n;
        u32x4 o; o.x = pk2(sp[0 * 65], sp[1 * 65]); o.y = pk2(sp[2 * 65], sp[3 * 65]); o.z = pk2(sp[4 * 65], sp[5 * 65]); o.w = pk2(sp[6 * 65], sp[7 * 65]);
        *(u32x4*)(WT + (size_t)(64 * nb64 + n) * K + k0 + 8 * c) = o; }
    asm volatile("s_waitcnt lgkmcnt(0)" ::: "memory");
}
__device__ __forceinline__ void convert_late(const Args& A, LAS unsigned char* lds, int vw, int NVW, int wave, int lane) {
    unsigned char* ws = A.ws;
    LAS float* scr = (LAS float*)(lds + wave * 16640);
    constexpr int I_UP = 16 * 64, I_DN = 64 * 16, I_O = 16 * 16, NIT = I_O + I_UP + I_DN;
    for (int it = vw; it < NIT; it += NVW) {
        int r = it;
        if (r < I_O) { transpose_item(A.in[21], 1024, 1024, (bf16*)(ws + W_O), nullptr, 0, scr, r, lane); continue; } r -= I_O;
        if (r < I_UP) { transpose_item(A.in[22] + 1024ull * 4096, 1024, 4096, (bf16*)(ws + W_UP1), A.in[8] + 1024, 0, scr, r, lane); continue; } r -= I_UP;
        transpose_item(A.in[23] + 4096ull * 1024, 4096, 1024, (bf16*)(ws + W_DN1), nullptr, 0, scr, r, lane);
    }
}

__device__ __forceinline__ void phase_prologue(const Args& A, LAS unsigned char* lds, int gw, int NGW, int wave, int lane) {
    unsigned char* ws = A.ws;
    LAS float* scr = (LAS float*)(lds + wave * 16640);
    constexpr int I_GLU = 16 * 32, I_UP = 16 * 64, I_DN = 64 * 16, I_Q = 16 * 48, I_KV = 16 * 24;
    constexpr int NIT = I_GLU + I_UP + I_DN + I_Q + I_KV;
    for (int it = gw; it < NIT; it += NGW) {
        int r = it;
        if (r < I_GLU) { transpose_item(A.in[17], 1024, 2048, (bf16*)(ws + W_GLU), nullptr, 1, scr, r, lane); continue; } r -= I_GLU;
        if (r < I_UP) { transpose_item(A.in[22], 1024, 4096, (bf16*)(ws + W_UP0), A.in[8], 0, scr, r, lane); continue; } r -= I_UP;
        if (r < I_DN) { transpose_item(A.in[23], 4096, 1024, (bf16*)(ws + W_DN0), nullptr, 0, scr, r, lane); continue; } r -= I_DN;
        if (r < I_Q) { transpose_item(A.in[20], 1024, 3072, (bf16*)(ws + W_QKV), A.in[7] + 1024, 2, scr, r, lane); continue; } r -= I_Q;
        transpose_item(A.in[19], 1024, 1536, (bf16*)(ws + W_QKV) + 3072ull * 1024, A.in[18], 2, scr, r, lane);
    }
    {
        const float* gmix = A.in[7];
        bf16* HN0 = (bf16*)(ws + WS_HN0);
        for (int row0 = 4 * gw; row0 < MREAL; row0 += 4 * NGW) {
            f32x4 v[4][4]; float ssq[4];
#pragma unroll
            for (int q = 0; q < 4; ++q) { const int row = row0 + q; const float* xr = row < NPROMPT ? A.in[0] + (size_t)row * D : A.in[1] + (size_t)(row - NPROMPT) * D;
#pragma unroll
                for (int j = 0; j < 4; ++j) v[q][j] = *((const f32x4*)xr + lane + 64 * j); }
#pragma unroll
            for (int q = 0; q < 4; ++q) { float sq = 0.f;
#pragma unroll
                for (int j = 0; j < 4; ++j) sq += (v[q][j][0] * v[q][j][0] + v[q][j][1] * v[q][j][1]) + (v[q][j][2] * v[q][j][2] + v[q][j][3] * v[q][j][3]);
                ssq[q] = __builtin_amdgcn_rsqf(wave_sum(sq) * (1.f / D) + EPS); }
#pragma unroll
            for (int j = 0; j < 4; ++j) { const f32x4 gg = *((const f32x4*)gmix + lane + 64 * j);
#pragma unroll
                for (int q = 0; q < 4; ++q) { const float rstd = ssq[q];
                    u32x2 w; w.x = pk2(v[q][j][0] * rstd * gg[0], v[q][j][1] * rstd * gg[1]); w.y = pk2(v[q][j][2] * rstd * gg[2], v[q][j][3] * rstd * gg[3]);
                    *((u32x2*)(HN0 + (size_t)(row0 + q) * D) + lane + 64 * j) = w; } }
        }
    }
    const int gt = gw * 64 + lane, NGT = NGW * 64;
    { float* rs = (float*)(ws + WS_ROWSS); for (int i = gt; i < 4 * MP; i += NGT) rs[i] = 0.f; }
    { float* rc = (float*)(ws + WS_ROPE); float* rsn = rc + 8196 * 32;
      for (int i = gt; i < 8196 * 32; i += NGT) { const int slot = i >> 5, d = i & 31; const float pos = slot < SEQ ? (float)slot : (float)(16384 + (slot - SEQ));
          const float inv = powf(10000.0f, -(float)d / 32.0f); const float ang = pos * inv; rc[i] = cosf(ang); rsn[i] = sinf(ang); } }
    { float* oc = (float*)(ws + WS_ROPE) + 2 * 8196 * 32; float* os = oc + 8 * 32;
      for (int i = gt; i < 8 * 32; i += NGT) { const int oi = i >> 5, d = i & 31; const float pos = (float)(128 * (oi >> 2) + 16 * (oi & 3));
          const float inv = powf(10000.0f, -(float)d / 32.0f); const float ang = pos * inv; oc[i] = cosf(ang); os[i] = sinf(ang); } }
    { float* lam = (float*)(ws + WS_LAM); bf16* BB = (bf16*)(ws + WS_BBAR); bf16* CC = (bf16*)(ws + WS_CC);
      const float *are = A.in[9], *aim = A.in[10], *ldt = A.in[11], *bre = A.in[12], *bim = A.in[13], *cre = A.in[14], *cim = A.in[15];
      for (int i = gt; i < 64 * 64 * 16; i += NGT) {
          const int c = i & 15, p = (i >> 4) & 63, g = i >> 10;
          const float dt = expf(ldt[g]); const float ar = are[g * 64 + p], ai = aim[g * 64 + p];
          const float mag = expf(ar * dt); const float lr = mag * cosf(ai * dt), li = mag * sinf(ai * dt);
          const float den = ar * ar + ai * ai, nr = lr - 1.f, ni = li;
          const float zr = (nr * ar + ni * ai) / den, zi = (ni * ar - nr * ai) / den;
          const float br = bre[(g * 64 + p) * 16 + c], bi = bim[(g * 64 + p) * 16 + c];
          const float bbr = zr * br - zi * bi, bbi = zr * bi + zi * br;
          BB[(g * 128 + p) * 16 + c] = (bf16)(pk2(bbr, 0.f) & 0xffffu);
          BB[(g * 128 + 64 + p) * 16 + c] = (bf16)(pk2(bbi, 0.f) & 0xffffu);
          CC[(g * 16 + c) * 128 + 4 * (p & 31) + (p >> 5)] = (bf16)(pk2(cre[(g * 16 + c) * 64 + p], 0.f) & 0xffffu);
          CC[(g * 16 + c) * 128 + 4 * (p & 31) + 2 + (p >> 5)] = (bf16)(pk2(-cim[(g * 16 + c) * 64 + p], 0.f) & 0xffffu);
          if (c == 0) { lam[(g * 64 + p) * 2] = lr; lam[(g * 64 + p) * 2 + 1] = li; }
      } }
}

#define CMUL_ADD(orr, oi, ar_, ai_, br_, bi_, cr_, ci_) do { const float _r = __builtin_fmaf((ar_), (br_), __builtin_fmaf(-(ai_), (bi_), (cr_))); const float _i = __builtin_fmaf((ar_), (bi_), __builtin_fmaf((ai_), (br_), (ci_))); orr = _r; oi = _i; } while (0)
template <bool PASS2>
__device__ __forceinline__ void s5_item(const Args& A, LAS unsigned char* hs, int item, int lane) {
    unsigned char* ws = A.ws;
    const bf16* HN0 = (const bf16*)(ws + WS_HN0);
    const bool samp = item >= 2048;
    const int g = item & 63, ch = samp ? 128 + ((item - 2048) >> 6) : 4 * (item >> 6);
    const int s = lane & 31, hf = lane >> 5;
    bf16x8 Bf[4], Cf[4];
    { const bf16* BB = (const bf16*)(ws + WS_BBAR) + (size_t)g * 128 * 16;
#pragma unroll
      for (int n = 0; n < 4; ++n) Bf[n] = *(const bf16x8*)(BB + (32 * n + s) * 16 + 8 * hf);
      if (PASS2) { const bf16* CC = (const bf16*)(ws + WS_CC) + (size_t)g * 16 * 128;
#pragma unroll
        for (int st = 0; st < 4; ++st) Cf[st] = *(const bf16x8*)(CC + (lane & 15) * 128 + 32 * st + 8 * (lane >> 4)); } }
    const float* lam = (const float*)(ws + WS_LAM) + (size_t)g * 128;
    float lr[2], li[2], l16r[2], l16i[2], l128r[2], l128i[2];
#pragma unroll
    for (int j = 0; j < 2; ++j) { lr[j] = lam[(s + 32 * j) * 2]; li[j] = lam[(s + 32 * j) * 2 + 1];
        float pr = lr[j], pi = li[j];
#pragma unroll
        for (int q = 0; q < 4; ++q) { const float nr = pr * pr - pi * pi, ni = 2.f * pr * pi; pr = nr; pi = ni; }
        l16r[j] = pr; l16i[j] = pi;
#pragma unroll
        for (int q = 0; q < 3; ++q) { const float nr = pr * pr - pi * pi, ni = 2.f * pr * pi; pr = nr; pi = ni; }
        l128r[j] = pr; l128i[j] = pi; }
    float cr[2] = {0.f, 0.f}, ci[2] = {0.f, 0.f};
    const float* E = (const float*)(ws + WS_E);
    if (PASS2) {
        if (samp) { const int n = ch - 128;
#pragma unroll
            for (int j = 0; j < 2; ++j) { cr[j] = A.in[5][((size_t)n * 64 + g) * 64 + s + 32 * j]; ci[j] = A.in[6][((size_t)n * 64 + g) * 64 + s + 32 * j]; } }
        else { const int first = (ch >> 6) << 6;
#pragma unroll 8
            for (int jj = first; jj < ch; ++jj) { const float* e = E + ((size_t)jj * 64 + g) * 128;
#pragma unroll
                for (int j = 0; j < 2; ++j) { const float er = e[j * 32 + s], ei = e[64 + j * 32 + s]; CMUL_ADD(cr[j], ci[j], l128r[j], l128i[j], cr[j], ci[j], er, ei); } } }
    }
    const int nblk = samp ? 1 : 16;
    const int rowbase = samp ? NPROMPT + 4 * (ch - 128) : ch * 128;
    const int tokA = 16 * ((s >> 2) & 1) + 4 * (s >> 3) + (s & 3);
    const float* dsk = A.in[16] + g * 16;
    bf16* Y = (bf16*)(ws + WS_Y);
    bf16x8 afn = *(const bf16x8*)(HN0 + (size_t)(rowbase + tokA) * D + g * 16 + 8 * hf);
    const int uoff = (lane & 15) * D + g * 16 + 4 * (lane >> 4);
    u32x2 un[2];
    if (PASS2) {
#pragma unroll
        for (int q = 0; q < 2; ++q) un[q] = *(const u32x2*)(HN0 + (size_t)(rowbase + 16 * q) * D + uoff);
    }
    const f32x4 dk4 = *(const f32x4*)(dsk + 4 * (lane >> 4));
    for (int blk = 0; blk < nblk; ++blk) {
        const int row0 = rowbase + 32 * blk;
        const bf16x8 af = afn;
        u32x2 uc[2];
        if (PASS2) {
#pragma unroll
            for (int q = 0; q < 2; ++q) uc[q] = un[q];
            if (blk + 1 < nblk) {
#pragma unroll
                for (int q = 0; q < 2; ++q) un[q] = *(const u32x2*)(HN0 + (size_t)(row0 + 32 + 16 * q) * D + uoff);
            }
        }
        if (!PASS2 && (blk & 3) == 0) { cr[0] = 0.f; cr[1] = 0.f; ci[0] = 0.f; ci[1] = 0.f; }
        if (blk + 1 < nblk) afn = *(const bf16x8*)(HN0 + (size_t)(row0 + 32 + tokA) * D + g * 16 + 8 * hf);
        f32x16 X[4];
        const f32x16 z16 = {0.f, 0.f, 0.f, 0.f, 0.f, 0.f, 0.f, 0.f, 0.f, 0.f, 0.f, 0.f, 0.f, 0.f, 0.f, 0.f};
#pragma unroll
        for (int n = 0; n < 4; ++n) X[n] = __builtin_amdgcn_mfma_f32_32x32x16_bf16(af, Bf[n], z16, 0, 0, 0);
        float cinr[2], cini[2];
#pragma unroll
        for (int j = 0; j < 2; ++j) {
            float er = 0.f, ei = 0.f;
#pragma unroll
            for (int r = 0; r < 16; ++r) CMUL_ADD(er, ei, lr[j], li[j], er, ei, X[j][r], X[2 + j][r]);
            const float or_ = __shfl_xor(er, 32), oi_ = __shfl_xor(ei, 32);
            const float e0r = hf ? or_ : er, e0i = hf ? oi_ : ei, e1r = hf ? er : or_, e1i = hf ? ei : oi_;
            float mr, mi; CMUL_ADD(mr, mi, l16r[j], l16i[j], cr[j], ci[j], e0r, e0i);
            cinr[j] = hf ? mr : cr[j]; cini[j] = hf ? mi : ci[j];
            CMUL_ADD(cr[j], ci[j], l16r[j], l16i[j], mr, mi, e1r, e1i);
        }
        if (PASS2) {
#pragma unroll
            for (int j = 0; j < 2; ++j) {
                float hr = cinr[j], hi = cini[j];
#pragma unroll
                for (int r = 0; r < 16; ++r) { CMUL_ADD(hr, hi, lr[j], li[j], hr, hi, X[j][r], X[2 + j][r]);
                    X[j][r] = hr; X[2 + j][r] = hi; }
            }
            if (samp && hf == 0) { const int n = ch - 128;
#pragma unroll
                for (int j = 0; j < 2; ++j) { A.out[O_SRES + ((size_t)n * 64 + g) * 64 + s + 32 * j] = X[j][3]; A.out[O_SIMS + ((size_t)n * 64 + g) * 64 + s + 32 * j] = X[2 + j][3]; } }
#pragma unroll
            for (int r = 0; r < 16; ++r) { LAS unsigned short* hp = (LAS unsigned short*)(hs + (16 * hf + r) * 272);
                u32x2 w; w.x = pk2(X[0][r], X[1][r]); w.y = pk2(X[2][r], X[3][r]);
                *(LAS u32x2*)(hp + 4 * s) = w; }
            asm volatile("s_waitcnt lgkmcnt(0)" ::: "memory");
#pragma unroll
            for (int tb = 0; tb < 2; ++tb) {
                f32x4 y = {0.f, 0.f, 0.f, 0.f};
#pragma unroll
                for (int st = 0; st < 4; ++st) { const bf16x8 hfrag = *(const LAS bf16x8*)(hs + (16 * tb + (lane & 15)) * 272 + 64 * st + 16 * (lane >> 4));
                    y = __builtin_amdgcn_mfma_f32_16x16x32_bf16(Cf[st], hfrag, y, 0, 0, 0); }
                const int tk = 16 * tb + (lane & 15);
                if (!samp || tk < 4) {
                    const float u0 = __uint_as_float(uc[tb].x << 16), u1 = __uint_as_float(uc[tb].x & 0xffff0000u), u2 = __uint_as_float(uc[tb].y << 16), u3 = __uint_as_float(uc[tb].y & 0xffff0000u);
                    f32x4 v = {y[0] + dk4[0] * u0, y[1] + dk4[1] * u1, y[2] + dk4[2] * u2, y[3] + dk4[3] * u3};
                    float ge[4];
#pragma unroll
                    for (int j = 0; j < 4; ++j) { const float vv = v[j] * v[j]; const float ex = __builtin_amdgcn_exp2f(v[j] * __builtin_fmaf(vv, -0.10294324f, -2.30220820f)); ge[j] = v[j] * __builtin_amdgcn_rcpf(1.f + ex); }
                    u32x2 w; w.x = pk2(ge[0], ge[1]); w.y = pk2(ge[2], ge[3]);
                    *(u32x2*)(Y + (size_t)(row0 + tk) * D + g * 16 + 4 * (lane >> 4)) = w;
                }
            }
            asm volatile("s_waitcnt lgkmcnt(0)" ::: "memory");
        }
        if (!PASS2 && (blk & 3) == 3 && hf == 0) { float* e = (float*)(ws + WS_E) + ((size_t)(ch + (blk >> 2)) * 64 + g) * 128;
#pragma unroll
            for (int j = 0; j < 2; ++j) { e[j * 32 + s] = cr[j]; e[64 + j * 32 + s] = ci[j]; } }
    }
    if (PASS2 && !samp && hf == 0 && ((ch + 3) & 63) == 63) { const int b = ch >> 6;
#pragma unroll
        for (int j = 0; j < 2; ++j) { A.out[O_SREP + ((size_t)b * 64 + g) * 64 + s + 32 * j] = cr[j]; A.out[O_SIMP + ((size_t)b * 64 + g) * 64 + s + 32 * j] = ci[j]; } }
}

typedef short v4i16_t __attribute__((ext_vector_type(4)));
constexpr int KIMG_STRIDE = 144, KIMG_BYTES = 192 * KIMG_STRIDE, VIMG_HALF = 192 * 64, NATT_ITEMS = 3072;
struct AttItem { int g, sh, b, r, u0, kvh; };
__device__ __forceinline__ AttItem att_decode(int bi) {
    AttItem I; I.g = bi >> 10; const int rem = bi & 1023; I.kvh = rem & 3; I.b = (rem >> 2) & 1; const int rq = rem >> 3;
    I.sh = 2 * I.g; const int nqb = 128 >> I.sh; I.r = rq / nqb; I.u0 = 64 * (rq % nqb); return I;
}
template <bool COMBINE, int MODE = 0>
__device__ __forceinline__ void attn_prompt_phase(const Args& A, LAS unsigned char* lds, int tid, int wave, int lane, int item_lo, int item_hi) {
    unsigned char* ws = A.ws;
    const bf16* Q = (const bf16*)(ws + WS_Q); const bf16* KB = (const bf16*)(ws + WS_KB); const bf16* VB = (const bf16*)(ws + WS_VT);
    bf16* OG = (bf16*)(ws + WS_OG); float* LSE = (float*)(ws + WS_LSE);
    const int G = gridDim.x, hh = wave & 3, sub = wave >> 2, n = lane & 31, hf = lane >> 5;
    const int kap = (n & 3) + 4 * ((n >> 3) & 1) + 8 * ((n >> 2) & 1) + 16 * (n >> 4);
    int bi = item_lo + blockIdx.x;
    const int NATT_HI = item_hi;
    if (bi >= NATT_HI) return;
    bf16* AT = (bf16*)(ws + WS_ATT);
    u32x4 pk_[3], pv_[3]; bf16x8 qn[4];
#define ATT_ISSUE_KV(bix) do { const AttItem J = att_decode(bix); const int L_ = SEQ >> J.sh; const size_t pb_ = (size_t)J.g * MP + (size_t)J.b * SEQ + (size_t)J.r * L_; \
        _Pragma("unroll") for (int i = 0; i < 3; ++i) { const int c_ = tid + 512 * i, row_ = c_ >> 3, ch_ = c_ & 7; int u_ = J.u0 - 128 + row_; u_ = u_ < 0 ? 0 : u_; \
            pk_[i] = *(const u32x4*)(KB + (pb_ + u_) * 256 + J.kvh * 64 + 8 * ch_); pv_[i] = *(const u32x4*)(VB + (pb_ + u_) * 256 + J.kvh * 64 + 8 * ch_); } } while (0)
#define ATT_ISSUE_Q(bix) do { const AttItem J = att_decode(bix); const int qrow_ = J.b * SEQ + ((J.u0 + 32 * sub + n) << J.sh) + J.r; \
        _Pragma("unroll") for (int ks = 0; ks < 4; ++ks) qn[ks] = *(const bf16x8*)(Q + (size_t)qrow_ * QW + J.g * 1024 + (4 * J.kvh + hh) * 64 + 16 * ks + 8 * hf); } while (0)
#define ATT_WRITE(bufo) do { _Pragma("unroll") for (int i = 0; i < 3; ++i) { const int c = tid + 512 * i, row = c >> 3, ch = c & 7; \
            *(LAS u32x4*)(lds + (bufo) + row * KIMG_STRIDE + 16 * ch) = pk_[i]; \
            *(LAS u32x4*)(lds + (bufo) + KIMG_BYTES + (ch >> 2) * VIMG_HALF + row * 64 + (ch & 3) * 16) = pv_[i]; } } while (0)
    constexpr int ABUF = KIMG_BYTES + 2 * VIMG_HALF;
    bf16x8 qf[4];
    ATT_ISSUE_KV(bi); ATT_ISSUE_Q(bi);
    ATT_WRITE(0);
#pragma unroll
    for (int ks = 0; ks < 4; ++ks) qf[ks] = qn[ks];
    if (bi + G < NATT_HI) ATT_ISSUE_KV(bi + G);
    asm volatile("s_waitcnt lgkmcnt(0)\n\ts_barrier" ::: "memory");
    int par = 0;
    for (; bi < NATT_HI; bi += G, par ^= 1) {
        const AttItem I = att_decode(bi);
        if (bi + G < NATT_HI) { ATT_WRITE((par ^ 1) * ABUF); ATT_ISSUE_Q(bi + G); }
        if (bi + 2 * G < NATT_HI) ATT_ISSUE_KV(bi + 2 * G);
        const LAS unsigned char* lbuf = lds + par * ABUF;
        const int u0w = I.u0 + 32 * sub;
        const int qrow = I.b * SEQ + ((u0w + n) << I.sh) + I.r;
        const int h = 4 * I.kvh + hh;
        f32x16 O0, O1;
#pragma unroll
        for (int i = 0; i < 16; ++i) { O0[i] = 0.f; O1[i] = 0.f; }
        float mrun = -INFINITY, lrun = 0.f;
        const int cc_ = lane & 7, rr0_ = lane >> 3;
        bf16x8 x1[4], x2[4]; float l1 = 0.f, l2 = 0.f;
        if (COMBINE) {
            l1 = LSE[((size_t)1 * MP + qrow) * 16 + h]; l2 = LSE[((size_t)2 * MP + qrow) * 16 + h];
#pragma unroll
            for (int j = 0; j < 4; ++j) { const int qr_ = I.b * SEQ + ((u0w + rr0_ + 8 * j) << I.sh) + I.r;
                x1[j] = *(const bf16x8*)(OG + ((size_t)1 * MP + qr_) * D + h * 64 + 8 * cc_); x2[j] = *(const bf16x8*)(OG + ((size_t)2 * MP + qr_) * D + h * 64 + 8 * cc_); }
        }
        const int kt0 = (MODE == 1 || MODE == 3) ? 5 : (u0w >= 128 ? 0 : (128 - u0w) >> 5);
        const LAS unsigned char* kimg = lbuf + (32 * sub + kap) * KIMG_STRIDE + 16 * hf;
        const LAS unsigned char* vimg = lbuf + KIMG_BYTES + (32 * sub + 8 * hf + ((lane & 15) >> 2)) * 64 + (16 * ((lane >> 4) & 1) + 4 * (lane & 3)) * 2;
        for (int kt = kt0; kt < 5; ++kt) {
            bf16x8 kf[4], vf[2][2];
#pragma unroll
            for (int ks = 0; ks < 4; ++ks) kf[ks] = *(const LAS bf16x8*)(kimg + (32 * kt) * KIMG_STRIDE + 32 * ks);
#pragma unroll
            for (int mb = 0; mb < 2; ++mb)
#pragma unroll
                for (int st = 0; st < 2; ++st) {
                    const LAS unsigned char* vp = vimg + mb * VIMG_HALF + (32 * kt + 16 * st) * 64;
                    const v4i16_t lo = __builtin_amdgcn_ds_read_tr16_b64_v4i16((LAS v4i16_t*)vp);
                    const v4i16_t hi = __builtin_amdgcn_ds_read_tr16_b64_v4i16((LAS v4i16_t*)(vp + 4 * 64));
                    vf[mb][st] = (bf16x8){lo[0], lo[1], lo[2], lo[3], hi[0], hi[1], hi[2], hi[3]};
                }
            f32x16 S;
#pragma unroll
            for (int i = 0; i < 16; ++i) S[i] = 0.f;
#pragma unroll
            for (int ks = 0; ks < 4; ++ks) S = __builtin_amdgcn_mfma_f32_32x32x16_bf16(kf[ks], qf[ks], S, 0, 0, 0);
            if (kt == 0) {
#pragma unroll
                for (int rr = 0; rr < 16; ++rr) { const int kp = (rr & 7) + 8 * hf + 16 * (rr >> 3); if (kp < n) S[rr] = -INFINITY; }
            } else if (kt == 4) {
#pragma unroll
                for (int rr = 0; rr < 16; ++rr) { const int kp = (rr & 7) + 8 * hf + 16 * (rr >> 3); if (kp > n) S[rr] = -INFINITY; }
            }
            float tm = S[0];
#pragma unroll
            for (int rr = 1; rr < 16; ++rr) tm = fmaxf(tm, S[rr]);
            tm = fmaxf(tm, __shfl_xor(tm, 32));
            const float mnew = fmaxf(mrun, tm);
            const float alpha = __builtin_amdgcn_exp2f(mrun - mnew);
            float ps = 0.f; float p[16];
#pragma unroll
            for (int rr = 0; rr < 16; ++rr) { p[rr] = __builtin_amdgcn_exp2f(S[rr] - mnew); ps += p[rr]; }
            lrun = lrun * alpha + ps; mrun = mnew;
            if (__builtin_amdgcn_ballot_w64(alpha != 1.f) != 0ull) {
#pragma unroll
                for (int i = 0; i < 16; ++i) { O0[i] *= alpha; O1[i] *= alpha; }
            }
#pragma unroll
            for (int st = 0; st < 2; ++st) {
                u32x4 pw; pw.x = pk2(p[8 * st + 0], p[8 * st + 1]); pw.y = pk2(p[8 * st + 2], p[8 * st + 3]); pw.z = pk2(p[8 * st + 4], p[8 * st + 5]); pw.w = pk2(p[8 * st + 6], p[8 * st + 7]);
                const bf16x8 pf = __builtin_bit_cast(bf16x8, pw);
                O0 = __builtin_amdgcn_mfma_f32_32x32x16_bf16(vf[0][st], pf, O0, 0, 0, 0);
                O1 = __builtin_amdgcn_mfma_f32_32x32x16_bf16(vf[1][st], pf, O1, 0, 0, 0);
            }
        }
        const float ltot = lrun + __shfl_xor(lrun, 32);
        LAS unsigned char* ost = lds + 2 * ABUF + wave * 4864;
        float sc0;
        if (!COMBINE) { sc0 = 1.f / ltot; if (hf == 0) LSE[((size_t)I.g * MP + qrow) * 16 + h] = mrun + log2f(ltot); }
        else { const float l0 = mrun + log2f(ltot); const float mx = fmaxf(l0, fmaxf(l1, l2));
            const float w0 = __builtin_amdgcn_exp2f(l0 - mx), w1 = __builtin_amdgcn_exp2f(l1 - mx), w2 = __builtin_amdgcn_exp2f(l2 - mx);
            const float invw = 1.f / (w0 + w1 + w2); sc0 = w0 * invw / ltot;
            if (hf == 0) { LAS float* wp = (LAS float*)(ost + 4608) + 2 * n; wp[0] = w1 * invw; wp[1] = w2 * invw; } }
        if (MODE < 2) {
#pragma unroll
            for (int a = 0; a < 4; ++a) {
                u32x2 w0v, w1v; w0v.x = pk2(O0[4 * a] * sc0, O0[4 * a + 1] * sc0); w0v.y = pk2(O0[4 * a + 2] * sc0, O0[4 * a + 3] * sc0);
                w1v.x = pk2(O1[4 * a] * sc0, O1[4 * a + 1] * sc0); w1v.y = pk2(O1[4 * a + 2] * sc0, O1[4 * a + 3] * sc0);
                *(LAS u32x2*)(ost + n * 144 + (8 * a + 4 * hf) * 2) = w0v; *(LAS u32x2*)(ost + n * 144 + 64 + (8 * a + 4 * hf) * 2) = w1v;
            }
            asm volatile("s_waitcnt lgkmcnt(0)" ::: "memory");
#pragma unroll
            for (int j = 0; j < 4; ++j) { const int rr_ = rr0_ + 8 * j; const int qr_ = I.b * SEQ + ((u0w + rr_) << I.sh) + I.r;
                const bf16x8 tv = *(const LAS bf16x8*)(ost + rr_ * 144 + 16 * cc_);
                if (!COMBINE) *(bf16x8*)(OG + ((size_t)I.g * MP + qr_) * D + h * 64 + 8 * cc_) = tv;
                else { const LAS float* wp = (const LAS float*)(ost + 4608) + 2 * rr_; const float w1 = wp[0], w2 = wp[1];
                    float o[8];
#pragma unroll
                    for (int i = 0; i < 8; ++i) o[i] = bf2f((unsigned short)tv[i]) + w1 * bf2f((unsigned short)x1[j][i]) + w2 * bf2f((unsigned short)x2[j][i]);
                    u32x4 y; y.x = pk2(o[0], o[1]); y.y = pk2(o[2], o[3]); y.z = pk2(o[4], o[5]); y.w = pk2(o[6], o[7]);
                    *(u32x4*)(AT + (size_t)qr_ * D + h * 64 + 8 * cc_) = y; }
            }
        } else { if (ltot == 123.456f) LSE[0] = ltot; }
#pragma unroll
        for (int ks = 0; ks < 4; ++ks) qf[ks] = qn[ks];
        asm volatile("s_waitcnt lgkmcnt(0)\n\ts_barrier" ::: "memory");
    }
#undef ATT_ISSUE_KV
#undef ATT_ISSUE_Q
#undef ATT_WRITE
}

__device__ __forceinline__ void attn_sample_item(const Args& A, LAS float* sl, int it, int lane) {
    unsigned char* ws = A.ws;
    const int h = it & 15, t = (it >> 4) & 3, n = it >> 6, kvh = h >> 2;
    const int row = NPROMPT + 4 * n + t;
    const bf16* Q = (const bf16*)(ws + WS_Q) + (size_t)row * QW + h * 64;
    const int kq = lane >> 2, dq = lane & 3;
    float mxl = -INFINITY;
#pragma unroll 1
    for (int g = 0; g < 3; ++g) {
        const int W = 128 << (2 * g), dil = 1 << (2 * g);
        const float* cache = A.in[2 + g] + (size_t)n * W * 512;
        const float* newkv = A.out + (g == 0 ? O_KVS0 : g == 1 ? O_KVS1 : O_KVS2) + (size_t)n * 4 * 512;
        float q[16];
#pragma unroll
        for (int c8 = 0; c8 < 2; ++c8) { const bf16x8 v = *(const bf16x8*)(Q + g * 1024 + 16 * dq + 8 * c8);
#pragma unroll
            for (int i = 0; i < 8; ++i) q[8 * c8 + i] = bf2f((unsigned short)v[i]); }
        f32x4 kvv[9][4];
#pragma unroll
        for (int bt = 0; bt < 9; ++bt) {
            const int j = 16 * bt + kq; const int jj = j <= 128 ? j : 128;
            const int idx = W + t - dil * jj;
            const float* kp = (idx >= W ? newkv + (size_t)(idx - W) * 512 : cache + (size_t)idx * 512) + kvh * 64 + 16 * dq;
#pragma unroll
            for (int c4 = 0; c4 < 4; ++c4) kvv[bt][c4] = *(const f32x4*)(kp + 4 * c4);
        }
        __builtin_amdgcn_sched_barrier(0);
#pragma unroll
        for (int bt = 0; bt < 9; ++bt) {
            const int j = 16 * bt + kq; const bool valid = j <= 128;
            float s = 0.f;
#pragma unroll
            for (int c4 = 0; c4 < 4; ++c4) { const f32x4 kv = kvv[bt][c4]; s += q[4 * c4] * kv[0] + q[4 * c4 + 1] * kv[1] + q[4 * c4 + 2] * kv[2] + q[4 * c4 + 3] * kv[3]; }
            s += __shfl_xor(s, 1); s += __shfl_xor(s, 2);
            if (valid && dq == 0) sl[g * 132 + j] = s;
            mxl = fmaxf(mxl, valid ? s : -INFINITY);
        }
    }
    const float mx = wave_max(mxl);
    asm volatile("s_waitcnt lgkmcnt(0)" ::: "memory");
    float sum = 0.f;
#pragma unroll 1
    for (int i = lane; i < 396; i += 64) { const int j = i % 132; if (j <= 128) { const float p = exp2f(sl[i] - mx); sl[i] = p; sum += p; } }
    sum = wave_sum(sum);
    asm volatile("s_waitcnt lgkmcnt(0)" ::: "memory");
    f32x4 acc = {0.f, 0.f, 0.f, 0.f};
    const int ksl = lane >> 4, dq4 = lane & 15;
#pragma unroll 1
    for (int g = 0; g < 3; ++g) {
        const int W = 128 << (2 * g), dil = 1 << (2 * g);
        const float* cache = A.in[2 + g] + (size_t)n * W * 512;
        const float* newkv = A.out + (g == 0 ? O_KVS0 : g == 1 ? O_KVS1 : O_KVS2) + (size_t)n * 4 * 512;
        f32x4 vvv[33];
#pragma unroll
        for (int jb = 0; jb < 33; ++jb) {
            const int j = 4 * jb + ksl; const int jj = j <= 128 ? j : 128;
            const int idx = W + t - dil * jj;
            vvv[jb] = *(const f32x4*)((idx >= W ? newkv + (size_t)(idx - W) * 512 : cache + (size_t)idx * 512) + 256 + kvh * 64 + 4 * dq4);
        }
        __builtin_amdgcn_sched_barrier(0);
#pragma unroll
        for (int jb = 0; jb < 33; ++jb) {
            const int j = 4 * jb + ksl; const bool valid = j <= 128; const int jj = valid ? j : 128;
            const float pj = valid ? sl[g * 132 + jj] : 0.f;
            acc += vvv[jb] * pj;
        }
    }
#pragma unroll
    for (int i = 0; i < 4; ++i) { acc[i] += __shfl_xor(acc[i], 16); acc[i] += __shfl_xor(acc[i], 32); }
    bf16* AT = (bf16*)(ws + WS_ATT);
    if (lane < 16) { const float inv = 1.f / sum; u32x2 w; w.x = pk2(acc[0] * inv, acc[1] * inv); w.y = pk2(acc[2] * inv, acc[3] * inv);
        *(u32x2*)(AT + (size_t)row * D + h * 64 + 4 * dq4) = w; }
    asm volatile("s_waitcnt lgkmcnt(0)" ::: "memory");
}

__device__ __forceinline__ void attn_combine(const Args& A, int gt, int NGT) {
    unsigned char* ws = A.ws;
    const bf16* OG = (const bf16*)(ws + WS_OG); const float* LSE = (const float*)(ws + WS_LSE); bf16* AT = (bf16*)(ws + WS_ATT);
    for (int i = gt; i < NPROMPT * 128; i += NGT) {
        const int row = i >> 7, c8 = i & 127, h = c8 >> 3;
        const float l0 = LSE[((size_t)0 * MP + row) * 16 + h], l1 = LSE[((size_t)1 * MP + row) * 16 + h], l2 = LSE[((size_t)2 * MP + row) * 16 + h];
        const float mx = fmaxf(l0, fmaxf(l1, l2));
        float w0 = exp2f(l0 - mx), w1 = exp2f(l1 - mx), w2 = exp2f(l2 - mx); const float inv = 1.f / (w0 + w1 + w2); w0 *= inv; w1 *= inv; w2 *= inv;
        const bf16x8 a = *(const bf16x8*)(OG + ((size_t)0 * MP + row) * D + 8 * c8), b = *(const bf16x8*)(OG + ((size_t)1 * MP + row) * D + 8 * c8), c = *(const bf16x8*)(OG + ((size_t)2 * MP + row) * D + 8 * c8);
        float o[8];
#pragma unroll
        for (int k = 0; k < 8; ++k) o[k] = w0 * bf2f((unsigned short)a[k]) + w1 * bf2f((unsigned short)b[k]) + w2 * bf2f((unsigned short)c[k]);
        u32x4 w; w.x = pk2(o[0], o[1]); w.y = pk2(o[2], o[3]); w.z = pk2(o[4], o[5]); w.w = pk2(o[6], o[7]);
        *(u32x4*)(AT + (size_t)row * D + 8 * c8) = w;
    }
}

#define XB_TMO      128
#define XB_XCNT(j)  (256  + 64 * (j))
#define XB_XSUB(j)  (1280 + 64 * (j))
#define XB_XGEN(j)  (2304 + 64 * (j))
#define XB_TOP      3328
#define XB_TOPGEN   3392
#define XCD_BAR_WORDS 3456
#define XB_SPIN_CAP (1u << 18)

__device__ __forceinline__ unsigned xb_ld(unsigned* p)              { return __hip_atomic_load(p, __ATOMIC_RELAXED, __HIP_MEMORY_SCOPE_AGENT); }
__device__ __forceinline__ unsigned xb_add(unsigned* p, unsigned v) { return __hip_atomic_fetch_add(p, v, __ATOMIC_RELAXED, __HIP_MEMORY_SCOPE_AGENT); }
__device__ __forceinline__ unsigned xb_xcc_id() { return (unsigned)__builtin_amdgcn_s_getreg((3 << 11) | 20) & 0xFu; }
#define XB_SPIN(cond, bar) do { unsigned _sp = 0; while (cond) { __builtin_amdgcn_s_sleep(1); \
    if ((++_sp & 255u) == 0u) { if (xb_ld(&(bar)[XB_TMO])) break; if (_sp > XB_SPIN_CAP) { atomicAdd(&(bar)[XB_TMO], 1u); break; } } } } while (0)

struct XcdBarrier {
    unsigned* bar; unsigned x;
    volatile LAS unsigned* st;
};

__device__ __forceinline__ XcdBarrier xcd_barrier_post(unsigned* bar, volatile LAS unsigned* st) {
    XcdBarrier b; b.bar = bar; b.x = xb_xcc_id(); b.st = st;
    if (threadIdx.x == 0) (void)xb_add(&bar[XB_XCNT(b.x)], 1u);
    return b;
}
__device__ __forceinline__ void xcd_barrier_complete(unsigned* bar, unsigned x, unsigned& nloc, unsigned& nx) {
    const unsigned G = gridDim.x * gridDim.y * gridDim.z;
    unsigned sum, cnt, mine, sp = 0u;
    for (;;) {
        sum = 0u; cnt = 0u; mine = 0u;
#pragma unroll
        for (unsigned j = 0; j < 16; ++j) { const unsigned c = xb_ld(&bar[XB_XCNT(j)]); sum += c; cnt += (c > 0u) ? 1u : 0u; mine = (j == x) ? c : mine; }
        if (sum == G) break;
        __builtin_amdgcn_s_sleep(1);
        if ((++sp & 255u) == 0u) { if (xb_ld(&bar[XB_TMO])) break; if (sp > XB_SPIN_CAP) { atomicAdd(&bar[XB_TMO], 1u); break; } }
    }
    nloc = mine > 0u ? mine : 1u; nx = cnt > 0u ? cnt : 1u;
}

__device__ __forceinline__ void xcd_barrier(const XcdBarrier& b) {
    asm volatile("s_waitcnt vmcnt(0)" ::: "memory");
    __syncthreads();
    if (threadIdx.x == 0) {
        unsigned* bar = b.bar;
        __builtin_amdgcn_s_waitcnt(0);
        unsigned nloc = b.st[0], nx = b.st[1];
        if (nloc == 0u) { xcd_barrier_complete(bar, b.x, nloc, nx); b.st[0] = nloc; b.st[1] = nx; }
        const unsigned old = xb_add(&bar[XB_XSUB(b.x)], 1u);
        const unsigned gen = old / nloc;
        if (old + 1u == (gen + 1u) * nloc) {
            __builtin_amdgcn_fence(__ATOMIC_RELEASE, "agent");
            asm volatile("s_waitcnt vmcnt(0)" ::: "memory");
            const unsigned og = xb_add(&bar[XB_TOP], 1u);
            const unsigned tg = og / nx;
            if (og + 1u == (tg + 1u) * nx) xb_add(&bar[XB_TOPGEN], 1u);
            else XB_SPIN(xb_ld(&bar[XB_TOPGEN]) == tg, bar);
            __builtin_amdgcn_fence(__ATOMIC_ACQUIRE, "agent");
            xb_add(&bar[XB_XGEN(b.x)], 1u);
            asm volatile("s_waitcnt vmcnt(0)" ::: "memory");
        } else {
            XB_SPIN(xb_ld(&bar[XB_XGEN(b.x)]) == gen, bar);
            __builtin_amdgcn_fence(__ATOMIC_ACQUIRE, "agent");
            asm volatile("s_waitcnt vmcnt(0)" ::: "memory");
        }
    }
    __syncthreads();
}

constexpr int NPHASE = 13;
#ifndef REP0
#define REP0 1
#endif
#ifndef REP12
#define REP12 1
#endif
#ifndef REP7
#define REP7 1
#endif
#ifndef REP8
#define REP8 1
#endif
#ifndef REP4
#define REP4 1
#endif
#ifndef REP6
#define REP6 1
#endif
#ifndef DUP4
#define DUP4 0
#endif
#ifndef DUP6
#define DUP6 0
#endif
#ifndef DUP5
#define DUP5 0
#endif
#ifndef PROBE8
#define PROBE8 0
#endif
#ifndef XSYNC
#define XSYNC 0
#endif
__global__ void __launch_bounds__(NTHREADS, 2) yoco_fwd(Args A) {
    extern __shared__ __attribute__((aligned(16))) unsigned char lds_raw[];
    LAS unsigned char* lds = (LAS unsigned char*)lds_raw;
    cg::grid_group grid = cg::this_grid();
    const int tid = threadIdx.x, lane = tid & 63, wave = __builtin_amdgcn_readfirstlane(tid >> 6);
    const int G = gridDim.x, gw = blockIdx.x * NWAVES + wave, NGW = G * NWAVES, gt = gw * 64 + lane, NGT = NGW * 64;
    unsigned char* ws = A.ws;
    float* rowss = (float*)(ws + WS_ROWSS);
    float* Hf = (float*)(ws + WS_H); bf16* HB = (bf16*)(ws + WS_HB);
    const int lo = A.ph_lo, hi = A.ph_hi;
    volatile LAS unsigned* bst = (volatile LAS unsigned*)(lds + LDS_BYTES - 64);
    if (tid < 2) bst[tid] = 0u;
    __syncthreads();
    XcdBarrier xbar = xcd_barrier_post((unsigned*)(ws + WS_BAR), bst);
    if (lo < 0) grid.sync();
#ifndef PH_MASK
#define PH_MASK 0xffff
#endif
#define IN(k) (((PH_MASK >> (k)) & 1) && lo <= (k) && (k) < hi)
#define SEAM(k) do { if (IN(k) && IN((k) + 1)) xcd_barrier(xbar); } while (0)
    if (IN(0)) { for (int rp = 0; rp < REP0; ++rp) phase_prologue(A, lds, gw, NGW, wave, lane); for (int rp = 0; rp < XSYNC; ++rp) xcd_barrier(xbar); }
    SEAM(0);
    if (IN(1)) for (int rp = 0; rp < REP12; ++rp) { for (int it = gw; it < 2048; it += NGW) s5_item<false>(A, lds + wave * 8704, it, lane); }
    SEAM(1);
    if (IN(2)) for (int rp = 0; rp < REP12; ++rp) { for (int it = gw; it < 4096; it += NGW) s5_item<true>(A, lds + wave * 8704, it, lane); }
    SEAM(2);
    if (IN(3)) { pg8::Gemm g{(const bf16*)(ws + WS_Y), (const bf16*)(ws + W_GLU), NPROMPT, 2048, 1024}; pg8::StaticOrder S; S.init(NPROMPT, 2048, G, (int)blockIdx.x);
        EpiGlu E{A.in[0], A.in[1], Hf, HB, rowss};
        pg8::gemm_phase<EpiGlu, pg8::StaticOrder, true, true>(lds, g, S, E);
        skinny_phase(lds, g.A, g.Bt, 2048, 1024, E, 0, wave, lane); }
    SEAM(3);
    if (IN(4)) { pg8::Gemm g{HB, (const bf16*)(ws + W_UP0), NPROMPT, FF, 1024}; pg8::StaticOrder S; S.init(NPROMPT, FF, G, (int)blockIdx.x);
        EpiUp E{(bf16*)(ws + WS_ACT), rowss};
        pg8::gemm_phase<EpiUp, pg8::StaticOrder, true, true>(lds, g, S, E);
        skinny_phase(lds, g.A, g.Bt, FF, 1024, E, 0, wave, lane);
#if DUP4 == 1
        pg8::gemm_phase<EpiUp, pg8::StaticOrder, true, true>(lds, g, S, E);
#endif
#if DUP4 == 3
        { EpiNull E0{(float*)(ws + WS_OG)};
        skinny_phase(lds, g.A, g.Bt, FF, 1024, E0, 0, wave, lane); skinny_phase(lds, g.A, g.Bt, FF, 1024, E0, 0, wave, lane);
        skinny_phase(lds, g.A, g.Bt, FF, 1024, E0, 0, wave, lane); skinny_phase(lds, g.A, g.Bt, FF, 1024, E0, 0, wave, lane); }
#endif
#if DUP4 == 2
        skinny_phase(lds, g.A, g.Bt, FF, 1024, E, 0, wave, lane);
        skinny_phase(lds, g.A, g.Bt, FF, 1024, E, 0, wave, lane);
        skinny_phase(lds, g.A, g.Bt, FF, 1024, E, 0, wave, lane);
        skinny_phase(lds, g.A, g.Bt, FF, 1024, E, 0, wave, lane);
#endif
    }
    SEAM(4);
    if (IN(5)) { pg8::Gemm g{(const bf16*)(ws + WS_ACT), (const bf16*)(ws + W_DN0), NPROMPT, 1024, FF}; pg8::StaticOrder S; S.init(NPROMPT, 1024, G, (int)blockIdx.x);
        EpiRes E{HB, nullptr, rowss + MP};
        pg8::gemm_phase<EpiRes, pg8::StaticOrder, true, true>(lds, g, S, E);
        skinny_phase(lds, g.A, g.Bt, 1024, FF, E, 0, wave, lane);
#if DUP5 == 2
        { EpiUp E2{(bf16*)(ws + WS_OG), rowss}; pg8::gemm_phase<EpiUp, pg8::StaticOrder, true, true>(lds, g, S, E2); }
#endif
    }
    SEAM(5);
    if (IN(6)) { pg8::Gemm g{HB, (const bf16*)(ws + W_QKV), NPROMPT, NQKV, 1024}; pg8::StaticOrder S; S.init(NPROMPT, NQKV, G, (int)blockIdx.x);
        EpiQKV E{(bf16*)(ws + WS_Q), (bf16*)(ws + WS_KB), (bf16*)(ws + WS_VT), A.out, rowss + MP, (const float*)(ws + WS_ROPE), (const float*)(ws + WS_ROPE) + 8196 * 32, (const float*)(ws + WS_ROPE) + 2 * 8196 * 32, (const float*)(ws + WS_ROPE) + 2 * 8196 * 32 + 8 * 32};
        pg8::gemm_phase<EpiQKV, pg8::StaticOrder, true, true>(lds, g, S, E);
        skinny_phase(lds, g.A, g.Bt, NQKV, 1024, E, G >= 256 ? 128 : 0, wave, lane);
        { const int cf = G >= 256 ? 128 : 0; if ((int)blockIdx.x >= cf) convert_late(A, lds, ((int)blockIdx.x - cf) * NWAVES + wave, (G - cf) * NWAVES, wave, lane); }
#if DUP6 == 1
        pg8::gemm_phase<EpiQKV, pg8::StaticOrder, true, true>(lds, g, S, E);
#endif
#if DUP6 == 2
        { EpiUp E2{(bf16*)(ws + WS_OG), rowss + MP}; pg8::gemm_phase<EpiUp, pg8::StaticOrder, true, true>(lds, g, S, E2); }
#endif
    }
    SEAM(6);
    if (IN(7)) for (int rp = 0; rp < REP7; ++rp) {
        for (int it = gw; it < 2048; it += NGW) attn_sample_item(A, (LAS float*)(lds + 65536 + wave * 2048), it, lane);
        __syncthreads();
        attn_prompt_phase<false>(A, lds, tid, wave, lane, 1024, NATT_ITEMS);
    }
    SEAM(7);
    if (IN(8)) {
#if PROBE8 > 0
        attn_prompt_phase<true, PROBE8>(A, lds, tid, wave, lane, 0, 1024); __syncthreads();
#endif
        attn_prompt_phase<true>(A, lds, tid, wave, lane, 0, 1024); }
    SEAM(8);
    if (IN(9)) { pg8::Gemm g{(const bf16*)(ws + WS_ATT), (const bf16*)(ws + W_O), NPROMPT, 1024, 1024}; pg8::StaticOrder S; S.init(NPROMPT, 1024, G, (int)blockIdx.x);
        EpiRes E{HB, nullptr, rowss + 2 * MP};
        pg8::gemm_phase<EpiRes, pg8::StaticOrder, true, true>(lds, g, S, E);
        skinny_phase(lds, g.A, g.Bt, 1024, 1024, E, 0, wave, lane); }
    SEAM(9);
    if (IN(10)) { pg8::Gemm g{HB, (const bf16*)(ws + W_UP1), NPROMPT, FF, 1024}; pg8::StaticOrder S; S.init(NPROMPT, FF, G, (int)blockIdx.x);
        EpiUp E{(bf16*)(ws + WS_ACT), rowss + 2 * MP};
        pg8::gemm_phase<EpiUp, pg8::StaticOrder, true, true>(lds, g, S, E);
        skinny_phase(lds, g.A, g.Bt, FF, 1024, E, 0, wave, lane); }
    SEAM(10);
    if (IN(11)) { pg8::Gemm g{(const bf16*)(ws + WS_ACT), (const bf16*)(ws + W_DN1), NPROMPT, 1024, FF}; pg8::StaticOrder S; S.init(NPROMPT, 1024, G, (int)blockIdx.x);
        EpiRes E{HB, nullptr, rowss + 3 * MP};
        pg8::gemm_phase<EpiRes, pg8::StaticOrder, true, true>(lds, g, S, E);
        skinny_phase(lds, g.A, g.Bt, 1024, FF, E, 0, wave, lane); }
    SEAM(11);
    if (IN(12)) {
        const float* gfin = A.in[24];
        for (int row0 = 4 * gw; row0 < MREAL; row0 += 4 * NGW) {
            bf16x8 hv[4][2]; float rs[4];
#pragma unroll
            for (int q = 0; q < 4; ++q) { rs[q] = rowss[3 * MP + row0 + q];
#pragma unroll
                for (int j = 0; j < 2; ++j) hv[q][j] = *((const bf16x8*)(HB + (size_t)(row0 + q) * D) + lane + 64 * j); }
#pragma unroll
            for (int j = 0; j < 2; ++j) { const f32x4 g0 = *((const f32x4*)gfin + 2 * (lane + 64 * j)), g1 = *((const f32x4*)gfin + 2 * (lane + 64 * j) + 1);
#pragma unroll
                for (int q = 0; q < 4; ++q) { const float rstd = __builtin_amdgcn_rsqf(rs[q] * (1.f / D) + EPS); float* orow = A.out + (size_t)(row0 + q) * D;
                    f32x4 o0, o1;
#pragma unroll
                    for (int i = 0; i < 4; ++i) { o0[i] = bf2f((unsigned short)hv[q][j][i]) * rstd * g0[i]; o1[i] = bf2f((unsigned short)hv[q][j][4 + i]) * rstd * g1[i]; }
                    *((f32x4*)orow + 2 * (lane + 64 * j)) = o0; *((f32x4*)orow + 2 * (lane + 64 * j) + 1) = o1; } }
        }
    }
#undef IN
#undef SEAM
}

#ifndef N_LAUNCHES
#define N_LAUNCHES 1
#endif
extern "C" void kernel_launch(void* const* d_in, const int* in_sizes, int n_in, void* d_out, int out_size, void* d_ws, size_t ws_size, hipStream_t stream) {
    static int grid = 0;
    if (grid == 0) {
        if (n_in != 25 || ws_size < WS_END) { fprintf(stderr, "kernel_launch: unexpected n_in %d / ws %zu\n", n_in, ws_size); grid = -1; return; }
        int dev = 0, cus = 0, per_cu = 0;
        hipGetDevice(&dev); hipDeviceGetAttribute(&cus, hipDeviceAttributeMultiprocessorCount, dev);
        if (hipFuncSetAttribute((const void*)yoco_fwd, hipFuncAttributeMaxDynamicSharedMemorySize, LDS_BYTES) != hipSuccess) { fprintf(stderr, "hipFuncSetAttribute failed\n"); grid = -1; return; }
        hipOccupancyMaxActiveBlocksPerMultiprocessor(&per_cu, (const void*)yoco_fwd, NTHREADS, LDS_BYTES);
        (void)hipGetLastError();
        if (per_cu < 1) per_cu = 1;
        grid = cus * per_cu;
    }
    if (grid < 0) return;
    Args a{};
    for (int i = 0; i < 25; ++i) a.in[i] = (const float*)d_in[i];
    a.out = (float*)d_out; a.ws = (unsigned char*)d_ws;
    if (hipMemsetAsync((char*)d_ws + WS_BAR, 0, 16384, stream) != hipSuccess) { fprintf(stderr, "memset failed\n"); return; }
    if (N_LAUNCHES == 1) {
        a.ph_lo = 0; a.ph_hi = NPHASE;
        void* args[] = {&a};
        hipError_t e = hipLaunchCooperativeKernel((const void*)yoco_fwd, dim3(grid), dim3(NTHREADS), args, LDS_BYTES, stream);
        if (e != hipSuccess) fprintf(stderr, "cooperative launch failed: %s (grid %d)\n", hipGetErrorString(e), grid);
    } else {
        for (int p = 0; p < NPHASE; ++p) { a.ph_lo = p; a.ph_hi = p + 1; hipLaunchKernelGGL(yoco_fwd, dim3(grid), dim3(NTHREADS), LDS_BYTES, stream, a); }
    }
}
```

```cpp
#include <hip/hip_runtime.h>
#include <hip/hip_cooperative_groups.h>
#include <cstdio>
#include <cstdint>
#include <cmath>
namespace cg = cooperative_groups;
namespace pg8 {
#define PG8_LAS __attribute__((address_space(3)))
typedef unsigned short bf16_t;
typedef short bf16x8 __attribute__((ext_vector_type(8)));
typedef float f32x4 __attribute__((ext_vector_type(4)));
typedef unsigned u32x4 __attribute__((ext_vector_type(4)));
constexpr int BM = 256, BK = 64, HALF = 128, HTB = HALF * BK * 2  , STAGE_BYTES = 8 * HTB, NXCD = 8, WGM = 8;

__host__ __device__ __forceinline__ int lds_byte(int r, int c) { const int st = (r >> 4) * 2 + (c >> 5), rr = r & 15, cc = c & 31, ob = rr * 64 + cc * 2; return st * 1024 + (ob ^ (((ob >> 9) & 1) << 5)); }
__host__ __device__ __forceinline__ void stage_rc(int b, int& R, int& C) { const int st = b / 1024, sb = b % 1024, swz = sb ^ (((sb >> 9) & 1) << 5); R = (st >> 1) * 16 + swz / 64; C = (st & 1) * 32 + (swz % 64) / 2; }
__host__ __device__ __forceinline__ int perm32(int rho) { const int n = rho >> 4, i = rho & 15; return 8 * (i >> 2) + 4 * n + (i & 3); }

struct Unit { int pm, pn; };
struct Gemm { const bf16_t* A; const bf16_t* Bt; int M, N, K; };

struct StaticOrder {
    int nM, nN, nwg, G, c;
    __host__ __device__ void init(int M, int N, int G_, int c_) { nM = M / BM; nN = N / BM; nwg = nM * nN; G = G_; c = c_; }
    __host__ __device__ bool next(int i, Unit& u) const {
        const long L = (long)i * G + c; if (L >= nwg) return false;
        int wgid = (int)L; { const int q = nwg / NXCD, r = nwg % NXCD, xcd = wgid % NXCD, off = wgid / NXCD; wgid = (xcd < r ? xcd * (q + 1) : r * (q + 1) + (xcd - r) * q) + off; }
        const int nig = WGM * nN, gid = wgid / nig, fm = gid * WGM, gsz = (nM - fm) < WGM ? (nM - fm) : WGM;
        u.pm = fm + ((wgid % nig) % gsz); u.pn = (wgid % nig) / gsz; return true;
    }
    __device__ __forceinline__ void a_ready(const Unit&) const {}
    __device__ __forceinline__ void done(const Unit&) const {}
};

__device__ __forceinline__ unsigned cvt_pk_bf16(float lo, float hi) { unsigned r; asm volatile("v_cvt_pk_bf16_f32 %0, %1, %2" : "=v"(r) : "v"(lo), "v"(hi)); return r; }
typedef float f32x2 __attribute__((ext_vector_type(2)));
__device__ __forceinline__ f32x2 gelu_pk(f32x2 v) {
    const f32x2 av = __builtin_elementwise_abs(v), d = av * 0.2316418882f + 1.0f;
    f32x2 t; t.x = __builtin_amdgcn_rcpf(d.x); t.y = __builtin_amdgcn_rcpf(d.y);
    f32x2 q = t * 0.5307027145f + (-0.7265760135f); q = q * t + 0.7107068705f; q = q * t + (-0.142248368f); q = q * t + 0.127414796f; q = q * t;
    const f32x2 s = (v * v) * (-0.72134752044f);
    f32x2 e; e.x = __builtin_amdgcn_exp2f(s.x); e.y = __builtin_amdgcn_exp2f(s.y);
    const f32x2 m = v * (q * e), r = v - m;
    f32x2 o; o.x = v.x < 0.f ? m.x : r.x; o.y = v.y < 0.f ? m.y : r.y; return o;
}


template <class Epi, class Sched, bool ALIGN_EPI = false, bool SP2 = false>
__device__ __forceinline__ void gemm_phase(PG8_LAS unsigned char* lds, const Gemm g, const Sched& S, const Epi& E) {
    const int tid = threadIdx.x, wid = __builtin_amdgcn_readfirstlane(tid >> 6), lane = tid & 63, wr = wid >> 2, wc = wid & 3, fr = lane & 15, fq = lane >> 4;
    const int K = g.K, nt = K / BK;
    unsigned voffA[2], voffB[2];
#pragma unroll
    for (int i = 0; i < 2; ++i) { int R, C; stage_rc(tid * 16 + i * 8192, R, C); const int Rb = Epi::PERM ? ((R & ~31) + perm32(R & 31)) : R;
        voffA[i] = (unsigned)(R * K + C) * 2u; voffB[i] = (unsigned)(Rb * K + C) * 2u; }
    const size_t kstep = (size_t)(BK * 2);
    const size_t hstep = (size_t)HALF * K * 2;
    const size_t tstep = 2 * hstep;
    const unsigned ldsw = (unsigned)wid * 1024u;
    const int aoff = lds_byte(wr * 64 + fr, fq * 8), boff = lds_byte(wc * 32 + fr, fq * 8);
#define PG8_SA(b, h) (((b) * 2 + (h)) * HTB)
#define PG8_SB(b, h) ((4 + (b) * 2 + (h)) * HTB)
#define PG8_STAGE(bufoff, gbase, voff) do { _Pragma("unroll") for (int _i = 0; _i < 2; ++_i) \
        __builtin_amdgcn_global_load_lds((const unsigned*)((const char*)(gbase) + (voff)[_i]), (PG8_LAS unsigned*)(lds + (bufoff) + ldsw + _i * 8192), 16, 0, 0); } while (0)
#define PG8_LDA(dst, b, h) do { _Pragma("unroll") for (int m = 0; m < 4; ++m) _Pragma("unroll") for (int k = 0; k < 2; ++k) dst[m][k] = *(const PG8_LAS bf16x8*)(lds + PG8_SA(b, h) + aoff + m * 2048 + k * 1024); } while (0)
#define PG8_LDB(dst, b, h) do { _Pragma("unroll") for (int n = 0; n < 2; ++n) _Pragma("unroll") for (int k = 0; k < 2; ++k) dst[n][k] = *(const PG8_LAS bf16x8*)(lds + PG8_SB(b, h) + boff + n * 2048 + k * 1024); } while (0)
#define PG8_MMA(ai, bj, At, Bt) do { __builtin_amdgcn_s_setprio(1); _Pragma("unroll") for (int m = 0; m < 4; ++m) _Pragma("unroll") for (int n = 0; n < 2; ++n) _Pragma("unroll") for (int k = 0; k < 2; ++k) \
        acc[ai][bj][m][n] = __builtin_amdgcn_mfma_f32_16x16x32_bf16(Bt[n][k], At[m][k], acc[ai][bj][m][n], 0, 0, 0); __builtin_amdgcn_s_setprio(0); } while (0)
#define PG8_WAIT_V(n) asm volatile("s_waitcnt vmcnt(" #n ")" ::: "memory")
#define PG8_WAIT_L(n) asm volatile("s_waitcnt lgkmcnt(" #n ")" ::: "memory")
#define PG8_BAR __builtin_amdgcn_s_barrier()
#define PG8_SCHED __builtin_amdgcn_sched_barrier(0)
    Unit cur, nxt; int ui = 0;
    if (!S.next(0, cur)) return;
    f32x4 acc[2][2][4][2];
#pragma unroll
    for (int a = 0; a < 2; ++a)
#pragma unroll
        for (int b = 0; b < 2; ++b)
#pragma unroll
            for (int m = 0; m < 4; ++m)
#pragma unroll
                for (int n = 0; n < 2; ++n) acc[a][b][m][n] = (f32x4){0.f, 0.f, 0.f, 0.f};
    bf16x8 At[4][2], B0[2][2], B1[2][2];
    const char* cA = (const char*)g.A + (size_t)cur.pm * tstep; const char* cB = (const char*)g.Bt + (size_t)cur.pn * tstep;
    S.a_ready(cur);
    if constexpr (SP2) {
        PG8_STAGE(PG8_SB(0, 0), cB, voffB); PG8_STAGE(PG8_SB(0, 1), cB + hstep, voffB); PG8_STAGE(PG8_SA(0, 0), cA, voffA); PG8_STAGE(PG8_SA(0, 1), cA + hstep, voffA);
        if (wr == 1) PG8_BAR;
        PG8_WAIT_V(2); PG8_BAR;
        PG8_STAGE(PG8_SB(1, 0), cB + kstep, voffB); PG8_STAGE(PG8_SA(1, 0), cA + kstep, voffA); PG8_STAGE(PG8_SB(1, 1), cB + hstep + kstep, voffB);
        PG8_WAIT_V(6); PG8_BAR;
    } else {
        PG8_STAGE(PG8_SB(0, 0), cB, voffB); PG8_STAGE(PG8_SA(0, 0), cA, voffA); PG8_STAGE(PG8_SB(0, 1), cB + hstep, voffB); PG8_STAGE(PG8_SA(0, 1), cA + hstep, voffA);
        if (wr == 1) PG8_BAR;
        PG8_WAIT_V(4); PG8_BAR;
        PG8_STAGE(PG8_SB(1, 0), cB + kstep, voffB); PG8_STAGE(PG8_SA(1, 0), cA + kstep, voffA); PG8_STAGE(PG8_SB(1, 1), cB + hstep + kstep, voffB);
        PG8_WAIT_V(6); PG8_BAR;
    }
    for (;;) {
        const bool has_next = S.next(ui + 1, nxt);
        const char* nA = has_next ? (const char*)g.A + (size_t)nxt.pm * tstep : cA; const char* nB = has_next ? (const char*)g.Bt + (size_t)nxt.pn * tstep : cB;
        for (int t = 0; t < nt; t += 2) {
            const bool last = (t == nt - 2);
            const char* a1 = cA + (size_t)(t + 1) * kstep;
            const char* a2 = last ? nA : cA + (size_t)(t + 2) * kstep; const char* b2 = last ? nB : cB + (size_t)(t + 2) * kstep;
            const char* a3 = a2 + kstep; const char* b3 = b2 + kstep;
            if (last && has_next) S.a_ready(nxt);
            if constexpr (SP2) {
            PG8_LDB(B0, 0, 0); PG8_LDB(B1, 0, 1); PG8_SCHED; PG8_LDA(At, 0, 0); PG8_STAGE(PG8_SA(1, 1), a1 + hstep, voffA);
            PG8_WAIT_V(8); PG8_WAIT_L(0); PG8_BAR; PG8_MMA(0, 0, At, B0); PG8_MMA(0, 1, At, B1); PG8_BAR; PG8_SCHED;
            PG8_LDA(At, 0, 1); PG8_STAGE(PG8_SB(0, 0), b2, voffB); PG8_STAGE(PG8_SB(0, 1), b2 + hstep, voffB); PG8_STAGE(PG8_SA(0, 0), a2, voffA);
            PG8_WAIT_V(8); PG8_WAIT_L(0); PG8_BAR; PG8_MMA(1, 0, At, B0); PG8_MMA(1, 1, At, B1); PG8_BAR; PG8_SCHED;
            PG8_LDB(B0, 1, 0); PG8_LDB(B1, 1, 1); PG8_SCHED; PG8_LDA(At, 1, 0); PG8_STAGE(PG8_SA(0, 1), a2 + hstep, voffA);
            PG8_WAIT_V(8); PG8_WAIT_L(0); PG8_BAR; PG8_MMA(0, 0, At, B0); PG8_MMA(0, 1, At, B1); PG8_BAR; PG8_SCHED;
            PG8_LDA(At, 1, 1); PG8_STAGE(PG8_SB(1, 0), b3, voffB); PG8_STAGE(PG8_SB(1, 1), b3 + hstep, voffB); PG8_STAGE(PG8_SA(1, 0), a3, voffA);
            PG8_WAIT_V(8); PG8_WAIT_L(0); PG8_BAR; PG8_MMA(1, 0, At, B0); PG8_MMA(1, 1, At, B1); PG8_BAR; PG8_SCHED;
            } else {
            PG8_LDB(B0, 0, 0); PG8_SCHED; PG8_LDA(At, 0, 0); PG8_STAGE(PG8_SA(1, 1), a1 + hstep, voffA);
            PG8_WAIT_L(8); PG8_BAR; PG8_WAIT_L(0); PG8_MMA(0, 0, At, B0); PG8_BAR; PG8_SCHED;
            PG8_LDB(B1, 0, 1); PG8_STAGE(PG8_SB(0, 0), b2, voffB);
            PG8_BAR; PG8_WAIT_L(0); PG8_MMA(0, 1, At, B1); PG8_BAR;
            PG8_LDA(At, 0, 1); PG8_STAGE(PG8_SA(0, 0), a2, voffA);
            PG8_BAR; PG8_WAIT_L(0); PG8_MMA(1, 0, At, B0); PG8_BAR; PG8_SCHED;
            PG8_STAGE(PG8_SB(0, 1), b2 + hstep, voffB);
            PG8_WAIT_V(6); PG8_BAR; PG8_MMA(1, 1, At, B1); PG8_BAR;
            PG8_LDB(B0, 1, 0); PG8_SCHED; PG8_LDA(At, 1, 0); PG8_STAGE(PG8_SA(0, 1), a2 + hstep, voffA);
            PG8_WAIT_L(8); PG8_BAR; PG8_WAIT_L(0); PG8_MMA(0, 0, At, B0); PG8_BAR; PG8_SCHED;
            PG8_LDB(B1, 1, 1); PG8_STAGE(PG8_SB(1, 0), b3, voffB);
            PG8_BAR; PG8_WAIT_L(0); PG8_MMA(0, 1, At, B1); PG8_BAR;
            PG8_LDA(At, 1, 1); PG8_STAGE(PG8_SA(1, 0), a3, voffA);
            PG8_BAR; PG8_WAIT_L(0); PG8_MMA(1, 0, At, B0); PG8_BAR; PG8_SCHED;
            PG8_STAGE(PG8_SB(1, 1), b3 + hstep, voffB);
            PG8_WAIT_V(6); PG8_BAR; PG8_MMA(1, 1, At, B1); PG8_BAR;
            }
        }
        if constexpr (ALIGN_EPI) { if (wr == 0) PG8_BAR; }
        if constexpr (!Epi::AFTER_DRAIN) { E(acc, cur, wr, wc, fr, fq); S.done(cur); }
        if (!has_next) break;
#pragma unroll
        for (int a = 0; a < 2; ++a)
#pragma unroll
            for (int b = 0; b < 2; ++b)
#pragma unroll
                for (int m = 0; m < 4; ++m)
#pragma unroll
                    for (int n = 0; n < 2; ++n) acc[a][b][m][n] = (f32x4){0.f, 0.f, 0.f, 0.f};
        cur = nxt; cA = nA; cB = nB; ++ui;
        if constexpr (ALIGN_EPI) { if (wr == 1) PG8_BAR; }
    }
    PG8_WAIT_V(0);
    if constexpr (!ALIGN_EPI) { if (wr == 0) PG8_BAR; }
    PG8_BAR;
    if constexpr (Epi::AFTER_DRAIN) { E.fused(acc, cur, wr, wc, fr, fq, lds, wid, lane); S.done(cur); }
#undef PG8_SA
#undef PG8_SB
#undef PG8_STAGE
#undef PG8_LDA
#undef PG8_LDB
#undef PG8_MMA
#undef PG8_WAIT_V
#undef PG8_WAIT_L
#undef PG8_BAR
#undef PG8_SCHED
}
}

#define LAS __attribute__((address_space(3)))
typedef unsigned short bf16;
typedef short bf16x8 __attribute__((ext_vector_type(8)));
typedef float f32x4 __attribute__((ext_vector_type(4)));
typedef float f32x16 __attribute__((ext_vector_type(16)));
typedef unsigned u32x4 __attribute__((ext_vector_type(4)));
typedef unsigned u32x2 __attribute__((ext_vector_type(2)));
typedef float f32x2_t __attribute__((ext_vector_type(2)));
typedef __bf16 bf16x2_t __attribute__((ext_vector_type(2)));

constexpr int NWAVES = 8, NTHREADS = 512;
constexpr int D = 1024, SEQ = 8192, NPROMPT = 16384, NSAMP = 128, MREAL = NPROMPT + NSAMP, MP = 16640;
constexpr int FF = 4096, QW = 3072, KVW = 1536, NQKV = QW + KVW;
constexpr float EPS = 1e-6f;
constexpr float QSCALE = 0.125f * 1.4426950408889634f;
constexpr int LDS_BYTES = 147456;

constexpr size_t MiB = 1u << 20;
constexpr size_t WS_ROWSS = 0;
constexpr size_t WS_BAR = 384 * 1024;
constexpr size_t WS_LAM = 512 * 1024;
constexpr size_t WS_BBAR = 576 * 1024;
constexpr size_t WS_CC = 1 * MiB;
constexpr size_t WS_ROPE = 1536 * 1024;
constexpr size_t WS_E = 3840 * 1024;
constexpr size_t WS_W = 8 * MiB;
constexpr size_t W_GLU = WS_W, W_UP0 = W_GLU + 2048ull * 1024 * 2, W_DN0 = W_UP0 + 4096ull * 1024 * 2, W_QKV = W_DN0 + 4096ull * 1024 * 2,
                 W_O = W_QKV + (size_t)NQKV * 1024 * 2, W_UP1 = W_O + 1024ull * 1024 * 2, W_DN1 = W_UP1 + 4096ull * 1024 * 2, W_END = W_DN1 + 4096ull * 1024 * 2;
static_assert(W_END <= 56 * MiB, "weights");
constexpr size_t WS_H = 56 * MiB;
constexpr size_t WS_HB = 121 * MiB;
constexpr size_t WS_HN0 = 154 * MiB;
constexpr size_t WS_VT = WS_HN0;
constexpr size_t WS_Y = 187 * MiB;
constexpr size_t WS_ATT = WS_Y;
constexpr size_t WS_ACT = 220 * MiB;
constexpr size_t WS_Q = WS_ACT;
constexpr size_t WS_KB = WS_Q + (size_t)MP * QW * 2;
static_assert(WS_KB + 3ull * MP * 256 * 2 <= 350 * MiB, "q/k overlay");
constexpr size_t WS_OG = 350 * MiB;
constexpr size_t WS_LSE = 448 * MiB;
constexpr size_t WS_END = 452 * MiB;

constexpr size_t O_YP = 0, O_YS = 16777216, O_KVP0 = 16908288, O_KVP1 = 17039360, O_KVP2 = 17563648,
                 O_KVS0 = 19660800, O_KVS1 = 19726336, O_KVS2 = 19791872, O_SREP = 19857408, O_SIMP = 19865600, O_SRES = 19873792, O_SIMS = 20004864;

__device__ __forceinline__ unsigned pk2(float lo, float hi) { f32x2_t v = {lo, hi}; bf16x2_t b = __builtin_convertvector(v, bf16x2_t); return __builtin_bit_cast(unsigned, b); }
__device__ __forceinline__ float bf2f(unsigned short u) { return __uint_as_float(((unsigned)u) << 16); }
__device__ __forceinline__ float wave_sum(float v) {
#pragma unroll
    for (int o = 1; o < 64; o <<= 1) v += __shfl_xor(v, o);
    return v;
}
__device__ __forceinline__ float wave_max(float v) {
#pragma unroll
    for (int o = 1; o < 64; o <<= 1) v = fmaxf(v, __shfl_xor(v, o));
    return v;
}

struct Args { const float* in[25]; float* out; unsigned char* ws; int ph_lo, ph_hi; };

struct EpiGlu {
    static constexpr bool PERM = true, AFTER_DRAIN = false;
    const float* xp; const float* xs; float* H; bf16* HB; float* rowss;
    __device__ __forceinline__ void operator()(const pg8::f32x4 (&acc)[2][2][4][2], const pg8::Unit& u, int wr, int wc, int fr, int fq) const { run<2>(acc, u, wr, wc, fr, fq); }
    template <int NAI> __device__ __forceinline__ void run(const pg8::f32x4 (&acc)[NAI][2][4][2], const pg8::Unit& u, int wr, int wc, int fr, int fq) const {
        const int col = u.pn * 128 + wc * 32 + 8 * fq;
#pragma unroll
        for (int ai = 0; ai < NAI; ++ai)
#pragma unroll
            for (int m = 0; m < 4; ++m) {
                const int row = u.pm * 256 + ai * 128 + wr * 64 + m * 16 + fr;
                if (row < MREAL) {
                    const float* xr = (row < NPROMPT ? xp + (size_t)row * D : xs + (size_t)(row - NPROMPT) * D) + col;
                    const f32x4 x0 = __builtin_nontemporal_load((const f32x4*)xr), x1 = __builtin_nontemporal_load((const f32x4*)(xr + 4));
                    f32x4 h0, h1;
#pragma unroll
                    for (int i = 0; i < 4; ++i) {
                        h0[i] = x0[i] + acc[ai][0][m][0][i] * __builtin_amdgcn_rcpf(1.f + __expf(-acc[ai][1][m][0][i]));
                        h1[i] = x1[i] + acc[ai][0][m][1][i] * __builtin_amdgcn_rcpf(1.f + __expf(-acc[ai][1][m][1][i]));
                    }
                    u32x4 w; w.x = pk2(h0[0], h0[1]); w.y = pk2(h0[2], h0[3]); w.z = pk2(h1[0], h1[1]); w.w = pk2(h1[2], h1[3]);
                    *(u32x4*)(HB + (size_t)row * D + col) = w;
                    float ss = (h0[0] * h0[0] + h0[1] * h0[1]) + (h0[2] * h0[2] + h0[3] * h0[3]) + (h1[0] * h1[0] + h1[1] * h1[1]) + (h1[2] * h1[2] + h1[3] * h1[3]);
                    ss += __shfl_xor(ss, 16); ss += __shfl_xor(ss, 32);
                    if (fq == 0) __hip_atomic_fetch_add(rowss + row, ss, __ATOMIC_RELAXED, __HIP_MEMORY_SCOPE_AGENT);
                } else { float ss = 0.f; ss += __shfl_xor(ss, 16); ss += __shfl_xor(ss, 32); (void)ss; }
            }
    }
};
struct EpiNull {
    static constexpr bool PERM = true, AFTER_DRAIN = false; float* sink;
    __device__ __forceinline__ void operator()(const pg8::f32x4 (&acc)[2][2][4][2], const pg8::Unit& u, int wr, int wc, int fr, int fq) const { run<2>(acc, u, wr, wc, fr, fq); }
    template <int NAI> __device__ __forceinline__ void run(const pg8::f32x4 (&acc)[NAI][2][4][2], const pg8::Unit& u, int wr, int wc, int fr, int fq) const {
        float t = 0.f;
#pragma unroll
        for (int b = 0; b < 2; ++b)
#pragma unroll
            for (int m = 0; m < 4; ++m)
#pragma unroll
                for (int n = 0; n < 2; ++n) t += acc[0][b][m][n][0] + acc[0][b][m][n][3];
        if (t == 1234.5678f) sink[0] = t;
    }
};
struct EpiUp {
    static constexpr bool PERM = true, AFTER_DRAIN = false;
    bf16* O; const float* rowss;
    __device__ __forceinline__ void operator()(const pg8::f32x4 (&acc)[2][2][4][2], const pg8::Unit& u, int wr, int wc, int fr, int fq) const { run<2>(acc, u, wr, wc, fr, fq); }
    template <int NAI> __device__ __forceinline__ void run(const pg8::f32x4 (&acc)[NAI][2][4][2], const pg8::Unit& u, int wr, int wc, int fr, int fq) const {
        const int col = u.pn * 256 + wc * 32 + 8 * fq;
#pragma unroll
        for (int ai = 0; ai < NAI; ++ai)
#pragma unroll
            for (int m = 0; m < 4; ++m) {
                const int row = u.pm * 256 + ai * 128 + wr * 64 + m * 16 + fr;
                if (row < MREAL) {
                    const float rstd = __builtin_amdgcn_rsqf(rowss[row] * (1.f / D) + EPS);
#pragma unroll
                    for (int bj = 0; bj < 2; ++bj) {
                        float v[8];
#pragma unroll
                        for (int i = 0; i < 4; ++i) { float a = fmaxf(acc[ai][bj][m][0][i] * rstd, 0.f), b = fmaxf(acc[ai][bj][m][1][i] * rstd, 0.f); v[i] = a * a; v[4 + i] = b * b; }
                        u32x4 w; w.x = pk2(v[0], v[1]); w.y = pk2(v[2], v[3]); w.z = pk2(v[4], v[5]); w.w = pk2(v[6], v[7]);
                        *(u32x4*)(O + (size_t)row * FF + col + bj * 128) = w;
                    }
                }
            }
    }
};
struct EpiRes {
    static constexpr bool PERM = true, AFTER_DRAIN = false;
    bf16* HB; float* OUT; float* rowss;
    __device__ __forceinline__ void operator()(const pg8::f32x4 (&acc)[2][2][4][2], const pg8::Unit& u, int wr, int wc, int fr, int fq) const { run<2>(acc, u, wr, wc, fr, fq); }
    template <int NAI> __device__ __forceinline__ void run(const pg8::f32x4 (&acc)[NAI][2][4][2], const pg8::Unit& u, int wr, int wc, int fr, int fq) const {
        const int col = u.pn * 256 + wc * 32 + 8 * fq;
#pragma unroll
        for (int ai = 0; ai < NAI; ++ai)
#pragma unroll
            for (int m = 0; m < 4; ++m) {
                const int row = u.pm * 256 + ai * 128 + wr * 64 + m * 16 + fr;
                float ss = 0.f;
                if (row < MREAL) {
#pragma unroll
                    for (int bj = 0; bj < 2; ++bj) {
                        bf16* hp = HB + (size_t)row * D + col + bj * 128;
                        const bf16x8 hv = *(const bf16x8*)hp;
                        f32x4 h0, h1;
#pragma unroll
                        for (int i = 0; i < 4; ++i) { h0[i] = bf2f((unsigned short)hv[i]) + acc[ai][bj][m][0][i]; h1[i] = bf2f((unsigned short)hv[4 + i]) + acc[ai][bj][m][1][i]; }
                        if (OUT) { float* op = OUT + (size_t)row * D + col + bj * 128; *(f32x4*)op = h0; *(f32x4*)(op + 4) = h1; }
                        else { u32x4 w; w.x = pk2(h0[0], h0[1]); w.y = pk2(h0[2], h0[3]); w.z = pk2(h1[0], h1[1]); w.w = pk2(h1[2], h1[3]); *(u32x4*)hp = w; }
                        ss += (h0[0] * h0[0] + h0[1] * h0[1]) + (h0[2] * h0[2] + h0[3] * h0[3]) + (h1[0] * h1[0] + h1[1] * h1[1]) + (h1[2] * h1[2] + h1[3] * h1[3]);
                    }
                }
                ss += __shfl_xor(ss, 16); ss += __shfl_xor(ss, 32);
                if (fq == 0 && row < MREAL) __hip_atomic_fetch_add(rowss + row, ss, __ATOMIC_RELAXED, __HIP_MEMORY_SCOPE_AGENT);
            }
    }
};
struct EpiQKV {
    static constexpr bool PERM = true, AFTER_DRAIN = false;
    bf16* Q; bf16* KB; bf16* VB; float* out; const float* rowss; const float* ropec; const float* ropes; const float* offc; const float* offs;
    __device__ __forceinline__ void operator()(const pg8::f32x4 (&acc)[2][2][4][2], const pg8::Unit& u, int wr, int wc, int fr, int fq) const { run<2>(acc, u, wr, wc, fr, fq); }
    template <int NAI> __device__ __forceinline__ void run(const pg8::f32x4 (&acc)[NAI][2][4][2], const pg8::Unit& u, int wr, int wc, int fr, int fq) const {
        const int pn = u.pn;
        const bool isq = pn < 12; const int kvi = pn - 12; const int g = isq ? (pn >> 2) : (kvi >> 1); const bool isv = (!isq) && (kvi & 1);
        const int sh = 2 * g, W = 128 << sh;
        const bool stile = u.pm == 64;
        const int d0 = 8 * fq;
        const int slb = ((u.pm * 256 + wr * 64 + fr) & (SEQ - 1)) * 32 + d0;
#pragma unroll
        for (int ai = 0; ai < NAI; ++ai)
#pragma unroll
            for (int m = 0; m < 4; ++m) {
                const int row = u.pm * 256 + ai * 128 + wr * 64 + m * 16 + fr;
                if (row >= MREAL) continue;
                const float rstd = __builtin_amdgcn_rsqf(rowss[row] * (1.f / D) + EPS) * (isq ? QSCALE : 1.f);
                const bool samp = row >= NPROMPT; const int t = samp ? ((row - NPROMPT) & 3) : (row & (SEQ - 1));
                int rowp = row;
                if (!samp) { const int b = row >> 13, r = t & ((1 << sh) - 1), uu = t >> sh; rowp = b * SEQ + r * (SEQ >> sh) + uu; }
                float* ob = nullptr;
                if (!isq) {
                    if (samp) ob = out + (g == 0 ? O_KVS0 : g == 1 ? O_KVS1 : O_KVS2) + (size_t)(row - NPROMPT) * 512;
                    else if (t >= SEQ - W) ob = out + (g == 0 ? O_KVP0 : g == 1 ? O_KVP1 : O_KVP2) + ((size_t)(row >> 13) * W + (t - (SEQ - W))) * 512;
                }
                f32x4 av[2], bv[2];
#pragma unroll
                for (int n = 0; n < 2; ++n) {
                    f32x4 a = acc[ai][0][m][n] * rstd, b = acc[ai][1][m][n] * rstd;
                    if (!isv) {
                        const int sl = (samp ? SEQ + t : t) * 32 + d0 + 4 * n; const f32x4 c = *(const f32x4*)(ropec + sl), sn = *(const f32x4*)(ropes + sl);
                        const f32x4 ra = a * c - b * sn, rb = b * c + a * sn; a = ra; b = rb;
                    }
                    av[n] = a; bv[n] = b;
                }
                if (isq) {
                    bf16* qp = Q + (size_t)row * QW + pn * 256 + wc * 64 + d0;
                    u32x4 w0, w1; w0.x = pk2(av[0][0], av[0][1]); w0.y = pk2(av[0][2], av[0][3]); w0.z = pk2(av[1][0], av[1][1]); w0.w = pk2(av[1][2], av[1][3]);
                    w1.x = pk2(bv[0][0], bv[0][1]); w1.y = pk2(bv[0][2], bv[0][3]); w1.z = pk2(bv[1][0], bv[1][1]); w1.w = pk2(bv[1][2], bv[1][3]);
                    *(u32x4*)qp = w0; *(u32x4*)(qp + 32) = w1;
                } else {
                    bf16* kp = (isv ? VB : KB) + ((size_t)g * MP + rowp) * 256 + wc * 64 + d0;
                    u32x4 w0, w1; w0.x = pk2(av[0][0], av[0][1]); w0.y = pk2(av[0][2], av[0][3]); w0.z = pk2(av[1][0], av[1][1]); w0.w = pk2(av[1][2], av[1][3]);
                    w1.x = pk2(bv[0][0], bv[0][1]); w1.y = pk2(bv[0][2], bv[0][3]); w1.z = pk2(bv[1][0], bv[1][1]); w1.w = pk2(bv[1][2], bv[1][3]);
                    *(u32x4*)kp = w0; *(u32x4*)(kp + 32) = w1;
                    if (ob) { float* o2 = ob + (isv ? 256 : 0) + wc * 64 + d0; *(f32x4*)o2 = av[0]; *(f32x4*)(o2 + 4) = av[1]; *(f32x4*)(o2 + 32) = bv[0]; *(f32x4*)(o2 + 36) = bv[1]; }
                }
            }
    }
};

template <class Epi>
__device__ __forceinline__ void skinny_phase(LAS unsigned char* lds, const bf16* Abuf, const bf16* Bt, int N, int K, const Epi& E, int first, int wave, int lane) {
    const int nroles = (N >> 8) * 8, G = gridDim.x;
    const int fr = lane & 15, fq = lane >> 4;
    LAS float* red = (LAS float*)lds;
    const int rstep = first ? G - first : G;
    for (int role = (int)blockIdx.x - first; role < nroles; role += rstep) {
        if (role < 0) break;
        const int pn = role >> 3, wr = (role >> 2) & 1, wc = role & 3;
        pg8::f32x4 acc[1][2][4][2];
#pragma unroll
        for (int b = 0; b < 2; ++b)
#pragma unroll
            for (int m = 0; m < 4; ++m)
#pragma unroll
                for (int n = 0; n < 2; ++n) acc[0][b][m][n] = (pg8::f32x4){0.f, 0.f, 0.f, 0.f};
        const int kper = K >> 3, k0 = wave * kper;
        const bf16* ap = Abuf + (size_t)(NPROMPT + 64 * wr + fr) * K + k0 + 8 * fq;
        const int r0 = Epi::PERM ? (8 * (fr >> 2) + (fr & 3)) : fr, r1 = Epi::PERM ? r0 + 4 : fr + 16;
        const bf16* bp = Bt + (size_t)(256 * pn + 32 * wc) * K + k0 + 8 * fq;
#pragma unroll 4
        for (int ks = 0; ks < kper; ks += 32) {
            bf16x8 af[4], bf_[2][2];
#pragma unroll
            for (int m = 0; m < 4; ++m) af[m] = *(const bf16x8*)(ap + (size_t)(16 * m) * K + ks);
#pragma unroll
            for (int b = 0; b < 2; ++b) { bf_[b][0] = *(const bf16x8*)(bp + (size_t)(128 * b + r0) * K + ks); bf_[b][1] = *(const bf16x8*)(bp + (size_t)(128 * b + r1) * K + ks); }
#pragma unroll
            for (int b = 0; b < 2; ++b)
#pragma unroll
                for (int m = 0; m < 4; ++m)
#pragma unroll
                    for (int n = 0; n < 2; ++n) acc[0][b][m][n] = __builtin_amdgcn_mfma_f32_16x16x32_bf16(bf_[b][n], af[m], acc[0][b][m][n], 0, 0, 0);
        }
        if (wave != 0) {
#pragma unroll
            for (int b = 0; b < 2; ++b)
#pragma unroll
                for (int m = 0; m < 4; ++m)
#pragma unroll
                    for (int n = 0; n < 2; ++n) *(LAS pg8::f32x4*)(red + ((size_t)((wave - 1) * 16 + b * 8 + m * 2 + n) * 64 + lane) * 4) = acc[0][b][m][n];
        }
        __syncthreads();
        if (wave == 0) {
#pragma unroll 1
            for (int w = 0; w < 7; ++w)
#pragma unroll
                for (int b = 0; b < 2; ++b)
#pragma unroll
                    for (int m = 0; m < 4; ++m)
#pragma unroll
                        for (int n = 0; n < 2; ++n) acc[0][b][m][n] += *(const LAS pg8::f32x4*)(red + ((size_t)(w * 16 + b * 8 + m * 2 + n) * 64 + lane) * 4);
            const pg8::Unit u{64, pn};
            E.template run<1>(acc, u, wr, wc, fr, fq);
        }
        __syncthreads();
    }
}
__device__ __forceinline__ int conv_srcc(int mode, int nb) {
    if (mode == 0) return 32 * nb;
    if (mode == 1) { const int pn = nb >> 3, bj = (nb >> 2) & 1, cb = nb & 3; return bj * 1024 + 128 * pn + 32 * cb; }
    const int pn = nb >> 3, bj = (nb >> 2) & 1, wc = nb & 3; return 256 * pn + 64 * wc + 32 * bj;
}
__device__ __forceinline__ void transpose_item(const float* W, int K, int N, bf16* WT, const float* gain, int mode, LAS float* scr, int item, int lane) {
    const int nblk = N >> 6, kb = item / nblk, nb64 = item % nblk, k0 = 64 * kb;
    const int l16 = lane & 15, srcc = conv_srcc(mode, 2 * nb64 + (l16 >> 3)) + 4 * (l16 & 7);
    f32x4 v[16];
#pragma unroll
    for (int i = 0; i < 16; ++i) { const int kk = 4 * i + (lane >> 4); v[i] = __builtin_nontemporal_load((const f32x4*)(W + (size_t)(k0 + kk) * N + srcc)); }
    if (gain) {
#pragma unroll
        for (int i = 0; i < 16; ++i) { const int kk = 4 * i + (lane >> 4); v[i] = v[i] * gain[k0 + kk]; }
    }
#pragma unroll
    for (int i = 0; i < 16; ++i) { const int kk = 4 * i + (lane >> 4); LAS float* d = scr + kk * 65 + 4 * l16; d[0] = v[i][0]; d[1] = v[i][1]; d[2] = v[i][2]; d[3] = v[i][3]; }
    asm volatile("s_waitcnt lgkmcnt(0)" ::: "memory");
    const int c = lane & 7;
#pragma unroll
    for (int j = 0; j < 8; ++j) { const int n = (lane >> 3) + 8 * j; const LAS float* sp = scr + (8 * c) * 65 + n;
        u32x4 o; o.x = pk2(sp[0 * 65], sp[1 * 65]); o.y = pk2(sp[2 * 65], sp[3 * 65]); o.z = pk2(sp[4 * 65], sp[5 * 65]); o.w = pk2(sp[6 * 65], sp[7 * 65]);
        *(u32x4*)(WT + (size_t)(64 * nb64 + n) * K + k0 + 8 * c) = o; }
    asm volatile("s_waitcnt lgkmcnt(0)" ::: "memory");
}
__device__ __forceinline__ void convert_late(const Args& A, LAS unsigned char* lds, int vw, int NVW, int wave, int lane) {
    unsigned char* ws = A.ws;
    LAS float* scr = (LAS float*)(lds + wave * 16640);
    constexpr int I_UP = 16 * 64, I_DN = 64 * 16, I_O = 16 * 16, NIT = I_O + I_UP + I_DN;
    for (int it = vw; it < NIT; it += NVW) {
        int r = it;
        if (r < I_O) { transpose_item(A.in[21], 1024, 1024, (bf16*)(ws + W_O), nullptr, 0, scr, r, lane); continue; } r -= I_O;
        if (r < I_UP) { transpose_item(A.in[22] + 1024ull * 4096, 1024, 4096, (bf16*)(ws + W_UP1), A.in[8] + 1024, 0, scr, r, lane); continue; } r -= I_UP;
        transpose_item(A.in[23] + 4096ull * 1024, 4096, 1024, (bf16*)(ws + W_DN1), nullptr, 0, scr, r, lane);
    }
}

__device__ __forceinline__ void phase_prologue(const Args& A, LAS unsigned char* lds, int gw, int NGW, int wave, int lane) {
    unsigned char* ws = A.ws;
    LAS float* scr = (LAS float*)(lds + wave * 16640);
    constexpr int I_GLU = 16 * 32, I_UP = 16 * 64, I_DN = 64 * 16, I_Q = 16 * 48, I_KV = 16 * 24;
    constexpr int NIT = I_GLU + I_UP + I_DN + I_Q + I_KV;
    for (int it = gw; it < NIT; it += NGW) {
        int r = it;
        if (r < I_GLU) { transpose_item(A.in[17], 1024, 2048, (bf16*)(ws + W_GLU), nullptr, 1, scr, r, lane); continue; } r -= I_GLU;
        if (r < I_UP) { transpose_item(A.in[22], 1024, 4096, (bf16*)(ws + W_UP0), A.in[8], 0, scr, r, lane); continue; } r -= I_UP;
        if (r < I_DN) { transpose_item(A.in[23], 4096, 1024, (bf16*)(ws + W_DN0), nullptr, 0, scr, r, lane); continue; } r -= I_DN;
        if (r < I_Q) { transpose_item(A.in[20], 1024, 3072, (bf16*)(ws + W_QKV), A.in[7] + 1024, 2, scr, r, lane); continue; } r -= I_Q;
        transpose_item(A.in[19], 1024, 1536, (bf16*)(ws + W_QKV) + 3072ull * 1024, A.in[18], 2, scr, r, lane);
    }
    {
        const float* gmix = A.in[7];
        bf16* HN0 = (bf16*)(ws + WS_HN0);
        for (int row0 = 4 * gw; row0 < MREAL; row0 += 4 * NGW) {
            f32x4 v[4][4]; float ssq[4];
#pragma unroll
            for (int q = 0; q < 4; ++q) { const int row = row0 + q; const float* xr = row < NPROMPT ? A.in[0] + (size_t)row * D : A.in[1] + (size_t)(row - NPROMPT) * D;
#pragma unroll
                for (int j = 0; j < 4; ++j) v[q][j] = __builtin_nontemporal_load((const f32x4*)xr + lane + 64 * j); }
#pragma unroll
            for (int q = 0; q < 4; ++q) { float sq = 0.f;
#pragma unroll
                for (int j = 0; j < 4; ++j) sq += (v[q][j][0] * v[q][j][0] + v[q][j][1] * v[q][j][1]) + (v[q][j][2] * v[q][j][2] + v[q][j][3] * v[q][j][3]);
                ssq[q] = __builtin_amdgcn_rsqf(wave_sum(sq) * (1.f / D) + EPS); }
#pragma unroll
            for (int j = 0; j < 4; ++j) { const f32x4 gg = *((const f32x4*)gmix + lane + 64 * j);
#pragma unroll
                for (int q = 0; q < 4; ++q) { const float rstd = ssq[q];
                    u32x2 w; w.x = pk2(v[q][j][0] * rstd * gg[0], v[q][j][1] * rstd * gg[1]); w.y = pk2(v[q][j][2] * rstd * gg[2], v[q][j][3] * rstd * gg[3]);
                    *((u32x2*)(HN0 + (size_t)(row0 + q) * D) + lane + 64 * j) = w; } }
        }
    }
    const int gt = gw * 64 + lane, NGT = NGW * 64;
    { float* rs = (float*)(ws + WS_ROWSS); for (int i = gt; i < 4 * MP; i += NGT) rs[i] = 0.f; }
    { float* rc = (float*)(ws + WS_ROPE); float* rsn = rc + 8196 * 32;
      for (int i = gt; i < 8196 * 32; i += NGT) { const int slot = i >> 5, d = i & 31; const float pos = slot < SEQ ? (float)slot : (float)(16384 + (slot - SEQ));
          const float inv = powf(10000.0f, -(float)d / 32.0f); const float ang = pos * inv; rc[i] = cosf(ang); rsn[i] = sinf(ang); } }
    { float* oc = (float*)(ws + WS_ROPE) + 2 * 8196 * 32; float* os = oc + 8 * 32;
      for (int i = gt; i < 8 * 32; i += NGT) { const int oi = i >> 5, d = i & 31; const float pos = (float)(128 * (oi >> 2) + 16 * (oi & 3));
          const float inv = powf(10000.0f, -(float)d / 32.0f); const float ang = pos * inv; oc[i] = cosf(ang); os[i] = sinf(ang); } }
    { float* lam = (float*)(ws + WS_LAM); bf16* BB = (bf16*)(ws + WS_BBAR); bf16* CC = (bf16*)(ws + WS_CC);
      const float *are = A.in[9], *aim = A.in[10], *ldt = A.in[11], *bre = A.in[12], *bim = A.in[13], *cre = A.in[14], *cim = A.in[15];
      for (int i = gt; i < 64 * 64 * 16; i += NGT) {
          const int c = i & 15, p = (i >> 4) & 63, g = i >> 10;
          const float dt = expf(ldt[g]); const float ar = are[g * 64 + p], ai = aim[g * 64 + p];
          const float mag = expf(ar * dt); const float lr = mag * cosf(ai * dt), li = mag * sinf(ai * dt);
          const float den = ar * ar + ai * ai, nr = lr - 1.f, ni = li;
          const float zr = (nr * ar + ni * ai) / den, zi = (ni * ar - nr * ai) / den;
          const float br = bre[(g * 64 + p) * 16 + c], bi = bim[(g * 64 + p) * 16 + c];
          const float bbr = zr * br - zi * bi, bbi = zr * bi + zi * br;
          BB[(g * 128 + p) * 16 + c] = (bf16)(pk2(bbr, 0.f) & 0xffffu);
          BB[(g * 128 + 64 + p) * 16 + c] = (bf16)(pk2(bbi, 0.f) & 0xffffu);
          CC[(g * 16 + c) * 128 + 4 * (p & 31) + (p >> 5)] = (bf16)(pk2(cre[(g * 16 + c) * 64 + p], 0.f) & 0xffffu);
          CC[(g * 16 + c) * 128 + 4 * (p & 31) + 2 + (p >> 5)] = (bf16)(pk2(-cim[(g * 16 + c) * 64 + p], 0.f) & 0xffffu);
          if (c == 0) { lam[(g * 64 + p) * 2] = lr; lam[(g * 64 + p) * 2 + 1] = li; }
      } }
}

#define CMUL_ADD(orr, oi, ar_, ai_, br_, bi_, cr_, ci_) do { const float _r = __builtin_fmaf((ar_), (br_), __builtin_fmaf(-(ai_), (bi_), (cr_))); const float _i = __builtin_fmaf((ar_), (bi_), __builtin_fmaf((ai_), (br_), (ci_))); orr = _r; oi = _i; } while (0)
template <bool PASS2>
__device__ __forceinline__ void s5_item(const Args& A, LAS unsigned char* hs, int item, int lane) {
    unsigned char* ws = A.ws;
    const bf16* HN0 = (const bf16*)(ws + WS_HN0);
    const bool samp = item >= 2048;
    const int g = item & 63, ch = samp ? 128 + ((item - 2048) >> 6) : 4 * (item >> 6);
    const int s = lane & 31, hf = lane >> 5;
    bf16x8 Bf[4], Cf[4];
    { const bf16* BB = (const bf16*)(ws + WS_BBAR) + (size_t)g * 128 * 16;
#pragma unroll
      for (int n = 0; n < 4; ++n) Bf[n] = *(const bf16x8*)(BB + (32 * n + s) * 16 + 8 * hf);
      if (PASS2) { const bf16* CC = (const bf16*)(ws + WS_CC) + (size_t)g * 16 * 128;
#pragma unroll
        for (int st = 0; st < 4; ++st) Cf[st] = *(const bf16x8*)(CC + (lane & 15) * 128 + 32 * st + 8 * (lane >> 4)); } }
    const float* lam = (const float*)(ws + WS_LAM) + (size_t)g * 128;
    float lr[2], li[2], l16r[2], l16i[2], l128r[2], l128i[2];
#pragma unroll
    for (int j = 0; j < 2; ++j) { lr[j] = lam[(s + 32 * j) * 2]; li[j] = lam[(s + 32 * j) * 2 + 1];
        float pr = lr[j], pi = li[j];
#pragma unroll
        for (int q = 0; q < 4; ++q) { const float nr = pr * pr - pi * pi, ni = 2.f * pr * pi; pr = nr; pi = ni; }
        l16r[j] = pr; l16i[j] = pi;
#pragma unroll
        for (int q = 0; q < 3; ++q) { const float nr = pr * pr - pi * pi, ni = 2.f * pr * pi; pr = nr; pi = ni; }
        l128r[j] = pr; l128i[j] = pi; }
    float cr[2] = {0.f, 0.f}, ci[2] = {0.f, 0.f};
    const float* E = (const float*)(ws + WS_E);
    if (PASS2) {
        if (samp) { const int n = ch - 128;
#pragma unroll
            for (int j = 0; j < 2; ++j) { cr[j] = A.in[5][((size_t)n * 64 + g) * 64 + s + 32 * j]; ci[j] = A.in[6][((size_t)n * 64 + g) * 64 + s + 32 * j]; } }
        else { const int first = (ch >> 6) << 6;
#pragma unroll 8
            for (int jj = first; jj < ch; ++jj) { const float* e = E + ((size_t)jj * 64 + g) * 128;
#pragma unroll
                for (int j = 0; j < 2; ++j) { const float er = e[j * 32 + s], ei = e[64 + j * 32 + s]; CMUL_ADD(cr[j], ci[j], l128r[j], l128i[j], cr[j], ci[j], er, ei); } } }
    }
    const int nblk = samp ? 1 : 16;
    const int rowbase = samp ? NPROMPT + 4 * (ch - 128) : ch * 128;
    const int tokA = 16 * ((s >> 2) & 1) + 4 * (s >> 3) + (s & 3);
    const float* dsk = A.in[16] + g * 16;
    bf16* Y = (bf16*)(ws + WS_Y);
    bf16x8 afn = *(const bf16x8*)(HN0 + (size_t)(rowbase + tokA) * D + g * 16 + 8 * hf);
    const int uoff = (lane & 15) * D + g * 16 + 4 * (lane >> 4);
    u32x2 un[2];
    if (PASS2) {
#pragma unroll
        for (int q = 0; q < 2; ++q) un[q] = *(const u32x2*)(HN0 + (size_t)(rowbase + 16 * q) * D + uoff);
    }
    const f32x4 dk4 = *(const f32x4*)(dsk + 4 * (lane >> 4));
    for (int blk = 0; blk < nblk; ++blk) {
        const int row0 = rowbase + 32 * blk;
        const bf16x8 af = afn;
        u32x2 uc[2];
        if (PASS2) {
#pragma unroll
            for (int q = 0; q < 2; ++q) uc[q] = un[q];
            if (blk + 1 < nblk) {
#pragma unroll
                for (int q = 0; q < 2; ++q) un[q] = *(const u32x2*)(HN0 + (size_t)(row0 + 32 + 16 * q) * D + uoff);
            }
        }
        if (!PASS2 && (blk & 3) == 0) { cr[0] = 0.f; cr[1] = 0.f; ci[0] = 0.f; ci[1] = 0.f; }
        if (blk + 1 < nblk) afn = *(const bf16x8*)(HN0 + (size_t)(row0 + 32 + tokA) * D + g * 16 + 8 * hf);
        f32x16 X[4];
        const f32x16 z16 = {0.f, 0.f, 0.f, 0.f, 0.f, 0.f, 0.f, 0.f, 0.f, 0.f, 0.f, 0.f, 0.f, 0.f, 0.f, 0.f};
#pragma unroll
        for (int n = 0; n < 4; ++n) X[n] = __builtin_amdgcn_mfma_f32_32x32x16_bf16(af, Bf[n], z16, 0, 0, 0);
        float cinr[2], cini[2];
#pragma unroll
        for (int j = 0; j < 2; ++j) {
            float er = 0.f, ei = 0.f;
#pragma unroll
            for (int r = 0; r < 16; ++r) CMUL_ADD(er, ei, lr[j], li[j], er, ei, X[j][r], X[2 + j][r]);
            const float or_ = __shfl_xor(er, 32), oi_ = __shfl_xor(ei, 32);
            const float e0r = hf ? or_ : er, e0i = hf ? oi_ : ei, e1r = hf ? er : or_, e1i = hf ? ei : oi_;
            float mr, mi; CMUL_ADD(mr, mi, l16r[j], l16i[j], cr[j], ci[j], e0r, e0i);
            cinr[j] = hf ? mr : cr[j]; cini[j] = hf ? mi : ci[j];
            CMUL_ADD(cr[j], ci[j], l16r[j], l16i[j], mr, mi, e1r, e1i);
        }
        if (PASS2) {
#pragma unroll
            for (int j = 0; j < 2; ++j) {
                float hr = cinr[j], hi = cini[j];
#pragma unroll
                for (int r = 0; r < 16; ++r) { CMUL_ADD(hr, hi, lr[j], li[j], hr, hi, X[j][r], X[2 + j][r]);
                    X[j][r] = hr; X[2 + j][r] = hi; }
            }
            if (samp && hf == 0) { const int n = ch - 128;
#pragma unroll
                for (int j = 0; j < 2; ++j) { A.out[O_SRES + ((size_t)n * 64 + g) * 64 + s + 32 * j] = X[j][3]; A.out[O_SIMS + ((size_t)n * 64 + g) * 64 + s + 32 * j] = X[2 + j][3]; } }
#pragma unroll
            for (int r = 0; r < 16; ++r) { LAS unsigned short* hp = (LAS unsigned short*)(hs + (16 * hf + r) * 272);
                u32x2 w; w.x = pk2(X[0][r], X[1][r]); w.y = pk2(X[2][r], X[3][r]);
                *(LAS u32x2*)(hp + 4 * s) = w; }
            asm volatile("s_waitcnt lgkmcnt(0)" ::: "memory");
#pragma unroll
            for (int tb = 0; tb < 2; ++tb) {
                f32x4 y = {0.f, 0.f, 0.f, 0.f};
#pragma unroll
                for (int st = 0; st < 4; ++st) { const bf16x8 hfrag = *(const LAS bf16x8*)(hs + (16 * tb + (lane & 15)) * 272 + 64 * st + 16 * (lane >> 4));
                    y = __builtin_amdgcn_mfma_f32_16x16x32_bf16(Cf[st], hfrag, y, 0, 0, 0); }
                const int tk = 16 * tb + (lane & 15);
                if (!samp || tk < 4) {
                    const float u0 = __uint_as_float(uc[tb].x << 16), u1 = __uint_as_float(uc[tb].x & 0xffff0000u), u2 = __uint_as_float(uc[tb].y << 16), u3 = __uint_as_float(uc[tb].y & 0xffff0000u);
                    f32x4 v = {y[0] + dk4[0] * u0, y[1] + dk4[1] * u1, y[2] + dk4[2] * u2, y[3] + dk4[3] * u3};
                    float ge[4];
#pragma unroll
                    for (int j = 0; j < 4; ++j) { const float vv = v[j] * v[j]; const float ex = __builtin_amdgcn_exp2f(v[j] * __builtin_fmaf(vv, -0.10294324f, -2.30220820f)); ge[j] = v[j] * __builtin_amdgcn_rcpf(1.f + ex); }
                    u32x2 w; w.x = pk2(ge[0], ge[1]); w.y = pk2(ge[2], ge[3]);
                    *(u32x2*)(Y + (size_t)(row0 + tk) * D + g * 16 + 4 * (lane >> 4)) = w;
                }
            }
            asm volatile("s_waitcnt lgkmcnt(0)" ::: "memory");
        }
        if (!PASS2 && (blk & 3) == 3 && hf == 0) { float* e = (float*)(ws + WS_E) + ((size_t)(ch + (blk >> 2)) * 64 + g) * 128;
#pragma unroll
            for (int j = 0; j < 2; ++j) { e[j * 32 + s] = cr[j]; e[64 + j * 32 + s] = ci[j]; } }
    }
    if (PASS2 && !samp && hf == 0 && ((ch + 3) & 63) == 63) { const int b = ch >> 6;
#pragma unroll
        for (int j = 0; j < 2; ++j) { A.out[O_SREP + ((size_t)b * 64 + g) * 64 + s + 32 * j] = cr[j]; A.out[O_SIMP + ((size_t)b * 64 + g) * 64 + s + 32 * j] = ci[j]; } }
}

typedef short v4i16_t __attribute__((ext_vector_type(4)));
constexpr int KIMG_STRIDE = 144, KIMG_BYTES = 192 * KIMG_STRIDE, VIMG_HALF = 192 * 64, NATT_ITEMS = 3072;
struct AttItem { int g, sh, b, r, u0, kvh; };
__device__ __forceinline__ AttItem att_decode(int bi) {
    AttItem I; I.g = bi >> 10; const int rem = bi & 1023; I.kvh = rem & 3; I.b = (rem >> 2) & 1; const int rq = rem >> 3;
    I.sh = 2 * I.g; const int nqb = 128 >> I.sh; I.r = rq / nqb; I.u0 = 64 * (rq % nqb); return I;
}
template <bool COMBINE, int MODE = 0>
__device__ __forceinline__ void attn_prompt_phase(const Args& A, LAS unsigned char* lds, int tid, int wave, int lane, int item_lo, int item_hi) {
    unsigned char* ws = A.ws;
    const bf16* Q = (const bf16*)(ws + WS_Q); const bf16* KB = (const bf16*)(ws + WS_KB); const bf16* VB = (const bf16*)(ws + WS_VT);
    bf16* OG = (bf16*)(ws + WS_OG); float* LSE = (float*)(ws + WS_LSE);
    const int G = gridDim.x, hh = wave & 3, sub = wave >> 2, n = lane & 31, hf = lane >> 5;
    const int kap = (n & 3) + 4 * ((n >> 3) & 1) + 8 * ((n >> 2) & 1) + 16 * (n >> 4);
    int bi = item_lo + blockIdx.x;
    const int NATT_HI = item_hi;
    if (bi >= NATT_HI) return;
    bf16* AT = (bf16*)(ws + WS_ATT);
    u32x4 pk_[3], pv_[3]; bf16x8 qn[4];
#define ATT_ISSUE_KV(bix) do { const AttItem J = att_decode(bix); const int L_ = SEQ >> J.sh; const size_t pb_ = (size_t)J.g * MP + (size_t)J.b * SEQ + (size_t)J.r * L_; \
        _Pragma("unroll") for (int i = 0; i < 3; ++i) { const int c_ = tid + 512 * i, row_ = c_ >> 3, ch_ = c_ & 7; int u_ = J.u0 - 128 + row_; u_ = u_ < 0 ? 0 : u_; \
            pk_[i] = *(const u32x4*)(KB + (pb_ + u_) * 256 + J.kvh * 64 + 8 * ch_); pv_[i] = *(const u32x4*)(VB + (pb_ + u_) * 256 + J.kvh * 64 + 8 * ch_); } } while (0)
#define ATT_ISSUE_Q(bix) do { const AttItem J = att_decode(bix); const int qrow_ = J.b * SEQ + ((J.u0 + 32 * sub + n) << J.sh) + J.r; \
        _Pragma("unroll") for (int ks = 0; ks < 4; ++ks) qn[ks] = *(const bf16x8*)(Q + (size_t)qrow_ * QW + J.g * 1024 + (4 * J.kvh + hh) * 64 + 16 * ks + 8 * hf); } while (0)
#define ATT_WRITE(bufo) do { _Pragma("unroll") for (int i = 0; i < 3; ++i) { const int c = tid + 512 * i, row = c >> 3, ch = c & 7; \
            *(LAS u32x4*)(lds + (bufo) + row * KIMG_STRIDE + 16 * ch) = pk_[i]; \
            *(LAS u32x4*)(lds + (bufo) + KIMG_BYTES + (ch >> 2) * VIMG_HALF + row * 64 + (ch & 3) * 16) = pv_[i]; } } while (0)
    constexpr int ABUF = KIMG_BYTES + 2 * VIMG_HALF;
    bf16x8 qf[4];
    ATT_ISSUE_KV(bi); ATT_ISSUE_Q(bi);
    ATT_WRITE(0);
#pragma unroll
    for (int ks = 0; ks < 4; ++ks) qf[ks] = qn[ks];
    if (bi + G < NATT_HI) ATT_ISSUE_KV(bi + G);
    asm volatile("s_waitcnt lgkmcnt(0)\n\ts_barrier" ::: "memory");
    int par = 0;
    for (; bi < NATT_HI; bi += G, par ^= 1) {
        const AttItem I = att_decode(bi);
        if (bi + G < NATT_HI) { ATT_WRITE((par ^ 1) * ABUF); ATT_ISSUE_Q(bi + G); }
        if (bi + 2 * G < NATT_HI) ATT_ISSUE_KV(bi + 2 * G);
        const LAS unsigned char* lbuf = lds + par * ABUF;
        const int u0w = I.u0 + 32 * sub;
        const int qrow = I.b * SEQ + ((u0w + n) << I.sh) + I.r;
        const int h = 4 * I.kvh + hh;
        f32x16 O0, O1;
#pragma unroll
        for (int i = 0; i < 16; ++i) { O0[i] = 0.f; O1[i] = 0.f; }
        float mrun = -INFINITY, lrun = 0.f;
        const int cc_ = lane & 7, rr0_ = lane >> 3;
        bf16x8 x1[4], x2[4]; float l1 = 0.f, l2 = 0.f;
        if (COMBINE) {
            l1 = LSE[((size_t)1 * MP + qrow) * 16 + h]; l2 = LSE[((size_t)2 * MP + qrow) * 16 + h];
#pragma unroll
            for (int j = 0; j < 4; ++j) { const int qr_ = I.b * SEQ + ((u0w + rr0_ + 8 * j) << I.sh) + I.r;
                x1[j] = *(const bf16x8*)(OG + ((size_t)1 * MP + qr_) * D + h * 64 + 8 * cc_); x2[j] = *(const bf16x8*)(OG + ((size_t)2 * MP + qr_) * D + h * 64 + 8 * cc_); }
        }
        const int kt0 = (MODE == 1 || MODE == 3) ? 5 : (u0w >= 128 ? 0 : (128 - u0w) >> 5);
        const LAS unsigned char* kimg = lbuf + (32 * sub + kap) * KIMG_STRIDE + 16 * hf;
        const LAS unsigned char* vimg = lbuf + KIMG_BYTES + (32 * sub + 8 * hf + ((lane & 15) >> 2)) * 64 + (16 * ((lane >> 4) & 1) + 4 * (lane & 3)) * 2;
        for (int kt = kt0; kt < 5; ++kt) {
            bf16x8 kf[4], vf[2][2];
#pragma unroll
            for (int ks = 0; ks < 4; ++ks) kf[ks] = *(const LAS bf16x8*)(kimg + (32 * kt) * KIMG_STRIDE + 32 * ks);
#pragma unroll
            for (int mb = 0; mb < 2; ++mb)
#pragma unroll
                for (int st = 0; st < 2; ++st) {
                    const LAS unsigned char* vp = vimg + mb * VIMG_HALF + (32 * kt + 16 * st) * 64;
                    const v4i16_t lo = __builtin_amdgcn_ds_read_tr16_b64_v4i16((LAS v4i16_t*)vp);
                    const v4i16_t hi = __builtin_amdgcn_ds_read_tr16_b64_v4i16((LAS v4i16_t*)(vp + 4 * 64));
                    vf[mb][st] = (bf16x8){lo[0], lo[1], lo[2], lo[3], hi[0], hi[1], hi[2], hi[3]};
                }
            f32x16 S;
#pragma unroll
            for (int i = 0; i < 16; ++i) S[i] = 0.f;
#pragma unroll
            for (int ks = 0; ks < 4; ++ks) S = __builtin_amdgcn_mfma_f32_32x32x16_bf16(kf[ks], qf[ks], S, 0, 0, 0);
            if (kt == 0) {
#pragma unroll
                for (int rr = 0; rr < 16; ++rr) { const int kp = (rr & 7) + 8 * hf + 16 * (rr >> 3); if (kp < n) S[rr] = -INFINITY; }
            } else if (kt == 4) {
#pragma unroll
                for (int rr = 0; rr < 16; ++rr) { const int kp = (rr & 7) + 8 * hf + 16 * (rr >> 3); if (kp > n) S[rr] = -INFINITY; }
            }
            float tm = S[0];
#pragma unroll
            for (int rr = 1; rr < 16; ++rr) tm = fmaxf(tm, S[rr]);
            tm = fmaxf(tm, __shfl_xor(tm, 32));
            const float mnew = fmaxf(mrun, tm);
            const float alpha = __builtin_amdgcn_exp2f(mrun - mnew);
            float ps = 0.f; float p[16];
#pragma unroll
            for (int rr = 0; rr < 16; ++rr) { p[rr] = __builtin_amdgcn_exp2f(S[rr] - mnew); ps += p[rr]; }
            lrun = lrun * alpha + ps; mrun = mnew;
            if (__builtin_amdgcn_ballot_w64(alpha != 1.f) != 0ull) {
#pragma unroll
                for (int i = 0; i < 16; ++i) { O0[i] *= alpha; O1[i] *= alpha; }
            }
#pragma unroll
            for (int st = 0; st < 2; ++st) {
                u32x4 pw; pw.x = pk2(p[8 * st + 0], p[8 * st + 1]); pw.y = pk2(p[8 * st + 2], p[8 * st + 3]); pw.z = pk2(p[8 * st + 4], p[8 * st + 5]); pw.w = pk2(p[8 * st + 6], p[8 * st + 7]);
                const bf16x8 pf = __builtin_bit_cast(bf16x8, pw);
                O0 = __builtin_amdgcn_mfma_f32_32x32x16_bf16(vf[0][st], pf, O0, 0, 0, 0);
                O1 = __builtin_amdgcn_mfma_f32_32x32x16_bf16(vf[1][st], pf, O1, 0, 0, 0);
            }
        }
        const float ltot = lrun + __shfl_xor(lrun, 32);
        LAS unsigned char* ost = lds + 2 * ABUF + wave * 4864;
        float sc0;
        if (!COMBINE) { sc0 = 1.f / ltot; if (hf == 0) LSE[((size_t)I.g * MP + qrow) * 16 + h] = mrun + log2f(ltot); }
        else { const float l0 = mrun + log2f(ltot); const float mx = fmaxf(l0, fmaxf(l1, l2));
            const float w0 = __builtin_amdgcn_exp2f(l0 - mx), w1 = __builtin_amdgcn_exp2f(l1 - mx), w2 = __builtin_amdgcn_exp2f(l2 - mx);
            const float invw = 1.f / (w0 + w1 + w2); sc0 = w0 * invw / ltot;
            if (hf == 0) { LAS float* wp = (LAS float*)(ost + 4608) + 2 * n; wp[0] = w1 * invw; wp[1] = w2 * invw; } }
        if (MODE < 2) {
#pragma unroll
            for (int a = 0; a < 4; ++a) {
                u32x2 w0v, w1v; w0v.x = pk2(O0[4 * a] * sc0, O0[4 * a + 1] * sc0); w0v.y = pk2(O0[4 * a + 2] * sc0, O0[4 * a + 3] * sc0);
                w1v.x = pk2(O1[4 * a] * sc0, O1[4 * a + 1] * sc0); w1v.y = pk2(O1[4 * a + 2] * sc0, O1[4 * a + 3] * sc0);
                *(LAS u32x2*)(ost + n * 144 + (8 * a + 4 * hf) * 2) = w0v; *(LAS u32x2*)(ost + n * 144 + 64 + (8 * a + 4 * hf) * 2) = w1v;
            }
            asm volatile("s_waitcnt lgkmcnt(0)" ::: "memory");
#pragma unroll
            for (int j = 0; j < 4; ++j) { const int rr_ = rr0_ + 8 * j; const int qr_ = I.b * SEQ + ((u0w + rr_) << I.sh) + I.r;
                const bf16x8 tv = *(const LAS bf16x8*)(ost + rr_ * 144 + 16 * cc_);
                if (!COMBINE) *(bf16x8*)(OG + ((size_t)I.g * MP + qr_) * D + h * 64 + 8 * cc_) = tv;
                else { const LAS float* wp = (const LAS float*)(ost + 4608) + 2 * rr_; const float w1 = wp[0], w2 = wp[1];
                    float o[8];
#pragma unroll
                    for (int i = 0; i < 8; ++i) o[i] = bf2f((unsigned short)tv[i]) + w1 * bf2f((unsigned short)x1[j][i]) + w2 * bf2f((unsigned short)x2[j][i]);
                    u32x4 y; y.x = pk2(o[0], o[1]); y.y = pk2(o[2], o[3]); y.z = pk2(o[4], o[5]); y.w = pk2(o[6], o[7]);
                    *(u32x4*)(AT + (size_t)qr_ * D + h * 64 + 8 * cc_) = y; }
            }
        } else { if (ltot == 123.456f) LSE[0] = ltot; }
#pragma unroll
        for (int ks = 0; ks < 4; ++ks) qf[ks] = qn[ks];
        asm volatile("s_waitcnt lgkmcnt(0)\n\ts_barrier" ::: "memory");
    }
#undef ATT_ISSUE_KV
#undef ATT_ISSUE_Q
#undef ATT_WRITE
}

__device__ __forceinline__ void attn_sample_item(const Args& A, LAS float* sl, int it, int lane) {
    unsigned char* ws = A.ws;
    const int h = it & 15, t = (it >> 4) & 3, n = it >> 6, kvh = h >> 2;
    const int row = NPROMPT + 4 * n + t;
    const bf16* Q = (const bf16*)(ws + WS_Q) + (size_t)row * QW + h * 64;
    const int kq = lane >> 2, dq = lane & 3;
    float mxl = -INFINITY;
#pragma unroll 1
    for (int g = 0; g < 3; ++g) {
        const int W = 128 << (2 * g), dil = 1 << (2 * g);
        const float* cache = A.in[2 + g] + (size_t)n * W * 512;
        const float* newkv = A.out + (g == 0 ? O_KVS0 : g == 1 ? O_KVS1 : O_KVS2) + (size_t)n * 4 * 512;
        float q[16];
#pragma unroll
        for (int c8 = 0; c8 < 2; ++c8) { const bf16x8 v = *(const bf16x8*)(Q + g * 1024 + 16 * dq + 8 * c8);
#pragma unroll
            for (int i = 0; i < 8; ++i) q[8 * c8 + i] = bf2f((unsigned short)v[i]); }
        f32x4 kvv[9][4];
#pragma unroll
        for (int bt = 0; bt < 9; ++bt) {
            const int j = 16 * bt + kq; const int jj = j <= 128 ? j : 128;
            const int idx = W + t - dil * jj;
            const float* kp = (idx >= W ? newkv + (size_t)(idx - W) * 512 : cache + (size_t)idx * 512) + kvh * 64 + 16 * dq;
#pragma unroll
            for (int c4 = 0; c4 < 4; ++c4) kvv[bt][c4] = *(const f32x4*)(kp + 4 * c4);
        }
        __builtin_amdgcn_sched_barrier(0);
#pragma unroll
        for (int bt = 0; bt < 9; ++bt) {
            const int j = 16 * bt + kq; const bool valid = j <= 128;
            float s = 0.f;
#pragma unroll
            for (int c4 = 0; c4 < 4; ++c4) { const f32x4 kv = kvv[bt][c4]; s += q[4 * c4] * kv[0] + q[4 * c4 + 1] * kv[1] + q[4 * c4 + 2] * kv[2] + q[4 * c4 + 3] * kv[3]; }
            s += __shfl_xor(s, 1); s += __shfl_xor(s, 2);
            if (valid && dq == 0) sl[g * 132 + j] = s;
            mxl = fmaxf(mxl, valid ? s : -INFINITY);
        }
    }
    const float mx = wave_max(mxl);
    asm volatile("s_waitcnt lgkmcnt(0)" ::: "memory");
    float sum = 0.f;
#pragma unroll 1
    for (int i = lane; i < 396; i += 64) { const int j = i % 132; if (j <= 128) { const float p = exp2f(sl[i] - mx); sl[i] = p; sum += p; } }
    sum = wave_sum(sum);
    asm volatile("s_waitcnt lgkmcnt(0)" ::: "memory");
    f32x4 acc = {0.f, 0.f, 0.f, 0.f};
    const int ksl = lane >> 4, dq4 = lane & 15;
#pragma unroll 1
    for (int g = 0; g < 3; ++g) {
        const int W = 128 << (2 * g), dil = 1 << (2 * g);
        const float* cache = A.in[2 + g] + (size_t)n * W * 512;
        const float* newkv = A.out + (g == 0 ? O_KVS0 : g == 1 ? O_KVS1 : O_KVS2) + (size_t)n * 4 * 512;
        f32x4 vvv[33];
#pragma unroll
        for (int jb = 0; jb < 33; ++jb) {
            const int j = 4 * jb + ksl; const int jj = j <= 128 ? j : 128;
            const int idx = W + t - dil * jj;
            vvv[jb] = *(const f32x4*)((idx >= W ? newkv + (size_t)(idx - W) * 512 : cache + (size_t)idx * 512) + 256 + kvh * 64 + 4 * dq4);
        }
        __builtin_amdgcn_sched_barrier(0);
#pragma unroll
        for (int jb = 0; jb < 33; ++jb) {
            const int j = 4 * jb + ksl; const bool valid = j <= 128; const int jj = valid ? j : 128;
            const float pj = valid ? sl[g * 132 + jj] : 0.f;
            acc += vvv[jb] * pj;
        }
    }
#pragma unroll
    for (int i = 0; i < 4; ++i) { acc[i] += __shfl_xor(acc[i], 16); acc[i] += __shfl_xor(acc[i], 32); }
    bf16* AT = (bf16*)(ws + WS_ATT);
    if (lane < 16) { const float inv = 1.f / sum; u32x2 w; w.x = pk2(acc[0] * inv, acc[1] * inv); w.y = pk2(acc[2] * inv, acc[3] * inv);
        *(u32x2*)(AT + (size_t)row * D + h * 64 + 4 * dq4) = w; }
    asm volatile("s_waitcnt lgkmcnt(0)" ::: "memory");
}

__device__ __forceinline__ void attn_combine(const Args& A, int gt, int NGT) {
    unsigned char* ws = A.ws;
    const bf16* OG = (const bf16*)(ws + WS_OG); const float* LSE = (const float*)(ws + WS_LSE); bf16* AT = (bf16*)(ws + WS_ATT);
    for (int i = gt; i < NPROMPT * 128; i += NGT) {
        const int row = i >> 7, c8 = i & 127, h = c8 >> 3;
        const float l0 = LSE[((size_t)0 * MP + row) * 16 + h], l1 = LSE[((size_t)1 * MP + row) * 16 + h], l2 = LSE[((size_t)2 * MP + row) * 16 + h];
        const float mx = fmaxf(l0, fmaxf(l1, l2));
        float w0 = exp2f(l0 - mx), w1 = exp2f(l1 - mx), w2 = exp2f(l2 - mx); const float inv = 1.f / (w0 + w1 + w2); w0 *= inv; w1 *= inv; w2 *= inv;
        const bf16x8 a = *(const bf16x8*)(OG + ((size_t)0 * MP + row) * D + 8 * c8), b = *(const bf16x8*)(OG + ((size_t)1 * MP + row) * D + 8 * c8), c = *(const bf16x8*)(OG + ((size_t)2 * MP + row) * D + 8 * c8);
        float o[8];
#pragma unroll
        for (int k = 0; k < 8; ++k) o[k] = w0 * bf2f((unsigned short)a[k]) + w1 * bf2f((unsigned short)b[k]) + w2 * bf2f((unsigned short)c[k]);
        u32x4 w; w.x = pk2(o[0], o[1]); w.y = pk2(o[2], o[3]); w.z = pk2(o[4], o[5]); w.w = pk2(o[6], o[7]);
        *(u32x4*)(AT + (size_t)row * D + 8 * c8) = w;
    }
}

#define XB_TMO      128
#define XB_XCNT(j)  (256  + 64 * (j))
#define XB_XSUB(j)  (1280 + 64 * (j))
#define XB_XGEN(j)  (2304 + 64 * (j))
#define XB_TOP      3328
#define XB_TOPGEN   3392
#define XCD_BAR_WORDS 3456
#define XB_SPIN_CAP (1u << 18)

__device__ __forceinline__ unsigned xb_ld(unsigned* p)              { return __hip_atomic_load(p, __ATOMIC_RELAXED, __HIP_MEMORY_SCOPE_AGENT); }
__device__ __forceinline__ unsigned xb_add(unsigned* p, unsigned v) { return __hip_atomic_fetch_add(p, v, __ATOMIC_RELAXED, __HIP_MEMORY_SCOPE_AGENT); }
__device__ __forceinline__ unsigned xb_xcc_id() { return (unsigned)__builtin_amdgcn_s_getreg((3 << 11) | 20) & 0xFu; }
#define XB_SPIN(cond, bar) do { unsigned _sp = 0; while (cond) { __builtin_amdgcn_s_sleep(1); \
    if ((++_sp & 255u) == 0u) { if (xb_ld(&(bar)[XB_TMO])) break; if (_sp > XB_SPIN_CAP) { atomicAdd(&(bar)[XB_TMO], 1u); break; } } } } while (0)

struct XcdBarrier {
    unsigned* bar; unsigned x;
    volatile LAS unsigned* st;
};

__device__ __forceinline__ XcdBarrier xcd_barrier_post(unsigned* bar, volatile LAS unsigned* st) {
    XcdBarrier b; b.bar = bar; b.x = xb_xcc_id(); b.st = st;
    if (threadIdx.x == 0) (void)xb_add(&bar[XB_XCNT(b.x)], 1u);
    return b;
}
__device__ __forceinline__ void xcd_barrier_complete(unsigned* bar, unsigned x, unsigned& nloc, unsigned& nx) {
    const unsigned G = gridDim.x * gridDim.y * gridDim.z;
    unsigned sum, cnt, mine, sp = 0u;
    for (;;) {
        sum = 0u; cnt = 0u; mine = 0u;
#pragma unroll
        for (unsigned j = 0; j < 16; ++j) { const unsigned c = xb_ld(&bar[XB_XCNT(j)]); sum += c; cnt += (c > 0u) ? 1u : 0u; mine = (j == x) ? c : mine; }
        if (sum == G) break;
        __builtin_amdgcn_s_sleep(1);
        if ((++sp & 255u) == 0u) { if (xb_ld(&bar[XB_TMO])) break; if (sp > XB_SPIN_CAP) { atomicAdd(&bar[XB_TMO], 1u); break; } }
    }
    nloc = mine > 0u ? mine : 1u; nx = cnt > 0u ? cnt : 1u;
}

__device__ __forceinline__ void xcd_barrier(const XcdBarrier& b) {
    asm volatile("s_waitcnt vmcnt(0)" ::: "memory");
    __syncthreads();
    if (threadIdx.x == 0) {
        unsigned* bar = b.bar;
        __builtin_amdgcn_s_waitcnt(0);
        unsigned nloc = b.st[0], nx = b.st[1];
        if (nloc == 0u) { xcd_barrier_complete(bar, b.x, nloc, nx); b.st[0] = nloc; b.st[1] = nx; }
        const unsigned old = xb_add(&bar[XB_XSUB(b.x)], 1u);
        const unsigned gen = old / nloc;
        if (old + 1u == (gen + 1u) * nloc) {
            __builtin_amdgcn_fence(__ATOMIC_RELEASE, "agent");
            asm volatile("s_waitcnt vmcnt(0)" ::: "memory");
            const unsigned og = xb_add(&bar[XB_TOP], 1u);
            const unsigned tg = og / nx;
            if (og + 1u == (tg + 1u) * nx) xb_add(&bar[XB_TOPGEN], 1u);
            else XB_SPIN(xb_ld(&bar[XB_TOPGEN]) == tg, bar);
            __builtin_amdgcn_fence(__ATOMIC_ACQUIRE, "agent");
            xb_add(&bar[XB_XGEN(b.x)], 1u);
            asm volatile("s_waitcnt vmcnt(0)" ::: "memory");
        } else {
            XB_SPIN(xb_ld(&bar[XB_XGEN(b.x)]) == gen, bar);
            __builtin_amdgcn_fence(__ATOMIC_ACQUIRE, "agent");
            asm volatile("s_waitcnt vmcnt(0)" ::: "memory");
        }
    }
    __syncthreads();
}

constexpr int NPHASE = 13;
#ifndef REP0
#define REP0 1
#endif
#ifndef REP12
#define REP12 1
#endif
#ifndef REP7
#define REP7 1
#endif
#ifndef REP8
#define REP8 1
#endif
#ifndef REP4
#define REP4 1
#endif
#ifndef REP6
#define REP6 1
#endif
#ifndef DUP4
#define DUP4 0
#endif
#ifndef DUP6
#define DUP6 0
#endif
#ifndef DUP5
#define DUP5 0
#endif
#ifndef PROBE8
#define PROBE8 0
#endif
#ifndef XSYNC
#define XSYNC 0
#endif
__global__ void __launch_bounds__(NTHREADS, 2) yoco_fwd(Args A) {
    extern __shared__ __attribute__((aligned(16))) unsigned char lds_raw[];
    LAS unsigned char* lds = (LAS unsigned char*)lds_raw;
    cg::grid_group grid = cg::this_grid();
    const int tid = threadIdx.x, lane = tid & 63, wave = __builtin_amdgcn_readfirstlane(tid >> 6);
    const int G = gridDim.x, gw = blockIdx.x * NWAVES + wave, NGW = G * NWAVES, gt = gw * 64 + lane, NGT = NGW * 64;
    unsigned char* ws = A.ws;
    float* rowss = (float*)(ws + WS_ROWSS);
    float* Hf = (float*)(ws + WS_H); bf16* HB = (bf16*)(ws + WS_HB);
    const int lo = A.ph_lo, hi = A.ph_hi;
    volatile LAS unsigned* bst = (volatile LAS unsigned*)(lds + LDS_BYTES - 64);
    if (tid < 2) bst[tid] = 0u;
    __syncthreads();
    XcdBarrier xbar = xcd_barrier_post((unsigned*)(ws + WS_BAR), bst);
    if (lo < 0) grid.sync();
#ifndef PH_MASK
#define PH_MASK 0xffff
#endif
#define IN(k) (((PH_MASK >> (k)) & 1) && lo <= (k) && (k) < hi)
#define SEAM(k) do { if (IN(k) && IN((k) + 1)) xcd_barrier(xbar); } while (0)
    if (IN(0)) { for (int rp = 0; rp < REP0; ++rp) phase_prologue(A, lds, gw, NGW, wave, lane); for (int rp = 0; rp < XSYNC; ++rp) xcd_barrier(xbar); }
    SEAM(0);
    if (IN(1)) for (int rp = 0; rp < REP12; ++rp) { for (int it = gw; it < 2048; it += NGW) s5_item<false>(A, lds + wave * 8704, it, lane); }
    SEAM(1);
    if (IN(2)) for (int rp = 0; rp < REP12; ++rp) { for (int it = gw; it < 4096; it += NGW) s5_item<true>(A, lds + wave * 8704, it, lane); }
    SEAM(2);
    if (IN(3)) { pg8::Gemm g{(const bf16*)(ws + WS_Y), (const bf16*)(ws + W_GLU), NPROMPT, 2048, 1024}; pg8::StaticOrder S; S.init(NPROMPT, 2048, G, (int)blockIdx.x);
        EpiGlu E{A.in[0], A.in[1], Hf, HB, rowss};
        pg8::gemm_phase<EpiGlu, pg8::StaticOrder, true, true>(lds, g, S, E);
        skinny_phase(lds, g.A, g.Bt, 2048, 1024, E, 0, wave, lane); }
    SEAM(3);
    if (IN(4)) { pg8::Gemm g{HB, (const bf16*)(ws + W_UP0), NPROMPT, FF, 1024}; pg8::StaticOrder S; S.init(NPROMPT, FF, G, (int)blockIdx.x);
        EpiUp E{(bf16*)(ws + WS_ACT), rowss};
        pg8::gemm_phase<EpiUp, pg8::StaticOrder, true, true>(lds, g, S, E);
        skinny_phase(lds, g.A, g.Bt, FF, 1024, E, 0, wave, lane);
#if DUP4 == 1
        pg8::gemm_phase<EpiUp, pg8::StaticOrder, true, true>(lds, g, S, E);
#endif
#if DUP4 == 3
        { EpiNull E0{(float*)(ws + WS_OG)};
        skinny_phase(lds, g.A, g.Bt, FF, 1024, E0, 0, wave, lane); skinny_phase(lds, g.A, g.Bt, FF, 1024, E0, 0, wave, lane);
        skinny_phase(lds, g.A, g.Bt, FF, 1024, E0, 0, wave, lane); skinny_phase(lds, g.A, g.Bt, FF, 1024, E0, 0, wave, lane); }
#endif
#if DUP4 == 2
        skinny_phase(lds, g.A, g.Bt, FF, 1024, E, 0, wave, lane);
        skinny_phase(lds, g.A, g.Bt, FF, 1024, E, 0, wave, lane);
        skinny_phase(lds, g.A, g.Bt, FF, 1024, E, 0, wave, lane);
        skinny_phase(lds, g.A, g.Bt, FF, 1024, E, 0, wave, lane);
#endif
    }
    SEAM(4);
    if (IN(5)) { pg8::Gemm g{(const bf16*)(ws + WS_ACT), (const bf16*)(ws + W_DN0), NPROMPT, 1024, FF}; pg8::StaticOrder S; S.init(NPROMPT, 1024, G, (int)blockIdx.x);
        EpiRes E{HB, nullptr, rowss + MP};
        pg8::gemm_phase<EpiRes, pg8::StaticOrder, true, true>(lds, g, S, E);
        skinny_phase(lds, g.A, g.Bt, 1024, FF, E, 0, wave, lane);
#if DUP5 == 2
        { EpiUp E2{(bf16*)(ws + WS_OG), rowss}; pg8::gemm_phase<EpiUp, pg8::StaticOrder, true, true>(lds, g, S, E2); }
#endif
    }
    SEAM(5);
    if (IN(6)) { pg8::Gemm g{HB, (const bf16*)(ws + W_QKV), NPROMPT, NQKV, 1024}; pg8::StaticOrder S; S.init(NPROMPT, NQKV, G, (int)blockIdx.x);
        EpiQKV E{(bf16*)(ws + WS_Q), (bf16*)(ws + WS_KB), (bf16*)(ws + WS_VT), A.out, rowss + MP, (const float*)(ws + WS_ROPE), (const float*)(ws + WS_ROPE) + 8196 * 32, (const float*)(ws + WS_ROPE) + 2 * 8196 * 32, (const float*)(ws + WS_ROPE) + 2 * 8196 * 32 + 8 * 32};
        pg8::gemm_phase<EpiQKV, pg8::StaticOrder, true, true>(lds, g, S, E);
        skinny_phase(lds, g.A, g.Bt, NQKV, 1024, E, G >= 256 ? 128 : 0, wave, lane);
        { const int cf = G >= 256 ? 128 : 0; if ((int)blockIdx.x >= cf) convert_late(A, lds, ((int)blockIdx.x - cf) * NWAVES + wave, (G - cf) * NWAVES, wave, lane); }
#if DUP6 == 1
        pg8::gemm_phase<EpiQKV, pg8::StaticOrder, true, true>(lds, g, S, E);
#endif
#if DUP6 == 2
        { EpiUp E2{(bf16*)(ws + WS_OG), rowss + MP}; pg8::gemm_phase<EpiUp, pg8::StaticOrder, true, true>(lds, g, S, E2); }
#endif
    }
    SEAM(6);
    if (IN(7)) for (int rp = 0; rp < REP7; ++rp) {
        for (int it = gw; it < 2048; it += NGW) attn_sample_item(A, (LAS float*)(lds + 65536 + wave * 2048), it, lane);
        __syncthreads();
        attn_prompt_phase<false>(A, lds, tid, wave, lane, 1024, NATT_ITEMS);
    }
    SEAM(7);
    if (IN(8)) {
#if PROBE8 > 0
        attn_prompt_phase<true, PROBE8>(A, lds, tid, wave, lane, 0, 1024); __syncthreads();
#endif
        attn_prompt_phase<true>(A, lds, tid, wave, lane, 0, 1024); }
    SEAM(8);
    if (IN(9)) { pg8::Gemm g{(const bf16*)(ws + WS_ATT), (const bf16*)(ws + W_O), NPROMPT, 1024, 1024}; pg8::StaticOrder S; S.init(NPROMPT, 1024, G, (int)blockIdx.x);
        EpiRes E{HB, nullptr, rowss + 2 * MP};
        pg8::gemm_phase<EpiRes, pg8::StaticOrder, true, true>(lds, g, S, E);
        skinny_phase(lds, g.A, g.Bt, 1024, 1024, E, 0, wave, lane); }
    SEAM(9);
    if (IN(10)) { pg8::Gemm g{HB, (const bf16*)(ws + W_UP1), NPROMPT, FF, 1024}; pg8::StaticOrder S; S.init(NPROMPT, FF, G, (int)blockIdx.x);
        EpiUp E{(bf16*)(ws + WS_ACT), rowss + 2 * MP};
        pg8::gemm_phase<EpiUp, pg8::StaticOrder, true, true>(lds, g, S, E);
        skinny_phase(lds, g.A, g.Bt, FF, 1024, E, 0, wave, lane); }
    SEAM(10);
    if (IN(11)) { pg8::Gemm g{(const bf16*)(ws + WS_ACT), (const bf16*)(ws + W_DN1), NPROMPT, 1024, FF}; pg8::StaticOrder S; S.init(NPROMPT, 1024, G, (int)blockIdx.x);
        EpiRes E{HB, nullptr, rowss + 3 * MP};
        pg8::gemm_phase<EpiRes, pg8::StaticOrder, true, true>(lds, g, S, E);
        skinny_phase(lds, g.A, g.Bt, 1024, FF, E, 0, wave, lane); }
    SEAM(11);
    if (IN(12)) {
        const float* gfin = A.in[24];
        for (int row0 = 4 * gw; row0 < MREAL; row0 += 4 * NGW) {
            bf16x8 hv[4][2]; float rs[4];
#pragma unroll
            for (int q = 0; q < 4; ++q) { rs[q] = rowss[3 * MP + row0 + q];
#pragma unroll
                for (int j = 0; j < 2; ++j) hv[q][j] = *((const bf16x8*)(HB + (size_t)(row0 + q) * D) + lane + 64 * j); }
#pragma unroll
            for (int j = 0; j < 2; ++j) { const f32x4 g0 = *((const f32x4*)gfin + 2 * (lane + 64 * j)), g1 = *((const f32x4*)gfin + 2 * (lane + 64 * j) + 1);
#pragma unroll
                for (int q = 0; q < 4; ++q) { const float rstd = __builtin_amdgcn_rsqf(rs[q] * (1.f / D) + EPS); float* orow = A.out + (size_t)(row0 + q) * D;
                    f32x4 o0, o1;
#pragma unroll
                    for (int i = 0; i < 4; ++i) { o0[i] = bf2f((unsigned short)hv[q][j][i]) * rstd * g0[i]; o1[i] = bf2f((unsigned short)hv[q][j][4 + i]) * rstd * g1[i]; }
                    __builtin_nontemporal_store(o0, (f32x4*)orow + 2 * (lane + 64 * j)); __builtin_nontemporal_store(o1, (f32x4*)orow + 2 * (lane + 64 * j) + 1); } }
        }
    }
#undef IN
#undef SEAM
}

#ifndef N_LAUNCHES
#define N_LAUNCHES 1
#endif
extern "C" void kernel_launch(void* const* d_in, const int* in_sizes, int n_in, void* d_out, int out_size, void* d_ws, size_t ws_size, hipStream_t stream) {
    static int grid = 0;
    if (grid == 0) {
        if (n_in != 25 || ws_size < WS_END) { fprintf(stderr, "kernel_launch: unexpected n_in %d / ws %zu\n", n_in, ws_size); grid = -1; return; }
        int dev = 0, cus = 0, per_cu = 0;
        hipGetDevice(&dev); hipDeviceGetAttribute(&cus, hipDeviceAttributeMultiprocessorCount, dev);
        if (hipFuncSetAttribute((const void*)yoco_fwd, hipFuncAttributeMaxDynamicSharedMemorySize, LDS_BYTES) != hipSuccess) { fprintf(stderr, "hipFuncSetAttribute failed\n"); grid = -1; return; }
        hipOccupancyMaxActiveBlocksPerMultiprocessor(&per_cu, (const void*)yoco_fwd, NTHREADS, LDS_BYTES);
        (void)hipGetLastError();
        if (per_cu < 1) per_cu = 1;
        grid = cus * per_cu;
    }
    if (grid < 0) return;
    Args a{};
    for (int i = 0; i < 25; ++i) a.in[i] = (const float*)d_in[i];
    a.out = (float*)d_out; a.ws = (unsigned char*)d_ws;
    if (hipMemsetAsync((char*)d_ws + WS_BAR, 0, 16384, stream) != hipSuccess) { fprintf(stderr, "memset failed\n"); return; }
    if (N_LAUNCHES == 1) {
        a.ph_lo = 0; a.ph_hi = NPHASE;
        void* args[] = {&a};
        hipError_t e = hipLaunchCooperativeKernel((const void*)yoco_fwd, dim3(grid), dim3(NTHREADS), args, LDS_BYTES, stream);
        if (e != hipSuccess) fprintf(stderr, "cooperative launch failed: %s (grid %d)\n", hipGetErrorString(e), grid);
    } else {
        for (int p = 0; p < NPHASE; ++p) { a.ph_lo = p; a.ph_hi = p + 1; hipLaunchKernelGGL(yoco_fwd, dim3(grid), dim3(NTHREADS), LDS_BYTES, stream, a); }
    }
}
```

```cpp
#include <hip/hip_runtime.h>
#include <hip/hip_cooperative_groups.h>
#include <cstdio>
#include <cstdint>
#include <cmath>
namespace cg = cooperative_groups;
namespace pg8 {
#define PG8_LAS __attribute__((address_space(3)))
typedef unsigned short bf16_t;
typedef short bf16x8 __attribute__((ext_vector_type(8)));
typedef float f32x4 __attribute__((ext_vector_type(4)));
typedef unsigned u32x4 __attribute__((ext_vector_type(4)));
constexpr int BM = 256, BK = 64, HALF = 128, HTB = HALF * BK * 2  , STAGE_BYTES = 8 * HTB, NXCD = 8, WGM = 8;

__host__ __device__ __forceinline__ int lds_byte(int r, int c) { const int st = (r >> 4) * 2 + (c >> 5), rr = r & 15, cc = c & 31, ob = rr * 64 + cc * 2; return st * 1024 + (ob ^ (((ob >> 9) & 1) << 5)); }
__host__ __device__ __forceinline__ void stage_rc(int b, int& R, int& C) { const int st = b / 1024, sb = b % 1024, swz = sb ^ (((sb >> 9) & 1) << 5); R = (st >> 1) * 16 + swz / 64; C = (st & 1) * 32 + (swz % 64) / 2; }
__host__ __device__ __forceinline__ int perm32(int rho) { const int n = rho >> 4, i = rho & 15; return 8 * (i >> 2) + 4 * n + (i & 3); }

struct Unit { int pm, pn; };
struct Gemm { const bf16_t* A; const bf16_t* Bt; int M, N, K; };

struct StaticOrder {
    int nM, nN, nwg, G, c;
    __host__ __device__ void init(int M, int N, int G_, int c_) { nM = M / BM; nN = N / BM; nwg = nM * nN; G = G_; c = c_; }
    __host__ __device__ bool next(int i, Unit& u) const {
        const long L = (long)i * G + c; if (L >= nwg) return false;
        int wgid = (int)L; { const int q = nwg / NXCD, r = nwg % NXCD, xcd = wgid % NXCD, off = wgid / NXCD; wgid = (xcd < r ? xcd * (q + 1) : r * (q + 1) + (xcd - r) * q) + off; }
        const int nig = WGM * nN, gid = wgid / nig, fm = gid * WGM, gsz = (nM - fm) < WGM ? (nM - fm) : WGM;
        u.pm = fm + ((wgid % nig) % gsz); u.pn = (wgid % nig) / gsz; return true;
    }
    __device__ __forceinline__ void a_ready(const Unit&) const {}
    __device__ __forceinline__ void done(const Unit&) const {}
};

__device__ __forceinline__ unsigned cvt_pk_bf16(float lo, float hi) { unsigned r; asm volatile("v_cvt_pk_bf16_f32 %0, %1, %2" : "=v"(r) : "v"(lo), "v"(hi)); return r; }
typedef float f32x2 __attribute__((ext_vector_type(2)));
__device__ __forceinline__ f32x2 gelu_pk(f32x2 v) {
    const f32x2 av = __builtin_elementwise_abs(v), d = av * 0.2316418882f + 1.0f;
    f32x2 t; t.x = __builtin_amdgcn_rcpf(d.x); t.y = __builtin_amdgcn_rcpf(d.y);
    f32x2 q = t * 0.5307027145f + (-0.7265760135f); q = q * t + 0.7107068705f; q = q * t + (-0.142248368f); q = q * t + 0.127414796f; q = q * t;
    const f32x2 s = (v * v) * (-0.72134752044f);
    f32x2 e; e.x = __builtin_amdgcn_exp2f(s.x); e.y = __builtin_amdgcn_exp2f(s.y);
    const f32x2 m = v * (q * e), r = v - m;
    f32x2 o; o.x = v.x < 0.f ? m.x : r.x; o.y = v.y < 0.f ? m.y : r.y; return o;
}


template <class Epi, class Sched, bool ALIGN_EPI = false, bool SP2 = false>
__device__ __forceinline__ void gemm_phase(PG8_LAS unsigned char* lds, const Gemm g, const Sched& S, const Epi& E) {
    const int tid = threadIdx.x, wid = __builtin_amdgcn_readfirstlane(tid >> 6), lane = tid & 63, wr = wid >> 2, wc = wid & 3, fr = lane & 15, fq = lane >> 4;
    const int K = g.K, nt = K / BK;
    unsigned voffA[2], voffB[2];
#pragma unroll
    for (int i = 0; i < 2; ++i) { int R, C; stage_rc(tid * 16 + i * 8192, R, C); const int Rb = Epi::PERM ? ((R & ~31) + perm32(R & 31)) : R;
        voffA[i] = (unsigned)(R * K + C) * 2u; voffB[i] = (unsigned)(Rb * K + C) * 2u; }
    const size_t kstep = (size_t)(BK * 2);
    const size_t hstep = (size_t)HALF * K * 2;
    const size_t tstep = 2 * hstep;
    const unsigned ldsw = (unsigned)wid * 1024u;
    const int aoff = lds_byte(wr * 64 + fr, fq * 8), boff = lds_byte(wc * 32 + fr, fq * 8);
#define PG8_SA(b, h) (((b) * 2 + (h)) * HTB)
#define PG8_SB(b, h) ((4 + (b) * 2 + (h)) * HTB)
#define PG8_STAGE(bufoff, gbase, voff) do { _Pragma("unroll") for (int _i = 0; _i < 2; ++_i) \
        __builtin_amdgcn_global_load_lds((const unsigned*)((const char*)(gbase) + (voff)[_i]), (PG8_LAS unsigned*)(lds + (bufoff) + ldsw + _i * 8192), 16, 0, 0); } while (0)
#define PG8_LDA(dst, b, h) do { _Pragma("unroll") for (int m = 0; m < 4; ++m) _Pragma("unroll") for (int k = 0; k < 2; ++k) dst[m][k] = *(const PG8_LAS bf16x8*)(lds + PG8_SA(b, h) + aoff + m * 2048 + k * 1024); } while (0)
#define PG8_LDB(dst, b, h) do { _Pragma("unroll") for (int n = 0; n < 2; ++n) _Pragma("unroll") for (int k = 0; k < 2; ++k) dst[n][k] = *(const PG8_LAS bf16x8*)(lds + PG8_SB(b, h) + boff + n * 2048 + k * 1024); } while (0)
#define PG8_MMA(ai, bj, At, Bt) do { __builtin_amdgcn_s_setprio(1); _Pragma("unroll") for (int m = 0; m < 4; ++m) _Pragma("unroll") for (int n = 0; n < 2; ++n) _Pragma("unroll") for (int k = 0; k < 2; ++k) \
        acc[ai][bj][m][n] = __builtin_amdgcn_mfma_f32_16x16x32_bf16(Bt[n][k], At[m][k], acc[ai][bj][m][n], 0, 0, 0); __builtin_amdgcn_s_setprio(0); } while (0)
#define PG8_WAIT_V(n) asm volatile("s_waitcnt vmcnt(" #n ")" ::: "memory")
#define PG8_WAIT_L(n) asm volatile("s_waitcnt lgkmcnt(" #n ")" ::: "memory")
#define PG8_BAR __builtin_amdgcn_s_barrier()
#define PG8_SCHED __builtin_amdgcn_sched_barrier(0)
    Unit cur, nxt; int ui = 0;
    if (!S.next(0, cur)) return;
    f32x4 acc[2][2][4][2];
#pragma unroll
    for (int a = 0; a < 2; ++a)
#pragma unroll
        for (int b = 0; b < 2; ++b)
#pragma unroll
            for (int m = 0; m < 4; ++m)
#pragma unroll
                for (int n = 0; n < 2; ++n) acc[a][b][m][n] = (f32x4){0.f, 0.f, 0.f, 0.f};
    bf16x8 At[4][2], B0[2][2], B1[2][2];
    const char* cA = (const char*)g.A + (size_t)cur.pm * tstep; const char* cB = (const char*)g.Bt + (size_t)cur.pn * tstep;
    S.a_ready(cur);
    if constexpr (SP2) {
        PG8_STAGE(PG8_SB(0, 0), cB, voffB); PG8_STAGE(PG8_SB(0, 1), cB + hstep, voffB); PG8_STAGE(PG8_SA(0, 0), cA, voffA); PG8_STAGE(PG8_SA(0, 1), cA + hstep, voffA);
        if (wr == 1) PG8_BAR;
        PG8_WAIT_V(2); PG8_BAR;
        PG8_STAGE(PG8_SB(1, 0), cB + kstep, voffB); PG8_STAGE(PG8_SA(1, 0), cA + kstep, voffA); PG8_STAGE(PG8_SB(1, 1), cB + hstep + kstep, voffB);
        PG8_WAIT_V(6); PG8_BAR;
    } else {
        PG8_STAGE(PG8_SB(0, 0), cB, voffB); PG8_STAGE(PG8_SA(0, 0), cA, voffA); PG8_STAGE(PG8_SB(0, 1), cB + hstep, voffB); PG8_STAGE(PG8_SA(0, 1), cA + hstep, voffA);
        if (wr == 1) PG8_BAR;
        PG8_WAIT_V(4); PG8_BAR;
        PG8_STAGE(PG8_SB(1, 0), cB + kstep, voffB); PG8_STAGE(PG8_SA(1, 0), cA + kstep, voffA); PG8_STAGE(PG8_SB(1, 1), cB + hstep + kstep, voffB);
        PG8_WAIT_V(6); PG8_BAR;
    }
    for (;;) {
        const bool has_next = S.next(ui + 1, nxt);
        const char* nA = has_next ? (const char*)g.A + (size_t)nxt.pm * tstep : cA; const char* nB = has_next ? (const char*)g.Bt + (size_t)nxt.pn * tstep : cB;
        for (int t = 0; t < nt; t += 2) {
            const bool last = (t == nt - 2);
            const char* a1 = cA + (size_t)(t + 1) * kstep;
            const char* a2 = last ? nA : cA + (size_t)(t + 2) * kstep; const char* b2 = last ? nB : cB + (size_t)(t + 2) * kstep;
            const char* a3 = a2 + kstep; const char* b3 = b2 + kstep;
            if (last && has_next) S.a_ready(nxt);
            if constexpr (SP2) {
            PG8_LDB(B0, 0, 0); PG8_LDB(B1, 0, 1); PG8_SCHED; PG8_LDA(At, 0, 0); PG8_STAGE(PG8_SA(1, 1), a1 + hstep, voffA);
            PG8_WAIT_V(8); PG8_WAIT_L(0); PG8_BAR; PG8_MMA(0, 0, At, B0); PG8_MMA(0, 1, At, B1); PG8_BAR; PG8_SCHED;
            PG8_LDA(At, 0, 1); PG8_STAGE(PG8_SB(0, 0), b2, voffB); PG8_STAGE(PG8_SB(0, 1), b2 + hstep, voffB); PG8_STAGE(PG8_SA(0, 0), a2, voffA);
            PG8_WAIT_V(8); PG8_WAIT_L(0); PG8_BAR; PG8_MMA(1, 0, At, B0); PG8_MMA(1, 1, At, B1); PG8_BAR; PG8_SCHED;
            PG8_LDB(B0, 1, 0); PG8_LDB(B1, 1, 1); PG8_SCHED; PG8_LDA(At, 1, 0); PG8_STAGE(PG8_SA(0, 1), a2 + hstep, voffA);
            PG8_WAIT_V(8); PG8_WAIT_L(0); PG8_BAR; PG8_MMA(0, 0, At, B0); PG8_MMA(0, 1, At, B1); PG8_BAR; PG8_SCHED;
            PG8_LDA(At, 1, 1); PG8_STAGE(PG8_SB(1, 0), b3, voffB); PG8_STAGE(PG8_SB(1, 1), b3 + hstep, voffB); PG8_STAGE(PG8_SA(1, 0), a3, voffA);
            PG8_WAIT_V(8); PG8_WAIT_L(0); PG8_BAR; PG8_MMA(1, 0, At, B0); PG8_MMA(1, 1, At, B1); PG8_BAR; PG8_SCHED;
            } else {
            PG8_LDB(B0, 0, 0); PG8_SCHED; PG8_LDA(At, 0, 0); PG8_STAGE(PG8_SA(1, 1), a1 + hstep, voffA);
            PG8_WAIT_L(8); PG8_BAR; PG8_WAIT_L(0); PG8_MMA(0, 0, At, B0); PG8_BAR; PG8_SCHED;
            PG8_LDB(B1, 0, 1); PG8_STAGE(PG8_SB(0, 0), b2, voffB);
            PG8_BAR; PG8_WAIT_L(0); PG8_MMA(0, 1, At, B1); PG8_BAR;
            PG8_LDA(At, 0, 1); PG8_STAGE(PG8_SA(0, 0), a2, voffA);
            PG8_BAR; PG8_WAIT_L(0); PG8_MMA(1, 0, At, B0); PG8_BAR; PG8_SCHED;
            PG8_STAGE(PG8_SB(0, 1), b2 + hstep, voffB);
            PG8_WAIT_V(6); PG8_BAR; PG8_MMA(1, 1, At, B1); PG8_BAR;
            PG8_LDB(B0, 1, 0); PG8_SCHED; PG8_LDA(At, 1, 0); PG8_STAGE(PG8_SA(0, 1), a2 + hstep, voffA);
            PG8_WAIT_L(8); PG8_BAR; PG8_WAIT_L(0); PG8_MMA(0, 0, At, B0); PG8_BAR; PG8_SCHED;
            PG8_LDB(B1, 1, 1); PG8_STAGE(PG8_SB(1, 0), b3, voffB);
            PG8_BAR; PG8_WAIT_L(0); PG8_MMA(0, 1, At, B1); PG8_BAR;
            PG8_LDA(At, 1, 1); PG8_STAGE(PG8_SA(1, 0), a3, voffA);
            PG8_BAR; PG8_WAIT_L(0); PG8_MMA(1, 0, At, B0); PG8_BAR; PG8_SCHED;
            PG8_STAGE(PG8_SB(1, 1), b3 + hstep, voffB);
            PG8_WAIT_V(6); PG8_BAR; PG8_MMA(1, 1, At, B1); PG8_BAR;
            }
        }
        if constexpr (ALIGN_EPI) { if (wr == 0) PG8_BAR; }
        if constexpr (!Epi::AFTER_DRAIN) { E(acc, cur, wr, wc, fr, fq); S.done(cur); }
        if (!has_next) break;
#pragma unroll
        for (int a = 0; a < 2; ++a)
#pragma unroll
            for (int b = 0; b < 2; ++b)
#pragma unroll
                for (int m = 0; m < 4; ++m)
#pragma unroll
                    for (int n = 0; n < 2; ++n) acc[a][b][m][n] = (f32x4){0.f, 0.f, 0.f, 0.f};
        cur = nxt; cA = nA; cB = nB; ++ui;
        if constexpr (ALIGN_EPI) { if (wr == 1) PG8_BAR; }
    }
    PG8_WAIT_V(0);
    if constexpr (!ALIGN_EPI) { if (wr == 0) PG8_BAR; }
    PG8_BAR;
    if constexpr (Epi::AFTER_DRAIN) { E.fused(acc, cur, wr, wc, fr, fq, lds, wid, lane); S.done(cur); }
#undef PG8_SA
#undef PG8_SB
#undef PG8_STAGE
#undef PG8_LDA
#undef PG8_LDB
#undef PG8_MMA
#undef PG8_WAIT_V
#undef PG8_WAIT_L
#undef PG8_BAR
#undef PG8_SCHED
}
}

#define LAS __attribute__((address_space(3)))
typedef unsigned short bf16;
typedef short bf16x8 __attribute__((ext_vector_type(8)));
typedef float f32x4 __attribute__((ext_vector_type(4)));
typedef float f32x16 __attribute__((ext_vector_type(16)));
typedef unsigned u32x4 __attribute__((ext_vector_type(4)));
typedef unsigned u32x2 __attribute__((ext_vector_type(2)));
typedef float f32x2_t __attribute__((ext_vector_type(2)));
typedef __bf16 bf16x2_t __attribute__((ext_vector_type(2)));

constexpr int NWAVES = 8, NTHREADS = 512;
constexpr int D = 1024, SEQ = 8192, NPROMPT = 16384, NSAMP = 128, MREAL = NPROMPT + NSAMP, MP = 16640;
constexpr int FF = 4096, QW = 3072, KVW = 1536, NQKV = QW + KVW;
constexpr float EPS = 1e-6f;
constexpr float QSCALE = 0.125f * 1.4426950408889634f;
constexpr int LDS_BYTES = 147456;

constexpr size_t MiB = 1u << 20;
constexpr size_t WS_ROWSS = 0;
constexpr size_t WS_BAR = 384 * 1024;
constexpr size_t WS_LAM = 512 * 1024;
constexpr size_t WS_BBAR = 576 * 1024;
constexpr size_t WS_CC = 1 * MiB;
constexpr size_t WS_ROPE = 1536 * 1024;
constexpr size_t WS_E = 3840 * 1024;
constexpr size_t WS_W = 8 * MiB;
constexpr size_t W_GLU = WS_W, W_UP0 = W_GLU + 2048ull * 1024 * 2, W_DN0 = W_UP0 + 4096ull * 1024 * 2, W_QKV = W_DN0 + 4096ull * 1024 * 2,
                 W_O = W_QKV + (size_t)NQKV * 1024 * 2, W_UP1 = W_O + 1024ull * 1024 * 2, W_DN1 = W_UP1 + 4096ull * 1024 * 2, W_END = W_DN1 + 4096ull * 1024 * 2;
static_assert(W_END <= 56 * MiB, "weights");
constexpr size_t WS_H = 56 * MiB;
constexpr size_t WS_HB = 121 * MiB;
constexpr size_t WS_HN0 = 154 * MiB;
constexpr size_t WS_VT = WS_HN0;
constexpr size_t WS_Y = 187 * MiB;
constexpr size_t WS_ATT = WS_Y;
constexpr size_t WS_ACT = 220 * MiB;
constexpr size_t WS_Q = WS_ACT;
constexpr size_t WS_KB = WS_Q + (size_t)MP * QW * 2;
static_assert(WS_KB + 3ull * MP * 256 * 2 <= 350 * MiB, "q/k overlay");
constexpr size_t WS_OG = 350 * MiB;
constexpr size_t WS_LSE = 448 * MiB;
constexpr size_t WS_END = 452 * MiB;

constexpr size_t O_YP = 0, O_YS = 16777216, O_KVP0 = 16908288, O_KVP1 = 17039360, O_KVP2 = 17563648,
                 O_KVS0 = 19660800, O_KVS1 = 19726336, O_KVS2 = 19791872, O_SREP = 19857408, O_SIMP = 19865600, O_SRES = 19873792, O_SIMS = 20004864;

__device__ __forceinline__ unsigned pk2(float lo, float hi) { f32x2_t v = {lo, hi}; bf16x2_t b = __builtin_convertvector(v, bf16x2_t); return __builtin_bit_cast(unsigned, b); }
__device__ __forceinline__ float bf2f(unsigned short u) { return __uint_as_float(((unsigned)u) << 16); }
__device__ __forceinline__ float wave_sum(float v) {
#pragma unroll
    for (int o = 1; o < 64; o <<= 1) v += __shfl_xor(v, o);
    return v;
}
__device__ __forceinline__ float wave_max(float v) {
#pragma unroll
    for (int o = 1; o < 64; o <<= 1) v = fmaxf(v, __shfl_xor(v, o));
    return v;
}

struct Args { const float* in[25]; float* out; unsigned char* ws; int ph_lo, ph_hi; };

struct EpiGlu {
    static constexpr bool PERM = true, AFTER_DRAIN = false;
    const float* xp; const float* xs; float* H; bf16* HB; float* rowss;
    __device__ __forceinline__ void operator()(const pg8::f32x4 (&acc)[2][2][4][2], const pg8::Unit& u, int wr, int wc, int fr, int fq) const { run<2>(acc, u, wr, wc, fr, fq); }
    template <int NAI> __device__ __forceinline__ void run(const pg8::f32x4 (&acc)[NAI][2][4][2], const pg8::Unit& u, int wr, int wc, int fr, int fq) const {
        const int col = u.pn * 128 + wc * 32 + 8 * fq;
#pragma unroll
        for (int ai = 0; ai < NAI; ++ai)
#pragma unroll
            for (int m = 0; m < 4; ++m) {
                const int row = u.pm * 256 + ai * 128 + wr * 64 + m * 16 + fr;
                if (row < MREAL) {
                    const float* xr = (row < NPROMPT ? xp + (size_t)row * D : xs + (size_t)(row - NPROMPT) * D) + col;
                    const f32x4 x0 = __builtin_nontemporal_load((const f32x4*)xr), x1 = __builtin_nontemporal_load((const f32x4*)(xr + 4));
                    f32x4 h0, h1;
#pragma unroll
                    for (int i = 0; i < 4; ++i) {
                        h0[i] = x0[i] + acc[ai][0][m][0][i] * __builtin_amdgcn_rcpf(1.f + __expf(-acc[ai][1][m][0][i]));
                        h1[i] = x1[i] + acc[ai][0][m][1][i] * __builtin_amdgcn_rcpf(1.f + __expf(-acc[ai][1][m][1][i]));
                    }
                    u32x4 w; w.x = pk2(h0[0], h0[1]); w.y = pk2(h0[2], h0[3]); w.z = pk2(h1[0], h1[1]); w.w = pk2(h1[2], h1[3]);
                    *(u32x4*)(HB + (size_t)row * D + col) = w;
                    float ss = (h0[0] * h0[0] + h0[1] * h0[1]) + (h0[2] * h0[2] + h0[3] * h0[3]) + (h1[0] * h1[0] + h1[1] * h1[1]) + (h1[2] * h1[2] + h1[3] * h1[3]);
                    ss += __shfl_xor(ss, 16); ss += __shfl_xor(ss, 32);
                    if (fq == 0) __hip_atomic_fetch_add(rowss + row, ss, __ATOMIC_RELAXED, __HIP_MEMORY_SCOPE_AGENT);
                } else { float ss = 0.f; ss += __shfl_xor(ss, 16); ss += __shfl_xor(ss, 32); (void)ss; }
            }
    }
};
struct EpiNull {
    static constexpr bool PERM = true, AFTER_DRAIN = false; float* sink;
    __device__ __forceinline__ void operator()(const pg8::f32x4 (&acc)[2][2][4][2], const pg8::Unit& u, int wr, int wc, int fr, int fq) const { run<2>(acc, u, wr, wc, fr, fq); }
    template <int NAI> __device__ __forceinline__ void run(const pg8::f32x4 (&acc)[NAI][2][4][2], const pg8::Unit& u, int wr, int wc, int fr, int fq) const {
        float t = 0.f;
#pragma unroll
        for (int b = 0; b < 2; ++b)
#pragma unroll
            for (int m = 0; m < 4; ++m)
#pragma unroll
                for (int n = 0; n < 2; ++n) t += acc[0][b][m][n][0] + acc[0][b][m][n][3];
        if (t == 1234.5678f) sink[0] = t;
    }
};
struct EpiUp {
    static constexpr bool PERM = true, AFTER_DRAIN = false;
    bf16* O; const float* rowss;
    __device__ __forceinline__ void operator()(const pg8::f32x4 (&acc)[2][2][4][2], const pg8::Unit& u, int wr, int wc, int fr, int fq) const { run<2>(acc, u, wr, wc, fr, fq); }
    template <int NAI> __device__ __forceinline__ void run(const pg8::f32x4 (&acc)[NAI][2][4][2], const pg8::Unit& u, int wr, int wc, int fr, int fq) const {
        const int col = u.pn * 256 + wc * 32 + 8 * fq;
#pragma unroll
        for (int ai = 0; ai < NAI; ++ai)
#pragma unroll
            for (int m = 0; m < 4; ++m) {
                const int row = u.pm * 256 + ai * 128 + wr * 64 + m * 16 + fr;
                if (row < MREAL) {
                    const float rstd = __builtin_amdgcn_rsqf(rowss[row] * (1.f / D) + EPS);
#pragma unroll
                    for (int bj = 0; bj < 2; ++bj) {
                        float v[8];
#pragma unroll
                        for (int i = 0; i < 4; ++i) { float a = fmaxf(acc[ai][bj][m][0][i] * rstd, 0.f), b = fmaxf(acc[ai][bj][m][1][i] * rstd, 0.f); v[i] = a * a; v[4 + i] = b * b; }
                        u32x4 w; w.x = pk2(v[0], v[1]); w.y = pk2(v[2], v[3]); w.z = pk2(v[4], v[5]); w.w = pk2(v[6], v[7]);
                        *(u32x4*)(O + (size_t)row * FF + col + bj * 128) = w;
                    }
                }
            }
    }
};
struct EpiRes {
    static constexpr bool PERM = true, AFTER_DRAIN = false;
    bf16* HB; float* OUT; float* rowss;
    __device__ __forceinline__ void operator()(const pg8::f32x4 (&acc)[2][2][4][2], const pg8::Unit& u, int wr, int wc, int fr, int fq) const { run<2>(acc, u, wr, wc, fr, fq); }
    template <int NAI> __device__ __forceinline__ void run(const pg8::f32x4 (&acc)[NAI][2][4][2], const pg8::Unit& u, int wr, int wc, int fr, int fq) const {
        const int col = u.pn * 256 + wc * 32 + 8 * fq;
#pragma unroll
        for (int ai = 0; ai < NAI; ++ai)
#pragma unroll
            for (int m = 0; m < 4; ++m) {
                const int row = u.pm * 256 + ai * 128 + wr * 64 + m * 16 + fr;
                float ss = 0.f;
                if (row < MREAL) {
#pragma unroll
                    for (int bj = 0; bj < 2; ++bj) {
                        bf16* hp = HB + (size_t)row * D + col + bj * 128;
                        const bf16x8 hv = *(const bf16x8*)hp;
                        f32x4 h0, h1;
#pragma unroll
                        for (int i = 0; i < 4; ++i) { h0[i] = bf2f((unsigned short)hv[i]) + acc[ai][bj][m][0][i]; h1[i] = bf2f((unsigned short)hv[4 + i]) + acc[ai][bj][m][1][i]; }
                        if (OUT) { float* op = OUT + (size_t)row * D + col + bj * 128; *(f32x4*)op = h0; *(f32x4*)(op + 4) = h1; }
                        else { u32x4 w; w.x = pk2(h0[0], h0[1]); w.y = pk2(h0[2], h0[3]); w.z = pk2(h1[0], h1[1]); w.w = pk2(h1[2], h1[3]); *(u32x4*)hp = w; }
                        ss += (h0[0] * h0[0] + h0[1] * h0[1]) + (h0[2] * h0[2] + h0[3] * h0[3]) + (h1[0] * h1[0] + h1[1] * h1[1]) + (h1[2] * h1[2] + h1[3] * h1[3]);
                    }
                }
                ss += __shfl_xor(ss, 16); ss += __shfl_xor(ss, 32);
                if (fq == 0 && row < MREAL) __hip_atomic_fetch_add(rowss + row, ss, __ATOMIC_RELAXED, __HIP_MEMORY_SCOPE_AGENT);
            }
    }
};
struct EpiQKV {
    static constexpr bool PERM = true, AFTER_DRAIN = false;
    bf16* Q; bf16* KB; bf16* VB; float* out; const float* rowss; const float* ropec; const float* ropes; const float* offc; const float* offs;
    __device__ __forceinline__ void operator()(const pg8::f32x4 (&acc)[2][2][4][2], const pg8::Unit& u, int wr, int wc, int fr, int fq) const { run<2>(acc, u, wr, wc, fr, fq); }
    template <int NAI> __device__ __forceinline__ void run(const pg8::f32x4 (&acc)[NAI][2][4][2], const pg8::Unit& u, int wr, int wc, int fr, int fq) const {
        const int pn = u.pn;
        const bool isq = pn < 12; const int kvi = pn - 12; const int g = isq ? (pn >> 2) : (kvi >> 1); const bool isv = (!isq) && (kvi & 1);
        const int sh = 2 * g, W = 128 << sh;
        const bool stile = u.pm == 64;
        const int d0 = 8 * fq;
        const int slb = ((u.pm * 256 + wr * 64 + fr) & (SEQ - 1)) * 32 + d0;
#pragma unroll
        for (int ai = 0; ai < NAI; ++ai)
#pragma unroll
            for (int m = 0; m < 4; ++m) {
                const int row = u.pm * 256 + ai * 128 + wr * 64 + m * 16 + fr;
                if (row >= MREAL) continue;
                const float rstd = __builtin_amdgcn_rsqf(rowss[row] * (1.f / D) + EPS) * (isq ? QSCALE : 1.f);
                const bool samp = row >= NPROMPT; const int t = samp ? ((row - NPROMPT) & 3) : (row & (SEQ - 1));
                int rowp = row;
                if (!samp) { const int b = row >> 13, r = t & ((1 << sh) - 1), uu = t >> sh; rowp = b * SEQ + r * (SEQ >> sh) + uu; }
                float* ob = nullptr;
                if (!isq) {
                    if (samp) ob = out + (g == 0 ? O_KVS0 : g == 1 ? O_KVS1 : O_KVS2) + (size_t)(row - NPROMPT) * 512;
                    else if (t >= SEQ - W) ob = out + (g == 0 ? O_KVP0 : g == 1 ? O_KVP1 : O_KVP2) + ((size_t)(row >> 13) * W + (t - (SEQ - W))) * 512;
                }
                f32x4 av[2], bv[2];
#pragma unroll
                for (int n = 0; n < 2; ++n) {
                    f32x4 a = acc[ai][0][m][n] * rstd, b = acc[ai][1][m][n] * rstd;
                    if (!isv) {
                        const int sl = (samp ? SEQ + t : t) * 32 + d0 + 4 * n; const f32x4 c = *(const f32x4*)(ropec + sl), sn = *(const f32x4*)(ropes + sl);
                        const f32x4 ra = a * c - b * sn, rb = b * c + a * sn; a = ra; b = rb;
                    }
                    av[n] = a; bv[n] = b;
                }
                if (isq) {
                    bf16* qp = Q + (size_t)row * QW + pn * 256 + wc * 64 + d0;
                    u32x4 w0, w1; w0.x = pk2(av[0][0], av[0][1]); w0.y = pk2(av[0][2], av[0][3]); w0.z = pk2(av[1][0], av[1][1]); w0.w = pk2(av[1][2], av[1][3]);
                    w1.x = pk2(bv[0][0], bv[0][1]); w1.y = pk2(bv[0][2], bv[0][3]); w1.z = pk2(bv[1][0], bv[1][1]); w1.w = pk2(bv[1][2], bv[1][3]);
                    *(u32x4*)qp = w0; *(u32x4*)(qp + 32) = w1;
                } else {
                    bf16* kp = (isv ? VB : KB) + ((size_t)g * MP + rowp) * 256 + wc * 64 + d0;
                    u32x4 w0, w1; w0.x = pk2(av[0][0], av[0][1]); w0.y = pk2(av[0][2], av[0][3]); w0.z = pk2(av[1][0], av[1][1]); w0.w = pk2(av[1][2], av[1][3]);
                    w1.x = pk2(bv[0][0], bv[0][1]); w1.y = pk2(bv[0][2], bv[0][3]); w1.z = pk2(bv[1][0], bv[1][1]); w1.w = pk2(bv[1][2], bv[1][3]);
                    *(u32x4*)kp = w0; *(u32x4*)(kp + 32) = w1;
                    if (ob) { float* o2 = ob + (isv ? 256 : 0) + wc * 64 + d0;
                        if (samp) { *(f32x4*)o2 = av[0]; *(f32x4*)(o2 + 4) = av[1]; *(f32x4*)(o2 + 32) = bv[0]; *(f32x4*)(o2 + 36) = bv[1]; }
                        else { __builtin_nontemporal_store(av[0], (f32x4*)o2); __builtin_nontemporal_store(av[1], (f32x4*)(o2 + 4)); __builtin_nontemporal_store(bv[0], (f32x4*)(o2 + 32)); __builtin_nontemporal_store(bv[1], (f32x4*)(o2 + 36)); } }
                }
            }
    }
};

template <class Epi>
__device__ __forceinline__ void skinny_phase(LAS unsigned char* lds, const bf16* Abuf, const bf16* Bt, int N, int K, const Epi& E, int first, int wave, int lane) {
    const int nroles = (N >> 8) * 8, G = gridDim.x;
    const int fr = lane & 15, fq = lane >> 4;
    LAS float* red = (LAS float*)lds;
    const int rstep = first ? G - first : G;
    for (int role = (int)blockIdx.x - first; role < nroles; role += rstep) {
        if (role < 0) break;
        const int pn = role >> 3, wr = (role >> 2) & 1, wc = role & 3;
        pg8::f32x4 acc[1][2][4][2];
#pragma unroll
        for (int b = 0; b < 2; ++b)
#pragma unroll
            for (int m = 0; m < 4; ++m)
#pragma unroll
                for (int n = 0; n < 2; ++n) acc[0][b][m][n] = (pg8::f32x4){0.f, 0.f, 0.f, 0.f};
        const int kper = K >> 3, k0 = wave * kper;
        const bf16* ap = Abuf + (size_t)(NPROMPT + 64 * wr + fr) * K + k0 + 8 * fq;
        const int r0 = Epi::PERM ? (8 * (fr >> 2) + (fr & 3)) : fr, r1 = Epi::PERM ? r0 + 4 : fr + 16;
        const bf16* bp = Bt + (size_t)(256 * pn + 32 * wc) * K + k0 + 8 * fq;
#pragma unroll 4
        for (int ks = 0; ks < kper; ks += 32) {
            bf16x8 af[4], bf_[2][2];
#pragma unroll
            for (int m = 0; m < 4; ++m) af[m] = *(const bf16x8*)(ap + (size_t)(16 * m) * K + ks);
#pragma unroll
            for (int b = 0; b < 2; ++b) { bf_[b][0] = *(const bf16x8*)(bp + (size_t)(128 * b + r0) * K + ks); bf_[b][1] = *(const bf16x8*)(bp + (size_t)(128 * b + r1) * K + ks); }
#pragma unroll
            for (int b = 0; b < 2; ++b)
#pragma unroll
                for (int m = 0; m < 4; ++m)
#pragma unroll
                    for (int n = 0; n < 2; ++n) acc[0][b][m][n] = __builtin_amdgcn_mfma_f32_16x16x32_bf16(bf_[b][n], af[m], acc[0][b][m][n], 0, 0, 0);
        }
        if (wave != 0) {
#pragma unroll
            for (int b = 0; b < 2; ++b)
#pragma unroll
                for (int m = 0; m < 4; ++m)
#pragma unroll
                    for (int n = 0; n < 2; ++n) *(LAS pg8::f32x4*)(red + ((size_t)((wave - 1) * 16 + b * 8 + m * 2 + n) * 64 + lane) * 4) = acc[0][b][m][n];
        }
        __syncthreads();
        if (wave == 0) {
#pragma unroll 1
            for (int w = 0; w < 7; ++w)
#pragma unroll
                for (int b = 0; b < 2; ++b)
#pragma unroll
                    for (int m = 0; m < 4; ++m)
#pragma unroll
                        for (int n = 0; n < 2; ++n) acc[0][b][m][n] += *(const LAS pg8::f32x4*)(red + ((size_t)(w * 16 + b * 8 + m * 2 + n) * 64 + lane) * 4);
            const pg8::Unit u{64, pn};
            E.template run<1>(acc, u, wr, wc, fr, fq);
        }
        __syncthreads();
    }
}
__device__ __forceinline__ int conv_srcc(int mode, int nb) {
    if (mode == 0) return 32 * nb;
    if (mode == 1) { const int pn = nb >> 3, bj = (nb >> 2) & 1, cb = nb & 3; return bj * 1024 + 128 * pn + 32 * cb; }
    const int pn = nb >> 3, bj = (nb >> 2) & 1, wc = nb & 3; return 256 * pn + 64 * wc + 32 * bj;
}
__device__ __forceinline__ void transpose_item(const float* W, int K, int N, bf16* WT, const float* gain, int mode, LAS float* scr, int item, int lane) {
    const int nblk = N >> 6, kb = item / nblk, nb64 = item % nblk, k0 = 64 * kb;
    const int l16 = lane & 15, srcc = conv_srcc(mode, 2 * nb64 + (l16 >> 3)) + 4 * (l16 & 7);
    f32x4 v[16];
#pragma unroll
    for (int i = 0; i < 16; ++i) { const int kk = 4 * i + (lane >> 4); v[i] = __builtin_nontemporal_load((const f32x4*)(W + (size_t)(k0 + kk) * N + srcc)); }
    if (gain) {
#pragma unroll
        for (int i = 0; i < 16; ++i) { const int kk = 4 * i + (lane >> 4); v[i] = v[i] * gain[k0 + kk]; }
    }
#pragma unroll
    for (int i = 0; i < 16; ++i) { const int kk = 4 * i + (lane >> 4); LAS float* d = scr + kk * 65 + 4 * l16; d[0] = v[i][0]; d[1] = v[i][1]; d[2] = v[i][2]; d[3] = v[i][3]; }
    asm volatile("s_waitcnt lgkmcnt(0)" ::: "memory");
    const int c = lane & 7;
#pragma unroll
    for (int j = 0; j < 8; ++j) { const int n = (lane >> 3) + 8 * j; const LAS float* sp = scr + (8 * c) * 65 + n;
        u32x4 o; o.x = pk2(sp[0 * 65], sp[1 * 65]); o.y = pk2(sp[2 * 65], sp[3 * 65]); o.z = pk2(sp[4 * 65], sp[5 * 65]); o.w = pk2(sp[6 * 65], sp[7 * 65]);
        *(u32x4*)(WT + (size_t)(64 * nb64 + n) * K + k0 + 8 * c) = o; }
    asm volatile("s_waitcnt lgkmcnt(0)" ::: "memory");
}
__device__ __forceinline__ void convert_late(const Args& A, LAS unsigned char* lds, int vw, int NVW, int wave, int lane) {
    unsigned char* ws = A.ws;
    LAS float* scr = (LAS float*)(lds + wave * 16640);
    constexpr int I_UP = 16 * 64, I_DN = 64 * 16, I_O = 16 * 16, NIT = I_O + I_UP + I_DN;
    for (int it = vw; it < NIT; it += NVW) {
        int r = it;
        if (r < I_O) { transpose_item(A.in[21], 1024, 1024, (bf16*)(ws + W_O), nullptr, 0, scr, r, lane); continue; } r -= I_O;
        if (r < I_UP) { transpose_item(A.in[22] + 1024ull * 4096, 1024, 4096, (bf16*)(ws + W_UP1), A.in[8] + 1024, 0, scr, r, lane); continue; } r -= I_UP;
        transpose_item(A.in[23] + 4096ull * 1024, 4096, 1024, (bf16*)(ws + W_DN1), nullptr, 0, scr, r, lane);
    }
}

__device__ __forceinline__ void phase_prologue(const Args& A, LAS unsigned char* lds, int gw, int NGW, int wave, int lane) {
    unsigned char* ws = A.ws;
    LAS float* scr = (LAS float*)(lds + wave * 16640);
    constexpr int I_GLU = 16 * 32, I_UP = 16 * 64, I_DN = 64 * 16, I_Q = 16 * 48, I_KV = 16 * 24;
    constexpr int NIT = I_GLU + I_UP + I_DN + I_Q + I_KV;
    for (int it = gw; it < NIT; it += NGW) {
        int r = it;
        if (r < I_GLU) { transpose_item(A.in[17], 1024, 2048, (bf16*)(ws + W_GLU), nullptr, 1, scr, r, lane); continue; } r -= I_GLU;
        if (r < I_UP) { transpose_item(A.in[22], 1024, 4096, (bf16*)(ws + W_UP0), A.in[8], 0, scr, r, lane); continue; } r -= I_UP;
        if (r < I_DN) { transpose_item(A.in[23], 4096, 1024, (bf16*)(ws + W_DN0), nullptr, 0, scr, r, lane); continue; } r -= I_DN;
        if (r < I_Q) { transpose_item(A.in[20], 1024, 3072, (bf16*)(ws + W_QKV), A.in[7] + 1024, 2, scr, r, lane); continue; } r -= I_Q;
        transpose_item(A.in[19], 1024, 1536, (bf16*)(ws + W_QKV) + 3072ull * 1024, A.in[18], 2, scr, r, lane);
    }
    {
        const float* gmix = A.in[7];
        bf16* HN0 = (bf16*)(ws + WS_HN0);
        for (int row0 = 4 * gw; row0 < MREAL; row0 += 4 * NGW) {
            f32x4 v[4][4]; float ssq[4];
#pragma unroll
            for (int q = 0; q < 4; ++q) { const int row = row0 + q; const float* xr = row < NPROMPT ? A.in[0] + (size_t)row * D : A.in[1] + (size_t)(row - NPROMPT) * D;
#pragma unroll
                for (int j = 0; j < 4; ++j) v[q][j] = __builtin_nontemporal_load((const f32x4*)xr + lane + 64 * j); }
#pragma unroll
            for (int q = 0; q < 4; ++q) { float sq = 0.f;
#pragma unroll
                for (int j = 0; j < 4; ++j) sq += (v[q][j][0] * v[q][j][0] + v[q][j][1] * v[q][j][1]) + (v[q][j][2] * v[q][j][2] + v[q][j][3] * v[q][j][3]);
                ssq[q] = __builtin_amdgcn_rsqf(wave_sum(sq) * (1.f / D) + EPS); }
#pragma unroll
            for (int j = 0; j < 4; ++j) { const f32x4 gg = *((const f32x4*)gmix + lane + 64 * j);
#pragma unroll
                for (int q = 0; q < 4; ++q) { const float rstd = ssq[q];
                    u32x2 w; w.x = pk2(v[q][j][0] * rstd * gg[0], v[q][j][1] * rstd * gg[1]); w.y = pk2(v[q][j][2] * rstd * gg[2], v[q][j][3] * rstd * gg[3]);
                    *((u32x2*)(HN0 + (size_t)(row0 + q) * D) + lane + 64 * j) = w; } }
        }
    }
    const int gt = gw * 64 + lane, NGT = NGW * 64;
    { float* rs = (float*)(ws + WS_ROWSS); for (int i = gt; i < 4 * MP; i += NGT) rs[i] = 0.f; }
    { float* rc = (float*)(ws + WS_ROPE); float* rsn = rc + 8196 * 32;
      for (int i = gt; i < 8196 * 32; i += NGT) { const int slot = i >> 5, d = i & 31; const float pos = slot < SEQ ? (float)slot : (float)(16384 + (slot - SEQ));
          const float inv = powf(10000.0f, -(float)d / 32.0f); const float ang = pos * inv; rc[i] = cosf(ang); rsn[i] = sinf(ang); } }
    { float* oc = (float*)(ws + WS_ROPE) + 2 * 8196 * 32; float* os = oc + 8 * 32;
      for (int i = gt; i < 8 * 32; i += NGT) { const int oi = i >> 5, d = i & 31; const float pos = (float)(128 * (oi >> 2) + 16 * (oi & 3));
          const float inv = powf(10000.0f, -(float)d / 32.0f); const float ang = pos * inv; oc[i] = cosf(ang); os[i] = sinf(ang); } }
    { float* lam = (float*)(ws + WS_LAM); bf16* BB = (bf16*)(ws + WS_BBAR); bf16* CC = (bf16*)(ws + WS_CC);
      const float *are = A.in[9], *aim = A.in[10], *ldt = A.in[11], *bre = A.in[12], *bim = A.in[13], *cre = A.in[14], *cim = A.in[15];
      for (int i = gt; i < 64 * 64 * 16; i += NGT) {
          const int c = i & 15, p = (i >> 4) & 63, g = i >> 10;
          const float dt = expf(ldt[g]); const float ar = are[g * 64 + p], ai = aim[g * 64 + p];
          const float mag = expf(ar * dt); const float lr = mag * cosf(ai * dt), li = mag * sinf(ai * dt);
          const float den = ar * ar + ai * ai, nr = lr - 1.f, ni = li;
          const float zr = (nr * ar + ni * ai) / den, zi = (ni * ar - nr * ai) / den;
          const float br = bre[(g * 64 + p) * 16 + c], bi = bim[(g * 64 + p) * 16 + c];
          const float bbr = zr * br - zi * bi, bbi = zr * bi + zi * br;
          BB[(g * 128 + p) * 16 + c] = (bf16)(pk2(bbr, 0.f) & 0xffffu);
          BB[(g * 128 + 64 + p) * 16 + c] = (bf16)(pk2(bbi, 0.f) & 0xffffu);
          CC[(g * 16 + c) * 128 + 4 * (p & 31) + (p >> 5)] = (bf16)(pk2(cre[(g * 16 + c) * 64 + p], 0.f) & 0xffffu);
          CC[(g * 16 + c) * 128 + 4 * (p & 31) + 2 + (p >> 5)] = (bf16)(pk2(-cim[(g * 16 + c) * 64 + p], 0.f) & 0xffffu);
          if (c == 0) { lam[(g * 64 + p) * 2] = lr; lam[(g * 64 + p) * 2 + 1] = li; }
      } }
}

#define CMUL_ADD(orr, oi, ar_, ai_, br_, bi_, cr_, ci_) do { const float _r = __builtin_fmaf((ar_), (br_), __builtin_fmaf(-(ai_), (bi_), (cr_))); const float _i = __builtin_fmaf((ar_), (bi_), __builtin_fmaf((ai_), (br_), (ci_))); orr = _r; oi = _i; } while (0)
template <bool PASS2>
__device__ __forceinline__ void s5_item(const Args& A, LAS unsigned char* hs, int item, int lane) {
    unsigned char* ws = A.ws;
    const bf16* HN0 = (const bf16*)(ws + WS_HN0);
    const bool samp = item >= 2048;
    const int g = item & 63, ch = samp ? 128 + ((item - 2048) >> 6) : 4 * (item >> 6);
    const int s = lane & 31, hf = lane >> 5;
    bf16x8 Bf[4], Cf[4];
    { const bf16* BB = (const bf16*)(ws + WS_BBAR) + (size_t)g * 128 * 16;
#pragma unroll
      for (int n = 0; n < 4; ++n) Bf[n] = *(const bf16x8*)(BB + (32 * n + s) * 16 + 8 * hf);
      if (PASS2) { const bf16* CC = (const bf16*)(ws + WS_CC) + (size_t)g * 16 * 128;
#pragma unroll
        for (int st = 0; st < 4; ++st) Cf[st] = *(const bf16x8*)(CC + (lane & 15) * 128 + 32 * st + 8 * (lane >> 4)); } }
    const float* lam = (const float*)(ws + WS_LAM) + (size_t)g * 128;
    float lr[2], li[2], l16r[2], l16i[2], l128r[2], l128i[2];
#pragma unroll
    for (int j = 0; j < 2; ++j) { lr[j] = lam[(s + 32 * j) * 2]; li[j] = lam[(s + 32 * j) * 2 + 1];
        float pr = lr[j], pi = li[j];
#pragma unroll
        for (int q = 0; q < 4; ++q) { const float nr = pr * pr - pi * pi, ni = 2.f * pr * pi; pr = nr; pi = ni; }
        l16r[j] = pr; l16i[j] = pi;
#pragma unroll
        for (int q = 0; q < 3; ++q) { const float nr = pr * pr - pi * pi, ni = 2.f * pr * pi; pr = nr; pi = ni; }
        l128r[j] = pr; l128i[j] = pi; }
    float cr[2] = {0.f, 0.f}, ci[2] = {0.f, 0.f};
    const float* E = (const float*)(ws + WS_E);
    if (PASS2) {
        if (samp) { const int n = ch - 128;
#pragma unroll
            for (int j = 0; j < 2; ++j) { cr[j] = A.in[5][((size_t)n * 64 + g) * 64 + s + 32 * j]; ci[j] = A.in[6][((size_t)n * 64 + g) * 64 + s + 32 * j]; } }
        else { const int first = (ch >> 6) << 6;
#pragma unroll 8
            for (int jj = first; jj < ch; ++jj) { const float* e = E + ((size_t)jj * 64 + g) * 128;
#pragma unroll
                for (int j = 0; j < 2; ++j) { const float er = e[j * 32 + s], ei = e[64 + j * 32 + s]; CMUL_ADD(cr[j], ci[j], l128r[j], l128i[j], cr[j], ci[j], er, ei); } } }
    }
    const int nblk = samp ? 1 : 16;
    const int rowbase = samp ? NPROMPT + 4 * (ch - 128) : ch * 128;
    const int tokA = 16 * ((s >> 2) & 1) + 4 * (s >> 3) + (s & 3);
    const float* dsk = A.in[16] + g * 16;
    bf16* Y = (bf16*)(ws + WS_Y);
    bf16x8 afn = *(const bf16x8*)(HN0 + (size_t)(rowbase + tokA) * D + g * 16 + 8 * hf);
    const int uoff = (lane & 15) * D + g * 16 + 4 * (lane >> 4);
    u32x2 un[2];
    if (PASS2) {
#pragma unroll
        for (int q = 0; q < 2; ++q) un[q] = *(const u32x2*)(HN0 + (size_t)(rowbase + 16 * q) * D + uoff);
    }
    const f32x4 dk4 = *(const f32x4*)(dsk + 4 * (lane >> 4));
    for (int blk = 0; blk < nblk; ++blk) {
        const int row0 = rowbase + 32 * blk;
        const bf16x8 af = afn;
        u32x2 uc[2];
        if (PASS2) {
#pragma unroll
            for (int q = 0; q < 2; ++q) uc[q] = un[q];
            if (blk + 1 < nblk) {
#pragma unroll
                for (int q = 0; q < 2; ++q) un[q] = *(const u32x2*)(HN0 + (size_t)(row0 + 32 + 16 * q) * D + uoff);
            }
        }
        if (!PASS2 && (blk & 3) == 0) { cr[0] = 0.f; cr[1] = 0.f; ci[0] = 0.f; ci[1] = 0.f; }
        if (blk + 1 < nblk) afn = *(const bf16x8*)(HN0 + (size_t)(row0 + 32 + tokA) * D + g * 16 + 8 * hf);
        f32x16 X[4];
        const f32x16 z16 = {0.f, 0.f, 0.f, 0.f, 0.f, 0.f, 0.f, 0.f, 0.f, 0.f, 0.f, 0.f, 0.f, 0.f, 0.f, 0.f};
#pragma unroll
        for (int n = 0; n < 4; ++n) X[n] = __builtin_amdgcn_mfma_f32_32x32x16_bf16(af, Bf[n], z16, 0, 0, 0);
        float cinr[2], cini[2];
#pragma unroll
        for (int j = 0; j < 2; ++j) {
            float er = 0.f, ei = 0.f;
#pragma unroll
            for (int r = 0; r < 16; ++r) CMUL_ADD(er, ei, lr[j], li[j], er, ei, X[j][r], X[2 + j][r]);
            const float or_ = __shfl_xor(er, 32), oi_ = __shfl_xor(ei, 32);
            const float e0r = hf ? or_ : er, e0i = hf ? oi_ : ei, e1r = hf ? er : or_, e1i = hf ? ei : oi_;
            float mr, mi; CMUL_ADD(mr, mi, l16r[j], l16i[j], cr[j], ci[j], e0r, e0i);
            cinr[j] = hf ? mr : cr[j]; cini[j] = hf ? mi : ci[j];
            CMUL_ADD(cr[j], ci[j], l16r[j], l16i[j], mr, mi, e1r, e1i);
        }
        if (PASS2) {
#pragma unroll
            for (int j = 0; j < 2; ++j) {
                float hr = cinr[j], hi = cini[j];
#pragma unroll
                for (int r = 0; r < 16; ++r) { CMUL_ADD(hr, hi, lr[j], li[j], hr, hi, X[j][r], X[2 + j][r]);
                    X[j][r] = hr; X[2 + j][r] = hi; }
            }
            if (samp && hf == 0) { const int n = ch - 128;
#pragma unroll
                for (int j = 0; j < 2; ++j) { A.out[O_SRES + ((size_t)n * 64 + g) * 64 + s + 32 * j] = X[j][3]; A.out[O_SIMS + ((size_t)n * 64 + g) * 64 + s + 32 * j] = X[2 + j][3]; } }
#pragma unroll
            for (int r = 0; r < 16; ++r) { LAS unsigned short* hp = (LAS unsigned short*)(hs + (16 * hf + r) * 272);
                u32x2 w; w.x = pk2(X[0][r], X[1][r]); w.y = pk2(X[2][r], X[3][r]);
                *(LAS u32x2*)(hp + 4 * s) = w; }
            asm volatile("s_waitcnt lgkmcnt(0)" ::: "memory");
#pragma unroll
            for (int tb = 0; tb < 2; ++tb) {
                f32x4 y = {0.f, 0.f, 0.f, 0.f};
#pragma unroll
                for (int st = 0; st < 4; ++st) { const bf16x8 hfrag = *(const LAS bf16x8*)(hs + (16 * tb + (lane & 15)) * 272 + 64 * st + 16 * (lane >> 4));
                    y = __builtin_amdgcn_mfma_f32_16x16x32_bf16(Cf[st], hfrag, y, 0, 0, 0); }
                const int tk = 16 * tb + (lane & 15);
                if (!samp || tk < 4) {
                    const float u0 = __uint_as_float(uc[tb].x << 16), u1 = __uint_as_float(uc[tb].x & 0xffff0000u), u2 = __uint_as_float(uc[tb].y << 16), u3 = __uint_as_float(uc[tb].y & 0xffff0000u);
                    f32x4 v = {y[0] + dk4[0] * u0, y[1] + dk4[1] * u1, y[2] + dk4[2] * u2, y[3] + dk4[3] * u3};
                    float ge[4];
#pragma unroll
                    for (int j = 0; j < 4; ++j) { const float vv = v[j] * v[j]; const float ex = __builtin_amdgcn_exp2f(v[j] * __builtin_fmaf(vv, -0.10294324f, -2.30220820f)); ge[j] = v[j] * __builtin_amdgcn_rcpf(1.f + ex); }
                    u32x2 w; w.x = pk2(ge[0], ge[1]); w.y = pk2(ge[2], ge[3]);
                    *(u32x2*)(Y + (size_t)(row0 + tk) * D + g * 16 + 4 * (lane >> 4)) = w;
                }
            }
            asm volatile("s_waitcnt lgkmcnt(0)" ::: "memory");
        }
        if (!PASS2 && (blk & 3) == 3 && hf == 0) { float* e = (float*)(ws + WS_E) + ((size_t)(ch + (blk >> 2)) * 64 + g) * 128;
#pragma unroll
            for (int j = 0; j < 2; ++j) { e[j * 32 + s] = cr[j]; e[64 + j * 32 + s] = ci[j]; } }
    }
    if (PASS2 && !samp && hf == 0 && ((ch + 3) & 63) == 63) { const int b = ch >> 6;
#pragma unroll
        for (int j = 0; j < 2; ++j) { A.out[O_SREP + ((size_t)b * 64 + g) * 64 + s + 32 * j] = cr[j]; A.out[O_SIMP + ((size_t)b * 64 + g) * 64 + s + 32 * j] = ci[j]; } }
}

typedef short v4i16_t __attribute__((ext_vector_type(4)));
constexpr int KIMG_STRIDE = 144, KIMG_BYTES = 192 * KIMG_STRIDE, VIMG_HALF = 192 * 64, NATT_ITEMS = 3072;
struct AttItem { int g, sh, b, r, u0, kvh; };
__device__ __forceinline__ AttItem att_decode(int bi) {
    AttItem I; I.g = bi >> 10; const int rem = bi & 1023; I.kvh = rem & 3; I.b = (rem >> 2) & 1; const int rq = rem >> 3;
    I.sh = 2 * I.g; const int nqb = 128 >> I.sh; I.r = rq / nqb; I.u0 = 64 * (rq % nqb); return I;
}
template <bool COMBINE, int MODE = 0>
__device__ __forceinline__ void attn_prompt_phase(const Args& A, LAS unsigned char* lds, int tid, int wave, int lane, int item_lo, int item_hi) {
    unsigned char* ws = A.ws;
    const bf16* Q = (const bf16*)(ws + WS_Q); const bf16* KB = (const bf16*)(ws + WS_KB); const bf16* VB = (const bf16*)(ws + WS_VT);
    bf16* OG = (bf16*)(ws + WS_OG); float* LSE = (float*)(ws + WS_LSE);
    const int G = gridDim.x, hh = wave & 3, sub = wave >> 2, n = lane & 31, hf = lane >> 5;
    const int kap = (n & 3) + 4 * ((n >> 3) & 1) + 8 * ((n >> 2) & 1) + 16 * (n >> 4);
    int bi = item_lo + blockIdx.x;
    const int NATT_HI = item_hi;
    if (bi >= NATT_HI) return;
    bf16* AT = (bf16*)(ws + WS_ATT);
    u32x4 pk_[3], pv_[3]; bf16x8 qn[4];
#define ATT_ISSUE_KV(bix) do { const AttItem J = att_decode(bix); const int L_ = SEQ >> J.sh; const size_t pb_ = (size_t)J.g * MP + (size_t)J.b * SEQ + (size_t)J.r * L_; \
        _Pragma("unroll") for (int i = 0; i < 3; ++i) { const int c_ = tid + 512 * i, row_ = c_ >> 3, ch_ = c_ & 7; int u_ = J.u0 - 128 + row_; u_ = u_ < 0 ? 0 : u_; \
            pk_[i] = *(const u32x4*)(KB + (pb_ + u_) * 256 + J.kvh * 64 + 8 * ch_); pv_[i] = *(const u32x4*)(VB + (pb_ + u_) * 256 + J.kvh * 64 + 8 * ch_); } } while (0)
#define ATT_ISSUE_Q(bix) do { const AttItem J = att_decode(bix); const int qrow_ = J.b * SEQ + ((J.u0 + 32 * sub + n) << J.sh) + J.r; \
        _Pragma("unroll") for (int ks = 0; ks < 4; ++ks) qn[ks] = *(const bf16x8*)(Q + (size_t)qrow_ * QW + J.g * 1024 + (4 * J.kvh + hh) * 64 + 16 * ks + 8 * hf); } while (0)
#define ATT_WRITE(bufo) do { _Pragma("unroll") for (int i = 0; i < 3; ++i) { const int c = tid + 512 * i, row = c >> 3, ch = c & 7; \
            *(LAS u32x4*)(lds + (bufo) + row * KIMG_STRIDE + 16 * ch) = pk_[i]; \
            *(LAS u32x4*)(lds + (bufo) + KIMG_BYTES + (ch >> 2) * VIMG_HALF + row * 64 + (ch & 3) * 16) = pv_[i]; } } while (0)
    constexpr int ABUF = KIMG_BYTES + 2 * VIMG_HALF;
    bf16x8 qf[4];
    ATT_ISSUE_KV(bi); ATT_ISSUE_Q(bi);
    ATT_WRITE(0);
#pragma unroll
    for (int ks = 0; ks < 4; ++ks) qf[ks] = qn[ks];
    if (bi + G < NATT_HI) ATT_ISSUE_KV(bi + G);
    asm volatile("s_waitcnt lgkmcnt(0)\n\ts_barrier" ::: "memory");
    int par = 0;
    for (; bi < NATT_HI; bi += G, par ^= 1) {
        const AttItem I = att_decode(bi);
        if (bi + G < NATT_HI) { ATT_WRITE((par ^ 1) * ABUF); ATT_ISSUE_Q(bi + G); }
        if (bi + 2 * G < NATT_HI) ATT_ISSUE_KV(bi + 2 * G);
        const LAS unsigned char* lbuf = lds + par * ABUF;
        const int u0w = I.u0 + 32 * sub;
        const int qrow = I.b * SEQ + ((u0w + n) << I.sh) + I.r;
        const int h = 4 * I.kvh + hh;
        f32x16 O0, O1;
#pragma unroll
        for (int i = 0; i < 16; ++i) { O0[i] = 0.f; O1[i] = 0.f; }
        float mrun = -INFINITY, lrun = 0.f;
        const int cc_ = lane & 7, rr0_ = lane >> 3;
        bf16x8 x1[4], x2[4]; float l1 = 0.f, l2 = 0.f;
        if (COMBINE) {
            l1 = LSE[((size_t)1 * MP + qrow) * 16 + h]; l2 = LSE[((size_t)2 * MP + qrow) * 16 + h];
#pragma unroll
            for (int j = 0; j < 4; ++j) { const int qr_ = I.b * SEQ + ((u0w + rr0_ + 8 * j) << I.sh) + I.r;
                x1[j] = *(const bf16x8*)(OG + ((size_t)1 * MP + qr_) * D + h * 64 + 8 * cc_); x2[j] = *(const bf16x8*)(OG + ((size_t)2 * MP + qr_) * D + h * 64 + 8 * cc_); }
        }
        const int kt0 = (MODE == 1 || MODE == 3) ? 5 : (u0w >= 128 ? 0 : (128 - u0w) >> 5);
        const LAS unsigned char* kimg = lbuf + (32 * sub + kap) * KIMG_STRIDE + 16 * hf;
        const LAS unsigned char* vimg = lbuf + KIMG_BYTES + (32 * sub + 8 * hf + ((lane & 15) >> 2)) * 64 + (16 * ((lane >> 4) & 1) + 4 * (lane & 3)) * 2;
        for (int kt = kt0; kt < 5; ++kt) {
            bf16x8 kf[4], vf[2][2];
#pragma unroll
            for (int ks = 0; ks < 4; ++ks) kf[ks] = *(const LAS bf16x8*)(kimg + (32 * kt) * KIMG_STRIDE + 32 * ks);
#pragma unroll
            for (int mb = 0; mb < 2; ++mb)
#pragma unroll
                for (int st = 0; st < 2; ++st) {
                    const LAS unsigned char* vp = vimg + mb * VIMG_HALF + (32 * kt + 16 * st) * 64;
                    const v4i16_t lo = __builtin_amdgcn_ds_read_tr16_b64_v4i16((LAS v4i16_t*)vp);
                    const v4i16_t hi = __builtin_amdgcn_ds_read_tr16_b64_v4i16((LAS v4i16_t*)(vp + 4 * 64));
                    vf[mb][st] = (bf16x8){lo[0], lo[1], lo[2], lo[3], hi[0], hi[1], hi[2], hi[3]};
                }
            f32x16 S;
#pragma unroll
            for (int i = 0; i < 16; ++i) S[i] = 0.f;
#pragma unroll
            for (int ks = 0; ks < 4; ++ks) S = __builtin_amdgcn_mfma_f32_32x32x16_bf16(kf[ks], qf[ks], S, 0, 0, 0);
            if (kt == 0) {
#pragma unroll
                for (int rr = 0; rr < 16; ++rr) { const int kp = (rr & 7) + 8 * hf + 16 * (rr >> 3); if (kp < n) S[rr] = -INFINITY; }
            } else if (kt == 4) {
#pragma unroll
                for (int rr = 0; rr < 16; ++rr) { const int kp = (rr & 7) + 8 * hf + 16 * (rr >> 3); if (kp > n) S[rr] = -INFINITY; }
            }
            float tm = S[0];
#pragma unroll
            for (int rr = 1; rr < 16; ++rr) tm = fmaxf(tm, S[rr]);
            tm = fmaxf(tm, __shfl_xor(tm, 32));
            const float mnew = fmaxf(mrun, tm);
            const float alpha = __builtin_amdgcn_exp2f(mrun - mnew);
            float ps = 0.f; float p[16];
#pragma unroll
            for (int rr = 0; rr < 16; ++rr) { p[rr] = __builtin_amdgcn_exp2f(S[rr] - mnew); ps += p[rr]; }
            lrun = lrun * alpha + ps; mrun = mnew;
            if (__builtin_amdgcn_ballot_w64(alpha != 1.f) != 0ull) {
#pragma unroll
                for (int i = 0; i < 16; ++i) { O0[i] *= alpha; O1[i] *= alpha; }
            }
#pragma unroll
            for (int st = 0; st < 2; ++st) {
                u32x4 pw; pw.x = pk2(p[8 * st + 0], p[8 * st + 1]); pw.y = pk2(p[8 * st + 2], p[8 * st + 3]); pw.z = pk2(p[8 * st + 4], p[8 * st + 5]); pw.w = pk2(p[8 * st + 6], p[8 * st + 7]);
                const bf16x8 pf = __builtin_bit_cast(bf16x8, pw);
                O0 = __builtin_amdgcn_mfma_f32_32x32x16_bf16(vf[0][st], pf, O0, 0, 0, 0);
                O1 = __builtin_amdgcn_mfma_f32_32x32x16_bf16(vf[1][st], pf, O1, 0, 0, 0);
            }
        }
        const float ltot = lrun + __shfl_xor(lrun, 32);
        LAS unsigned char* ost = lds + 2 * ABUF + wave * 4864;
        float sc0;
        if (!COMBINE) { sc0 = 1.f / ltot; if (hf == 0) LSE[((size_t)I.g * MP + qrow) * 16 + h] = mrun + log2f(ltot); }
        else { const float l0 = mrun + log2f(ltot); const float mx = fmaxf(l0, fmaxf(l1, l2));
            const float w0 = __builtin_amdgcn_exp2f(l0 - mx), w1 = __builtin_amdgcn_exp2f(l1 - mx), w2 = __builtin_amdgcn_exp2f(l2 - mx);
            const float invw = 1.f / (w0 + w1 + w2); sc0 = w0 * invw / ltot;
            if (hf == 0) { LAS float* wp = (LAS float*)(ost + 4608) + 2 * n; wp[0] = w1 * invw; wp[1] = w2 * invw; } }
        if (MODE < 2) {
#pragma unroll
            for (int a = 0; a < 4; ++a) {
                u32x2 w0v, w1v; w0v.x = pk2(O0[4 * a] * sc0, O0[4 * a + 1] * sc0); w0v.y = pk2(O0[4 * a + 2] * sc0, O0[4 * a + 3] * sc0);
                w1v.x = pk2(O1[4 * a] * sc0, O1[4 * a + 1] * sc0); w1v.y = pk2(O1[4 * a + 2] * sc0, O1[4 * a + 3] * sc0);
                *(LAS u32x2*)(ost + n * 144 + (8 * a + 4 * hf) * 2) = w0v; *(LAS u32x2*)(ost + n * 144 + 64 + (8 * a + 4 * hf) * 2) = w1v;
            }
            asm volatile("s_waitcnt lgkmcnt(0)" ::: "memory");
#pragma unroll
            for (int j = 0; j < 4; ++j) { const int rr_ = rr0_ + 8 * j; const int qr_ = I.b * SEQ + ((u0w + rr_) << I.sh) + I.r;
                const bf16x8 tv = *(const LAS bf16x8*)(ost + rr_ * 144 + 16 * cc_);
                if (!COMBINE) *(bf16x8*)(OG + ((size_t)I.g * MP + qr_) * D + h * 64 + 8 * cc_) = tv;
                else { const LAS float* wp = (const LAS float*)(ost + 4608) + 2 * rr_; const float w1 = wp[0], w2 = wp[1];
                    float o[8];
#pragma unroll
                    for (int i = 0; i < 8; ++i) o[i] = bf2f((unsigned short)tv[i]) + w1 * bf2f((unsigned short)x1[j][i]) + w2 * bf2f((unsigned short)x2[j][i]);
                    u32x4 y; y.x = pk2(o[0], o[1]); y.y = pk2(o[2], o[3]); y.z = pk2(o[4], o[5]); y.w = pk2(o[6], o[7]);
                    *(u32x4*)(AT + (size_t)qr_ * D + h * 64 + 8 * cc_) = y; }
            }
        } else { if (ltot == 123.456f) LSE[0] = ltot; }
#pragma unroll
        for (int ks = 0; ks < 4; ++ks) qf[ks] = qn[ks];
        asm volatile("s_waitcnt lgkmcnt(0)\n\ts_barrier" ::: "memory");
    }
#undef ATT_ISSUE_KV
#undef ATT_ISSUE_Q
#undef ATT_WRITE
}

__device__ __forceinline__ void attn_sample_item(const Args& A, LAS float* sl, int it, int lane) {
    unsigned char* ws = A.ws;
    const int h = it & 15, t = (it >> 4) & 3, n = it >> 6, kvh = h >> 2;
    const int row = NPROMPT + 4 * n + t;
    const bf16* Q = (const bf16*)(ws + WS_Q) + (size_t)row * QW + h * 64;
    const int kq = lane >> 2, dq = lane & 3;
    float mxl = -INFINITY;
#pragma unroll 1
    for (int g = 0; g < 3; ++g) {
        const int W = 128 << (2 * g), dil = 1 << (2 * g);
        const float* cache = A.in[2 + g] + (size_t)n * W * 512;
        const float* newkv = A.out + (g == 0 ? O_KVS0 : g == 1 ? O_KVS1 : O_KVS2) + (size_t)n * 4 * 512;
        float q[16];
#pragma unroll
        for (int c8 = 0; c8 < 2; ++c8) { const bf16x8 v = *(const bf16x8*)(Q + g * 1024 + 16 * dq + 8 * c8);
#pragma unroll
            for (int i = 0; i < 8; ++i) q[8 * c8 + i] = bf2f((unsigned short)v[i]); }
        f32x4 kvv[9][4];
#pragma unroll
        for (int bt = 0; bt < 9; ++bt) {
            const int j = 16 * bt + kq; const int jj = j <= 128 ? j : 128;
            const int idx = W + t - dil * jj;
            const float* kp = (idx >= W ? newkv + (size_t)(idx - W) * 512 : cache + (size_t)idx * 512) + kvh * 64 + 16 * dq;
#pragma unroll
            for (int c4 = 0; c4 < 4; ++c4) kvv[bt][c4] = *(const f32x4*)(kp + 4 * c4);
        }
        __builtin_amdgcn_sched_barrier(0);
#pragma unroll
        for (int bt = 0; bt < 9; ++bt) {
            const int j = 16 * bt + kq; const bool valid = j <= 128;
            float s = 0.f;
#pragma unroll
            for (int c4 = 0; c4 < 4; ++c4) { const f32x4 kv = kvv[bt][c4]; s += q[4 * c4] * kv[0] + q[4 * c4 + 1] * kv[1] + q[4 * c4 + 2] * kv[2] + q[4 * c4 + 3] * kv[3]; }
            s += __shfl_xor(s, 1); s += __shfl_xor(s, 2);
            if (valid && dq == 0) sl[g * 132 + j] = s;
            mxl = fmaxf(mxl, valid ? s : -INFINITY);
        }
    }
    const float mx = wave_max(mxl);
    asm volatile("s_waitcnt lgkmcnt(0)" ::: "memory");
    float sum = 0.f;
#pragma unroll 1
    for (int i = lane; i < 396; i += 64) { const int j = i % 132; if (j <= 128) { const float p = exp2f(sl[i] - mx); sl[i] = p; sum += p; } }
    sum = wave_sum(sum);
    asm volatile("s_waitcnt lgkmcnt(0)" ::: "memory");
    f32x4 acc = {0.f, 0.f, 0.f, 0.f};
    const int ksl = lane >> 4, dq4 = lane & 15;
#pragma unroll 1
    for (int g = 0; g < 3; ++g) {
        const int W = 128 << (2 * g), dil = 1 << (2 * g);
        const float* cache = A.in[2 + g] + (size_t)n * W * 512;
        const float* newkv = A.out + (g == 0 ? O_KVS0 : g == 1 ? O_KVS1 : O_KVS2) + (size_t)n * 4 * 512;
        f32x4 vvv[33];
#pragma unroll
        for (int jb = 0; jb < 33; ++jb) {
            const int j = 4 * jb + ksl; const int jj = j <= 128 ? j : 128;
            const int idx = W + t - dil * jj;
            vvv[jb] = *(const f32x4*)((idx >= W ? newkv + (size_t)(idx - W) * 512 : cache + (size_t)idx * 512) + 256 + kvh * 64 + 4 * dq4);
        }
        __builtin_amdgcn_sched_barrier(0);
#pragma unroll
        for (int jb = 0; jb < 33; ++jb) {
            const int j = 4 * jb + ksl; const bool valid = j <= 128; const int jj = valid ? j : 128;
            const float pj = valid ? sl[g * 132 + jj] : 0.f;
            acc += vvv[jb] * pj;
        }
    }
#pragma unroll
    for (int i = 0; i < 4; ++i) { acc[i] += __shfl_xor(acc[i], 16); acc[i] += __shfl_xor(acc[i], 32); }
    bf16* AT = (bf16*)(ws + WS_ATT);
    if (lane < 16) { const float inv = 1.f / sum; u32x2 w; w.x = pk2(acc[0] * inv, acc[1] * inv); w.y = pk2(acc[2] * inv, acc[3] * inv);
        *(u32x2*)(AT + (size_t)row * D + h * 64 + 4 * dq4) = w; }
    asm volatile("s_waitcnt lgkmcnt(0)" ::: "memory");
}

__device__ __forceinline__ void attn_combine(const Args& A, int gt, int NGT) {
    unsigned char* ws = A.ws;
    const bf16* OG = (const bf16*)(ws + WS_OG); const float* LSE = (const float*)(ws + WS_LSE); bf16* AT = (bf16*)(ws + WS_ATT);
    for (int i = gt; i < NPROMPT * 128; i += NGT) {
        const int row = i >> 7, c8 = i & 127, h = c8 >> 3;
        const float l0 = LSE[((size_t)0 * MP + row) * 16 + h], l1 = LSE[((size_t)1 * MP + row) * 16 + h], l2 = LSE[((size_t)2 * MP + row) * 16 + h];
        const float mx = fmaxf(l0, fmaxf(l1, l2));
        float w0 = exp2f(l0 - mx), w1 = exp2f(l1 - mx), w2 = exp2f(l2 - mx); const float inv = 1.f / (w0 + w1 + w2); w0 *= inv; w1 *= inv; w2 *= inv;
        const bf16x8 a = *(const bf16x8*)(OG + ((size_t)0 * MP + row) * D + 8 * c8), b = *(const bf16x8*)(OG + ((size_t)1 * MP + row) * D + 8 * c8), c = *(const bf16x8*)(OG + ((size_t)2 * MP + row) * D + 8 * c8);
        float o[8];
#pragma unroll
        for (int k = 0; k < 8; ++k) o[k] = w0 * bf2f((unsigned short)a[k]) + w1 * bf2f((unsigned short)b[k]) + w2 * bf2f((unsigned short)c[k]);
        u32x4 w; w.x = pk2(o[0], o[1]); w.y = pk2(o[2], o[3]); w.z = pk2(o[4], o[5]); w.w = pk2(o[6], o[7]);
        *(u32x4*)(AT + (size_t)row * D + 8 * c8) = w;
    }
}

#define XB_TMO      128
#define XB_XCNT(j)  (256  + 64 * (j))
#define XB_XSUB(j)  (1280 + 64 * (j))
#define XB_XGEN(j)  (2304 + 64 * (j))
#define XB_TOP      3328
#define XB_TOPGEN   3392
#define XCD_BAR_WORDS 3456
#define XB_SPIN_CAP (1u << 18)

__device__ __forceinline__ unsigned xb_ld(unsigned* p)              { return __hip_atomic_load(p, __ATOMIC_RELAXED, __HIP_MEMORY_SCOPE_AGENT); }
__device__ __forceinline__ unsigned xb_add(unsigned* p, unsigned v) { return __hip_atomic_fetch_add(p, v, __ATOMIC_RELAXED, __HIP_MEMORY_SCOPE_AGENT); }
__device__ __forceinline__ unsigned xb_xcc_id() { return (unsigned)__builtin_amdgcn_s_getreg((3 << 11) | 20) & 0xFu; }
#define XB_SPIN(cond, bar) do { unsigned _sp = 0; while (cond) { __builtin_amdgcn_s_sleep(1); \
    if ((++_sp & 255u) == 0u) { if (xb_ld(&(bar)[XB_TMO])) break; if (_sp > XB_SPIN_CAP) { atomicAdd(&(bar)[XB_TMO], 1u); break; } } } } while (0)

struct XcdBarrier {
    unsigned* bar; unsigned x;
    volatile LAS unsigned* st;
};

__device__ __forceinline__ XcdBarrier xcd_barrier_post(unsigned* bar, volatile LAS unsigned* st) {
    XcdBarrier b; b.bar = bar; b.x = xb_xcc_id(); b.st = st;
    if (threadIdx.x == 0) (void)xb_add(&bar[XB_XCNT(b.x)], 1u);
    return b;
}
__device__ __forceinline__ void xcd_barrier_complete(unsigned* bar, unsigned x, unsigned& nloc, unsigned& nx) {
    const unsigned G = gridDim.x * gridDim.y * gridDim.z;
    unsigned sum, cnt, mine, sp = 0u;
    for (;;) {
        sum = 0u; cnt = 0u; mine = 0u;
#pragma unroll
        for (unsigned j = 0; j < 16; ++j) { const unsigned c = xb_ld(&bar[XB_XCNT(j)]); sum += c; cnt += (c > 0u) ? 1u : 0u; mine = (j == x) ? c : mine; }
        if (sum == G) break;
        __builtin_amdgcn_s_sleep(1);
        if ((++sp & 255u) == 0u) { if (xb_ld(&bar[XB_TMO])) break; if (sp > XB_SPIN_CAP) { atomicAdd(&bar[XB_TMO], 1u); break; } }
    }
    nloc = mine > 0u ? mine : 1u; nx = cnt > 0u ? cnt : 1u;
}

__device__ __forceinline__ void xcd_barrier(const XcdBarrier& b) {
    asm volatile("s_waitcnt vmcnt(0)" ::: "memory");
    __syncthreads();
    if (threadIdx.x == 0) {
        unsigned* bar = b.bar;
        __builtin_amdgcn_s_waitcnt(0);
        unsigned nloc = b.st[0], nx = b.st[1];
        if (nloc == 0u) { xcd_barrier_complete(bar, b.x, nloc, nx); b.st[0] = nloc; b.st[1] = nx; }
        const unsigned old = xb_add(&bar[XB_XSUB(b.x)], 1u);
        const unsigned gen = old / nloc;
        if (old + 1u == (gen + 1u) * nloc) {
            __builtin_amdgcn_fence(__ATOMIC_RELEASE, "agent");
            asm volatile("s_waitcnt vmcnt(0)" ::: "memory");
            const unsigned og = xb_add(&bar[XB_TOP], 1u);
            const unsigned tg = og / nx;
            if (og + 1u == (tg + 1u) * nx) xb_add(&bar[XB_TOPGEN], 1u);
            else XB_SPIN(xb_ld(&bar[XB_TOPGEN]) == tg, bar);
            __builtin_amdgcn_fence(__ATOMIC_ACQUIRE, "agent");
            xb_add(&bar[XB_XGEN(b.x)], 1u);
            asm volatile("s_waitcnt vmcnt(0)" ::: "memory");
        } else {
            XB_SPIN(xb_ld(&bar[XB_XGEN(b.x)]) == gen, bar);
            __builtin_amdgcn_fence(__ATOMIC_ACQUIRE, "agent");
            asm volatile("s_waitcnt vmcnt(0)" ::: "memory");
        }
    }
    __syncthreads();
}

constexpr int NPHASE = 13;
#ifndef REP0
#define REP0 1
#endif
#ifndef REP12
#define REP12 1
#endif
#ifndef REP7
#define REP7 1
#endif
#ifndef REP8
#define REP8 1
#endif
#ifndef REP4
#define REP4 1
#endif
#ifndef REP6
#define REP6 1
#endif
#ifndef DUP4
#define DUP4 0
#endif
#ifndef DUP6
#define DUP6 0
#endif
#ifndef DUP5
#define DUP5 0
#endif
#ifndef PROBE8
#define PROBE8 0
#endif
#ifndef XSYNC
#define XSYNC 0
#endif
__global__ void __launch_bounds__(NTHREADS, 2) yoco_fwd(Args A) {
    extern __shared__ __attribute__((aligned(16))) unsigned char lds_raw[];
    LAS unsigned char* lds = (LAS unsigned char*)lds_raw;
    cg::grid_group grid = cg::this_grid();
    const int tid = threadIdx.x, lane = tid & 63, wave = __builtin_amdgcn_readfirstlane(tid >> 6);
    const int G = gridDim.x, gw = blockIdx.x * NWAVES + wave, NGW = G * NWAVES, gt = gw * 64 + lane, NGT = NGW * 64;
    unsigned char* ws = A.ws;
    float* rowss = (float*)(ws + WS_ROWSS);
    float* Hf = (float*)(ws + WS_H); bf16* HB = (bf16*)(ws + WS_HB);
    const int lo = A.ph_lo, hi = A.ph_hi;
    volatile LAS unsigned* bst = (volatile LAS unsigned*)(lds + LDS_BYTES - 64);
    if (tid < 2) bst[tid] = 0u;
    __syncthreads();
    XcdBarrier xbar = xcd_barrier_post((unsigned*)(ws + WS_BAR), bst);
    if (lo < 0) grid.sync();
#ifndef PH_MASK
#define PH_MASK 0xffff
#endif
#define IN(k) (((PH_MASK >> (k)) & 1) && lo <= (k) && (k) < hi)
#define SEAM(k) do { if (IN(k) && IN((k) + 1)) xcd_barrier(xbar); } while (0)
    if (IN(0)) { for (int rp = 0; rp < REP0; ++rp) phase_prologue(A, lds, gw, NGW, wave, lane); for (int rp = 0; rp < XSYNC; ++rp) xcd_barrier(xbar); }
    SEAM(0);
    if (IN(1)) for (int rp = 0; rp < REP12; ++rp) { for (int it = gw; it < 2048; it += NGW) s5_item<false>(A, lds + wave * 8704, it, lane); }
    SEAM(1);
    if (IN(2)) for (int rp = 0; rp < REP12; ++rp) { for (int it = gw; it < 4096; it += NGW) s5_item<true>(A, lds + wave * 8704, it, lane); }
    SEAM(2);
    if (IN(3)) { pg8::Gemm g{(const bf16*)(ws + WS_Y), (const bf16*)(ws + W_GLU), NPROMPT, 2048, 1024}; pg8::StaticOrder S; S.init(NPROMPT, 2048, G, (int)blockIdx.x);
        EpiGlu E{A.in[0], A.in[1], Hf, HB, rowss};
        pg8::gemm_phase<EpiGlu, pg8::StaticOrder, true, true>(lds, g, S, E);
        skinny_phase(lds, g.A, g.Bt, 2048, 1024, E, 0, wave, lane); }
    SEAM(3);
    if (IN(4)) { pg8::Gemm g{HB, (const bf16*)(ws + W_UP0), NPROMPT, FF, 1024}; pg8::StaticOrder S; S.init(NPROMPT, FF, G, (int)blockIdx.x);
        EpiUp E{(bf16*)(ws + WS_ACT), rowss};
        pg8::gemm_phase<EpiUp, pg8::StaticOrder, true, true>(lds, g, S, E);
        skinny_phase(lds, g.A, g.Bt, FF, 1024, E, 0, wave, lane);
#if DUP4 == 1
        pg8::gemm_phase<EpiUp, pg8::StaticOrder, true, true>(lds, g, S, E);
#endif
#if DUP4 == 3
        { EpiNull E0{(float*)(ws + WS_OG)};
        skinny_phase(lds, g.A, g.Bt, FF, 1024, E0, 0, wave, lane); skinny_phase(lds, g.A, g.Bt, FF, 1024, E0, 0, wave, lane);
        skinny_phase(lds, g.A, g.Bt, FF, 1024, E0, 0, wave, lane); skinny_phase(lds, g.A, g.Bt, FF, 1024, E0, 0, wave, lane); }
#endif
#if DUP4 == 2
        skinny_phase(lds, g.A, g.Bt, FF, 1024, E, 0, wave, lane);
        skinny_phase(lds, g.A, g.Bt, FF, 1024, E, 0, wave, lane);
        skinny_phase(lds, g.A, g.Bt, FF, 1024, E, 0, wave, lane);
        skinny_phase(lds, g.A, g.Bt, FF, 1024, E, 0, wave, lane);
#endif
    }
    SEAM(4);
    if (IN(5)) { pg8::Gemm g{(const bf16*)(ws + WS_ACT), (const bf16*)(ws + W_DN0), NPROMPT, 1024, FF}; pg8::StaticOrder S; S.init(NPROMPT, 1024, G, (int)blockIdx.x);
        EpiRes E{HB, nullptr, rowss + MP};
        pg8::gemm_phase<EpiRes, pg8::StaticOrder, true, true>(lds, g, S, E);
        skinny_phase(lds, g.A, g.Bt, 1024, FF, E, 0, wave, lane);
#if DUP5 == 2
        { EpiUp E2{(bf16*)(ws + WS_OG), rowss}; pg8::gemm_phase<EpiUp, pg8::StaticOrder, true, true>(lds, g, S, E2); }
#endif
    }
    SEAM(5);
    if (IN(6)) { pg8::Gemm g{HB, (const bf16*)(ws + W_QKV), NPROMPT, NQKV, 1024}; pg8::StaticOrder S; S.init(NPROMPT, NQKV, G, (int)blockIdx.x);
        EpiQKV E{(bf16*)(ws + WS_Q), (bf16*)(ws + WS_KB), (bf16*)(ws + WS_VT), A.out, rowss + MP, (const float*)(ws + WS_ROPE), (const float*)(ws + WS_ROPE) + 8196 * 32, (const float*)(ws + WS_ROPE) + 2 * 8196 * 32, (const float*)(ws + WS_ROPE) + 2 * 8196 * 32 + 8 * 32};
        pg8::gemm_phase<EpiQKV, pg8::StaticOrder, true, true>(lds, g, S, E);
        skinny_phase(lds, g.A, g.Bt, NQKV, 1024, E, G >= 256 ? 128 : 0, wave, lane);
        { const int cf = G >= 256 ? 128 : 0; if ((int)blockIdx.x >= cf) convert_late(A, lds, ((int)blockIdx.x - cf) * NWAVES + wave, (G - cf) * NWAVES, wave, lane); }
#if DUP6 == 1
        pg8::gemm_phase<EpiQKV, pg8::StaticOrder, true, true>(lds, g, S, E);
#endif
#if DUP6 == 2
        { EpiUp E2{(bf16*)(ws + WS_OG), rowss + MP}; pg8::gemm_phase<EpiUp, pg8::StaticOrder, true, true>(lds, g, S, E2); }
#endif
    }
    SEAM(6);
    if (IN(7)) for (int rp = 0; rp < REP7; ++rp) {
        for (int it = gw; it < 2048; it += NGW) attn_sample_item(A, (LAS float*)(lds + 65536 + wave * 2048), it, lane);
        __syncthreads();
        attn_prompt_phase<false>(A, lds, tid, wave, lane, 1024, NATT_ITEMS);
    }
    SEAM(7);
    if (IN(8)) {
#if PROBE8 > 0
        attn_prompt_phase<true, PROBE8>(A, lds, tid, wave, lane, 0, 1024); __syncthreads();
#endif
        attn_prompt_phase<true>(A, lds, tid, wave, lane, 0, 1024); }
    SEAM(8);
    if (IN(9)) { pg8::Gemm g{(const bf16*)(ws + WS_ATT), (const bf16*)(ws + W_O), NPROMPT, 1024, 1024}; pg8::StaticOrder S; S.init(NPROMPT, 1024, G, (int)blockIdx.x);
        EpiRes E{HB, nullptr, rowss + 2 * MP};
        pg8::gemm_phase<EpiRes, pg8::StaticOrder, true, true>(lds, g, S, E);
        skinny_phase(lds, g.A, g.Bt, 1024, 1024, E, 0, wave, lane); }
    SEAM(9);
    if (IN(10)) { pg8::Gemm g{HB, (const bf16*)(ws + W_UP1), NPROMPT, FF, 1024}; pg8::StaticOrder S; S.init(NPROMPT, FF, G, (int)blockIdx.x);
        EpiUp E{(bf16*)(ws + WS_ACT), rowss + 2 * MP};
        pg8::gemm_phase<EpiUp, pg8::StaticOrder, true, true>(lds, g, S, E);
        skinny_phase(lds, g.A, g.Bt, FF, 1024, E, 0, wave, lane); }
    SEAM(10);
    if (IN(11)) { pg8::Gemm g{(const bf16*)(ws + WS_ACT), (const bf16*)(ws + W_DN1), NPROMPT, 1024, FF}; pg8::StaticOrder S; S.init(NPROMPT, 1024, G, (int)blockIdx.x);
        EpiRes E{HB, nullptr, rowss + 3 * MP};
        pg8::gemm_phase<EpiRes, pg8::StaticOrder, true, true>(lds, g, S, E);
        skinny_phase(lds, g.A, g.Bt, 1024, FF, E, 0, wave, lane); }
    SEAM(11);
    if (IN(12)) {
        const float* gfin = A.in[24];
        for (int row0 = 4 * gw; row0 < MREAL; row0 += 4 * NGW) {
            bf16x8 hv[4][2]; float rs[4];
#pragma unroll
            for (int q = 0; q < 4; ++q) { rs[q] = rowss[3 * MP + row0 + q];
#pragma unroll
                for (int j = 0; j < 2; ++j) hv[q][j] = __builtin_nontemporal_load((const bf16x8*)(HB + (size_t)(row0 + q) * D) + lane + 64 * j); }
#pragma unroll
            for (int j = 0; j < 2; ++j) { const f32x4 g0 = *((const f32x4*)gfin + 2 * (lane + 64 * j)), g1 = *((const f32x4*)gfin + 2 * (lane + 64 * j) + 1);
#pragma unroll
                for (int q = 0; q < 4; ++q) { const float rstd = __builtin_amdgcn_rsqf(rs[q] * (1.f / D) + EPS); float* orow = A.out + (size_t)(row0 + q) * D;
                    f32x4 o0, o1;
#pragma unroll
                    for (int i = 0; i < 4; ++i) { o0[i] = bf2f((unsigned short)hv[q][j][i]) * rstd * g0[i]; o1[i] = bf2f((unsigned short)hv[q][j][4 + i]) * rstd * g1[i]; }
                    __builtin_nontemporal_store(o0, (f32x4*)orow + 2 * (lane + 64 * j)); __builtin_nontemporal_store(o1, (f32x4*)orow + 2 * (lane + 64 * j) + 1); } }
        }
    }
#undef IN
#undef SEAM
}

#ifndef N_LAUNCHES
#define N_LAUNCHES 1
#endif
extern "C" void kernel_launch(void* const* d_in, const int* in_sizes, int n_in, void* d_out, int out_size, void* d_ws, size_t ws_size, hipStream_t stream) {
    static int grid = 0;
    if (grid == 0) {
        if (n_in != 25 || ws_size < WS_END) { fprintf(stderr, "kernel_launch: unexpected n_in %d / ws %zu\n", n_in, ws_size); grid = -1; return; }
        int dev = 0, cus = 0, per_cu = 0;
        hipGetDevice(&dev); hipDeviceGetAttribute(&cus, hipDeviceAttributeMultiprocessorCount, dev);
        if (hipFuncSetAttribute((const void*)yoco_fwd, hipFuncAttributeMaxDynamicSharedMemorySize, LDS_BYTES) != hipSuccess) { fprintf(stderr, "hipFuncSetAttribute failed\n"); grid = -1; return; }
        hipOccupancyMaxActiveBlocksPerMultiprocessor(&per_cu, (const void*)yoco_fwd, NTHREADS, LDS_BYTES);
        (void)hipGetLastError();
        if (per_cu < 1) per_cu = 1;
        grid = cus * per_cu;
    }
    if (grid < 0) return;
    Args a{};
    for (int i = 0; i < 25; ++i) a.in[i] = (const float*)d_in[i];
    a.out = (float*)d_out; a.ws = (unsigned char*)d_ws;
    if (hipMemsetAsync((char*)d_ws + WS_BAR, 0, 16384, stream) != hipSuccess) { fprintf(stderr, "memset failed\n"); return; }
    if (N_LAUNCHES == 1) {
        a.ph_lo = 0; a.ph_hi = NPHASE;
        void* args[] = {&a};
        hipError_t e = hipLaunchCooperativeKernel((const void*)yoco_fwd, dim3(grid), dim3(NTHREADS), args, LDS_BYTES, stream);
        if (e != hipSuccess) fprintf(stderr, "cooperative launch failed: %s (grid %d)\n", hipGetErrorString(e), grid);
    } else {
        for (int p = 0; p < NPHASE; ++p) { a.ph_lo = p; a.ph_hi = p + 1; hipLaunchKernelGGL(yoco_fwd, dim3(grid), dim3(NTHREADS), LDS_BYTES, stream, a); }
    }
}
```
